# Optimizing an MI355X kernel written in HIP

```python
import math
import jax
import jax.numpy as jnp
from jax import lax
import numpy as np


D_MODEL = 1024
BATCH = 8
SEQ = 4096
DEPTH = 4

HEAD_DIM = 64
ROPE_THETA = 10000.0
NEG_INF = -1e30
BIG_SCORE = 1e30
LN_EPS = 1e-5
Q_BLOCK = 128

A_HEADS = 4
A_VDIM = 2 * HEAD_DIM
B_HEADS = 8
B_KV_HEADS = 2
IDX_HEADS = 4
IDX_DIM = 64
DSA_TOPK = 256
DSA_Q_CHUNK = 64
C_HEADS = 8
MOBA_BLOCK = 256
MOBA_TOPK = 3
MOBA_Q_CHUNK = 16
D_HEADS = 8
D_KV_HEADS = 2
NSA_CMP_LEN = 32
NSA_CMP_STRIDE = 16
NSA_SLC_BLOCK = 64
NSA_SLC_TOPK = 16
NSA_WINDOW = 512
NSA_PHI_HIDDEN = 256
NSA_Q_CHUNK = 32

F_DENSE = 2816
N_EXPERTS = 8
TOP_K = 2
F_EXPERT = 3584
MOE_BLOCK = 256

DN_ALPHA = (2 * DEPTH) ** 0.25
DN_BETA = (8 * DEPTH) ** -0.25
N_EVEN = (DEPTH + 1) // 2
N_ODD = DEPTH // 2

A_QK = A_HEADS * 2 * HEAD_DIM
A_V = A_HEADS * A_VDIM
B_Q = B_HEADS * HEAD_DIM
B_KV = B_KV_HEADS * HEAD_DIM
I_Q = IDX_HEADS * IDX_DIM
EVEN_SIZES = (A_QK, A_QK, A_V, B_Q, B_KV, B_KV, I_Q, IDX_DIM, IDX_HEADS)
P_EVEN = sum(EVEN_SIZES)
D_MIX_EVEN = A_V + B_Q
C_QKV = C_HEADS * HEAD_DIM
D_Q = D_HEADS * HEAD_DIM
D_KV = D_KV_HEADS * HEAD_DIM
ODD_SIZES = (C_QKV, C_QKV, C_QKV, D_Q) + (D_KV,) * 6 + (D_HEADS * 3,)
P_ODD = sum(ODD_SIZES)
D_MIX_ODD = C_QKV + D_Q

kernel_name = 'hybrid_diff_dsa_moba_nsa_moe'

F32 = jnp.float32


def split_cols(h, sizes):
    out, off = [], 0
    for s in sizes:
        out.append(h[..., off:off + s])
        off += s
    return out


def layer_norm(x, g, b):
    xf = x.astype(F32)
    mu = jnp.mean(xf, axis=-1, keepdims=True)
    var = jnp.mean(jnp.square(xf - mu), axis=-1, keepdims=True)
    return ((xf - mu) * lax.rsqrt(var + LN_EPS) * g.astype(F32) + b.astype(F32)).astype(x.dtype)


def rope(x, pos):
    d = x.shape[-1]
    inv = ROPE_THETA ** (-jnp.arange(0, d, 2, dtype=F32) / d)
    ang = pos.astype(F32)[:, None] * inv[None, :]
    cos = jnp.cos(ang)[None, :, None, :]
    sin = jnp.sin(ang)[None, :, None, :]
    xf = x.astype(F32)
    x1, x2 = xf[..., : d // 2], xf[..., d // 2:]
    return jnp.concatenate([x1 * cos - x2 * sin, x2 * cos + x1 * sin], axis=-1).astype(x.dtype)


def masked_softmax(s, mask):
    p = jax.nn.softmax(jnp.where(mask, s, NEG_INF), axis=-1)
    return jnp.where(mask, p, 0.0)


def map_query_chunks(fn, seq_len, chunk):
    starts = jnp.arange(seq_len // chunk, dtype=jnp.int32) * chunk
    out = lax.map(fn, starts)
    out = jnp.moveaxis(out, 0, 1)
    return out.reshape(out.shape[0], seq_len, *out.shape[3:])


def swiglu(x, wg, wu, wd):
    return (jax.nn.silu(x @ wg) * (x @ wu)) @ wd


def diff_attention(q, k, v, lam_params, subln_w, lam_init):
    B, S, Ha, _, dh = q.shape
    scale = dh ** -0.5
    lp = lam_params.astype(F32)
    lam = jnp.exp(jnp.sum(lp[0] * lp[1])) - jnp.exp(jnp.sum(lp[2] * lp[3])) + lam_init
    key_pos = jnp.arange(S)

    def block(c0):
        qb = lax.dynamic_slice_in_dim(q, c0, Q_BLOCK, axis=1)
        s = jnp.einsum('bqhjd,bshjd->bhjqs', qb, k, preferred_element_type=F32) * scale
        mask = key_pos[None, :] <= (c0 + jnp.arange(Q_BLOCK))[:, None]
        p = masked_softmax(s, mask)
        w = p[:, :, 0] - lam * p[:, :, 1]
        return jnp.einsum('bhqs,bshe->bqhe', w.astype(v.dtype), v)

    o = map_query_chunks(block, S, Q_BLOCK).astype(F32)
    o = o * lax.rsqrt(jnp.mean(o * o, axis=-1, keepdims=True) + LN_EPS)
    o = o * subln_w.astype(F32) * (1.0 - lam_init)
    return o.astype(v.dtype).reshape(B, S, Ha * v.shape[-1])


def dsa_attention(q, k, v, iq, ik, iw):
    B, S, H, dh = q.shape
    G = k.shape[2]
    R = H // G
    dt = q.dtype
    scale = dh ** -0.5
    q5 = q.reshape(B, S, G, R, dh)
    k_sel = min(DSA_TOPK, S // 4)
    key_pos = jnp.arange(S)
    bi = jnp.arange(B)[:, None, None]

    def chunk(c0):
        n = DSA_Q_CHUNK
        qc = lax.dynamic_slice_in_dim(q5, c0, n, axis=1)
        iqc = lax.dynamic_slice_in_dim(iq, c0, n, axis=1)
        iwc = lax.dynamic_slice_in_dim(iw, c0, n, axis=1)
        tq = c0 + jnp.arange(n)
        logits = jnp.einsum('bqhd,bsd->bqhs', iqc, ik, preferred_element_type=F32)
        score = jnp.einsum('bqh,bqhs->bqs', iwc.astype(F32), jax.nn.relu(logits))
        score = jnp.where(key_pos[None, None, :] <= tq[None, :, None], score, NEG_INF)
        _, idx = lax.top_k(score, k_sel)
        ok = idx <= tq[None, :, None]
        kg = k[bi, idx]
        vg = v[bi, idx]
        s = jnp.einsum('bqgrd,bqkgd->bgrqk', qc, kg, preferred_element_type=F32) * scale
        p = masked_softmax(s, ok[:, None, None]).astype(dt)
        return jnp.einsum('bgrqk,bqkgd->bqgrd', p, vg)

    o = map_query_chunks(chunk, S, DSA_Q_CHUNK)
    return o.reshape(B, S, H * dh)


def moba_attention(q, k, v):
    B, S, H, dh = q.shape
    dt = q.dtype
    scale = dh ** -0.5
    blk_len = MOBA_BLOCK
    nb = -(-S // blk_len)
    pad = nb * blk_len - S
    k_pad = jnp.pad(k, ((0, 0), (0, pad), (0, 0), (0, 0)))
    v_pad = jnp.pad(v, ((0, 0), (0, pad), (0, 0), (0, 0)))
    k_blk = k_pad.reshape(B, nb, blk_len, H, dh)
    k_mean = jnp.mean(k_blk.astype(F32), axis=2).astype(dt)
    k_bt = k_blk.transpose(0, 3, 1, 2, 4)
    v_bt = v_pad.reshape(B, nb, blk_len, H, dh).transpose(0, 3, 1, 2, 4)
    n_sel = max(1, min(MOBA_TOPK, nb - 1))
    bi = jnp.arange(B)[:, None, None, None]
    hi = jnp.arange(H)[None, :, None, None]
    blk_ids = jnp.arange(nb)
    own_off = jnp.arange(blk_len)
    n = MOBA_Q_CHUNK

    def chunk(c0):
        qc = lax.dynamic_slice_in_dim(q, c0, n, axis=1)
        tq = c0 + jnp.arange(n)
        blk = c0 // blk_len
        gate = jnp.einsum('bqhd,bnhd->bhqn', qc, k_mean, preferred_element_type=F32)
        gate = jnp.where(blk_ids < blk, gate, NEG_INF)
        _, idx = lax.top_k(gate, n_sel)
        sel_ok = idx < blk
        kg = k_bt[bi, hi, idx]
        vg = v_bt[bi, hi, idx]
        s_sel = jnp.einsum('bqhd,bhqmkd->bhqmk', qc, kg, preferred_element_type=F32) * scale
        own_k = lax.dynamic_slice_in_dim(k_pad, blk * blk_len, blk_len, axis=1)
        own_v = lax.dynamic_slice_in_dim(v_pad, blk * blk_len, blk_len, axis=1)
        s_own = jnp.einsum('bqhd,bkhd->bhqk', qc, own_k, preferred_element_type=F32) * scale
        own_ok = (blk * blk_len + own_off)[None, :] <= tq[:, None]
        s = jnp.concatenate([s_sel.reshape(B, H, n, n_sel * blk_len), s_own], axis=-1)
        mask = jnp.concatenate([
            jnp.broadcast_to(sel_ok[..., None], (B, H, n, n_sel, blk_len)).reshape(B, H, n, n_sel * blk_len),
            jnp.broadcast_to(own_ok, (B, H, n, blk_len))], axis=-1)
        p = masked_softmax(s, mask).astype(dt)
        p_sel = p[..., : n_sel * blk_len].reshape(B, H, n, n_sel, blk_len)
        p_own = p[..., n_sel * blk_len:]
        return (jnp.einsum('bhqmk,bhqmkd->bqhd', p_sel, vg)
                + jnp.einsum('bhqk,bkhd->bqhd', p_own, own_v))

    o = map_query_chunks(chunk, S, n)
    return o.reshape(B, S, H * dh)


def compress_blocks(blocks, pe, w1, w2):
    B, Nc, L, G, dh = blocks.shape
    h = blocks + pe[:, None, :].astype(blocks.dtype)
    h = jnp.moveaxis(h, 3, 2).reshape(B, Nc, G, L * dh)
    return jax.nn.gelu(h @ w1) @ w2


def nsa_attention(q, kc_tok, vc_tok, ks, vs, kw, vw, gates, pe, phi_w1, phi_w2, pos):
    B, S, H, dh = q.shape
    G = ks.shape[2]
    R = H // G
    dt = q.dtype
    scale = dh ** -0.5
    q_raw = q.reshape(B, S, G, R, dh)
    q_rot = rope(q, pos).reshape(B, S, G, R, dh)
    ks = rope(ks, pos)
    kw = rope(kw, pos)
    n_cmp = (S - NSA_CMP_LEN) // NSA_CMP_STRIDE + 1
    cmp_start = np.arange(n_cmp) * NSA_CMP_STRIDE
    tok_idx = cmp_start[:, None] + np.arange(NSA_CMP_LEN)[None, :]
    k_cmp = compress_blocks(kc_tok[:, tok_idx], pe[0], phi_w1[0], phi_w2[0])
    v_cmp = compress_blocks(vc_tok[:, tok_idx], pe[1], phi_w1[1], phi_w2[1])
    cmp_end = jnp.asarray(cmp_start + NSA_CMP_LEN - 1, dtype=jnp.int32)
    sb = NSA_SLC_BLOCK
    n_sb = S // sb
    sb_start = np.arange(n_sb) * sb
    shares = ((cmp_start[:, None] <= sb_start[None, :] + sb - 1)
              & (cmp_start[:, None] + NSA_CMP_LEN - 1 >= sb_start[None, :]))
    cmp_to_slc = jnp.asarray(shares, dtype=F32)
    n_sel = min(NSA_SLC_TOPK, n_sb)
    ks_blk = ks.reshape(B, n_sb, sb, G, dh).transpose(0, 3, 1, 2, 4)
    vs_blk = vs.reshape(B, n_sb, sb, G, dh).transpose(0, 3, 1, 2, 4)
    win = NSA_WINDOW
    kw_pad = jnp.pad(kw, ((0, 0), (win, 0), (0, 0), (0, 0)))
    vw_pad = jnp.pad(vw, ((0, 0), (win, 0), (0, 0), (0, 0)))
    bi = jnp.arange(B)[:, None, None, None]
    gi = jnp.arange(G)[None, :, None, None]
    sb_ids = jnp.arange(n_sb)
    sb_off = jnp.arange(sb)
    n = NSA_Q_CHUNK
    win_off = jnp.arange(win + n)

    def chunk(c0):
        tq = c0 + jnp.arange(n)
        qr = lax.dynamic_slice_in_dim(q_rot, c0, n, axis=1)
        qraw = lax.dynamic_slice_in_dim(q_raw, c0, n, axis=1)
        g = lax.dynamic_slice_in_dim(gates, c0, n, axis=1)
        s_c = jnp.einsum('bqgrd,bngd->bgrqn', qraw, k_cmp, preferred_element_type=F32) * scale
        p_c = masked_softmax(s_c, cmp_end[None, :] <= tq[:, None])
        o_cmp = jnp.einsum('bgrqn,bngd->bqgrd', p_c.astype(dt), v_cmp)
        imp = jnp.einsum('bgrqn,nj->bgqj', p_c, cmp_to_slc)
        cur = (tq // sb)[:, None]
        causal = sb_ids[None, :] <= cur
        forced = (sb_ids[None, :] == 0) | ((sb_ids[None, :] >= cur - 1) & causal)
        imp = jnp.where(forced, BIG_SCORE, jnp.where(causal, imp, NEG_INF))
        _, idx = lax.top_k(imp, n_sel)
        kg = ks_blk[bi, gi, idx].reshape(B, G, n, n_sel * sb, dh)
        vg = vs_blk[bi, gi, idx].reshape(B, G, n, n_sel * sb, dh)
        key_pos = (idx[..., None] * sb + sb_off).reshape(B, G, n, n_sel * sb)
        s_s = jnp.einsum('bqgrd,bgqmd->bgrqm', qr, kg, preferred_element_type=F32) * scale
        p_s = masked_softmax(s_s, (key_pos <= tq[None, None, :, None])[:, :, None]).astype(dt)
        o_slc = jnp.einsum('bgrqm,bgqmd->bqgrd', p_s, vg)
        kwc = lax.dynamic_slice_in_dim(kw_pad, c0, win + n, axis=1)
        vwc = lax.dynamic_slice_in_dim(vw_pad, c0, win + n, axis=1)
        kpos = c0 - win + win_off
        dist = tq[:, None] - kpos[None, :]
        s_w = jnp.einsum('bqgrd,bkgd->bgrqk', qr, kwc, preferred_element_type=F32) * scale
        p_w = masked_softmax(s_w, (dist >= 0) & (dist < win) & (kpos[None, :] >= 0)).astype(dt)
        o_win = jnp.einsum('bgrqk,bkgd->bqgrd', p_w, vwc)
        return g[..., 0:1] * o_cmp + g[..., 1:2] * o_slc + g[..., 2:3] * o_win

    o = map_query_chunks(chunk, S, n)
    return o.reshape(B, S, H * dh)


def even_mixer(x, w_in, w_out, lam_params, subln_w, lam_init, pos):
    B, S, _ = x.shape
    aq, ak, av, bq, bk, bv, iq, ik, iw = split_cols(x @ w_in, EVEN_SIZES)
    aq = rope(aq.reshape(B, S, 2 * A_HEADS, HEAD_DIM), pos).reshape(B, S, A_HEADS, 2, HEAD_DIM)
    ak = rope(ak.reshape(B, S, 2 * A_HEADS, HEAD_DIM), pos).reshape(B, S, A_HEADS, 2, HEAD_DIM)
    o_a = diff_attention(aq, ak, av.reshape(B, S, A_HEADS, A_VDIM), lam_params, subln_w, lam_init)
    bq = rope(bq.reshape(B, S, B_HEADS, HEAD_DIM), pos)
    bk = rope(bk.reshape(B, S, B_KV_HEADS, HEAD_DIM), pos)
    bv = bv.reshape(B, S, B_KV_HEADS, HEAD_DIM)
    iq = rope(iq.reshape(B, S, IDX_HEADS, IDX_DIM), pos)
    ik = rope(ik[:, :, None, :], pos)[:, :, 0]
    o_b = dsa_attention(bq, bk, bv, iq, ik, iw)
    return jnp.concatenate([o_a, o_b], axis=-1) @ w_out


def odd_mixer(x, w_in, w_out, gate_b, pe, phi_w1, phi_w2, pos):
    B, S, _ = x.shape
    cq, ck, cv, dq, dkc, dvc, dks, dvs, dkw, dvw, dg = split_cols(x @ w_in, ODD_SIZES)
    hs = (B, S, C_HEADS, HEAD_DIM)
    o_c = moba_attention(rope(cq.reshape(hs), pos), rope(ck.reshape(hs), pos), cv.reshape(hs))
    kv = (B, S, D_KV_HEADS, HEAD_DIM)
    gates = jax.nn.sigmoid(dg.astype(F32) + gate_b.astype(F32)).astype(x.dtype)
    gates = gates.reshape(B, S, D_KV_HEADS, D_HEADS // D_KV_HEADS, 3)
    o_d = nsa_attention(dq.reshape(B, S, D_HEADS, HEAD_DIM), dkc.reshape(kv), dvc.reshape(kv),
                        dks.reshape(kv), dvs.reshape(kv), dkw.reshape(kv), dvw.reshape(kv),
                        gates, pe, phi_w1, phi_w2, pos)
    return jnp.concatenate([o_c, o_d], axis=-1) @ w_out


def moe_swiglu(x, w_router, b_router, w_gate, w_up, w_down):
    B, S, D = x.shape
    xt = x.reshape(-1, D)
    N = xt.shape[0]
    logits = jnp.dot(xt, w_router, preferred_element_type=F32) + b_router.astype(F32)
    top_logit, top_e = lax.top_k(logits, TOP_K)
    gate = jax.nn.softmax(top_logit, axis=-1)
    nk = N * TOP_K
    e_flat = top_e.reshape(-1)
    tok_flat = jnp.repeat(jnp.arange(N, dtype=jnp.int32), TOP_K)
    g_flat = gate.reshape(-1)
    order = jnp.argsort(e_flat)
    e_sorted = e_flat[order]
    counts = jnp.bincount(e_flat, length=N_EXPERTS)
    padded = (counts + MOE_BLOCK - 1) // MOE_BLOCK * MOE_BLOCK
    pad_end = jnp.cumsum(padded)
    pad_start = pad_end - padded
    grp_start = jnp.cumsum(counts) - counts
    slot = pad_start[e_sorted] + jnp.arange(nk) - grp_start[e_sorted]
    n_blocks = -(-nk // MOE_BLOCK) + N_EXPERTS
    n_slots = n_blocks * MOE_BLOCK
    slot_tok = jnp.full((n_slots,), N, jnp.int32).at[slot].set(tok_flat[order])
    slot_gate = jnp.zeros((n_slots,), F32).at[slot].set(g_flat[order])
    block_e = jnp.minimum(jnp.searchsorted(pad_end, jnp.arange(n_blocks) * MOE_BLOCK, side='right'),
                          N_EXPERTS - 1)
    x_pad = jnp.concatenate([xt, jnp.zeros((1, D), xt.dtype)], axis=0)

    def expert_block(args):
        toks, e = args
        h = x_pad[toks]
        return (jax.nn.silu(h @ w_gate[e]) * (h @ w_up[e])) @ w_down[e]

    y_slots = lax.map(expert_block, (slot_tok.reshape(n_blocks, MOE_BLOCK), block_e))
    y_slots = y_slots.reshape(n_slots, D).astype(F32) * slot_gate[:, None]
    y = jnp.zeros((N + 1, D), F32).at[slot_tok].add(y_slots)[:N]
    return y.astype(x.dtype).reshape(B, S, D)


def setup_inputs(seed: int = 0) -> dict:
    key = jax.random.key(seed)
    keys = iter(jax.random.split(key, 32))

    def nrm(shape, scale):
        return jax.random.normal(next(keys), shape, F32) * scale

    d = D_MODEL
    return {
        'x': nrm((BATCH, SEQ, d), 1.0),
        'ev_w_in': nrm((N_EVEN, d, P_EVEN), d ** -0.5),
        'ev_w_out': nrm((N_EVEN, D_MIX_EVEN, d), D_MIX_EVEN ** -0.5 * DN_BETA),
        'dif_lambda': nrm((N_EVEN, 4, HEAD_DIM), 0.1),
        'dif_subln': 1.0 + nrm((N_EVEN, A_VDIM), 0.05),
        'ffd_w_gate': nrm((N_EVEN, d, F_DENSE), d ** -0.5),
        'ffd_w_up': nrm((N_EVEN, d, F_DENSE), d ** -0.5),
        'ffd_w_down': nrm((N_EVEN, F_DENSE, d), F_DENSE ** -0.5 * DN_BETA),
        'od_w_in': nrm((N_ODD, d, P_ODD), d ** -0.5),
        'od_w_out': nrm((N_ODD, D_MIX_ODD, d), D_MIX_ODD ** -0.5 * DN_BETA),
        'nsa_gate_b': nrm((N_ODD, D_HEADS * 3), 0.01),
        'nsa_pe': nrm((N_ODD, 2, NSA_CMP_LEN, HEAD_DIM), 0.1),
        'nsa_phi_w1': nrm((N_ODD, 2, NSA_CMP_LEN * HEAD_DIM, NSA_PHI_HIDDEN), (NSA_CMP_LEN * HEAD_DIM) ** -0.5),
        'nsa_phi_w2': nrm((N_ODD, 2, NSA_PHI_HIDDEN, HEAD_DIM), NSA_PHI_HIDDEN ** -0.5),
        'moe_w_router': nrm((N_ODD, d, N_EXPERTS), d ** -0.5),
        'moe_b_router': nrm((N_ODD, N_EXPERTS), 0.01),
        'moe_w_gate': nrm((N_ODD, N_EXPERTS, d, F_EXPERT), d ** -0.5),
        'moe_w_up': nrm((N_ODD, N_EXPERTS, d, F_EXPERT), d ** -0.5),
        'moe_w_down': nrm((N_ODD, N_EXPERTS, F_EXPERT, d), F_EXPERT ** -0.5 * DN_BETA),
        'ln_mix_g': 1.0 + nrm((DEPTH, d), 0.05),
        'ln_mix_b': nrm((DEPTH, d), 0.02),
        'ln_ffn_g': 1.0 + nrm((DEPTH, d), 0.05),
        'ln_ffn_b': nrm((DEPTH, d), 0.02),
    }


def reference(x, ev_w_in, ev_w_out, dif_lambda, dif_subln, ffd_w_gate, ffd_w_up, ffd_w_down,
              od_w_in, od_w_out, nsa_gate_b, nsa_pe, nsa_phi_w1, nsa_phi_w2,
              moe_w_router, moe_b_router, moe_w_gate, moe_w_up, moe_w_down,
              ln_mix_g, ln_mix_b, ln_ffn_g, ln_ffn_b):
    pos = jnp.arange(x.shape[1], dtype=jnp.int32)
    for l in range(DEPTH):
        i = l // 2
        if l % 2 == 0:
            lam_init = 0.8 - 0.6 * math.exp(-0.3 * l)
            mix = even_mixer(x, ev_w_in[i], ev_w_out[i], dif_lambda[i], dif_subln[i], lam_init, pos)
        else:
            mix = odd_mixer(x, od_w_in[i], od_w_out[i], nsa_gate_b[i], nsa_pe[i],
                            nsa_phi_w1[i], nsa_phi_w2[i], pos)
        x = layer_norm(DN_ALPHA * x + mix, ln_mix_g[l], ln_mix_b[l])
        if l % 2 == 0:
            ffn = swiglu(x, ffd_w_gate[i], ffd_w_up[i], ffd_w_down[i])
        else:
            ffn = moe_swiglu(x, moe_w_router[i], moe_b_router[i], moe_w_gate[i], moe_w_up[i], moe_w_down[i])
        x = layer_norm(DN_ALPHA * x + ffn, ln_ffn_g[l], ln_ffn_b[l])
    return x
```

```cpp
#include <hip/hip_runtime.h>
#include <stdint.h>
#include <string.h>
#include <math.h>

typedef float f32x16 __attribute__((ext_vector_type(16)));

#define NT 512
constexpr int NTOK = 32768, DM = 1024, SEQ = 4096;
constexpr int LDP = 2840;
constexpr float ALPHA = 1.681792830507429f;
constexpr float LN_EPS = 1e-5f;
constexpr int E_AQ = 0, E_AK = 512, E_AV = 1024, E_BQ = 1536, E_BK = 2048, E_BV = 2176, E_IQ = 2304, E_IK = 2560, E_IW = 2624, P_EVEN = 2628;
constexpr int O_CQ = 0, O_CK = 512, O_CV = 1024, O_DQ = 1536, O_KC = 2048, O_VC = 2176, O_KS = 2304, O_VS = 2432, O_KW = 2560, O_VW = 2688, O_DG = 2816, P_ODD = 2840;
constexpr int F_DENSE = 2816, F_EXPERT = 3584, N_EXP = 8;
constexpr int NSLOT = 65536 + 8 * 256;
constexpr int NTILE256 = NSLOT / 256;
constexpr int MOE_CHUNK = 8192;
constexpr int N_MOE_CHUNK = (NSLOT + MOE_CHUNK - 1) / MOE_CHUNK;
constexpr int LDS_BYTES = 147456;

__constant__ float c_inv[32] = {1.0f, 0.7498942613601685f, 0.5623413324356079f, 0.4216965138912201f, 0.3162277638912201f, 0.23713737726211548f, 0.17782793939113617f, 0.133352130651474f,
    0.10000000149011612f, 0.07498941570520401f, 0.05623413249850273f, 0.04216965287923813f, 0.03162277489900589f, 0.023713737726211548f, 0.017782794311642647f, 0.01333521492779255f,
    0.009999999776482582f, 0.007498941849917173f, 0.005623413249850273f, 0.0042169648222625256f, 0.003162277629598975f, 0.00237137358635664f, 0.0017782794311642647f, 0.0013335214462131262f,
    0.0010000000474974513f, 0.0007498942431993783f, 0.000562341301701963f, 0.0004216965171508491f, 0.0003162277571391314f, 0.00023713737027719617f, 0.00017782794020604342f, 0.0001333521504420787f};

struct Params {
    const float* in[23];
    float* X;
    float* P;
    float* O;
    float* Y;
    float* QR;
    float* ropecs;
    float* kmean;
    float* cmpk;
    float* cmpv;
    int* tok_e;
    float* tok_g;
    int* tok_slot;
    int* slot_tok;
    float* slot_gate;
    int* chunk_cnt;
    int* tile_e;
    unsigned* bar;
    float lam_init[2];
    int pad[2];
};

enum { IN_X = 0, IN_EV_WIN, IN_EV_WOUT, IN_DIF_LAMBDA, IN_DIF_SUBLN, IN_FFD_WG, IN_FFD_WU, IN_FFD_WD, IN_OD_WIN, IN_OD_WOUT, IN_NSA_GATE_B, IN_NSA_PE, IN_NSA_W1, IN_NSA_W2,
       IN_MOE_WR, IN_MOE_BR, IN_MOE_WG, IN_MOE_WU, IN_MOE_WD, IN_LN_MIX_G, IN_LN_MIX_B, IN_LN_FFN_G, IN_LN_FFN_B };

__device__ __forceinline__ float wave_max(float v) {
#pragma unroll
    for (int o = 32; o >= 1; o >>= 1) v = fmaxf(v, __shfl_xor(v, o));
    return v;
}
__device__ __forceinline__ float wave_sum(float v) {
#pragma unroll
    for (int o = 32; o >= 1; o >>= 1) v += __shfl_xor(v, o);
    return v;
}
__device__ __forceinline__ int wave_sumi(int v) {
#pragma unroll
    for (int o = 32; o >= 1; o >>= 1) v += __shfl_xor(v, o);
    return v;
}
__device__ __forceinline__ float rl_f(float v, int l) { return __builtin_bit_cast(float, __builtin_amdgcn_readlane(__builtin_bit_cast(int, v), l)); }
__device__ __forceinline__ const float* rl_p(const float* p, int l) {
    unsigned long long u = (unsigned long long)p;
    unsigned lo = (unsigned)__builtin_amdgcn_readlane((int)(unsigned)u, l), hi = (unsigned)__builtin_amdgcn_readlane((int)(unsigned)(u >> 32), l);
    return (const float*)(((unsigned long long)hi << 32) | lo);
}
__device__ __forceinline__ int lane_rank(unsigned long long m) {
    return __builtin_amdgcn_mbcnt_hi((unsigned)(m >> 32), __builtin_amdgcn_mbcnt_lo((unsigned)m, 0));
}
__device__ __forceinline__ float dot64(const float* __restrict__ a, const float* __restrict__ q) {
    float acc = 0.f;
#pragma unroll
    for (int d = 0; d < 64; d += 4) {
        const float4 kv = *(const float4*)(a + d); const float4 qv = *(const float4*)(q + d);
        acc += kv.x * qv.x; acc += kv.y * qv.y; acc += kv.z * qv.z; acc += kv.w * qv.w;
    }
    return acc;
}

template <int VD> struct ASt { float m, l; float o[VD / 64]; };
template <int VD> __device__ __forceinline__ void ast_init(ASt<VD>& s) { s.m = -INFINITY; s.l = 0.f;
#pragma unroll
    for (int c = 0; c < VD / 64; ++c) s.o[c] = 0.f; }
template <int VD>
__device__ __forceinline__ void attn_tile(ASt<VD>& st, const float* q, const float* kp, const float* vp, bool valid, int lane) {
    const float acc = dot64(kp, q);
    const float s = valid ? acc : -INFINITY;
    const float tmax = wave_max(s);
    if (tmax == -INFINITY) return;
    const float mn = fmaxf(st.m, tmax);
    const float alpha = expf(st.m - mn);
    const float p = valid ? expf(s - mn) : 0.f;
    st.l = st.l * alpha + wave_sum(p);
    st.m = mn;
#pragma unroll
    for (int c = 0; c < VD / 64; ++c) st.o[c] *= alpha;
#pragma unroll 8
    for (int j = 0; j < 64; ++j) {
        const float pj = rl_f(p, j);
        const float* vj = rl_p(vp, j);
#pragma unroll
        for (int c = 0; c < VD / 64; ++c) st.o[c] += pj * vj[lane + 64 * c];
    }
}

struct GemmArgs {
    const float* A; int lda; const int* rowidx;
    const float* B; const float* B2; int ldb;
    const int* tile_e; size_t estride; int tile_e_row0;
    int M, N, K;
};
template <bool DUAL, class Epi>
__device__ __forceinline__ void gemm_f32(const GemmArgs& g, float* lds, Epi epi) {
    float* As = lds;
    float* Bs = lds + 128 * 17;
    float* Bs2 = Bs + 16 * 128;
    const int tid = threadIdx.x, lane = tid & 63, wid = tid >> 6, wr = wid >> 2, wc = wid & 3;
    const int ntm = (g.M + 127) / 128, ntn = (g.N + 127) / 128, ntile = ntm * ntn;
    for (int tile = blockIdx.x; tile < ntile; tile += gridDim.x) {
        const int tm = tile / ntn, tn = tile % ntn, m0 = tm * 128, n0 = tn * 128;
        const float* Bp = g.B; const float* Bp2 = g.B2;
        if (g.tile_e) { const int e = g.tile_e[(g.tile_e_row0 + m0) >> 8]; if (e < 0) continue; Bp += (size_t)e * g.estride; if (DUAL) Bp2 += (size_t)e * g.estride; }
        f32x16 acc[2], acc2[2];
#pragma unroll
        for (int s = 0; s < 2; ++s)
#pragma unroll
            for (int r = 0; r < 16; ++r) { acc[s][r] = 0.f; acc2[s][r] = 0.f; }
        const int ar = tid >> 2, akq = (tid & 3) * 4;
        int arow = m0 + ar; bool aok = arow < g.M;
        if (aok && g.rowidx) { arow = g.rowidx[arow]; aok = arow >= 0; }
        const float* ap = g.A + (size_t)(aok ? arow : 0) * g.lda + akq;
        const int bkr = tid >> 5, bc4 = (tid & 31) * 4;
        const bool bok = (n0 + bc4) < g.N;
        const float* bp = Bp + (size_t)bkr * g.ldb + n0 + (bok ? bc4 : 0);
        const float* bp2 = DUAL ? (Bp2 + (size_t)bkr * g.ldb + n0 + (bok ? bc4 : 0)) : bp;
        const float am = aok ? 1.f : 0.f, bm = bok ? 1.f : 0.f;
        float4 ra, rb, rb2;
        ra = *(const float4*)ap;
        rb = *(const float4*)bp;
        rb2 = *(const float4*)bp2;
        for (int k0 = 0; k0 < g.K; k0 += 16) {
            __syncthreads();
            As[ar * 17 + akq + 0] = ra.x * am; As[ar * 17 + akq + 1] = ra.y * am; As[ar * 17 + akq + 2] = ra.z * am; As[ar * 17 + akq + 3] = ra.w * am;
            rb.x *= bm; rb.y *= bm; rb.z *= bm; rb.w *= bm;
            *(float4*)(Bs + bkr * 128 + bc4) = rb;
            if (DUAL) { rb2.x *= bm; rb2.y *= bm; rb2.z *= bm; rb2.w *= bm; *(float4*)(Bs2 + bkr * 128 + bc4) = rb2; }
            __syncthreads();
            if (k0 + 16 < g.K) {
                ra = *(const float4*)(ap + k0 + 16);
                rb = *(const float4*)(bp + (size_t)(k0 + 16) * g.ldb);
                if (DUAL) rb2 = *(const float4*)(bp2 + (size_t)(k0 + 16) * g.ldb);
            }
#pragma unroll
            for (int kk = 0; kk < 16; kk += 2) {
                const float a0 = As[(wr * 64 + (lane & 31)) * 17 + kk + (lane >> 5)];
                const float a1 = As[(wr * 64 + 32 + (lane & 31)) * 17 + kk + (lane >> 5)];
                const float b = Bs[(kk + (lane >> 5)) * 128 + wc * 32 + (lane & 31)];
                acc[0] = __builtin_amdgcn_mfma_f32_32x32x2f32(a0, b, acc[0], 0, 0, 0);
                acc[1] = __builtin_amdgcn_mfma_f32_32x32x2f32(a1, b, acc[1], 0, 0, 0);
                if (DUAL) {
                    const float b2 = Bs2[(kk + (lane >> 5)) * 128 + wc * 32 + (lane & 31)];
                    acc2[0] = __builtin_amdgcn_mfma_f32_32x32x2f32(a0, b2, acc2[0], 0, 0, 0);
                    acc2[1] = __builtin_amdgcn_mfma_f32_32x32x2f32(a1, b2, acc2[1], 0, 0, 0);
                }
            }
        }
        const int col = n0 + wc * 32 + (lane & 31);
        if (col < g.N) {
#pragma unroll
            for (int s = 0; s < 2; ++s)
#pragma unroll
                for (int r = 0; r < 16; ++r) {
                    const int row = m0 + wr * 64 + s * 32 + (r & 3) + 8 * (r >> 2) + 4 * (lane >> 5);
                    if (row < g.M) epi(row, col, acc[s][r], acc2[s][r]);
                }
        }
    }
}

__device__ __forceinline__ void sincos_d(double a, double& s, double& c) {
    const double n = rint(a * 0.6366197723675814);
    double y = fma(-n, 1.5707963267948966, a); y = fma(-n, 6.123233995736766e-17, y);
    const int q = ((int)n) & 3;
    const double y2 = y * y;
    const double sp = y * (1.0 + y2 * (-1.0 / 6 + y2 * (1.0 / 120 + y2 * (-1.0 / 5040 + y2 * (1.0 / 362880 + y2 * (-1.0 / 39916800 + y2 * (1.0 / 6227020800.0)))))));
    const double cp = 1.0 + y2 * (-0.5 + y2 * (1.0 / 24 + y2 * (-1.0 / 720 + y2 * (1.0 / 40320 + y2 * (-1.0 / 3628800 + y2 * (1.0 / 479001600.0 + y2 * (-1.0 / 87178291200.0)))))));
    s = (q == 0) ? sp : (q == 1) ? cp : (q == 2) ? -sp : -cp;
    c = (q == 0) ? cp : (q == 1) ? -sp : (q == 2) ? -cp : sp;
}

__device__ void ph_init(const Params& p) {
    const int gid = blockIdx.x * NT + threadIdx.x, gs = gridDim.x * NT;
    for (int i = gid; i < 4096 * 32; i += gs) {
        const int pos = i >> 5, f = i & 31;
        const float angf = (float)pos * c_inv[f];
        double s, c; sincos_d((double)angf, s, c);
        p.ropecs[2 * i] = (float)c; p.ropecs[2 * i + 1] = (float)s;
    }
    const float4* xs = (const float4*)p.in[IN_X]; float4* xd = (float4*)p.X;
    for (int i = gid; i < NTOK * DM / 4; i += gs) xd[i] = xs[i];
}

__device__ void ph_rope_even(const Params& p) {
    const long total = (long)NTOK * 992;
    for (long idx = (long)blockIdx.x * NT + threadIdx.x; idx < total; idx += (long)gridDim.x * NT) {
        const int t = (int)(idx / 992), r = (int)(idx % 992), hs = r >> 5, i = r & 31;
        int cb;
        if (hs < 16) cb = hs * 64; else if (hs < 24) cb = E_BQ + (hs - 16) * 64; else if (hs < 26) cb = E_BK + (hs - 24) * 64; else if (hs < 30) cb = E_IQ + (hs - 26) * 64; else cb = E_IK;
        const int pos = t & (SEQ - 1);
        const float c = p.ropecs[(pos * 32 + i) * 2], s = p.ropecs[(pos * 32 + i) * 2 + 1];
        float* row = p.P + (size_t)t * LDP + cb;
        const float x1 = row[i], x2 = row[i + 32];
        row[i] = x1 * c - x2 * s; row[i + 32] = x2 * c + x1 * s;
    }
}
__device__ void ph_rope_odd(const Params& p, int li) {
    const long total = (long)NTOK * 896;
    const float* gb = p.in[IN_NSA_GATE_B] + li * 24;
    for (long idx = (long)blockIdx.x * NT + threadIdx.x; idx < total; idx += (long)gridDim.x * NT) {
        const int t = (int)(idx / 896), r = (int)(idx % 896), hs = r >> 5, i = r & 31;
        const int pos = t & (SEQ - 1);
        const float c = p.ropecs[(pos * 32 + i) * 2], s = p.ropecs[(pos * 32 + i) * 2 + 1];
        if (hs < 20) {
            int cb;
            if (hs < 16) cb = hs * 64; else if (hs < 18) cb = O_KS + (hs - 16) * 64; else cb = O_KW + (hs - 18) * 64;
            float* row = p.P + (size_t)t * LDP + cb;
            const float x1 = row[i], x2 = row[i + 32];
            row[i] = x1 * c - x2 * s; row[i + 32] = x2 * c + x1 * s;
        } else {
            const float* row = p.P + (size_t)t * LDP + O_DQ + (hs - 20) * 64;
            float* dst = p.QR + (size_t)t * 512 + (hs - 20) * 64;
            const float x1 = row[i], x2 = row[i + 32];
            dst[i] = x1 * c - x2 * s; dst[i + 32] = x2 * c + x1 * s;
        }
    }
    for (long idx = (long)blockIdx.x * NT + threadIdx.x; idx < (long)NTOK * 24; idx += (long)gridDim.x * NT) {
        const int t = (int)(idx / 24), j = (int)(idx % 24);
        float* q = p.P + (size_t)t * LDP + O_DG + j;
        const float v = *q + gb[j];
        *q = 1.f / (1.f + expf(-v));
    }
}

__device__ void ph_diff(const Params& p, int li, float* lds) {
    const int lane = threadIdx.x & 63, wid = threadIdx.x >> 6;
    float* lq = lds + wid * 128;
    const float* lp = p.in[IN_DIF_LAMBDA] + li * 256;
    float d01 = wave_sum(lp[lane] * lp[64 + lane]), d23 = wave_sum(lp[128 + lane] * lp[192 + lane]);
    const float lam_init = p.lam_init[li];
    const float lam = expf(d01) - expf(d23) + lam_init;
    const float* subln = p.in[IN_DIF_SUBLN] + li * 128;
    const float sw0 = subln[lane] * (1.f - lam_init), sw1 = subln[lane + 64] * (1.f - lam_init);
    const int nitem = NTOK * 4;
    for (int item = blockIdx.x * 8 + wid; item < nitem; item += gridDim.x * 8) {
        const int t = item & (SEQ - 1), bh = item >> 12, h = bh & 3, b = bh >> 2;
        const float* prow = p.P + (size_t)(b * SEQ + t) * LDP;
        lq[lane] = prow[E_AQ + (2 * h) * 64 + lane] * 0.125f;
        lq[64 + lane] = prow[E_AQ + (2 * h + 1) * 64 + lane] * 0.125f;
        float m0 = -INFINITY, l0 = 0.f, m1 = -INFINITY, l1 = 0.f, o00 = 0.f, o01 = 0.f, o10 = 0.f, o11 = 0.f;
        const int ntile = (t >> 6) + 1;
        for (int kt = 0; kt < ntile; ++kt) {
            const int key = kt * 64 + lane; const bool valid = key <= t;
            const float* krow = p.P + (size_t)(b * SEQ + key) * LDP;
            const float a0 = dot64(krow + E_AK + (2 * h) * 64, lq), a1 = dot64(krow + E_AK + (2 * h + 1) * 64, lq + 64);
            const float s0 = valid ? a0 : -INFINITY, s1 = valid ? a1 : -INFINITY;
            const float mn0 = fmaxf(m0, wave_max(s0)), mn1 = fmaxf(m1, wave_max(s1));
            const float al0 = expf(m0 - mn0), al1 = expf(m1 - mn1);
            const float p0 = valid ? expf(s0 - mn0) : 0.f, p1 = valid ? expf(s1 - mn1) : 0.f;
            l0 = l0 * al0 + wave_sum(p0); l1 = l1 * al1 + wave_sum(p1); m0 = mn0; m1 = mn1;
            o00 *= al0; o01 *= al0; o10 *= al1; o11 *= al1;
            const float* vb = p.P + (size_t)(b * SEQ + kt * 64) * LDP + E_AV + h * 128 + lane;
#pragma unroll 8
            for (int j = 0; j < 64; ++j) {
                const float pj0 = rl_f(p0, j), pj1 = rl_f(p1, j);
                const float v0 = vb[(size_t)j * LDP], v1 = vb[(size_t)j * LDP + 64];
                o00 += pj0 * v0; o01 += pj0 * v1; o10 += pj1 * v0; o11 += pj1 * v1;
            }
        }
        float r0 = o00 / l0 - lam * (o10 / l1), r1 = o01 / l0 - lam * (o11 / l1);
        const float ms = wave_sum(r0 * r0 + r1 * r1) * (1.f / 128.f);
        const float sc = 1.0f / sqrtf(ms + LN_EPS);
        float* orow = p.O + (size_t)(b * SEQ + t) * DM + h * 128;
        orow[lane] = r0 * sc * sw0; orow[lane + 64] = r1 * sc * sw1;
    }
}

__device__ void ph_dsa(const Params& p, float* lds) {
    const int lane = threadIdx.x & 63, wid = threadIdx.x >> 6;
    float* wl = lds + wid * 4608;
    unsigned* sc = (unsigned*)wl;
    float* lq = wl + 4096;
    int* list = (int*)(wl + 4096 + 256);
    for (int item = blockIdx.x * 8 + wid; item < NTOK; item += gridDim.x * 8) {
        const int t = item & (SEQ - 1), b = item >> 12;
        const float* prow = p.P + (size_t)item * LDP;
        int cnt;
        if (t < 256) {
            for (int i = lane; i <= t; i += 64) list[i] = i;
            cnt = t + 1;
        } else {
#pragma unroll
            for (int c = 0; c < 4; ++c) lq[c * 64 + lane] = prow[E_IQ + c * 64 + lane];
            const float iw0 = prow[E_IW], iw1 = prow[E_IW + 1], iw2 = prow[E_IW + 2], iw3 = prow[E_IW + 3];
            const int ntile = (t >> 6) + 1;
            for (int i = 0; i < ntile; ++i) {
                const int key = i * 64 + lane;
                const float* kr = p.P + (size_t)(b * SEQ + key) * LDP + E_IK;
                float d0 = 0.f, d1 = 0.f, d2 = 0.f, d3 = 0.f;
#pragma unroll
                for (int d = 0; d < 64; d += 4) {
                    const float4 kv = *(const float4*)(kr + d);
                    const float4 q0 = *(const float4*)(lq + d), q1 = *(const float4*)(lq + 64 + d), q2 = *(const float4*)(lq + 128 + d), q3 = *(const float4*)(lq + 192 + d);
                    d0 += kv.x * q0.x; d0 += kv.y * q0.y; d0 += kv.z * q0.z; d0 += kv.w * q0.w;
                    d1 += kv.x * q1.x; d1 += kv.y * q1.y; d1 += kv.z * q1.z; d1 += kv.w * q1.w;
                    d2 += kv.x * q2.x; d2 += kv.y * q2.y; d2 += kv.z * q2.z; d2 += kv.w * q2.w;
                    d3 += kv.x * q3.x; d3 += kv.y * q3.y; d3 += kv.z * q3.z; d3 += kv.w * q3.w;
                }
                float s = iw0 * fmaxf(d0, 0.f);
                s += iw1 * fmaxf(d1, 0.f); s += iw2 * fmaxf(d2, 0.f); s += iw3 * fmaxf(d3, 0.f);
                const unsigned u = __builtin_bit_cast(unsigned, s);
                const unsigned ks = (u & 0x80000000u) ? ~u : (u | 0x80000000u);
                sc[key] = (key <= t) ? ks : 0u;
            }
            unsigned kreg[64];
#pragma unroll
            for (int i = 0; i < 64; ++i) kreg[i] = (i < ntile) ? sc[i * 64 + lane] : 0u;
            unsigned T = 0u;
            for (int bit = 31; bit >= 0; --bit) {
                const unsigned cand = T | (1u << bit);
                int c = 0;
#pragma unroll
                for (int i = 0; i < 64; ++i) c += (kreg[i] >= cand) ? 1 : 0;
                c = wave_sumi(c);
                if (c >= 256) T = cand;
            }
            int cgt = 0;
#pragma unroll
            for (int i = 0; i < 64; ++i) cgt += (kreg[i] > T) ? 1 : 0;
            cgt = wave_sumi(cgt);
            const int need = 256 - cgt;
            int base = 0, taken = 0;
#pragma unroll
            for (int i = 0; i < 64; ++i) {
                const bool gt = kreg[i] > T, eq = kreg[i] == T;
                const unsigned long long meq = __ballot(eq);
                const bool sel = gt || (eq && (taken + lane_rank(meq) < need));
                const unsigned long long msel = __ballot(sel);
                if (sel) list[base + lane_rank(msel)] = i * 64 + lane;
                base += __popcll(msel); taken += __popcll(meq);
            }
            cnt = 256;
        }
        for (int h = 0; h < 8; ++h) {
            const int g = h >> 2;
            lq[lane] = prow[E_BQ + h * 64 + lane] * 0.125f;
            ASt<64> st; ast_init(st);
            for (int c = 0; c < 4; ++c) {
                const int idx = c * 64 + lane;
                if (c * 64 >= cnt) break;
                const bool valid = idx < cnt;
                const int key = valid ? list[idx] : 0;
                const float* kr = p.P + (size_t)(b * SEQ + key) * LDP;
                attn_tile<64>(st, lq, kr + E_BK + g * 64, kr + E_BV + g * 64, valid, lane);
            }
            p.O[(size_t)item * DM + 512 + h * 64 + lane] = st.o[0] / st.l;
        }
    }
}

__device__ void ph_kmean(const Params& p, float* lds) {
    const int tid = threadIdx.x, d = tid & 63, part = tid >> 6;
    for (int item = blockIdx.x; item < 8 * 16 * 8; item += gridDim.x) {
        const int h = item & 7, blk = (item >> 3) & 15, b = item >> 7;
        float s = 0.f;
        for (int k = part * 32; k < part * 32 + 32; ++k) s += p.P[(size_t)(b * SEQ + blk * 256 + k) * LDP + O_CK + h * 64 + d];
        __syncthreads();
        lds[part * 64 + d] = s;
        __syncthreads();
        if (part == 0) { float a = 0.f; for (int q = 0; q < 8; ++q) a += lds[q * 64 + d]; p.kmean[(size_t)item * 64 + d] = a * (1.f / 256.f); }
    }
}

__device__ void ph_moba(const Params& p, float* lds) {
    const int lane = threadIdx.x & 63, wid = threadIdx.x >> 6;
    float* lq = lds + wid * 64;
    const int nitem = NTOK * 8;
    for (int item = blockIdx.x * 8 + wid; item < nitem; item += gridDim.x * 8) {
        const int t = item & (SEQ - 1), bh = item >> 12, h = bh & 7, b = bh >> 3;
        const int blk = t >> 8;
        const float* prow = p.P + (size_t)(b * SEQ + t) * LDP;
        lq[lane] = prow[O_CQ + h * 64 + lane] * 0.125f;
        float gate = -INFINITY;
        if (lane < blk) gate = dot64(p.kmean + (size_t)((b * 16 + lane) * 8 + h) * 64, lq);
        int rank = 0;
        for (int n = 0; n < 16; ++n) { const float gn = rl_f(gate, n); rank += (gn > gate || (gn == gate && n < lane)) ? 1 : 0; }
        const bool sel = (lane < blk) && (rank < 3);
        unsigned long long mask = __ballot(sel);
        ASt<64> st; ast_init(st);
        while (mask) {
            const int n = __builtin_ctzll(mask); mask &= mask - 1;
            for (int c = 0; c < 4; ++c) {
                const int key = n * 256 + c * 64 + lane;
                const float* kr = p.P + (size_t)(b * SEQ + key) * LDP;
                attn_tile<64>(st, lq, kr + O_CK + h * 64, kr + O_CV + h * 64, true, lane);
            }
        }
        const int nown = ((t & 255) >> 6) + 1;
        for (int c = 0; c < nown; ++c) {
            const int key = blk * 256 + c * 64 + lane;
            const float* kr = p.P + (size_t)(b * SEQ + key) * LDP;
            attn_tile<64>(st, lq, kr + O_CK + h * 64, kr + O_CV + h * 64, key <= t, lane);
        }
        p.O[(size_t)(b * SEQ + t) * DM + h * 64 + lane] = st.o[0] / st.l;
    }
}

__device__ void ph_compress(const Params& p, int li, float* lds) {
    const int tid = threadIdx.x;
    float* hbuf = lds;
    float* part = lds + 2048;
    float* hid = lds + 2560;
    for (int item = blockIdx.x; item < 2 * 8 * 256 * 2; item += gridDim.x) {
        const int g = item & 1; int r = item >> 1; const int i = r & 255; r >>= 8; const int b = r & 7, which = r >> 3;
        if (i == 255) { if (tid < 64) { float* dst = (which ? p.cmpv : p.cmpk) + (size_t)((b * 256 + i) * 2 + g) * 64; dst[tid] = 0.f; } continue; }
        const float* pe = p.in[IN_NSA_PE] + (size_t)(li * 2 + which) * 2048;
        const float* w1 = p.in[IN_NSA_W1] + (size_t)(li * 2 + which) * 2048 * 256;
        const float* w2 = p.in[IN_NSA_W2] + (size_t)(li * 2 + which) * 256 * 64;
        const int col = (which ? O_VC : O_KC) + g * 64;
        __syncthreads();
        for (int e = tid; e < 2048; e += NT) { const int tt = e >> 6, d = e & 63; hbuf[e] = p.P[(size_t)(b * SEQ + 16 * i + tt) * LDP + col + d] + pe[e]; }
        __syncthreads();
        { const int n = tid & 255, half = tid >> 8; float a = 0.f;
          for (int k = half * 1024; k < half * 1024 + 1024; ++k) a += hbuf[k] * w1[(size_t)k * 256 + n];
          part[tid] = a; }
        __syncthreads();
        if (tid < 256) { const float x = part[tid] + part[tid + 256];
            const float u = 0.7978845608028654f * (x + 0.044715f * x * x * x);
            hid[tid] = 0.5f * x * (1.f + tanhf(u)); }
        __syncthreads();
        if (tid < 64) { float a = 0.f; for (int n = 0; n < 256; ++n) a += hid[n] * w2[n * 64 + tid];
            float* dst = (which ? p.cmpv : p.cmpk) + (size_t)((b * 256 + i) * 2 + g) * 64; dst[tid] = a; }
    }
}

__device__ void ph_nsa(const Params& p, float* lds) {
    const int lane = threadIdx.x & 63, wid = threadIdx.x >> 6;
    float* lq = lds + wid * 320;
    float* lpc = lq + 64;
    const int nitem = NTOK * 2;
    for (int item = blockIdx.x * 8 + wid; item < nitem; item += gridDim.x * 8) {
        const int t = item & (SEQ - 1), bg = item >> 12, g = bg & 1, b = bg >> 1;
        const int tok = b * SEQ + t;
        const float* prow = p.P + (size_t)tok * LDP;
        const int nv = (t >= 31) ? ((t - 31) >> 4) + 1 : 0;
        float ocmp[4]; float pcs[4] = {0.f, 0.f, 0.f, 0.f};
#pragma unroll
        for (int r = 0; r < 4; ++r) {
            const int h = g * 4 + r;
            lq[lane] = prow[O_DQ + h * 64 + lane] * 0.125f;
            float s[4]; float mx = -INFINITY;
#pragma unroll
            for (int c = 0; c < 4; ++c) {
                const int n = c * 64 + lane; const bool valid = n < nv;
                const float a = (c * 64 < nv) ? dot64(p.cmpk + (size_t)((b * 256 + (valid ? n : 0)) * 2 + g) * 64, lq) : 0.f;
                s[c] = valid ? a : -INFINITY; mx = fmaxf(mx, s[c]);
            }
            mx = wave_max(mx);
            float o = 0.f;
            if (nv > 0) {
                float pp[4]; float l = 0.f;
#pragma unroll
                for (int c = 0; c < 4; ++c) { pp[c] = (c * 64 + lane < nv) ? expf(s[c] - mx) : 0.f; l += pp[c]; }
                l = wave_sum(l);
#pragma unroll
                for (int c = 0; c < 4; ++c) { pp[c] = pp[c] / l; pcs[c] += pp[c]; }
#pragma unroll
                for (int c = 0; c < 4; ++c) {
                    if (c * 64 < nv) {
                        const float* vb = p.cmpv + (size_t)((b * 256 + c * 64) * 2 + g) * 64 + lane;
#pragma unroll 8
                        for (int j = 0; j < 64; ++j) { const float pj = rl_f(pp[c], j); o += pj * vb[(size_t)j * 128]; }
                    }
                }
            }
            ocmp[r] = o;
        }
#pragma unroll
        for (int c = 0; c < 4; ++c) lpc[c * 64 + lane] = pcs[c];
        float imp = 0.f;
        { const int lo = (4 * lane - 1 < 0) ? 0 : 4 * lane - 1, hi = (4 * lane + 3 > 254) ? 254 : 4 * lane + 3;
          for (int n = lo; n <= hi; ++n) imp += lpc[n]; }
        const int cur = t >> 6;
        const bool causal = lane <= cur, forced = (lane == 0) || (lane >= cur - 1 && causal);
        const float val = forced ? 1e30f : (causal ? imp : -1e30f);
        int rank = 0;
        for (int k = 0; k < 64; ++k) { const float vk = rl_f(val, k); rank += (vk > val || (vk == val && k < lane)) ? 1 : 0; }
        const unsigned long long selmask = __ballot(rank < 16);
#pragma unroll
        for (int r = 0; r < 4; ++r) {
            const int h = g * 4 + r;
            lq[lane] = p.QR[(size_t)tok * 512 + h * 64 + lane] * 0.125f;
            ASt<64> ss; ast_init(ss);
            unsigned long long mask = selmask;
            while (mask) {
                const int jb = __builtin_ctzll(mask); mask &= mask - 1;
                if (jb > cur) break;
                const int key = jb * 64 + lane;
                const float* kr = p.P + (size_t)(b * SEQ + key) * LDP;
                attn_tile<64>(ss, lq, kr + O_KS + g * 64, kr + O_VS + g * 64, key <= t, lane);
            }
            ASt<64> sw; ast_init(sw);
            for (int c = 0; c < 8; ++c) {
                const int key = t - 511 + c * 64 + lane;
                if (t - 511 + c * 64 + 63 < 0) continue;
                const float* kr = p.P + (size_t)(b * SEQ + (key < 0 ? 0 : key)) * LDP;
                attn_tile<64>(sw, lq, kr + O_KW + g * 64, kr + O_VW + g * 64, key >= 0, lane);
            }
            const float g0 = prow[O_DG + h * 3], g1 = prow[O_DG + h * 3 + 1], g2 = prow[O_DG + h * 3 + 2];
            p.O[(size_t)tok * DM + 512 + h * 64 + lane] = g0 * ocmp[r] + g1 * (ss.o[0] / ss.l) + g2 * (sw.o[0] / sw.l);
        }
    }
}

template <int MODE>
__device__ void ph_ln(const Params& p, const float* gam, const float* bet) {
    const int lane = threadIdx.x & 63, wid = threadIdx.x >> 6;
    for (int t = blockIdx.x * 8 + wid; t < NTOK; t += gridDim.x * 8) {
        float4* xr = (float4*)(p.X + (size_t)t * DM);
        const float4* y0; const float4* y1 = nullptr;
        if (MODE == 0) y0 = (const float4*)(p.Y + (size_t)t * DM);
        else { y0 = (const float4*)(p.Y + (size_t)p.tok_slot[2 * t] * DM); y1 = (const float4*)(p.Y + (size_t)p.tok_slot[2 * t + 1] * DM); }
        float4 v[4]; float s = 0.f;
#pragma unroll
        for (int c = 0; c < 4; ++c) {
            const float4 x = xr[c * 64 + lane]; float4 y = y0[c * 64 + lane];
            if (MODE == 1) { const float4 z = y1[c * 64 + lane]; y.x += z.x; y.y += z.y; y.z += z.z; y.w += z.w; }
            v[c].x = ALPHA * x.x + y.x; v[c].y = ALPHA * x.y + y.y; v[c].z = ALPHA * x.z + y.z; v[c].w = ALPHA * x.w + y.w;
            s += (v[c].x + v[c].y) + (v[c].z + v[c].w);
        }
        const float mu = wave_sum(s) * (1.f / 1024.f);
        float q = 0.f;
#pragma unroll
        for (int c = 0; c < 4; ++c) { const float a = v[c].x - mu, b2 = v[c].y - mu, c2 = v[c].z - mu, d2 = v[c].w - mu; q += (a * a + b2 * b2) + (c2 * c2 + d2 * d2); }
        const float var = wave_sum(q) * (1.f / 1024.f);
        const float rs = 1.0f / sqrtf(var + LN_EPS);
#pragma unroll
        for (int c = 0; c < 4; ++c) {
            const float4 gg = ((const float4*)gam)[c * 64 + lane], bb = ((const float4*)bet)[c * 64 + lane];
            float4 o; o.x = (v[c].x - mu) * rs * gg.x + bb.x; o.y = (v[c].y - mu) * rs * gg.y + bb.y; o.z = (v[c].z - mu) * rs * gg.z + bb.z; o.w = (v[c].w - mu) * rs * gg.w + bb.w;
            xr[c * 64 + lane] = o;
        }
    }
}

__device__ void ph_router(const Params& p, int li, float* lds) {
    const int tid = threadIdx.x, lane = tid & 63, wid = tid >> 6;
    int* lcnt = (int*)lds;
    const float* wr = p.in[IN_MOE_WR] + (size_t)li * 1024 * 8;
    const float* br = p.in[IN_MOE_BR] + li * 8;
    for (int i = blockIdx.x * NT + tid; i < NSLOT; i += gridDim.x * NT) p.slot_tok[i] = -1;
    for (int chunk = blockIdx.x; chunk < 256; chunk += gridDim.x) {
        __syncthreads();
        if (tid < 8) lcnt[tid] = 0;
        __syncthreads();
        for (int q = 0; q < 16; ++q) {
            const int t = chunk * 128 + wid * 16 + q;
            const float* xr = p.X + (size_t)t * DM;
            float a[8] = {0.f, 0.f, 0.f, 0.f, 0.f, 0.f, 0.f, 0.f};
            for (int c = 0; c < 16; ++c) {
                const int k = c * 64 + lane; const float x = xr[k];
                const float4 w0 = *(const float4*)(wr + k * 8), w1 = *(const float4*)(wr + k * 8 + 4);
                a[0] += x * w0.x; a[1] += x * w0.y; a[2] += x * w0.z; a[3] += x * w0.w; a[4] += x * w1.x; a[5] += x * w1.y; a[6] += x * w1.z; a[7] += x * w1.w;
            }
#pragma unroll
            for (int e = 0; e < 8; ++e) a[e] = wave_sum(a[e]) + br[e];
            int e1 = 0; float l1 = a[0];
#pragma unroll
            for (int e = 1; e < 8; ++e) if (a[e] > l1) { l1 = a[e]; e1 = e; }
            int e2 = -1; float l2 = -INFINITY;
#pragma unroll
            for (int e = 0; e < 8; ++e) if (e != e1 && a[e] > l2) { l2 = a[e]; e2 = e; }
            const float ex = expf(l2 - l1);
            if (lane == 0) {
                p.tok_e[2 * t] = e1; p.tok_e[2 * t + 1] = e2;
                p.tok_g[2 * t] = 1.f / (1.f + ex); p.tok_g[2 * t + 1] = ex / (1.f + ex);
                atomicAdd(&lcnt[e1], 1); atomicAdd(&lcnt[e2], 1);
            }
        }
        __syncthreads();
        if (tid < 8) p.chunk_cnt[chunk * 8 + tid] = lcnt[tid];
    }
}
__device__ void ph_slots(const Params& p, float* lds) {
    const int tid = threadIdx.x;
    int* lbase = (int*)lds;
    int* lpad = lbase + 8;
    int* lent = lpad + 16;
    int* lslot = lent + 256;
    for (int chunk = blockIdx.x; chunk < 256; chunk += gridDim.x) {
        __syncthreads();
        if (tid < 8) {
            int tot = 0, before = 0;
            for (int c = 0; c < 256; ++c) { const int v = p.chunk_cnt[c * 8 + tid]; tot += v; if (c < chunk) before += v; }
            lbase[tid] = before; lpad[tid] = (tot + 255) / 256 * 256;
        }
        if (tid < 256) lent[tid] = p.tok_e[chunk * 256 + tid];
        __syncthreads();
        if (tid == 0) { int acc = 0; for (int e = 0; e < 8; ++e) { const int n = lpad[e]; lpad[e] = acc; acc += n; } lpad[8] = acc; }
        __syncthreads();
        if (tid < 8) { int r = lpad[tid] + lbase[tid]; for (int i = 0; i < 256; ++i) if (lent[i] == tid) lslot[i] = r++; }
        __syncthreads();
        if (tid < 256) {
            const int slot = lslot[tid], tk = chunk * 128 + (tid >> 1);
            p.slot_tok[slot] = tk; p.slot_gate[slot] = p.tok_g[chunk * 256 + tid]; p.tok_slot[chunk * 256 + tid] = slot;
        }
        if (chunk == 0 && tid < NTILE256) {
            const int s0 = tid * 256; int e = -1;
            for (int q = 0; q < 8; ++q) if (s0 >= lpad[q] && s0 < lpad[q + 1]) e = q;
            p.tile_e[tid] = e;
        }
    }
}

enum { PH_INIT = 0, PH_GEMM_IN_E, PH_ROPE_E, PH_DIFF, PH_DSA, PH_GEMM_OUT, PH_LN_MIX, PH_GEMM_GU, PH_GEMM_DOWN, PH_LN_FFN,
       PH_GEMM_IN_O, PH_ROPE_O, PH_KMEAN, PH_MOBA, PH_COMPRESS, PH_NSA, PH_ROUTER, PH_SLOTS, PH_MOE_GU, PH_MOE_DOWN, PH_LN_MOE };

template <int PH>
__global__ void __launch_bounds__(NT) kph(Params p, int l, int arg) {
    extern __shared__ __attribute__((aligned(16))) float lds[];
    const int li = l >> 1;
    if (PH == PH_INIT) ph_init(p);
    if (PH == PH_GEMM_IN_E) {
        GemmArgs g{}; g.A = p.X; g.lda = DM; g.B = p.in[IN_EV_WIN] + (size_t)li * DM * P_EVEN; g.ldb = P_EVEN; g.M = NTOK; g.N = P_EVEN; g.K = DM;
        float* P = p.P; gemm_f32<false>(g, lds, [=](int r, int c, float v, float) { P[(size_t)r * LDP + c] = v; });
    }
    if (PH == PH_GEMM_IN_O) {
        GemmArgs g{}; g.A = p.X; g.lda = DM; g.B = p.in[IN_OD_WIN] + (size_t)li * DM * P_ODD; g.ldb = P_ODD; g.M = NTOK; g.N = P_ODD; g.K = DM;
        float* P = p.P; gemm_f32<false>(g, lds, [=](int r, int c, float v, float) { P[(size_t)r * LDP + c] = v; });
    }
    if (PH == PH_ROPE_E) ph_rope_even(p);
    if (PH == PH_ROPE_O) ph_rope_odd(p, li);
    if (PH == PH_DIFF) ph_diff(p, li, lds);
    if (PH == PH_DSA) ph_dsa(p, lds);
    if (PH == PH_KMEAN) ph_kmean(p, lds);
    if (PH == PH_MOBA) ph_moba(p, lds);
    if (PH == PH_COMPRESS) ph_compress(p, li, lds);
    if (PH == PH_NSA) ph_nsa(p, lds);
    if (PH == PH_GEMM_OUT) {
        GemmArgs g{}; g.A = p.O; g.lda = DM; g.B = p.in[(l & 1) ? IN_OD_WOUT : IN_EV_WOUT] + (size_t)li * DM * DM; g.ldb = DM; g.M = NTOK; g.N = DM; g.K = DM;
        float* Y = p.Y; gemm_f32<false>(g, lds, [=](int r, int c, float v, float) { Y[(size_t)r * DM + c] = v; });
    }
    if (PH == PH_LN_MIX) ph_ln<0>(p, p.in[IN_LN_MIX_G] + l * DM, p.in[IN_LN_MIX_B] + l * DM);
    if (PH == PH_LN_FFN) ph_ln<0>(p, p.in[IN_LN_FFN_G] + l * DM, p.in[IN_LN_FFN_B] + l * DM);
    if (PH == PH_LN_MOE) ph_ln<1>(p, p.in[IN_LN_FFN_G] + l * DM, p.in[IN_LN_FFN_B] + l * DM);
    if (PH == PH_GEMM_GU) {
        GemmArgs g{}; g.A = p.X; g.lda = DM; g.B = p.in[IN_FFD_WG] + (size_t)li * DM * F_DENSE; g.B2 = p.in[IN_FFD_WU] + (size_t)li * DM * F_DENSE; g.ldb = F_DENSE; g.M = NTOK; g.N = F_DENSE; g.K = DM;
        float* H = p.P; gemm_f32<true>(g, lds, [=](int r, int c, float gv, float uv) { H[(size_t)r * F_DENSE + c] = gv / (1.f + expf(-gv)) * uv; });
    }
    if (PH == PH_GEMM_DOWN) {
        GemmArgs g{}; g.A = p.P; g.lda = F_DENSE; g.B = p.in[IN_FFD_WD] + (size_t)li * F_DENSE * DM; g.ldb = DM; g.M = NTOK; g.N = DM; g.K = F_DENSE;
        float* Y = p.Y; gemm_f32<false>(g, lds, [=](int r, int c, float v, float) { Y[(size_t)r * DM + c] = v; });
    }
    if (PH == PH_ROUTER) ph_router(p, li, lds);
    if (PH == PH_SLOTS) ph_slots(p, lds);
    if (PH == PH_MOE_GU) {
        const int s0 = arg * MOE_CHUNK;
        GemmArgs g{}; g.A = p.X; g.lda = DM; g.rowidx = p.slot_tok + s0; g.B = p.in[IN_MOE_WG] + (size_t)li * N_EXP * DM * F_EXPERT; g.B2 = p.in[IN_MOE_WU] + (size_t)li * N_EXP * DM * F_EXPERT;
        g.ldb = F_EXPERT; g.tile_e = p.tile_e; g.estride = (size_t)DM * F_EXPERT; g.tile_e_row0 = s0; g.M = (NSLOT - s0 < MOE_CHUNK) ? NSLOT - s0 : MOE_CHUNK; g.N = F_EXPERT; g.K = DM;
        float* H = p.P; gemm_f32<true>(g, lds, [=](int r, int c, float gv, float uv) { H[(size_t)r * F_EXPERT + c] = gv / (1.f + expf(-gv)) * uv; });
    }
    if (PH == PH_MOE_DOWN) {
        const int s0 = arg * MOE_CHUNK;
        GemmArgs g{}; g.A = p.P; g.lda = F_EXPERT; g.B = p.in[IN_MOE_WD] + (size_t)li * N_EXP * F_EXPERT * DM; g.ldb = DM; g.tile_e = p.tile_e; g.estride = (size_t)F_EXPERT * DM; g.tile_e_row0 = s0;
        g.M = (NSLOT - s0 < MOE_CHUNK) ? NSLOT - s0 : MOE_CHUNK; g.N = DM; g.K = F_EXPERT;
        float* Ys = p.Y + (size_t)s0 * DM; const float* sg = p.slot_gate + s0;
        gemm_f32<false>(g, lds, [=](int r, int c, float v, float) { Ys[(size_t)r * DM + c] = v * sg[r]; });
    }
}

template <int PH> static void launch(const Params& p, int l, int arg, int grid, hipStream_t s) {
    static bool attr = false;
    const int ldsb = (PH == PH_DSA) ? LDS_BYTES : 32768;
    if (!attr) { hipFuncSetAttribute((const void*)kph<PH>, hipFuncAttributeMaxDynamicSharedMemorySize, ldsb); attr = true; }
    kph<PH><<<grid, NT, ldsb, s>>>(p, l, arg);
}

extern "C" void kernel_launch(void* const* d_in, const int* in_sizes, int n_in, void* d_out, int out_size, void* d_ws, size_t ws_size, hipStream_t stream) {
    Params p; memset(&p, 0, sizeof(p));
    for (int i = 0; i < 23; ++i) p.in[i] = (const float*)d_in[i];
    p.X = (float*)d_out;
    unsigned char* w = (unsigned char*)d_ws; size_t off = 0;
    auto take = [&](size_t bytes) { unsigned char* r = w + off; off += (bytes + 255) / 256 * 256; return r; };
    p.bar = (unsigned*)take(16384);
    p.P = (float*)take((size_t)NTOK * LDP * 4);
    p.O = (float*)take((size_t)NTOK * DM * 4);
    p.Y = (float*)take((size_t)NSLOT * DM * 4);
    p.QR = p.Y + (size_t)NTOK * DM;
    p.ropecs = (float*)take(4096 * 32 * 2 * 4);
    p.kmean = (float*)take(8 * 16 * 8 * 64 * 4);
    p.cmpk = (float*)take(8 * 256 * 2 * 64 * 4);
    p.cmpv = (float*)take(8 * 256 * 2 * 64 * 4);
    p.tok_e = (int*)take(NTOK * 2 * 4);
    p.tok_g = (float*)take(NTOK * 2 * 4);
    p.tok_slot = (int*)take(NTOK * 2 * 4);
    p.slot_tok = (int*)take(NSLOT * 4);
    p.slot_gate = (float*)take(NSLOT * 4);
    p.chunk_cnt = (int*)take(256 * 8 * 4);
    p.tile_e = (int*)take(NTILE256 * 4);
    p.lam_init[0] = (float)(0.8 - 0.6 * exp(-0.3 * 0.0));
    p.lam_init[1] = (float)(0.8 - 0.6 * exp(-0.3 * 2.0));
    const int G = 1024;
    launch<PH_INIT>(p, 0, 0, G, stream);
    for (int l = 0; l < 4; ++l) {
        if ((l & 1) == 0) {
            launch<PH_GEMM_IN_E>(p, l, 0, G, stream);
            launch<PH_ROPE_E>(p, l, 0, G, stream);
            launch<PH_DIFF>(p, l, 0, G, stream);
            launch<PH_DSA>(p, l, 0, G, stream);
            launch<PH_GEMM_OUT>(p, l, 0, G, stream);
            launch<PH_LN_MIX>(p, l, 0, G, stream);
            launch<PH_GEMM_GU>(p, l, 0, G, stream);
            launch<PH_GEMM_DOWN>(p, l, 0, G, stream);
            launch<PH_LN_FFN>(p, l, 0, G, stream);
        } else {
            launch<PH_GEMM_IN_O>(p, l, 0, G, stream);
            launch<PH_ROPE_O>(p, l, 0, G, stream);
            launch<PH_KMEAN>(p, l, 0, G, stream);
            launch<PH_MOBA>(p, l, 0, G, stream);
            launch<PH_COMPRESS>(p, l, 0, G, stream);
            launch<PH_NSA>(p, l, 0, G, stream);
            launch<PH_GEMM_OUT>(p, l, 0, G, stream);
            launch<PH_LN_MIX>(p, l, 0, G, stream);
            launch<PH_ROUTER>(p, l, 0, 256, stream);
            launch<PH_SLOTS>(p, l, 0, 256, stream);
            for (int c = 0; c < N_MOE_CHUNK; ++c) {
                launch<PH_MOE_GU>(p, l, c, G, stream);
                launch<PH_MOE_DOWN>(p, l, c, G, stream);
            }
            launch<PH_LN_MOE>(p, l, 0, G, stream);
        }
    }
}
```

```cpp
#include <hip/hip_runtime.h>
#include <stdint.h>
#include <string.h>
#include <math.h>

__device__ __forceinline__ int tid_() { int t = threadIdx.x; asm volatile("" : "+v"(t)); return t; }
__device__ __forceinline__ float zero1_() { float z = 0.f; asm volatile("" : "+v"(z)); return z; }
namespace pg8 {
#define PG8_LAS __attribute__((address_space(3)))
typedef unsigned short bf16_t;
typedef short bf16x8 __attribute__((ext_vector_type(8)));
typedef float f32x4 __attribute__((ext_vector_type(4)));
typedef unsigned u32x4 __attribute__((ext_vector_type(4)));
constexpr int BM = 256, BK = 64, HALF = 128, HTB = HALF * BK * 2  , STAGE_BYTES = 8 * HTB, NXCD = 8, WGM = 8;

__host__ __device__ __forceinline__ int lds_byte(int r, int c) { const int st = (r >> 4) * 2 + (c >> 5), rr = r & 15, cc = c & 31, ob = rr * 64 + cc * 2; return st * 1024 + (ob ^ (((ob >> 9) & 1) << 5)); }
__host__ __device__ __forceinline__ void stage_rc(int b, int& R, int& C) { const int st = b / 1024, sb = b % 1024, swz = sb ^ (((sb >> 9) & 1) << 5); R = (st >> 1) * 16 + swz / 64; C = (st & 1) * 32 + (swz % 64) / 2; }
__host__ __device__ __forceinline__ int perm32(int rho) { const int n = rho >> 4, i = rho & 15; return 8 * (i >> 2) + 4 * n + (i & 3); }

struct Unit { int pm, pn, ko; };
struct Gemm { const bf16_t* A; const bf16_t* Bt; int M, N, K, ld; };

struct StaticOrder {
    static constexpr bool KSPLIT = false, GATHER_A = false;
    int nM, nN, nwg, G, c;
    __host__ __device__ void init(int M, int N, int G_, int c_) { nM = M / BM; nN = N / BM; nwg = nM * nN; G = G_; c = c_; }
    __host__ __device__ bool next(int i, Unit& u) const {
        const long L = (long)i * G + c; if (L >= nwg) return false;
        int wgid = (int)L; { const int q = nwg / NXCD, r = nwg % NXCD, xcd = wgid % NXCD, off = wgid / NXCD; wgid = (xcd < r ? xcd * (q + 1) : r * (q + 1) + (xcd - r) * q) + off; }
        const int nig = WGM * nN, gid = wgid / nig, fm = gid * WGM, gsz = (nM - fm) < WGM ? (nM - fm) : WGM;
        u.pm = fm + ((wgid % nig) % gsz); u.pn = (wgid % nig) / gsz; return true;
    }
    __device__ __forceinline__ void a_ready(const Unit&) const {}
    __device__ __forceinline__ void done(const Unit&) const {}
};

__device__ __forceinline__ unsigned cvt_pk_bf16(float lo, float hi) { unsigned r; asm volatile("v_cvt_pk_bf16_f32 %0, %1, %2" : "=v"(r) : "v"(lo), "v"(hi)); return r; }
typedef float f32x2 __attribute__((ext_vector_type(2)));
template <class Epi, class Sched, bool ALIGN_EPI = false, bool SP2 = false>
__device__ __forceinline__ void gemm_phase(PG8_LAS unsigned char* lds, const Gemm g, const Sched& S, const Epi& E) {
    const int tid = tid_(), wid = __builtin_amdgcn_readfirstlane(tid >> 6), lane = tid & 63, wr = wid >> 2, wc = wid & 3, fr = lane & 15, fq = lane >> 4;
    const int K = g.K, nt = K / BK, LD = g.ld ? g.ld : K;
    unsigned voffA[2], voffB[2];
#pragma unroll
    for (int i = 0; i < 2; ++i) { int R, C; stage_rc(tid * 16 + i * 8192, R, C); const int Rb = Epi::PERM ? ((R & ~31) + perm32(R & 31)) : R;
        voffA[i] = (unsigned)(R * LD + C) * 2u; voffB[i] = (unsigned)(Rb * LD + C) * 2u; }
    const size_t kstep = (size_t)(BK * 2);
    const size_t hstep = (size_t)HALF * LD * 2;
    const size_t tstep = 2 * hstep;
    const unsigned ldsw = (unsigned)wid * 1024u;
    const int aoff = lds_byte(wr * 64 + fr, fq * 8), boff = lds_byte(wc * 32 + fr, fq * 8);
#define PG8_SA(b, h) (((b) * 2 + (h)) * HTB)
#define PG8_SB(b, h) ((4 + (b) * 2 + (h)) * HTB)
#define PG8_STAGE(bufoff, gbase, voff) do { _Pragma("unroll") for (int _i = 0; _i < 2; ++_i) \
        __builtin_amdgcn_global_load_lds((const unsigned*)((const char*)(gbase) + (voff)[_i]), (PG8_LAS unsigned*)(lds + (bufoff) + ldsw + _i * 8192), 16, 0, 0); } while (0)
#define PG8_LDA(dst, b, h) do { _Pragma("unroll") for (int m = 0; m < 4; ++m) _Pragma("unroll") for (int k = 0; k < 2; ++k) dst[m][k] = *(const PG8_LAS bf16x8*)(lds + PG8_SA(b, h) + aoff + m * 2048 + k * 1024); } while (0)
#define PG8_LDB(dst, b, h) do { _Pragma("unroll") for (int n = 0; n < 2; ++n) _Pragma("unroll") for (int k = 0; k < 2; ++k) dst[n][k] = *(const PG8_LAS bf16x8*)(lds + PG8_SB(b, h) + boff + n * 2048 + k * 1024); } while (0)
#define PG8_MMA(ai, bj, At, Bt) do { __builtin_amdgcn_s_setprio(1); _Pragma("unroll") for (int m = 0; m < 4; ++m) _Pragma("unroll") for (int n = 0; n < 2; ++n) _Pragma("unroll") for (int k = 0; k < 2; ++k) \
        acc[ai][bj][m][n] = __builtin_amdgcn_mfma_f32_16x16x32_bf16(Bt[n][k], At[m][k], acc[ai][bj][m][n], 0, 0, 0); __builtin_amdgcn_s_setprio(0); } while (0)
#define PG8_WAIT_V(n) asm volatile("s_waitcnt vmcnt(" #n ")" ::: "memory")
#define PG8_WAIT_L(n) asm volatile("s_waitcnt lgkmcnt(" #n ")" ::: "memory")
#define PG8_BAR __builtin_amdgcn_s_barrier()
#define PG8_SCHED __builtin_amdgcn_sched_barrier(0)
    Unit cur, nxt; int ui = 0;
    if (!S.next(0, cur)) return;
    unsigned voffA1[2]; size_t hstepA = hstep;
#pragma unroll
    for (int i = 0; i < 2; ++i) voffA1[i] = voffA[i];
    if constexpr (Sched::GATHER_A) {
        hstepA = 0;
#pragma unroll
        for (int i = 0; i < 2; ++i) { int R, C; stage_rc(tid * 16 + i * 8192, R, C);
            voffA[i] = (unsigned)(S.arow(cur.pm * 256 + R) * LD + C) * 2u; voffA1[i] = (unsigned)(S.arow(cur.pm * 256 + 128 + R) * LD + C) * 2u; }
    }
    f32x4 acc[2][2][4][2];
#pragma unroll
    for (int a = 0; a < 2; ++a)
#pragma unroll
        for (int b = 0; b < 2; ++b)
#pragma unroll
            for (int m = 0; m < 4; ++m)
#pragma unroll
                for (int n = 0; n < 2; ++n) acc[a][b][m][n] = ([]() { const float z = zero1_(); return (f32x4){z, z, z, z}; }());
    bf16x8 At[4][2], B0[2][2], B1[2][2];
    const char* cA = (const char*)g.A + (Sched::GATHER_A ? (size_t)0 : (size_t)cur.pm * tstep); const char* cB = (const char*)g.Bt + (size_t)cur.pn * tstep;
    if constexpr (Sched::KSPLIT) { cA += (size_t)cur.ko * 2; cB += (size_t)cur.ko * 2; }
    S.a_ready(cur);
    if constexpr (SP2) {
        PG8_STAGE(PG8_SB(0, 0), cB, voffB); PG8_STAGE(PG8_SB(0, 1), cB + hstep, voffB); PG8_STAGE(PG8_SA(0, 0), cA, voffA); PG8_STAGE(PG8_SA(0, 1), cA + hstepA, voffA1);
        if (wr == 1) PG8_BAR;
        PG8_WAIT_V(2); PG8_BAR;
        PG8_STAGE(PG8_SB(1, 0), cB + kstep, voffB); PG8_STAGE(PG8_SA(1, 0), cA + kstep, voffA); PG8_STAGE(PG8_SB(1, 1), cB + hstep + kstep, voffB);
        PG8_WAIT_V(6); PG8_BAR;
    } else {
        PG8_STAGE(PG8_SB(0, 0), cB, voffB); PG8_STAGE(PG8_SA(0, 0), cA, voffA); PG8_STAGE(PG8_SB(0, 1), cB + hstep, voffB); PG8_STAGE(PG8_SA(0, 1), cA + hstepA, voffA1);
        if (wr == 1) PG8_BAR;
        PG8_WAIT_V(4); PG8_BAR;
        PG8_STAGE(PG8_SB(1, 0), cB + kstep, voffB); PG8_STAGE(PG8_SA(1, 0), cA + kstep, voffA); PG8_STAGE(PG8_SB(1, 1), cB + hstep + kstep, voffB);
        PG8_WAIT_V(6); PG8_BAR;
    }
    for (;;) {
        const bool has_next = S.next(ui + 1, nxt);
        const char* nA = has_next ? (const char*)g.A + (Sched::GATHER_A ? (size_t)0 : (size_t)nxt.pm * tstep) : cA; const char* nB = has_next ? (const char*)g.Bt + (size_t)nxt.pn * tstep : cB;
        if constexpr (Sched::KSPLIT) { if (has_next) { nA += (size_t)nxt.ko * 2; nB += (size_t)nxt.ko * 2; } }
        for (int t = 0; t < nt; t += 2) {
            const bool last = (t == nt - 2);
            const char* a1 = cA + (size_t)(t + 1) * kstep;
            const char* a2 = last ? nA : cA + (size_t)(t + 2) * kstep; const char* b2 = last ? nB : cB + (size_t)(t + 2) * kstep;
            const char* a3 = a2 + kstep; const char* b3 = b2 + kstep;
            if (last && has_next) S.a_ready(nxt);
            if constexpr (SP2) {
            PG8_LDB(B0, 0, 0); PG8_LDB(B1, 0, 1); PG8_SCHED; PG8_LDA(At, 0, 0); PG8_STAGE(PG8_SA(1, 1), a1 + hstepA, voffA1);
            PG8_WAIT_V(8); PG8_WAIT_L(0); PG8_BAR; PG8_MMA(0, 0, At, B0); PG8_MMA(0, 1, At, B1); PG8_BAR; PG8_SCHED;
            PG8_LDA(At, 0, 1); PG8_STAGE(PG8_SB(0, 0), b2, voffB); PG8_STAGE(PG8_SB(0, 1), b2 + hstep, voffB); PG8_STAGE(PG8_SA(0, 0), a2, voffA);
            PG8_WAIT_V(8); PG8_WAIT_L(0); PG8_BAR; PG8_MMA(1, 0, At, B0); PG8_MMA(1, 1, At, B1); PG8_BAR; PG8_SCHED;
            PG8_LDB(B0, 1, 0); PG8_LDB(B1, 1, 1); PG8_SCHED; PG8_LDA(At, 1, 0); PG8_STAGE(PG8_SA(0, 1), a2 + hstepA, voffA1);
            PG8_WAIT_V(8); PG8_WAIT_L(0); PG8_BAR; PG8_MMA(0, 0, At, B0); PG8_MMA(0, 1, At, B1); PG8_BAR; PG8_SCHED;
            PG8_LDA(At, 1, 1); PG8_STAGE(PG8_SB(1, 0), b3, voffB); PG8_STAGE(PG8_SB(1, 1), b3 + hstep, voffB); PG8_STAGE(PG8_SA(1, 0), a3, voffA);
            PG8_WAIT_V(8); PG8_WAIT_L(0); PG8_BAR; PG8_MMA(1, 0, At, B0); PG8_MMA(1, 1, At, B1); PG8_BAR; PG8_SCHED;
            } else {
            PG8_LDB(B0, 0, 0); PG8_SCHED; PG8_LDA(At, 0, 0); PG8_STAGE(PG8_SA(1, 1), a1 + hstepA, voffA1);
            PG8_WAIT_L(8); PG8_BAR; PG8_WAIT_L(0); PG8_MMA(0, 0, At, B0); PG8_BAR; PG8_SCHED;
            PG8_LDB(B1, 0, 1); PG8_STAGE(PG8_SB(0, 0), b2, voffB);
            PG8_BAR; PG8_WAIT_L(0); PG8_MMA(0, 1, At, B1); PG8_BAR;
            PG8_LDA(At, 0, 1); PG8_STAGE(PG8_SA(0, 0), a2, voffA);
            PG8_BAR; PG8_WAIT_L(0); PG8_MMA(1, 0, At, B0); PG8_BAR; PG8_SCHED;
            PG8_STAGE(PG8_SB(0, 1), b2 + hstep, voffB);
            PG8_WAIT_V(6); PG8_BAR; PG8_MMA(1, 1, At, B1); PG8_BAR;
            PG8_LDB(B0, 1, 0); PG8_SCHED; PG8_LDA(At, 1, 0); PG8_STAGE(PG8_SA(0, 1), a2 + hstepA, voffA1);
            PG8_WAIT_L(8); PG8_BAR; PG8_WAIT_L(0); PG8_MMA(0, 0, At, B0); PG8_BAR; PG8_SCHED;
            PG8_LDB(B1, 1, 1); PG8_STAGE(PG8_SB(1, 0), b3, voffB);
            PG8_BAR; PG8_WAIT_L(0); PG8_MMA(0, 1, At, B1); PG8_BAR;
            PG8_LDA(At, 1, 1); PG8_STAGE(PG8_SA(1, 0), a3, voffA);
            PG8_BAR; PG8_WAIT_L(0); PG8_MMA(1, 0, At, B0); PG8_BAR; PG8_SCHED;
            PG8_STAGE(PG8_SB(1, 1), b3 + hstep, voffB);
            PG8_WAIT_V(6); PG8_BAR; PG8_MMA(1, 1, At, B1); PG8_BAR;
            }
        }
        if constexpr (ALIGN_EPI) { if (wr == 0) PG8_BAR; }
        if constexpr (!Epi::AFTER_DRAIN) { E(acc, cur, wr, wc, fr, fq); S.done(cur); }
        if (!has_next) break;
#pragma unroll
        for (int a = 0; a < 2; ++a)
#pragma unroll
            for (int b = 0; b < 2; ++b)
#pragma unroll
                for (int m = 0; m < 4; ++m)
#pragma unroll
                    for (int n = 0; n < 2; ++n) acc[a][b][m][n] = ([]() { const float z = zero1_(); return (f32x4){z, z, z, z}; }());
        cur = nxt; cA = nA; cB = nB; ++ui;
        if constexpr (ALIGN_EPI) { if (wr == 1) PG8_BAR; }
    }
    PG8_WAIT_V(0);
    if constexpr (!ALIGN_EPI) { if (wr == 0) PG8_BAR; }
    PG8_BAR;
    if constexpr (Epi::AFTER_DRAIN) { E.fused(acc, cur, wr, wc, fr, fq, lds, wid, lane); S.done(cur); }
#undef PG8_SA
#undef PG8_SB
#undef PG8_STAGE
#undef PG8_LDA
#undef PG8_LDB
#undef PG8_MMA
#undef PG8_WAIT_V
#undef PG8_WAIT_L
#undef PG8_BAR
#undef PG8_SCHED
}
}
using pg8::bf16_t; using pg8::f32x4; using pg8::Unit;
typedef unsigned u32x2 __attribute__((ext_vector_type(2)));

#define NT 512
#define Z4_ ([]() { const float z = zero1_(); return (f32x4){z, z, z, z}; }())
#define LAS __attribute__((address_space(3)))
constexpr int NTOK = 32768, DM = 1024, SEQ = 4096;
constexpr int LDPB = 3072;
constexpr float ALPHA = 1.681792830507429f;
constexpr float LN_EPS = 1e-5f;
constexpr int E_AQ = 0, E_AK = 512, E_AV = 1024, E_BQ = 1536, E_BK = 2048, E_BV = 2176, E_IQ = 2304, E_IK = 2560, E_IW = 2624, P_EVEN = 2628, NP_EVEN = 2816;
constexpr int O_CQ = 0, O_CK = 512, O_CV = 1024, O_DQ = 1536, O_KC = 2048, O_VC = 2176, O_KS = 2304, O_VS = 2432, O_KW = 2560, O_VW = 2688, O_DG = 2816, P_ODD = 2840, NP_ODD = 3072;
constexpr int F_DENSE = 2816, F_EXPERT = 3584, N_EXP = 8;
constexpr int NSLOT = 65536 + 8 * 256;
constexpr int NTILE256 = NSLOT / 256;
constexpr int MOE_HALF_TILES = NTILE256 / 2;
constexpr int LDS_BYTES = 147456;

__constant__ float c_inv[32] = {1.0f, 0.7498942613601685f, 0.5623413324356079f, 0.4216965138912201f, 0.3162277638912201f, 0.23713737726211548f, 0.17782793939113617f, 0.133352130651474f,
    0.10000000149011612f, 0.07498941570520401f, 0.05623413249850273f, 0.04216965287923813f, 0.03162277489900589f, 0.023713737726211548f, 0.017782794311642647f, 0.01333521492779255f,
    0.009999999776482582f, 0.007498941849917173f, 0.005623413249850273f, 0.0042169648222625256f, 0.003162277629598975f, 0.00237137358635664f, 0.0017782794311642647f, 0.0013335214462131262f,
    0.0010000000474974513f, 0.0007498942431993783f, 0.000562341301701963f, 0.0004216965171508491f, 0.0003162277571391314f, 0.00023713737027719617f, 0.00017782794020604342f, 0.0001333521504420787f};

struct Params {
    const float* in[23];
    float* X;
    bf16_t* Xb;
    bf16_t* Pb;
    bf16_t* Ob;
    bf16_t* QRb;
    float* Y;
    bf16_t* H;
    bf16_t* Xs;
    bf16_t* Hm;
    bf16_t* Ys;
    bf16_t* Yp;
    bf16_t* W1T; bf16_t* W2T;
    bf16_t* Ac; bf16_t* Hc; bf16_t* CMP;
    bf16_t* WinE; bf16_t* WoutE; bf16_t* WguD; bf16_t* WdD; bf16_t* WinO; bf16_t* WoutO; bf16_t* WguM; bf16_t* WdM;
    float* ropecs;
    float* IW;
    unsigned long long* BM;
    float* GATES;
    float* kmean;
    float* cmpk;
    float* cmpv;
    int* tok_e; float* tok_g; int* tok_slot; int* slot_tok; float* slot_gate; int* chunk_cnt; int* tile_e;
    unsigned* bar;
    float lam_init[2];
};

enum { IN_X = 0, IN_EV_WIN, IN_EV_WOUT, IN_DIF_LAMBDA, IN_DIF_SUBLN, IN_FFD_WG, IN_FFD_WU, IN_FFD_WD, IN_OD_WIN, IN_OD_WOUT, IN_NSA_GATE_B, IN_NSA_PE, IN_NSA_W1, IN_NSA_W2,
       IN_MOE_WR, IN_MOE_BR, IN_MOE_WG, IN_MOE_WU, IN_MOE_WD, IN_LN_MIX_G, IN_LN_MIX_B, IN_LN_FFN_G, IN_LN_FFN_B };

__device__ __forceinline__ float bf2f(bf16_t u) { return __builtin_bit_cast(float, (unsigned)u << 16); }
__device__ __forceinline__ unsigned pk2(float lo, float hi) { return pg8::cvt_pk_bf16(lo, hi); }
__device__ __forceinline__ bf16_t f2bf(float f) { return (bf16_t)(pg8::cvt_pk_bf16(f, 0.f) & 0xffffu); }
__device__ __forceinline__ float wave_max(float v) {
#pragma unroll
    for (int o = 32; o >= 1; o >>= 1) v = fmaxf(v, __shfl_xor(v, o));
    return v;
}
__device__ __forceinline__ float wave_sum(float v) {
#pragma unroll
    for (int o = 32; o >= 1; o >>= 1) v += __shfl_xor(v, o);
    return v;
}
__device__ __forceinline__ int wave_sumi(int v) {
#pragma unroll
    for (int o = 32; o >= 1; o >>= 1) v += __shfl_xor(v, o);
    return v;
}
__device__ __forceinline__ float rl_f(float v, int l) { return __builtin_bit_cast(float, __builtin_amdgcn_readlane(__builtin_bit_cast(int, v), l)); }
__device__ __forceinline__ int lane_rank(unsigned long long m) { return __builtin_amdgcn_mbcnt_hi((unsigned)(m >> 32), __builtin_amdgcn_mbcnt_lo((unsigned)m, 0)); }

#define EPI_LOOP_BEGIN \
    _Pragma("unroll") for (int ai = 0; ai < 2; ++ai) _Pragma("unroll") for (int m = 0; m < 4; ++m) { const int rloc = ai * 128 + wr * 64 + m * 16 + fr; \
    _Pragma("unroll") for (int bj = 0; bj < 2; ++bj) _Pragma("unroll") for (int n = 0; n < 2; ++n) { const int cloc = bj * 128 + wc * 32 + n * 16 + fq * 4; const f32x4 v = acc[ai][bj][m][n];
#define EPI_LOOP_END } }

struct EpiInEven {
    static constexpr bool PERM = false, AFTER_DRAIN = false;
    bf16_t* Pb; float* IW; const float* cs;
    __device__ __forceinline__ void operator()(const f32x4 (&acc)[2][2][4][2], const Unit& u, int wr, int wc, int fr, int fq) const {
        EPI_LOOP_BEGIN
            const int row = u.pm * 256 + rloc, c0 = u.pn * 256 + cloc, pos = row & (SEQ - 1);
            if (c0 < P_EVEN) {
                if (c0 == E_IW) { *(f32x4*)(IW + (size_t)row * 4) = v; }
                else {
                    f32x4 o = v;
                    const bool rope = (c0 < 1024) || (c0 >= 1536 && c0 < 2176) || (c0 >= 2304 && c0 < 2624);
                    if (rope) { const f32x4 t = *(const f32x4*)(cs + ((size_t)pos * 32 + ((c0 & 63) >> 1)) * 2);
                        o[0] = v[0] * t[0] - v[1] * t[1]; o[1] = v[1] * t[0] + v[0] * t[1]; o[2] = v[2] * t[2] - v[3] * t[3]; o[3] = v[3] * t[2] + v[2] * t[3]; }
                    u32x2 w; w.x = pk2(o[0], o[1]); w.y = pk2(o[2], o[3]);
                    *(u32x2*)(Pb + (size_t)row * LDPB + c0) = w;
                }
            }
        EPI_LOOP_END
    }
};
struct EpiInOdd {
    static constexpr bool PERM = false, AFTER_DRAIN = false;
    bf16_t* Pb; bf16_t* QRb; float* G; const float* cs; const float* gb;
    __device__ __forceinline__ void operator()(const f32x4 (&acc)[2][2][4][2], const Unit& u, int wr, int wc, int fr, int fq) const {
        EPI_LOOP_BEGIN
            const int row = u.pm * 256 + rloc, c0 = u.pn * 256 + cloc, pos = row & (SEQ - 1);
            if (c0 < P_ODD) {
                if (c0 >= O_DG) {
                    const int j = c0 - O_DG; f32x4 o;
#pragma unroll
                    for (int e = 0; e < 4; ++e) o[e] = 1.f / (1.f + expf(-(v[e] + gb[j + e])));
                    *(f32x4*)(G + (size_t)row * 24 + j) = o;
                } else {
                    const bool isq = (c0 >= O_DQ && c0 < O_KC);
                    const bool rope = (c0 < 1024) || isq || (c0 >= O_KS && c0 < O_VS) || (c0 >= O_KW && c0 < O_VW);
                    f32x4 o = v;
                    if (rope) { const f32x4 t = *(const f32x4*)(cs + ((size_t)pos * 32 + ((c0 & 63) >> 1)) * 2);
                        o[0] = v[0] * t[0] - v[1] * t[1]; o[1] = v[1] * t[0] + v[0] * t[1]; o[2] = v[2] * t[2] - v[3] * t[3]; o[3] = v[3] * t[2] + v[2] * t[3]; }
                    u32x2 w; w.x = pk2(o[0], o[1]); w.y = pk2(o[2], o[3]);
                    if (isq) { *(u32x2*)(QRb + (size_t)row * 512 + (c0 - O_DQ)) = w; w.x = pk2(v[0], v[1]); w.y = pk2(v[2], v[3]); }
                    *(u32x2*)(Pb + (size_t)row * LDPB + c0) = w;
                }
            }
        EPI_LOOP_END
    }
};
struct EpiY {
    static constexpr bool PERM = false, AFTER_DRAIN = false;
    bf16_t* Y;
    __device__ __forceinline__ void operator()(const f32x4 (&acc)[2][2][4][2], const Unit& u, int wr, int wc, int fr, int fq) const {
        EPI_LOOP_BEGIN
            u32x2 w; w.x = pk2(v[0], v[1]); w.y = pk2(v[2], v[3]);
            *(u32x2*)(Y + (size_t)(u.pm * 256 + rloc) * DM + u.pn * 256 + cloc) = w;
        EPI_LOOP_END
    }
};
struct EpiGU {
    static constexpr bool PERM = false, AFTER_DRAIN = false;
    bf16_t* H; int ldh; int npn; int row_tile0;
    __device__ __forceinline__ void operator()(const f32x4 (&acc)[2][2][4][2], const Unit& u, int wr, int wc, int fr, int fq) const {
        const int pnl = u.pn % npn;
#pragma unroll
        for (int ai = 0; ai < 2; ++ai)
#pragma unroll
            for (int m = 0; m < 4; ++m) { const int rloc = ai * 128 + wr * 64 + m * 16 + fr;
                bf16_t* hrow = H + (size_t)((u.pm - row_tile0) * 256 + rloc) * ldh;
#pragma unroll
                for (int bj = 0; bj < 2; ++bj) { const f32x4 g = acc[ai][bj][m][0], uu = acc[ai][bj][m][1];
                    const int unit0 = (pnl * 256 + bj * 128 + wc * 32) / 2 + fq * 4;
                    f32x4 o;
#pragma unroll
                    for (int e = 0; e < 4; ++e) o[e] = g[e] * __builtin_amdgcn_rcpf(1.f + __expf(-g[e])) * uu[e];
                    u32x2 w; w.x = pk2(o[0], o[1]); w.y = pk2(o[2], o[3]);
                    *(u32x2*)(hrow + unit0) = w; } }
    }
};
struct EpiDownMoe {
    static constexpr bool PERM = false, AFTER_DRAIN = false;
    bf16_t* Ys; const float* sg;
    __device__ __forceinline__ void operator()(const f32x4 (&acc)[2][2][4][2], const Unit& u, int wr, int wc, int fr, int fq) const {
        const int pnl = u.pn & 3;
#pragma unroll
        for (int ai = 0; ai < 2; ++ai)
#pragma unroll
            for (int m = 0; m < 4; ++m) { const int slot = u.pm * 256 + ai * 128 + wr * 64 + m * 16 + fr; const float gt = sg[slot];
#pragma unroll
                for (int bj = 0; bj < 2; ++bj)
#pragma unroll
                    for (int n = 0; n < 2; ++n) { const f32x4 v = acc[ai][bj][m][n] * gt; const int c0 = pnl * 256 + bj * 128 + wc * 32 + n * 16 + fq * 4;
                        u32x2 w; w.x = pk2(v[0], v[1]); w.y = pk2(v[2], v[3]);
                        *(u32x2*)(Ys + (size_t)slot * DM + c0) = w; } }
    }
};
struct EpiGeluH {
    static constexpr bool PERM = false, AFTER_DRAIN = false;
    bf16_t* Hc;
    __device__ __forceinline__ void operator()(const f32x4 (&acc)[2][2][4][2], const Unit& u, int wr, int wc, int fr, int fq) const {
        EPI_LOOP_BEGIN
            f32x4 o;
#pragma unroll
            for (int e = 0; e < 4; ++e) { const float x = v[e], uu = 0.7978845608028654f * (x + 0.044715f * x * x * x); o[e] = x - x * __builtin_amdgcn_rcpf(1.f + __expf(2.f * uu)); }
            u32x2 w; w.x = pk2(o[0], o[1]); w.y = pk2(o[2], o[3]);
            *(u32x2*)(Hc + (size_t)(u.pm * 256 + rloc) * 256 + cloc) = w;
        EPI_LOOP_END
    }
};
struct EpiCmp {
    static constexpr bool PERM = false, AFTER_DRAIN = false;
    bf16_t* C;
    __device__ __forceinline__ void operator()(const f32x4 (&acc)[2][2][4][2], const Unit& u, int wr, int wc, int fr, int fq) const {
        EPI_LOOP_BEGIN
            if (cloc < 64) { u32x2 w; w.x = pk2(v[0], v[1]); w.y = pk2(v[2], v[3]); *(u32x2*)(C + (size_t)(u.pm * 256 + rloc) * 64 + cloc) = w; }
        EPI_LOOP_END
    }
};
struct ListOrder {
    static constexpr bool KSPLIT = false, GATHER_A = false;
    int n, G, c;
    __device__ __forceinline__ bool next(int i, Unit& u) const { const int L = i * G + c; if (L >= n) return false; u.pm = L; u.pn = L >> 4; return true; }
    __device__ __forceinline__ void a_ready(const Unit&) const {}
    __device__ __forceinline__ void done(const Unit&) const {}
};
constexpr int MOE_TE_LDS = 139264;
struct MoeOrder {
    static constexpr bool KSPLIT = false, GATHER_A = false;
    int t0, ntr, npn, G, c;
    __device__ __forceinline__ bool next(int i, Unit& u) const {
        extern __shared__ __attribute__((aligned(16))) float lds_dyn_[];
        int tm, pl;
        if (G == 256 && ntr == 128) {
            const int x = c & 7, j = c >> 3, ncb = npn >> 2, nrounds = 2 * ncb;
            if (i >= nrounds) return false;
            const int rb = i / ncb, cb = i - rb * ncb;
            tm = t0 + 16 * x + 8 * rb + (j >> 2); pl = 4 * cb + (j & 3);
        } else {
            const int L = i * G + c; if (L >= ntr * npn) return false;
            tm = t0 + L / npn; pl = L % npn;
        }
        const int e = ((const LAS int*)((LAS unsigned char*)lds_dyn_ + MOE_TE_LDS))[tm];
        if (e < 0) return false;
        u.pm = tm; u.pn = e * npn + pl; return true;
    }
    __device__ __forceinline__ void a_ready(const Unit&) const {}
    __device__ __forceinline__ void done(const Unit&) const {}
};
struct MoeOrderG {
    static constexpr bool KSPLIT = false, GATHER_A = true;
    int t0, ntr, npn, G, c, rb; const int* slot_tok;
    __device__ __forceinline__ int arow(int slot) const { const int t = slot_tok[slot]; return t < 0 ? NTOK : t; }
    __device__ __forceinline__ bool next(int i, Unit& u) const {
        extern __shared__ __attribute__((aligned(16))) float lds_dyn_[];
        int tm, pl;
        if (ntr == 128) { const int x = c & 7, j = c >> 3, ncb = npn >> 2; if (i >= ncb) return false; tm = t0 + 16 * x + 8 * rb + (j >> 2); pl = 4 * i + (j & 3); }
        else { if (i > 0 || c >= ntr * npn) return false; tm = t0 + c / npn; pl = c % npn; }
        const int e = ((const LAS int*)((LAS unsigned char*)lds_dyn_ + MOE_TE_LDS))[tm];
        if (e < 0) return false;
        u.pm = tm; u.pn = e * npn + pl; return true;
    }
    __device__ __forceinline__ void a_ready(const Unit&) const {}
    __device__ __forceinline__ void done(const Unit&) const {}
};
constexpr int MOE_TAIL_T0 = 256, MOE_TAIL_TILES = NTILE256 - 256, MOE_KSL = 7, MOE_KSL_K = F_EXPERT / MOE_KSL;
struct TailOrder {
    static constexpr bool KSPLIT = true, GATHER_A = false;
    int G, c;
    __device__ __forceinline__ bool next(int i, Unit& u) const {
        extern __shared__ __attribute__((aligned(16))) float lds_dyn_[];
        const int L = i * G + c; if (L >= MOE_TAIL_TILES * 4 * MOE_KSL) return false;
        const int sl = L / (MOE_TAIL_TILES * 4), rem = L - sl * (MOE_TAIL_TILES * 4), tm = MOE_TAIL_T0 + (rem >> 2), pl = rem & 3;
        const int e = ((const LAS int*)((LAS unsigned char*)lds_dyn_ + MOE_TE_LDS))[tm];
        if (e < 0) return false;
        u.pm = tm; u.pn = e * 4 + pl; u.ko = sl * MOE_KSL_K; return true;
    }
    __device__ __forceinline__ void a_ready(const Unit&) const {}
    __device__ __forceinline__ void done(const Unit&) const {}
};
struct EpiDownTail {
    static constexpr bool PERM = false, AFTER_DRAIN = false;
    bf16_t* Yp; const float* sg;
    __device__ __forceinline__ void operator()(const f32x4 (&acc)[2][2][4][2], const Unit& u, int wr, int wc, int fr, int fq) const {
        const int pnl = u.pn & 3, sl = u.ko / MOE_KSL_K;
#pragma unroll
        for (int ai = 0; ai < 2; ++ai)
#pragma unroll
            for (int m = 0; m < 4; ++m) { const int slot = u.pm * 256 + ai * 128 + wr * 64 + m * 16 + fr; const float gt = sg[slot];
                bf16_t* row = Yp + ((size_t)sl * (MOE_TAIL_TILES * 256) + (slot - MOE_TAIL_T0 * 256)) * DM;
#pragma unroll
                for (int bj = 0; bj < 2; ++bj)
#pragma unroll
                    for (int n = 0; n < 2; ++n) { const f32x4 v = acc[ai][bj][m][n] * gt; const int c0 = pnl * 256 + bj * 128 + wc * 32 + n * 16 + fq * 4;
                        u32x2 w; w.x = pk2(v[0], v[1]); w.y = pk2(v[2], v[3]);
                        *(u32x2*)(row + c0) = w; } }
    }
};

template <class F>
__device__ __forceinline__ void convert_T(bf16_t* dst, int Nphys, int K, int ld, F rowsrc, long gid, long gstride) {
    const long total = (long)Nphys * (K >> 3);
    for (long idx0 = gid; idx0 < total; idx0 += 4 * gstride) {
        float v[4][8]; int nn[4], kk[4]; bool ok[4];
#pragma unroll
        for (int u = 0; u < 4; ++u) {
            const long idx = idx0 + u * gstride; ok[u] = idx < total;
            const long idc = ok[u] ? idx : idx0;
            nn[u] = (int)(idc % Nphys); kk[u] = (int)(idc / Nphys);
            const float* s = rowsrc(nn[u]);
            if (s) {
#pragma unroll
                for (int i = 0; i < 8; ++i) v[u][i] = s[(size_t)(kk[u] * 8 + i) * ld];
            } else {
#pragma unroll
                for (int i = 0; i < 8; ++i) v[u][i] = 0.f;
            }
        }
#pragma unroll
        for (int u = 0; u < 4; ++u) if (ok[u]) {
            uint4 w; w.x = pk2(v[u][0], v[u][1]); w.y = pk2(v[u][2], v[u][3]); w.z = pk2(v[u][4], v[u][5]); w.w = pk2(v[u][6], v[u][7]);
            *(uint4*)(dst + (size_t)nn[u] * K + kk[u] * 8) = w;
        }
    }
}
__device__ __forceinline__ int rope_nat(int n) { const int w = n & 63; return (n & ~63) + (w >> 1) + 32 * (w & 1); }

__device__ __forceinline__ void sincos_d(double a, double& s, double& c) {
    const double n = rint(a * 0.6366197723675814);
    double y = fma(-n, 1.5707963267948966, a); y = fma(-n, 6.123233995736766e-17, y);
    const int q = ((int)n) & 3;
    const double y2 = y * y;
    const double sp = y * (1.0 + y2 * (-1.0 / 6 + y2 * (1.0 / 120 + y2 * (-1.0 / 5040 + y2 * (1.0 / 362880 + y2 * (-1.0 / 39916800 + y2 * (1.0 / 6227020800.0)))))));
    const double cp = 1.0 + y2 * (-0.5 + y2 * (1.0 / 24 + y2 * (-1.0 / 720 + y2 * (1.0 / 40320 + y2 * (-1.0 / 3628800 + y2 * (1.0 / 479001600.0 + y2 * (-1.0 / 87178291200.0)))))));
    s = (q == 0) ? sp : (q == 1) ? cp : (q == 2) ? -sp : -cp;
    c = (q == 0) ? cp : (q == 1) ? -sp : (q == 2) ? -cp : sp;
}

template <class F>
__device__ __forceinline__ void convert_tiles(bf16_t* dst, int Nphys, int K, int ld, F src8, float* ldsf, int tile0, int tile_step) {
    const int tid = tid_();
    bf16_t* lt = (bf16_t*)ldsf;
    const int nkt = K >> 6, ntiles = (Nphys >> 7) * nkt;
    const int kl = tid >> 4, c = tid & 15;
    const int rn = tid >> 2, rq = tid & 3;
    float4 a0, a1, b0, b1;
#define CT_LOAD(tl, A0, A1, B0, B1) do { const int nt_ = (tl) / nkt, kt_ = (tl) - nt_ * nkt; const float* s_ = src8(nt_ * 128, c) + (size_t)(kt_ * 64 + kl) * ld; \
        A0 = *(const float4*)s_; A1 = *(const float4*)(s_ + 4); B0 = *(const float4*)(s_ + (size_t)32 * ld); B1 = *(const float4*)(s_ + (size_t)32 * ld + 4); } while (0)
    if (tile0 < ntiles) CT_LOAD(tile0, a0, a1, b0, b1);
    for (int tile = tile0; tile < ntiles; tile += tile_step) {
        const int nt = tile / nkt, kt = tile - nt * nkt, n0 = nt * 128, k0 = kt * 64;
        float4 na0 = a0, na1 = a1, nb0 = b0, nb1 = b1;
        if (tile + tile_step < ntiles) CT_LOAD(tile + tile_step, na0, na1, nb0, nb1);
        __syncthreads();
        const float va[8] = {a0.x, a0.y, a0.z, a0.w, a1.x, a1.y, a1.z, a1.w}, vb[8] = {b0.x, b0.y, b0.z, b0.w, b1.x, b1.y, b1.z, b1.w};
#pragma unroll
        for (int e = 0; e < 8; ++e) { lt[(8 * c + e) * 72 + kl] = f2bf(va[e]); lt[(8 * c + e) * 72 + kl + 32] = f2bf(vb[e]); }
        __syncthreads();
        const uint4 w0 = *(const uint4*)(lt + rn * 72 + rq * 16), w1 = *(const uint4*)(lt + rn * 72 + rq * 16 + 8);
        bf16_t* d = dst + (size_t)(n0 + rn) * K + k0 + rq * 16;
        *(uint4*)d = w0; *(uint4*)(d + 8) = w1;
        a0 = na0; a1 = na1; b0 = nb0; b1 = nb1;
    }
#undef CT_LOAD
}

__device__ __forceinline__ int rot_tile0(int rot, int G) { const int r = (int)blockIdx.x - rot % G; return r < 0 ? r + G : r; }
__device__ __forceinline__ void ph_init(const Params& p, float* lds) {
    const int tid = tid_();
    const long gid = (long)blockIdx.x * NT + tid, gs = (long)gridDim.x * NT;
    int rot = 0;
    for (long i = gid; i < 4096 * 32; i += gs) {
        const int pos = (int)(i >> 5), f = (int)(i & 31);
        const float angf = (float)pos * c_inv[f];
        double s, c; sincos_d((double)angf, s, c);
        p.ropecs[2 * i] = (float)c; p.ropecs[2 * i + 1] = (float)s;
    }
    if (gid < DM / 2) ((unsigned*)(p.Xb + (size_t)NTOK * DM))[gid] = 0u;
    const float4* xs = (const float4*)p.in[IN_X]; u32x2* xb = (u32x2*)p.Xb;
    for (long i = gid; i < (long)NTOK * DM / 4; i += 4 * gs) {
        float4 v[4];
#pragma unroll
        for (int u = 0; u < 4; ++u) { const long j = i + u * gs; v[u] = xs[j < (long)NTOK * DM / 4 ? j : i]; }
#pragma unroll
        for (int u = 0; u < 4; ++u) { const long j = i + u * gs; if (j < (long)NTOK * DM / 4) { u32x2 w; w.x = pk2(v[u].x, v[u].y); w.y = pk2(v[u].z, v[u].w); xb[j] = w; } }
    }
#pragma unroll 1
    for (int li = 0; li < 2; ++li) {
        { const float* W = p.in[IN_EV_WIN] + (size_t)li * DM * P_EVEN;
          convert_T(p.WinE + (size_t)li * NP_EVEN * DM, NP_EVEN, DM, P_EVEN, [=](int n) -> const float* {
              if (n >= P_EVEN) return nullptr;
              const bool rope = (n < 1024) || (n >= 1536 && n < 2176) || (n >= 2304 && n < 2624);
              return W + (rope ? rope_nat(n) : n); }, gid, gs); }
        { const float* W = p.in[IN_OD_WIN] + (size_t)li * DM * P_ODD;
          convert_T(p.WinO + (size_t)li * NP_ODD * DM, NP_ODD, DM, P_ODD, [=](int n) -> const float* {
              if (n >= P_ODD) return nullptr;
              const bool rope = (n < 1024) || (n >= O_DQ && n < O_KC) || (n >= O_KS && n < O_VS) || (n >= O_KW && n < O_VW);
              return W + (rope ? rope_nat(n) : n); }, gid, gs); }
        { const float* W = p.in[IN_EV_WOUT] + (size_t)li * DM * DM;
          convert_tiles(p.WoutE + (size_t)li * DM * DM, DM, DM, DM, [=](int n0, int c) -> const float* { return W + n0 + 8 * c; }, lds, rot_tile0(rot, gridDim.x), gridDim.x); rot += 128; }
        { const float* W = p.in[IN_OD_WOUT] + (size_t)li * DM * DM;
          convert_tiles(p.WoutO + (size_t)li * DM * DM, DM, DM, DM, [=](int n0, int c) -> const float* { return W + n0 + 8 * c; }, lds, rot_tile0(rot, gridDim.x), gridDim.x); rot += 128; }
        { const float* Wg = p.in[IN_FFD_WG] + (size_t)li * DM * F_DENSE; const float* Wu = p.in[IN_FFD_WU] + (size_t)li * DM * F_DENSE; const long dWu = (const char*)Wu - (const char*)Wg;
          convert_tiles(p.WguD + (size_t)li * 2 * F_DENSE * DM, 2 * F_DENSE, DM, F_DENSE, [=](int n0, int c) -> const float* {
              const int unit0 = n0 / 2 + (c >> 2) * 16 + (c & 1) * 8; return (const float*)((const char*)Wg + ((c & 2) ? dWu : 0l)) + unit0; }, lds, rot_tile0(rot, gridDim.x), gridDim.x); rot += 704; }
        { const float* W = p.in[IN_FFD_WD] + (size_t)li * F_DENSE * DM;
          convert_tiles(p.WdD + (size_t)li * DM * F_DENSE, DM, F_DENSE, DM, [=](int n0, int c) -> const float* { return W + n0 + 8 * c; }, lds, rot_tile0(rot, gridDim.x), gridDim.x); rot += 352; }
#pragma unroll 1
        for (int which = 0; which < 2; ++which) {
            const float* W1 = p.in[IN_NSA_W1] + (size_t)(li * 2 + which) * 2048 * 256;
            convert_tiles(p.W1T + (size_t)(li * 2 + which) * 256 * 2048, 256, 2048, 256, [=](int n0, int c) -> const float* { return W1 + n0 + 8 * c; }, lds, rot_tile0(rot, gridDim.x), gridDim.x); rot += 64;
            const float* W2 = p.in[IN_NSA_W2] + (size_t)(li * 2 + which) * 256 * 64;
            convert_T(p.W2T + (size_t)(li * 2 + which) * 256 * 256, 256, 256, 64, [=](int n) -> const float* { if (n >= 64) return nullptr; return W2 + (which ? n : rope_nat(n)); }, gid, gs);
        }
    }
}
__device__ __forceinline__ void ph_convert_moe(const Params& p, int li, float* lds) {
    const float* Wg = p.in[IN_MOE_WG] + (size_t)li * N_EXP * DM * F_EXPERT; const float* Wu = p.in[IN_MOE_WU] + (size_t)li * N_EXP * DM * F_EXPERT; const long dWu = (const char*)Wu - (const char*)Wg;
    convert_tiles(p.WguM, N_EXP * 2 * F_EXPERT, DM, F_EXPERT, [=](int n0, int c) -> const float* {
        const int e = n0 / (2 * F_EXPERT), unit0 = (n0 % (2 * F_EXPERT)) / 2 + (c >> 2) * 16 + (c & 1) * 8;
        return (const float*)((const char*)Wg + ((c & 2) ? dWu : 0l)) + (size_t)e * DM * F_EXPERT + unit0; }, lds, blockIdx.x, gridDim.x);
    const float* Wd = p.in[IN_MOE_WD] + (size_t)li * N_EXP * F_EXPERT * DM;
    convert_tiles(p.WdM, N_EXP * DM, F_EXPERT, DM, [=](int n0, int c) -> const float* { return Wd + (size_t)(n0 >> 10) * F_EXPERT * DM + (n0 & 1023) + 8 * c; }, lds, blockIdx.x, gridDim.x);
}

struct CvJob {
    const float* Wg; long dWu; const float* Wd; bf16_t* dgu; bf16_t* ddn; bf16_t* lt0;
    int t, tend, step_, par; bool pend; bf16_t* pdst;
    float4 a0, a1, b0, b1;
    static constexpr int NT1 = (N_EXP * 2 * F_EXPERT / 128) * (DM / 64), NT2 = (N_EXP * DM / 128) * (F_EXPERT / 64);
    __device__ __forceinline__ void load(int tl, int tid) {
        const int kl = tid >> 4, c = tid & 15; const float* s_; size_t ld;
        if (tl < NT1) { const int nt = tl >> 4, kt = tl & 15, n0 = nt * 128; const int e = n0 / (2 * F_EXPERT), unit0 = (n0 % (2 * F_EXPERT)) / 2 + (c >> 2) * 16 + (c & 1) * 8;
            ld = F_EXPERT; s_ = (const float*)((const char*)Wg + ((c & 2) ? dWu : 0l)) + (size_t)e * DM * F_EXPERT + unit0 + (size_t)(kt * 64 + kl) * ld; }
        else { const int t2 = tl - NT1, nt = t2 / (F_EXPERT / 64), kt = t2 - nt * (F_EXPERT / 64), n0 = nt * 128;
            ld = DM; s_ = Wd + (size_t)(n0 >> 10) * F_EXPERT * DM + (n0 & 1023) + 8 * c + (size_t)(kt * 64 + kl) * ld; }
        a0 = *(const float4*)s_; a1 = *(const float4*)(s_ + 4); b0 = *(const float4*)(s_ + 32 * ld); b1 = *(const float4*)(s_ + 32 * ld + 4);
    }
    __device__ __forceinline__ void init(const Params& p, int li, float* ldsf, int tid) {
        Wg = p.in[IN_MOE_WG] + (size_t)li * N_EXP * DM * F_EXPERT; const float* Wu = p.in[IN_MOE_WU] + (size_t)li * N_EXP * DM * F_EXPERT; dWu = (const char*)Wu - (const char*)Wg;
        Wd = p.in[IN_MOE_WD] + (size_t)li * N_EXP * F_EXPERT * DM; dgu = p.WguM; ddn = p.WdM; lt0 = (bf16_t*)ldsf;
        t = blockIdx.x; step_ = gridDim.x; tend = NT1 + NT2; par = 0; pend = false; pdst = dgu;
        if (t < tend) load(t, tid);
    }
    __device__ __forceinline__ void step(int tid) {
        const int kl = tid >> 4, c = tid & 15, rn = tid >> 2, rq = tid & 3;
        if (pend) { const bf16_t* lt = lt0 + (par ^ 1) * (128 * 72);
            const uint4 w0 = *(const uint4*)(lt + rn * 72 + rq * 16), w1 = *(const uint4*)(lt + rn * 72 + rq * 16 + 8);
            *(uint4*)pdst = w0; *(uint4*)(pdst + 8) = w1; }
        if (t < tend) {
            bf16_t* lt = lt0 + par * (128 * 72);
            const float va[8] = {a0.x, a0.y, a0.z, a0.w, a1.x, a1.y, a1.z, a1.w}, vb[8] = {b0.x, b0.y, b0.z, b0.w, b1.x, b1.y, b1.z, b1.w};
#pragma unroll
            for (int e = 0; e < 8; ++e) { lt[(8 * c + e) * 72 + kl] = f2bf(va[e]); lt[(8 * c + e) * 72 + kl + 32] = f2bf(vb[e]); }
            if (t < NT1) { const int nt = t >> 4, kt = t & 15; pdst = dgu + (size_t)(nt * 128 + rn) * DM + kt * 64 + rq * 16; }
            else { const int t2 = t - NT1, nt = t2 / (F_EXPERT / 64), kt = t2 - nt * (F_EXPERT / 64); pdst = ddn + (size_t)(nt * 128 + rn) * F_EXPERT + kt * 64 + rq * 16; }
            pend = true; t += step_;
            if (t < tend) load(t, tid);
        } else pend = false;
        par ^= 1;
    }
    __device__ __forceinline__ void finish(int tid) { while (pend || t < tend) { __syncthreads(); step(tid); } }
};

__device__ __forceinline__ void ph_kmean(const Params& p, float* lds) {
    const int tid = tid_(), ch = tid & 7, kg = tid >> 3;
    for (int item = blockIdx.x; item < 8 * 16 * 8; item += gridDim.x) {
        const int h = item & 7, blk = (item >> 3) & 15, b = item >> 7;
        float s[8] = {0.f, 0.f, 0.f, 0.f, 0.f, 0.f, 0.f, 0.f};
        uint4 kv[4];
#pragma unroll
        for (int j = 0; j < 4; ++j) kv[j] = *(const uint4*)(p.Pb + (size_t)(b * SEQ + blk * 256 + kg * 4 + j) * LDPB + O_CK + h * 64 + ch * 8);
#pragma unroll
        for (int j = 0; j < 4; ++j) {
            s[0] += __builtin_bit_cast(float, kv[j].x << 16); s[1] += __builtin_bit_cast(float, kv[j].x & 0xffff0000u);
            s[2] += __builtin_bit_cast(float, kv[j].y << 16); s[3] += __builtin_bit_cast(float, kv[j].y & 0xffff0000u);
            s[4] += __builtin_bit_cast(float, kv[j].z << 16); s[5] += __builtin_bit_cast(float, kv[j].z & 0xffff0000u);
            s[6] += __builtin_bit_cast(float, kv[j].w << 16); s[7] += __builtin_bit_cast(float, kv[j].w & 0xffff0000u);
        }
#pragma unroll
        for (int e = 0; e < 8; ++e) { s[e] += __shfl_xor(s[e], 8); s[e] += __shfl_xor(s[e], 16); s[e] += __shfl_xor(s[e], 32); }
        __syncthreads();
        if ((tid & 63) < 8) {
#pragma unroll
            for (int e = 0; e < 8; ++e) lds[(tid >> 6) * 64 + ch * 8 + e] = s[e];
        }
        __syncthreads();
        if (tid < 64) { float a = 0.f;
#pragma unroll
            for (int q = 0; q < 8; ++q) a += lds[q * 64 + tid];
            p.kmean[(size_t)item * 64 + tid] = a * (1.f / 256.f); }
    }
}

__device__ __forceinline__ void ph_cmp_build(const Params& p, int li) {
    const int tid = tid_();
    const long gs = (long)gridDim.x * NT;
    for (long idx0 = (long)blockIdx.x * NT + tid; idx0 < 2l * 4096 * 256; idx0 += 4 * gs) {
      pg8::u32x4 kvv[4];
#pragma unroll
      for (int u = 0; u < 4; ++u) {
        const long idx = (idx0 + u * gs < 2l * 4096 * 256) ? idx0 + u * gs : idx0;
        const int ch = (int)(idx & 255), m = (int)((idx >> 8) & 4095), which = (int)(idx >> 20);
        const int i = (m & 255) < 255 ? (m & 255) : 0, bg = m >> 8, b = bg >> 1, g = bg & 1, t = ch >> 3, d0 = (ch & 7) * 8;
        kvv[u] = *(const pg8::u32x4*)(p.Pb + (size_t)(b * SEQ + 16 * i + t) * LDPB + (which ? O_VC : O_KC) + g * 64 + d0);
      }
#pragma unroll
      for (int u = 0; u < 4; ++u) {
        const long idx = idx0 + u * gs;
        if (idx >= 2l * 4096 * 256) continue;
        const int ch = (int)(idx & 255), m = (int)((idx >> 8) & 4095), which = (int)(idx >> 20);
        const int i = m & 255, t = ch >> 3, d0 = (ch & 7) * 8;
        uint4 w = make_uint4(0u, 0u, 0u, 0u);
        if (i < 255) {
            uint4 kv; kv.x = kvv[u].x; kv.y = kvv[u].y; kv.z = kvv[u].z; kv.w = kvv[u].w;
            const float* pe = p.in[IN_NSA_PE] + (size_t)(li * 2 + which) * 2048 + t * 64 + d0;
            const float4 e0 = *(const float4*)pe, e1 = *(const float4*)(pe + 4);
            w.x = pk2(__builtin_bit_cast(float, kv.x << 16) + e0.x, __builtin_bit_cast(float, kv.x & 0xffff0000u) + e0.y);
            w.y = pk2(__builtin_bit_cast(float, kv.y << 16) + e0.z, __builtin_bit_cast(float, kv.y & 0xffff0000u) + e0.w);
            w.z = pk2(__builtin_bit_cast(float, kv.z << 16) + e1.x, __builtin_bit_cast(float, kv.z & 0xffff0000u) + e1.y);
            w.w = pk2(__builtin_bit_cast(float, kv.w << 16) + e1.z, __builtin_bit_cast(float, kv.w & 0xffff0000u) + e1.w);
        }
        *(uint4*)(p.Ac + ((size_t)(which * 4096 + m) * 2048 + ch * 8)) = w;
      }
    }
}

typedef unsigned u32x8v __attribute__((ext_vector_type(8)));
typedef float f32x16v __attribute__((ext_vector_type(16)));
__device__ __forceinline__ u32x8v ld_row8(const bf16_t* row, int lane) {
    const u32x2* r = (const u32x2*)row; const u32x2 a = r[lane], b = r[64 + lane], c = r[128 + lane], d = r[192 + lane];
    return (u32x8v){a.x, a.y, b.x, b.y, c.x, c.y, d.x, d.y};
}
__device__ __forceinline__ f32x16v ld_row16f(const float* row, int lane) {
    const float4* r = (const float4*)row; const float4 a = r[lane], b = r[64 + lane], c = r[128 + lane], d = r[192 + lane];
    return (f32x16v){a.x, a.y, a.z, a.w, b.x, b.y, b.z, b.w, c.x, c.y, c.z, c.w, d.x, d.y, d.z, d.w};
}
__device__ __forceinline__ float bf_el(const u32x8v v, int i) { const unsigned u = v[i >> 1]; return __builtin_bit_cast(float, (i & 1) ? (u & 0xffff0000u) : (u << 16)); }
__device__ __forceinline__ u32x8v ld_slot8(const Params& p, int slot_v, int lane) {
    const int slot = __builtin_amdgcn_readfirstlane(slot_v);
    if (slot < MOE_TAIL_T0 * 256) return ld_row8(p.Ys + (size_t)slot * DM, lane);
    u32x8v part[MOE_KSL];
#pragma unroll
    for (int sl = 0; sl < MOE_KSL; ++sl) part[sl] = ld_row8(p.Yp + ((size_t)sl * (MOE_TAIL_TILES * 256) + (slot - MOE_TAIL_T0 * 256)) * DM, lane);
    u32x8v o;
#pragma unroll
    for (int j = 0; j < 8; ++j) {
        float lo = 0.f, hi = 0.f;
#pragma unroll
        for (int sl = 0; sl < MOE_KSL; ++sl) { lo += __builtin_bit_cast(float, part[sl][j] << 16); hi += __builtin_bit_cast(float, part[sl][j] & 0xffff0000u); }
        o[j] = pk2(lo, hi);
    }
    return o;
}
template <int MODE, int XSRC>
__device__ __forceinline__ void ph_ln(const Params& p, const float* gam, const float* bet, const float* Xin, float* Xout, bf16_t* Xbout, const bool wf32) {
    const int lane = tid_() & 63, wid = tid_() >> 6;
    const int stride = gridDim.x * 8;
    int t = blockIdx.x * 8 + wid;
    if (t < NTOK) {
        f32x16v xf, xfn; u32x8v xb8, xbn, ya, yan, yb, ybn;
        int n0 = 0, n1 = 0;
#define LN_LOAD(tt, S0, S1, XF, XB, YA, YB) do { \
        if (XSRC == 0) XF = ld_row16f(Xin + (size_t)(tt) * DM, lane); else XB = ld_row8(Xbout + (size_t)(tt) * DM, lane); \
        if (MODE == 0) YA = ld_row8((const bf16_t*)p.Y + (size_t)(tt) * DM, lane); \
        else { YA = ld_slot8(p, S0, lane); YB = ld_slot8(p, S1, lane); } } while (0)
        {
            int s0 = 0, s1 = 0;
            if (MODE == 1) { s0 = p.tok_slot[2 * t]; s1 = p.tok_slot[2 * t + 1]; const int tn = (t + stride < NTOK) ? t + stride : t; n0 = p.tok_slot[2 * tn]; n1 = p.tok_slot[2 * tn + 1]; }
            LN_LOAD(t, s0, s1, xf, xb8, ya, yb);
        }
        for (; t < NTOK; t += stride) {
            const int tn = (t + stride < NTOK) ? t + stride : t;
            LN_LOAD(tn, n0, n1, xfn, xbn, yan, ybn);
            int m0 = 0, m1 = 0;
            if (MODE == 1) { const int t2 = (tn + stride < NTOK) ? tn + stride : tn; m0 = p.tok_slot[2 * t2]; m1 = p.tok_slot[2 * t2 + 1]; }
            f32x16v v; float s = 0.f;
#pragma unroll
            for (int c = 0; c < 4; ++c) {
#pragma unroll
                for (int e = 0; e < 4; ++e) {
                    const int i = c * 4 + e;
                    const float x = (XSRC == 0) ? xf[i] : bf_el(xb8, i);
                    const float y = (MODE == 0) ? bf_el(ya, i) : bf_el(ya, i) + bf_el(yb, i);
                    v[i] = ALPHA * x + y;
                }
                s += (v[c * 4] + v[c * 4 + 1]) + (v[c * 4 + 2] + v[c * 4 + 3]);
            }
            const float mu = wave_sum(s) * (1.f / 1024.f);
            float q = 0.f;
#pragma unroll
            for (int c = 0; c < 4; ++c) { const float a = v[c * 4] - mu, b2 = v[c * 4 + 1] - mu, c2 = v[c * 4 + 2] - mu, d2 = v[c * 4 + 3] - mu; q += (a * a + b2 * b2) + (c2 * c2 + d2 * d2); }
            const float var = wave_sum(q) * (1.f / 1024.f);
            const float rs = 1.0f / sqrtf(var + LN_EPS);
            u32x2* xb = (u32x2*)(Xbout + (size_t)t * DM); float4* xo = (float4*)(Xout + (size_t)t * DM);
#pragma unroll
            for (int c = 0; c < 4; ++c) {
                const float4 gg = ((const float4*)gam)[c * 64 + lane], bb = ((const float4*)bet)[c * 64 + lane];
                float4 o; o.x = (v[c * 4] - mu) * rs * gg.x + bb.x; o.y = (v[c * 4 + 1] - mu) * rs * gg.y + bb.y; o.z = (v[c * 4 + 2] - mu) * rs * gg.z + bb.z; o.w = (v[c * 4 + 3] - mu) * rs * gg.w + bb.w;
                if (wf32) xo[c * 64 + lane] = o;
                u32x2 w; w.x = pk2(o.x, o.y); w.y = pk2(o.z, o.w); xb[c * 64 + lane] = w;
            }
            xf = xfn; xb8 = xbn; ya = yan; yb = ybn; n0 = m0; n1 = m1;
        }
#undef LN_LOAD
    }
}

__device__ __forceinline__ void ph_ln_router(const Params& p, const float* gam, const float* bet, int li, float* lds) {
    const int tid = tid_(), lane = tid & 63, wid = tid >> 6;
    int* lcnt = (int*)lds;
    const float* wr = p.in[IN_MOE_WR] + (size_t)li * 1024 * 8;
    const float* br = p.in[IN_MOE_BR] + li * 8;
    for (int chunk = blockIdx.x; chunk < 256; chunk += gridDim.x) {
        __syncthreads();
        if (tid < 8) lcnt[tid] = 0;
        __syncthreads();
        u32x8v xb8 = ld_row8(p.Xb + (size_t)(chunk * 128 + wid * 16) * DM, lane), ya = ld_row8((const bf16_t*)p.Y + (size_t)(chunk * 128 + wid * 16) * DM, lane);
        for (int q = 0; q < 16; ++q) {
            const int t = chunk * 128 + wid * 16 + q;
            const int tn = (q < 15) ? t + 1 : t;
            const u32x8v xbn = ld_row8(p.Xb + (size_t)tn * DM, lane), yan = ld_row8((const bf16_t*)p.Y + (size_t)tn * DM, lane);
            float4 v[4]; float s = 0.f;
#pragma unroll
            for (int c = 0; c < 4; ++c) {
                v[c].x = ALPHA * bf_el(xb8, c * 4) + bf_el(ya, c * 4); v[c].y = ALPHA * bf_el(xb8, c * 4 + 1) + bf_el(ya, c * 4 + 1);
                v[c].z = ALPHA * bf_el(xb8, c * 4 + 2) + bf_el(ya, c * 4 + 2); v[c].w = ALPHA * bf_el(xb8, c * 4 + 3) + bf_el(ya, c * 4 + 3);
                s += (v[c].x + v[c].y) + (v[c].z + v[c].w);
            }
            xb8 = xbn; ya = yan;
            const float mu = wave_sum(s) * (1.f / 1024.f);
            float qq = 0.f;
#pragma unroll
            for (int c = 0; c < 4; ++c) { const float a = v[c].x - mu, b2 = v[c].y - mu, c2 = v[c].z - mu, d2 = v[c].w - mu; qq += (a * a + b2 * b2) + (c2 * c2 + d2 * d2); }
            const float var = wave_sum(qq) * (1.f / 1024.f);
            const float rs = 1.0f / sqrtf(var + LN_EPS);
            u32x2* xb = (u32x2*)(p.Xb + (size_t)t * DM);
            float a[8] = {0.f, 0.f, 0.f, 0.f, 0.f, 0.f, 0.f, 0.f};
#pragma unroll
            for (int c = 0; c < 4; ++c) {
                const float4 gg = ((const float4*)gam)[c * 64 + lane], bb = ((const float4*)bet)[c * 64 + lane];
                float4 o; o.x = (v[c].x - mu) * rs * gg.x + bb.x; o.y = (v[c].y - mu) * rs * gg.y + bb.y; o.z = (v[c].z - mu) * rs * gg.z + bb.z; o.w = (v[c].w - mu) * rs * gg.w + bb.w;
                u32x2 w; w.x = pk2(o.x, o.y); w.y = pk2(o.z, o.w); xb[c * 64 + lane] = w;
                const float ov[4] = {o.x, o.y, o.z, o.w};
                const float* wk = wr + (size_t)((c * 64 + lane) * 4) * 8;
#pragma unroll
                for (int j = 0; j < 4; ++j) { const float4 w0 = *(const float4*)(wk + j * 8), w1 = *(const float4*)(wk + j * 8 + 4);
                    a[0] += ov[j] * w0.x; a[1] += ov[j] * w0.y; a[2] += ov[j] * w0.z; a[3] += ov[j] * w0.w; a[4] += ov[j] * w1.x; a[5] += ov[j] * w1.y; a[6] += ov[j] * w1.z; a[7] += ov[j] * w1.w; }
            }
            {
                float b4[4], b2[2], b1;
                const bool up1 = lane & 1, up2 = lane & 2, up4 = lane & 4;
#pragma unroll
                for (int e = 0; e < 4; ++e) { const float keep = up1 ? a[e + 4] : a[e], send = up1 ? a[e] : a[e + 4]; b4[e] = keep + __shfl_xor(send, 1); }
#pragma unroll
                for (int e = 0; e < 2; ++e) { const float keep = up2 ? b4[e + 2] : b4[e], send = up2 ? b4[e] : b4[e + 2]; b2[e] = keep + __shfl_xor(send, 2); }
                { const float keep = up4 ? b2[1] : b2[0], send = up4 ? b2[0] : b2[1]; b1 = keep + __shfl_xor(send, 4); }
                b1 += __shfl_xor(b1, 8); b1 += __shfl_xor(b1, 16); b1 += __shfl_xor(b1, 32);
#pragma unroll
                for (int e = 0; e < 8; ++e) { const int src = ((e >> 2) & 1) | (e & 2) | ((e & 1) << 2); a[e] = __shfl(b1, src) + br[e]; }
            }
            int e1 = 0; float l1 = a[0];
#pragma unroll
            for (int e = 1; e < 8; ++e) if (a[e] > l1) { l1 = a[e]; e1 = e; }
            int e2 = -1; float l2 = -INFINITY;
#pragma unroll
            for (int e = 0; e < 8; ++e) if (e != e1 && a[e] > l2) { l2 = a[e]; e2 = e; }
            const float ex = expf(l2 - l1);
            if (lane == 0) {
                p.tok_e[2 * t] = e1; p.tok_e[2 * t + 1] = e2;
                p.tok_g[2 * t] = 1.f / (1.f + ex); p.tok_g[2 * t + 1] = ex / (1.f + ex);
                atomicAdd(&lcnt[e1], 1); atomicAdd(&lcnt[e2], 1);
            }
        }
        __syncthreads();
        if (tid < 8) p.chunk_cnt[chunk * 8 + tid] = lcnt[tid];
    }
}
__device__ __forceinline__ void ph_slots(const Params& p, float* lds) {
    const int tid = tid_();
    int* lbase = (int*)lds;
    int* lpad = lbase + 8;
    int* ltot = lpad + 16;
    int* lent = ltot + 8;
    int* lslot = lent + 256;
    for (int chunk = blockIdx.x; chunk < 256; chunk += gridDim.x) {
        __syncthreads();
        {
            int* lcc = lslot + 256;
            const int4 v4 = ((const int4*)p.chunk_cnt)[tid]; ((int4*)lcc)[tid] = v4;
            if (tid < 256) lent[tid] = p.tok_e[chunk * 256 + tid];
            __syncthreads();
            {
                const int e = tid >> 6, ln = tid & 63; int tot = 0, before = 0;
#pragma unroll
                for (int q = 0; q < 4; ++q) { const int cc = ln * 4 + q, v = lcc[cc * 8 + e]; tot += v; before += (cc < chunk) ? v : 0; }
#pragma unroll
                for (int o = 32; o >= 1; o >>= 1) { tot += __shfl_xor(tot, o); before += __shfl_xor(before, o); }
                if (ln == 0) { lbase[e] = before; ltot[e] = tot; }
            }
        }
        __syncthreads();
        if (tid == 0) { int acc = 0; for (int e = 0; e < 8; ++e) { lpad[e] = acc; acc += (ltot[e] + 255) / 256 * 256; } lpad[8] = acc; }
        __syncthreads();
        {
            int* lwc = lslot + 256 + 2048;
            const int wv = tid >> 6, ln = tid & 63;
            int my_e = -1, my_rank = 0;
            if (tid < 256) {
                my_e = lent[tid];
#pragma unroll
                for (int e = 0; e < 8; ++e) { const unsigned long long mb = __ballot(my_e == e); if (my_e == e) my_rank = lane_rank(mb); if (ln == 0) lwc[wv * 8 + e] = __popcll(mb); }
            }
            __syncthreads();
            if (tid < 256) { int r = lpad[my_e] + lbase[my_e] + my_rank; for (int q = 0; q < wv; ++q) r += lwc[q * 8 + my_e]; lslot[tid] = r; }
        }
        __syncthreads();
        if (tid < 256) {
            const int slot = lslot[tid], tk = chunk * 128 + (tid >> 1);
            p.slot_tok[slot] = tk; p.slot_gate[slot] = p.tok_g[chunk * 256 + tid]; p.tok_slot[chunk * 256 + tid] = slot;
        }
        if (gridDim.x != 256)
        for (int idx0 = tid; idx0 < 256 * 128; idx0 += 8 * NT) {
            pg8::u32x4 v[8];
#pragma unroll
            for (int u = 0; u < 8; ++u) { const int idx = idx0 + u * NT, e = idx >> 7, piece = idx & 127; v[u] = ((const pg8::u32x4*)p.Xb)[(size_t)(chunk * 128 + (e >> 1)) * 128 + piece]; }
#pragma unroll
            for (int u = 0; u < 8; ++u) { const int idx = idx0 + u * NT, e = idx >> 7, piece = idx & 127; ((pg8::u32x4*)p.Xs)[(size_t)lslot[e] * 128 + piece] = v[u]; }
        }
        if (chunk < 8) {
            const int s0 = lpad[chunk] + ltot[chunk], s1 = lpad[chunk + 1];
            if (gridDim.x != 256) for (int idx = tid; idx < (s1 - s0) * 128; idx += NT) ((uint4*)p.Xs)[(size_t)(s0 + (idx >> 7)) * 128 + (idx & 127)] = make_uint4(0u, 0u, 0u, 0u);
            for (int s = s0 + tid; s < s1; s += NT) { p.slot_tok[s] = -1; p.slot_gate[s] = 0.f; }
        }
        if (chunk == 8 && tid < NTILE256) {
            const int s0 = tid * 256; int e = -1;
            for (int q = 0; q < 8; ++q) if (s0 >= lpad[q] && s0 < lpad[q + 1]) e = q;
            p.tile_e[tid] = e;
        }
    }
}

typedef short bf16x8 __attribute__((ext_vector_type(8)));
typedef short s16x4 __attribute__((ext_vector_type(4)));
typedef __attribute__((address_space(3))) const unsigned char* lds_cptr;
__device__ __forceinline__ s16x4 vtr(lds_cptr p) { return __builtin_bit_cast(s16x4, __builtin_amdgcn_ds_read_tr16_b64_v4i16((__attribute__((address_space(3))) s16x4*)p)); }
__device__ __forceinline__ bf16x8 cat8(s16x4 lo, s16x4 hi) { bf16x8 r; r[0] = lo[0]; r[1] = lo[1]; r[2] = lo[2]; r[3] = lo[3]; r[4] = hi[0]; r[5] = hi[1]; r[6] = hi[2]; r[7] = hi[3]; return r; }
constexpr int AT_KP = 160;
template <int VD> struct AtL { static constexpr int VP = VD * 2 + 32, KB = 64 * AT_KP, VB = 64 * VP, BUF = KB + VB; };
constexpr float AT_SCALE2 = 0.125f * 1.4426950408889634f;

template <int VD> struct AtState {
    f32x4 o[2][VD / 16]; float m[2], l[2];
    __device__ __forceinline__ void init() {
#pragma unroll
        for (int g = 0; g < 2; ++g) { m[g] = -1e30f; l[g] = 0.f;
#pragma unroll
            for (int n = 0; n < VD / 16; ++n) o[g][n] = Z4_; }
    }
};
typedef float f32x2 __attribute__((ext_vector_type(2)));
__device__ __forceinline__ float max3f_(float a, float b, float c) { float r; asm("v_max3_f32 %0, %1, %2, %3" : "=v"(r) : "v"(a), "v"(b), "v"(c)); return r; }
__device__ __forceinline__ float max2f_(float a, float b) { float r; asm("v_max_f32_e32 %0, %1, %2" : "=v"(r) : "v"(a), "v"(b)); return r; }
__device__ __forceinline__ float xmax16(float v) { const unsigned u = __builtin_bit_cast(unsigned, v); const auto r = __builtin_amdgcn_permlane16_swap(u, u, false, false);
    return max2f_(__builtin_bit_cast(float, r[0]), __builtin_bit_cast(float, r[1])); }
__device__ __forceinline__ float xmax32(float v) { const unsigned u = __builtin_bit_cast(unsigned, v); const auto r = __builtin_amdgcn_permlane32_swap(u, u, false, false);
    return max2f_(__builtin_bit_cast(float, r[0]), __builtin_bit_cast(float, r[1])); }
template <int VD, int MODE, class RowOk, class Allow>
__device__ __forceinline__ void at_tile(AtState<VD>& st, lds_cptr Kb, lds_cptr Vb, const bf16x8 (&q)[2][2], int fr, int fq, RowOk rowok, Allow allow) {
    f32x4 s[2][4];
#pragma unroll
    for (int kk = 0; kk < 4; ++kk) {
        const bf16x8 kf0 = *(const __attribute__((address_space(3))) bf16x8*)(Kb + (16 * kk + fr) * AT_KP + fq * 16);
        const bf16x8 kf1 = *(const __attribute__((address_space(3))) bf16x8*)(Kb + (16 * kk + fr) * AT_KP + 64 + fq * 16);
#pragma unroll
        for (int g = 0; g < 2; ++g) s[g][kk] = __builtin_amdgcn_mfma_f32_16x16x32_bf16(kf0, q[g][0], (f32x4){0.f, 0.f, 0.f, 0.f}, 0, 0, 0);
#pragma unroll
        for (int g = 0; g < 2; ++g) s[g][kk] = __builtin_amdgcn_mfma_f32_16x16x32_bf16(kf1, q[g][1], s[g][kk], 0, 0, 0);
    }
    bf16x8 pf[2][2];
#pragma unroll
    for (int g = 0; g < 2; ++g) {
        float mloc = fmaxf(fmaxf(s[g][0][0], s[g][0][1]), s[g][0][2]);
        mloc = fmaxf(fmaxf(mloc, s[g][0][3]), s[g][1][0]);
        mloc = fmaxf(fmaxf(mloc, s[g][1][1]), s[g][1][2]);
        mloc = fmaxf(fmaxf(mloc, s[g][1][3]), s[g][2][0]);
        mloc = fmaxf(fmaxf(mloc, s[g][2][1]), s[g][2][2]);
        mloc = fmaxf(fmaxf(mloc, s[g][2][3]), s[g][3][0]);
        mloc = fmaxf(fmaxf(mloc, s[g][3][1]), s[g][3][2]);
        mloc = fmaxf(mloc, s[g][3][3]);
        mloc = xmax16(mloc); mloc = xmax32(mloc);
        float mn = max2f_(st.m[g], mloc * AT_SCALE2);
        float cadd;
        if (MODE & 1) { const bool ro = rowok(g); mn = ro ? mn : st.m[g]; cadd = ro ? -mn : -INFINITY; } else cadd = -mn;
        const float alpha = __builtin_amdgcn_exp2f(st.m[g] - mn);
        st.m[g] = mn;
        float ls = 0.f;
#pragma unroll
        for (int kk = 0; kk < 4; ++kk)
#pragma unroll
            for (int r = 0; r < 4; ++r) {
                float pv = __builtin_amdgcn_exp2f(__builtin_fmaf(s[g][kk][r], AT_SCALE2, cadd));
                if (MODE & 2) pv = allow(g, kk, r) ? pv : 0.f;
                if (MODE & 4) pv = __builtin_bit_cast(float, __builtin_bit_cast(int, pv) & allow(g, kk, r));
                s[g][kk][r] = pv; ls += pv;
            }
        st.l[g] = st.l[g] * alpha + ls;
#pragma unroll
        for (int n = 0; n < VD / 16; ++n) st.o[g][n] = st.o[g][n] * alpha;
#pragma unroll
        for (int sp = 0; sp < 2; ++sp) {
            const unsigned w0 = pk2(s[g][2 * sp][0], s[g][2 * sp][1]), w1 = pk2(s[g][2 * sp][2], s[g][2 * sp][3]);
            const unsigned w2 = pk2(s[g][2 * sp + 1][0], s[g][2 * sp + 1][1]), w3 = pk2(s[g][2 * sp + 1][2], s[g][2 * sp + 1][3]);
            pf[g][sp] = __builtin_bit_cast(bf16x8, (pg8::u32x4){w0, w1, w2, w3});
        }
    }
#pragma unroll
    for (int n = 0; n < VD / 16; ++n)
#pragma unroll
        for (int sp = 0; sp < 2; ++sp) {
            const lds_cptr vp = Vb + (32 * sp + 4 * fq + (fr >> 2)) * AtL<VD>::VP + (n * 16 + 4 * (fr & 3)) * 2;
            const bf16x8 vf = cat8(vtr(vp), vtr(vp + 16 * AtL<VD>::VP));
#pragma unroll
            for (int g = 0; g < 2; ++g) st.o[g][n] = __builtin_amdgcn_mfma_f32_16x16x32_bf16(vf, pf[g][sp], st.o[g][n], 0, 0, 0);
        }
}
template <int VD, int MODE, class RowOk, class Allow>
__device__ __forceinline__ void at_tile_sp(AtState<VD>& st, lds_cptr Kb, const bf16x8 (&q)[2][2], int fr, int fq, RowOk rowok, Allow allow, bf16x8 (&pf)[2][2]) {
    f32x4 s[2][4];
#pragma unroll
    for (int kk = 0; kk < 4; ++kk) {
        const bf16x8 kf0 = *(const __attribute__((address_space(3))) bf16x8*)(Kb + (16 * kk + fr) * AT_KP + fq * 16);
        const bf16x8 kf1 = *(const __attribute__((address_space(3))) bf16x8*)(Kb + (16 * kk + fr) * AT_KP + 64 + fq * 16);
#pragma unroll
        for (int g = 0; g < 2; ++g) s[g][kk] = __builtin_amdgcn_mfma_f32_16x16x32_bf16(kf0, q[g][0], (f32x4){0.f, 0.f, 0.f, 0.f}, 0, 0, 0);
#pragma unroll
        for (int g = 0; g < 2; ++g) s[g][kk] = __builtin_amdgcn_mfma_f32_16x16x32_bf16(kf1, q[g][1], s[g][kk], 0, 0, 0);
    }
#pragma unroll
    for (int g = 0; g < 2; ++g) {
        float mloc = fmaxf(fmaxf(s[g][0][0], s[g][0][1]), s[g][0][2]);
        mloc = fmaxf(fmaxf(mloc, s[g][0][3]), s[g][1][0]);
        mloc = fmaxf(fmaxf(mloc, s[g][1][1]), s[g][1][2]);
        mloc = fmaxf(fmaxf(mloc, s[g][1][3]), s[g][2][0]);
        mloc = fmaxf(fmaxf(mloc, s[g][2][1]), s[g][2][2]);
        mloc = fmaxf(fmaxf(mloc, s[g][2][3]), s[g][3][0]);
        mloc = fmaxf(fmaxf(mloc, s[g][3][1]), s[g][3][2]);
        mloc = fmaxf(mloc, s[g][3][3]);
        mloc = xmax16(mloc); mloc = xmax32(mloc);
        float mn = max2f_(st.m[g], mloc * AT_SCALE2);
        float cadd;
        if (MODE & 1) { const bool ro = rowok(g); mn = ro ? mn : st.m[g]; cadd = ro ? -mn : -INFINITY; } else cadd = -mn;
        const float alpha = __builtin_amdgcn_exp2f(st.m[g] - mn);
        st.m[g] = mn;
        float ls = 0.f;
#pragma unroll
        for (int kk = 0; kk < 4; ++kk)
#pragma unroll
            for (int r = 0; r < 4; ++r) {
                float pv = __builtin_amdgcn_exp2f(__builtin_fmaf(s[g][kk][r], AT_SCALE2, cadd));
                if (MODE & 2) pv = allow(g, kk, r) ? pv : 0.f;
                if (MODE & 4) pv = __builtin_bit_cast(float, __builtin_bit_cast(int, pv) & allow(g, kk, r));
                s[g][kk][r] = pv; ls += pv;
            }
        st.l[g] = st.l[g] * alpha + ls;
#pragma unroll
        for (int n = 0; n < VD / 16; ++n) st.o[g][n] = st.o[g][n] * alpha;
#pragma unroll
        for (int sp = 0; sp < 2; ++sp) {
            const unsigned w0 = pk2(s[g][2 * sp][0], s[g][2 * sp][1]), w1 = pk2(s[g][2 * sp][2], s[g][2 * sp][3]);
            const unsigned w2 = pk2(s[g][2 * sp + 1][0], s[g][2 * sp + 1][1]), w3 = pk2(s[g][2 * sp + 1][2], s[g][2 * sp + 1][3]);
            pf[g][sp] = __builtin_bit_cast(bf16x8, (pg8::u32x4){w0, w1, w2, w3});
        }
    }
}
template <int VD>
__device__ __forceinline__ void at_tile_pv(AtState<VD>& st, lds_cptr Vb, const bf16x8 (&pf)[2][2], int fr, int fq) {
#pragma unroll
    for (int n = 0; n < VD / 16; ++n)
#pragma unroll
        for (int sp = 0; sp < 2; ++sp) {
            const lds_cptr vp = Vb + (32 * sp + 4 * fq + (fr >> 2)) * AtL<VD>::VP + (n * 16 + 4 * (fr & 3)) * 2;
            const bf16x8 vf = cat8(vtr(vp), vtr(vp + 16 * AtL<VD>::VP));
#pragma unroll
            for (int g = 0; g < 2; ++g) st.o[g][n] = __builtin_amdgcn_mfma_f32_16x16x32_bf16(vf, pf[g][sp], st.o[g][n], 0, 0, 0);
        }
}
struct AtNoRow { __device__ __forceinline__ bool operator()(int) const { return true; } };
struct AtNoEl { __device__ __forceinline__ bool operator()(int, int, int) const { return true; } };
template <int VD> struct AtStage {
    pg8::u32x4 k, v[VD / 64];
    __device__ __forceinline__ void load(const bf16_t* kbase, const bf16_t* vbase, int key0, int tid) {
        const int row = tid >> 3, ch = tid & 7;
        k = *(const pg8::u32x4*)(kbase + (size_t)(key0 + row) * LDPB + ch * 8);
#pragma unroll
        for (int i = 0; i < VD / 64; ++i) v[i] = *(const pg8::u32x4*)(vbase + (size_t)(key0 + row) * LDPB + (ch + 8 * i) * 8);
    }
    __device__ __forceinline__ void store(LAS unsigned char* buf, int tid) const {
        const int row = tid >> 3, ch = tid & 7;
        *(LAS pg8::u32x4*)(buf + row * AT_KP + ch * 16) = k;
#pragma unroll
        for (int i = 0; i < VD / 64; ++i) *(LAS pg8::u32x4*)(buf + AtL<VD>::KB + row * AtL<VD>::VP + (ch + 8 * i) * 16) = v[i];
    }
};
template <int VD>
__device__ __forceinline__ void at_finish(AtState<VD>& st) {
#pragma unroll
    for (int g = 0; g < 2; ++g) { float l = st.l[g]; l += __shfl_xor(l, 16); l += __shfl_xor(l, 32); st.l[g] = l; }
}


template <int VD> struct AtStageP {
    pg8::u32x4 k, v[VD / 64];
    __device__ __forceinline__ void load(const bf16_t* kbase, const bf16_t* vbase, int pitch, int key0, int tid) {
        const int row = tid >> 3, ch = tid & 7;
        k = *(const pg8::u32x4*)(kbase + (size_t)(key0 + row) * pitch + ch * 8);
#pragma unroll
        for (int i = 0; i < VD / 64; ++i) v[i] = *(const pg8::u32x4*)(vbase + (size_t)(key0 + row) * pitch + (ch + 8 * i) * 8);
    }
    __device__ __forceinline__ void store(LAS unsigned char* buf, int tid) const {
        const int row = tid >> 3, ch = tid & 7;
        *(LAS pg8::u32x4*)(buf + row * AT_KP + ch * 16) = k;
#pragma unroll
        for (int i = 0; i < VD / 64; ++i) *(LAS pg8::u32x4*)(buf + AtL<VD>::KB + row * AtL<VD>::VP + (ch + 8 * i) * 16) = v[i];
    }
    __device__ __forceinline__ void store2(LAS unsigned char* kbuf, LAS unsigned char* vbuf, int tid) const {
        const int row = tid >> 3, ch = tid & 7;
        *(LAS pg8::u32x4*)(kbuf + row * AT_KP + ch * 16) = k;
#pragma unroll
        for (int i = 0; i < VD / 64; ++i) *(LAS pg8::u32x4*)(vbuf + row * AtL<VD>::VP + (ch + 8 * i) * 16) = v[i];
    }
};
template <int VD, class SpFn>
__device__ __forceinline__ void at_run_pp(LAS unsigned char* lds, AtState<VD>& st, const bf16_t* kbase, const bf16_t* vbase, int pitch, int tile_lo, int tile_hi, int tid, int fr, int fq, SpFn sp) {
    if (tile_lo >= tile_hi) return;
    const bool late = tid >= 256;
    AtStageP<VD> sg; sg.load(kbase, vbase, pitch, tile_lo * 64, tid);
    __syncthreads();
    bf16x8 pf[2][2];
    lds_cptr vprev = (lds_cptr)lds; bool have = false; int vi = 0;
    for (int i = tile_lo; i < tile_hi; ++i) {
        LAS unsigned char* kbuf = lds + ((i - tile_lo) & 1) * AtL<VD>::KB;
        LAS unsigned char* vbuf = lds + 2 * AtL<VD>::KB + vi * AtL<VD>::VB;
        sg.store2(kbuf, vbuf, tid);
        __syncthreads();
        if (i + 1 < tile_hi) sg.load(kbase, vbase, pitch, (i + 1) * 64, tid);
        if (late) {
            if (have) at_tile_pv<VD>(st, vprev, pf, fr, fq);
            sp(i, (lds_cptr)kbuf, pf);
            vprev = (lds_cptr)vbuf; have = true;
        } else {
            sp(i, (lds_cptr)kbuf, pf);
            at_tile_pv<VD>(st, (lds_cptr)vbuf, pf, fr, fq);
        }
        vi = (vi == 2) ? 0 : vi + 1;
    }
    if (late && have) at_tile_pv<VD>(st, vprev, pf, fr, fq);
}
template <int VD, class Fn>
__device__ __forceinline__ void at_run(LAS unsigned char* lds, const bf16_t* kbase, const bf16_t* vbase, int pitch, int tile_lo, int tile_hi, int tid, Fn fn) {
    if (tile_lo >= tile_hi) return;
    AtStageP<VD> sg; sg.load(kbase, vbase, pitch, tile_lo * 64, tid);
    __syncthreads();
    for (int i = tile_lo; i < tile_hi; ++i) {
        LAS unsigned char* buf = lds + ((i - tile_lo) & 1) * AtL<VD>::BUF;
        sg.store(buf, tid);
        __syncthreads();
        if (i + 1 < tile_hi) sg.load(kbase, vbase, pitch, (i + 1) * 64, tid);
        fn(i, (lds_cptr)buf, (lds_cptr)buf + AtL<VD>::KB);
    }
}
template <int VD, class Fn>
__device__ __forceinline__ void at_run_side(LAS unsigned char* lds, const bf16_t* kbase, const bf16_t* vbase, int pitch, int tile_lo, int tile_hi, int tid, CvJob& job, Fn fn) {
    if (tile_lo >= tile_hi) return;
    AtStageP<VD> sg; sg.load(kbase, vbase, pitch, tile_lo * 64, tid);
    __syncthreads();
    for (int i = tile_lo; i < tile_hi; ++i) {
        LAS unsigned char* buf = lds + ((i - tile_lo) & 1) * AtL<VD>::BUF;
        sg.store(buf, tid);
        __syncthreads();
        job.step(tid);
        if (i + 1 < tile_hi) sg.load(kbase, vbase, pitch, (i + 1) * 64, tid);
        fn(i, (lds_cptr)buf, (lds_cptr)buf + AtL<VD>::KB);
    }
}
template <int VD>
__device__ __forceinline__ void at_scores(f32x4 (&s)[2][4], lds_cptr Kb, const bf16x8 (&q)[2][2], int fr, int fq) {
#pragma unroll
    for (int kk = 0; kk < 4; ++kk) {
        const bf16x8 kf0 = *(const __attribute__((address_space(3))) bf16x8*)(Kb + (16 * kk + fr) * AT_KP + fq * 16);
        const bf16x8 kf1 = *(const __attribute__((address_space(3))) bf16x8*)(Kb + (16 * kk + fr) * AT_KP + 64 + fq * 16);
#pragma unroll
        for (int g = 0; g < 2; ++g) s[g][kk] = __builtin_amdgcn_mfma_f32_16x16x32_bf16(kf0, q[g][0], (f32x4){0.f, 0.f, 0.f, 0.f}, 0, 0, 0);
#pragma unroll
        for (int g = 0; g < 2; ++g) s[g][kk] = __builtin_amdgcn_mfma_f32_16x16x32_bf16(kf1, q[g][1], s[g][kk], 0, 0, 0);
    }
}

__device__ __forceinline__ void ph_diff_mfma(const Params& p, LAS unsigned char* lds, int li) {
    const int tid = tid_(), lane = tid & 63, w = tid >> 6, fr = lane & 15, fq = lane >> 4;
    const int G = gridDim.x, c = blockIdx.x;
    const float* lp = p.in[IN_DIF_LAMBDA] + li * 256;
    const float d01 = wave_sum(lp[lane] * lp[64 + lane]), d23 = wave_sum(lp[128 + lane] * lp[192 + lane]);
    const float lam_init = li ? p.lam_init[1] : p.lam_init[0];
    const float lam = expf(d01) - expf(d23) + lam_init;
    const float* subln = p.in[IN_DIF_SUBLN] + li * 128;
    LAS unsigned* oal = (LAS unsigned*)(lds + 2 * AtL<128>::BUF) + w * 2048 + lane;
    for (int L = c; L < 512; L += G) {
        int qb, b, h;
        if (G == 256) { const int rnd = L >> 8, x = c & 7, j = c >> 3; b = x; h = j >> 3; qb = rnd ? 15 - (j & 7) : (j & 7); }
        else { const int rnd = L / G; const int u = ((rnd & 1) && (512 % G == 0)) ? rnd * G + (G - 1 - (L - rnd * G)) : L; qb = u & 15; h = (u >> 4) & 3; b = u >> 6; }
        const bf16_t* vbase = p.Pb + (size_t)b * SEQ * LDPB + E_AV + h * 128;
        const int t0 = qb * 256 + w * 32;
#pragma unroll 1
        for (int jm = 0; jm < 2; ++jm) {
            const int hj = 2 * h + jm;
            const bf16_t* kbase = p.Pb + (size_t)b * SEQ * LDPB + E_AK + hj * 64;
            bf16x8 q[2][2];
#pragma unroll
            for (int g = 0; g < 2; ++g)
#pragma unroll
                for (int ks = 0; ks < 2; ++ks) q[g][ks] = *(const bf16x8*)(p.Pb + (size_t)(b * SEQ + t0 + g * 16 + fr) * LDPB + E_AQ + hj * 64 + ks * 32 + fq * 8);
            AtState<128> st; st.init();
            at_run<128>(lds, kbase, vbase, LDPB, 0, 4 * qb + 4, tid, [&](int i, lds_cptr Kb, lds_cptr Vb) {
                const int key0 = i * 64;
                if (key0 <= t0 + 31) {
                    if (key0 + 63 <= t0) at_tile<128, 0>(st, Kb, Vb, q, fr, fq, AtNoRow(), AtNoEl());
                    else { const int tq0 = t0 + fr - key0 - 4 * fq; at_tile<128, 2>(st, Kb, Vb, q, fr, fq, AtNoRow(), [=](int g, int kk, int r) { return 16 * kk + r <= tq0 + g * 16; }); }
                }
            });
            at_finish(st);
            if (jm == 0) {
#pragma unroll
                for (int g = 0; g < 2; ++g) { const float inv = 1.f / st.l[g];
#pragma unroll
                    for (int n = 0; n < 8; ++n) { const f32x4 o = st.o[g][n] * inv; oal[((g * 8 + n) * 2) * 64] = pk2(o[0], o[1]); oal[((g * 8 + n) * 2 + 1) * 64] = pk2(o[2], o[3]); } }
            } else {
#pragma unroll
                for (int g = 0; g < 2; ++g) { const float inv = 1.f / st.l[g];
                    float ss = 0.f;
#pragma unroll
                    for (int n = 0; n < 8; ++n) {
                        const f32x4 ob = st.o[g][n] * inv;
                        const unsigned b01 = pk2(ob[0], ob[1]), b23 = pk2(ob[2], ob[3]);
                        const unsigned a01 = oal[((g * 8 + n) * 2) * 64], a23 = oal[((g * 8 + n) * 2 + 1) * 64];
                        f32x4 r;
                        r[0] = __builtin_bit_cast(float, a01 << 16) - lam * __builtin_bit_cast(float, b01 << 16);
                        r[1] = __builtin_bit_cast(float, a01 & 0xffff0000u) - lam * __builtin_bit_cast(float, b01 & 0xffff0000u);
                        r[2] = __builtin_bit_cast(float, a23 << 16) - lam * __builtin_bit_cast(float, b23 << 16);
                        r[3] = __builtin_bit_cast(float, a23 & 0xffff0000u) - lam * __builtin_bit_cast(float, b23 & 0xffff0000u);
                        st.o[g][n] = r;
                        ss += (r[0] * r[0] + r[1] * r[1]) + (r[2] * r[2] + r[3] * r[3]);
                    }
                    ss += __shfl_xor(ss, 16); ss += __shfl_xor(ss, 32);
                    const float sc = (1.0f / sqrtf(ss * (1.f / 128.f) + LN_EPS)) * (1.f - lam_init);
                    bf16_t* dst = p.Ob + (size_t)(b * SEQ + t0 + g * 16 + fr) * DM + h * 128 + 4 * fq;
#pragma unroll
                    for (int n = 0; n < 8; ++n) { const float4 sw = *(const float4*)(subln + n * 16 + 4 * fq); const f32x4 r = st.o[g][n];
                        u32x2 wv; wv.x = pk2(r[0] * sc * sw.x, r[1] * sc * sw.y); wv.y = pk2(r[2] * sc * sw.z, r[3] * sc * sw.w); *(u32x2*)(dst + n * 16) = wv; }
                }
            }
        }
    }
}

__device__ __forceinline__ float quad_xor1(float x) { return __builtin_bit_cast(float, __builtin_amdgcn_update_dpp(0, __builtin_bit_cast(int, x), 0xB1, 0xf, 0xf, false)); }
__device__ __forceinline__ float quad_xor2(float x) { return __builtin_bit_cast(float, __builtin_amdgcn_update_dpp(0, __builtin_bit_cast(int, x), 0x4E, 0xf, 0xf, false)); }
__device__ __forceinline__ void ph_moba_mfma(const Params& p, LAS unsigned char* lds, int li) {
    const int tid = tid_(), lane = tid & 63, w = tid >> 6, fr = lane & 15, fq = lane >> 4;
    CvJob job; job.init(p, li, (float*)((unsigned char*)lds + 65536), tid);
    const int G = gridDim.x, c = blockIdx.x;
    LAS unsigned* lmask = (LAS unsigned*)(lds + 40960);
#define MB_E(k, isb, qbv) ((unsigned long long)(((isb) << 4) | (qbv)) << (5 * (k)))
    unsigned long long code = 0ull; int nun = 0, sA = 0, sB = 0;
    if (G == 256) {
        if (c < 32) { sA = c; nun = 3; code = MB_E(0, 0, 15) | MB_E(1, 0, 8) | MB_E(2, 0, 1); }
        else {
            const int c2 = c - 32, pidx = c2 / 7, grp = c2 - pidx * 7; sA = pidx; sB = pidx + 32;
            if (grp == 0) { nun = 3; code = MB_E(0, 1, 15) | MB_E(1, 1, 14) | MB_E(2, 0, 4); }
            else if (grp == 1) { nun = 3; code = MB_E(0, 0, 14) | MB_E(1, 0, 13) | MB_E(2, 1, 6); }
            else if (grp == 2) { nun = 3; code = MB_E(0, 1, 13) | MB_E(1, 1, 12) | MB_E(2, 1, 8); }
            else if (grp == 3) { nun = 3; code = MB_E(0, 0, 12) | MB_E(1, 0, 11) | MB_E(2, 0, 10); }
            else if (grp == 4) { nun = 4; code = MB_E(0, 1, 11) | MB_E(1, 1, 10) | MB_E(2, 0, 7) | MB_E(3, 0, 3); }
            else if (grp == 5) { nun = 4; code = MB_E(0, 0, 9) | MB_E(1, 1, 9) | MB_E(2, 1, 7) | MB_E(3, 0, 6); }
            else { nun = 9; code = MB_E(0, 0, 5) | MB_E(1, 1, 5) | MB_E(2, 1, 4) | MB_E(3, 1, 3) | MB_E(4, 0, 2) | MB_E(5, 1, 2) | MB_E(6, 1, 1) | MB_E(7, 0, 0) | MB_E(8, 1, 0); }
        }
    } else nun = (c < 1024) ? (1024 - c + G - 1) / G : 0;
#undef MB_E
    for (int ui = 0; ui < nun; ++ui) {
        int qb, stream;
        if (G == 256) { const int e = (int)(code >> (5 * ui)) & 31; stream = (e & 16) ? sB : sA; qb = e & 15; }
        else { const int L = c + ui * G; const int rnd = L / G; const int u = ((rnd & 1) && (1024 % G == 0)) ? rnd * G + (G - 1 - (L - rnd * G)) : L; qb = u & 15; stream = u >> 4; }
        const int h = stream & 7, b = stream >> 3;
        const bf16_t* kbase = p.Pb + (size_t)b * SEQ * LDPB + O_CK + h * 64;
        const bf16_t* vbase = p.Pb + (size_t)b * SEQ * LDPB + O_CV + h * 64;
        const int t0 = qb * 256 + w * 32;
        bf16x8 q[2][2];
#pragma unroll
        for (int g = 0; g < 2; ++g)
#pragma unroll
            for (int ks = 0; ks < 2; ++ks) q[g][ks] = *(const bf16x8*)(p.Pb + (size_t)(b * SEQ + t0 + g * 16 + fr) * LDPB + O_CQ + h * 64 + ks * 32 + fq * 8);
        unsigned msk[2];
        {
            bf16x8 kmf[2];
#pragma unroll
            for (int ks = 0; ks < 2; ++ks) { const float* km = p.kmean + (size_t)((b * 16 + fr) * 8 + h) * 64 + ks * 32 + fq * 8;
                const float4 a0 = *(const float4*)km, a1 = *(const float4*)(km + 4);
                kmf[ks] = __builtin_bit_cast(bf16x8, (pg8::u32x4){pk2(a0.x, a0.y), pk2(a0.z, a0.w), pk2(a1.x, a1.y), pk2(a1.z, a1.w)}); }
            LAS float* lg = (LAS float*)(lds + 40960) + w * 512;
#pragma unroll
            for (int g = 0; g < 2; ++g) {
                f32x4 gs = Z4_;
                gs = __builtin_amdgcn_mfma_f32_16x16x32_bf16(kmf[0], q[g][0], gs, 0, 0, 0);
                gs = __builtin_amdgcn_mfma_f32_16x16x32_bf16(kmf[1], q[g][1], gs, 0, 0, 0);
                *(LAS f32x4*)(lg + (g * 16 + fr) * 16 + 4 * fq) = gs;
            }
#pragma unroll
            for (int g = 0; g < 2; ++g) {
                float gv[16];
#pragma unroll
                for (int c4 = 0; c4 < 4; ++c4) { const f32x4 t4 = *(const LAS f32x4*)(lg + (g * 16 + fr) * 16 + 4 * c4);
#pragma unroll
                    for (int e = 0; e < 4; ++e) gv[4 * c4 + e] = (4 * c4 + e < qb) ? t4[e] : -INFINITY; }
                unsigned m = 0u;
#pragma unroll
                for (int pick = 0; pick < 3; ++pick) {
                    float best = -INFINITY; int bi = -1;
#pragma unroll
                    for (int n = 0; n < 16; ++n) if (gv[n] > best) { best = gv[n]; bi = n; }
                    if (bi >= 0) m |= 1u << bi;
#pragma unroll
                    for (int n = 0; n < 16; ++n) gv[n] = (n == bi) ? -INFINITY : gv[n];
                }
                msk[g] = m;
            }
        }
        AtState<64> st; st.init();
        at_run_side<64>(lds, kbase, vbase, LDPB, 0, 4 * qb + 4, tid, job, [&](int i, lds_cptr Kb, lds_cptr Vb) {
            const int n = i >> 2, key0 = i * 64;
            if (n < qb) {
                const bool b0 = (msk[0] >> n) & 1u, b1 = (msk[1] >> n) & 1u;
                at_tile<64, 1>(st, Kb, Vb, q, fr, fq, [=](int g) { return g ? b1 : b0; }, AtNoEl());
            } else if (key0 <= t0 + 31) {
                const int tq0 = t0 + fr - key0 - 4 * fq;
                if (key0 + 63 <= t0) at_tile<64, 0>(st, Kb, Vb, q, fr, fq, AtNoRow(), AtNoEl());
                else at_tile<64, 2>(st, Kb, Vb, q, fr, fq, AtNoRow(), [=](int g, int kk, int r) { return 16 * kk + r <= tq0 + g * 16; });
            }
        });
        at_finish(st);
#pragma unroll
        for (int g = 0; g < 2; ++g) { const float inv = 1.f / st.l[g]; bf16_t* dst = p.Ob + (size_t)(b * SEQ + t0 + g * 16 + fr) * DM + h * 64 + 4 * fq;
#pragma unroll
            for (int n = 0; n < 4; ++n) { const f32x4 o = st.o[g][n] * inv; u32x2 wv; wv.x = pk2(o[0], o[1]); wv.y = pk2(o[2], o[3]); *(u32x2*)(dst + n * 16) = wv; } }
    }
    job.finish(tid);
}

__device__ __forceinline__ void ph_nsa_mfma(const Params& p, LAS unsigned char* lds, const bf16_t* cmpkb, const bf16_t* cmpvb) {
    const int tid = tid_(), lane = tid & 63, w = tid >> 6, fr = lane & 15, fq = lane >> 4;
    const int G = gridDim.x, c = blockIdx.x;
    LAS float* impA = (LAS float*)(lds + 40960) + w * 1024;
    LAS float* impB = impA + 512;
    LAS unsigned long long* selm = (LAS unsigned long long*)(lds + 73728) + w * 8;
    static_assert(2 * AtL<64>::BUF <= 40960, "NSA LDS map");
    for (int L = c; L < 1024; L += G) {
        int qb, stream;
        if (G == 256) { const int rnd = L >> 8, x = c & 7, j = c >> 3;
            stream = 2 * x + (rnd >> 1); qb = (rnd & 1) ? 63 - j : j; }
        else { const int rnd = L / G; const int u = ((rnd & 1) && (1024 % G == 0)) ? rnd * G + (G - 1 - (L - rnd * G)) : L; qb = u & 63; stream = u >> 6; }
        const int grp = stream & 1, b = stream >> 1;
        const int tw = qb * 64 + w * 8;
#define TQ(g) (tw + (g) * 4 + (fr >> 2))
#define TOKG(g) (b * SEQ + TQ(g))
        bf16x8 qraw[2][2];
#pragma unroll
        for (int g = 0; g < 2; ++g) {
            const int head = grp * 4 + (fr & 3);
#pragma unroll
            for (int ks = 0; ks < 2; ++ks) qraw[g][ks] = *(const bf16x8*)(p.Pb + (size_t)TOKG(g) * LDPB + O_DQ + head * 64 + ks * 32 + fq * 8);
        }
        LAS float* accl = (LAS float*)(lds + 75776) + w * 2048 + lane;
        const bf16_t* ck = cmpkb + (size_t)(b * 2 + grp) * 256 * 64; const bf16_t* cv = cmpvb + (size_t)(b * 2 + grp) * 256 * 64;
        int nv[2];
#pragma unroll
        for (int g = 0; g < 2; ++g) nv[g] = (TQ(g) >= 31) ? ((TQ(g) - 31) >> 4) + 1 : 0;
        const int nvmax_w = (tw + 7 >= 31) ? ((tw + 7 - 31) >> 4) + 1 : 0;
        const int nvmax_b = (qb * 64 + 63 >= 31) ? ((qb * 64 + 63 - 31) >> 4) + 1 : 0;
        const int ncmp_tiles = (nvmax_b + 63) >> 6;
        float mfin[2], linv[2];
        {
            AtState<64> st; st.init();
            at_run<64>(lds, ck, cv, 64, 0, ncmp_tiles, tid, [&](int i, lds_cptr Kb, lds_cptr Vb) {
                if (i * 64 < nvmax_w) { const int n0 = nv[0] - i * 64, n1 = nv[1] - i * 64;
                    at_tile<64, 2>(st, Kb, Vb, qraw, fr, fq, AtNoRow(), [=](int g, int kk, int r) { return 16 * kk + 4 * fq + r < (g ? n1 : n0); }); }
            });
            at_finish(st);
#pragma unroll
            for (int g = 0; g < 2; ++g) { mfin[g] = st.m[g]; linv[g] = st.l[g] > 0.f ? 1.f / st.l[g] : 0.f;
#pragma unroll
                for (int n = 0; n < 4; ++n) { const f32x4 o = st.o[g][n] * (linv[g] * p.GATES[(size_t)TOKG(g) * 24 + (grp * 4 + (fr & 3)) * 3]);
#pragma unroll
                    for (int r = 0; r < 4; ++r) accl[((g * 4 + n) * 4 + r) * 64] = o[r]; } }
        }
        for (int e = lane; e < 512; e += 64) { impA[e] = 0.f; impB[e] = 0.f; }
        at_run<64>(lds, ck, cv, 64, 0, ncmp_tiles, tid, [&](int i, lds_cptr Kb, lds_cptr) {
            if (i * 64 < nvmax_w) {
                f32x4 s[2][4]; at_scores<64>(s, Kb, qraw, fr, fq);
#pragma unroll
                for (int g = 0; g < 2; ++g)
#pragma unroll
                    for (int kk = 0; kk < 4; ++kk) {
                        float a = 0.f, last = 0.f;
#pragma unroll
                        for (int r = 0; r < 4; ++r) { const int n = i * 64 + 16 * kk + 4 * fq + r;
                            const float pv = (n < nv[g]) ? __builtin_amdgcn_exp2f(s[g][kk][r] * AT_SCALE2 - mfin[g]) * linv[g] : 0.f; a += pv; last = pv; }
                        a += quad_xor1(a); a += quad_xor2(a); last += quad_xor1(last); last += quad_xor2(last);
                        const int j = 16 * i + 4 * kk + fq, qi = g * 4 + (fr >> 2);
                        if ((fr & 3) == 0) { impA[qi * 64 + j] = a; if (j + 1 < 64) impB[qi * 64 + j + 1] = last; }
                    }
            }
        });
        {
            unsigned key[8], T[8];
#pragma unroll
            for (int qi = 0; qi < 8; ++qi) {
                const float imp = impA[qi * 64 + lane] + impB[qi * 64 + lane];
                const bool causal = lane <= qb, forced = (lane == 0) || (lane >= qb - 1 && causal);
                const float val = forced ? 1e30f : (causal ? imp : -1e30f);
                const unsigned u = __builtin_bit_cast(unsigned, val);
                key[qi] = (u & 0x80000000u) ? ~u : (u | 0x80000000u); T[qi] = 0u;
            }
#pragma nounroll
            for (int bit = 31; bit >= 0; --bit) {
#pragma unroll
                for (int qi = 0; qi < 8; ++qi) { const unsigned cand = T[qi] | (1u << bit); if (__popcll(__ballot(key[qi] >= cand)) >= 16) T[qi] = cand; }
            }
#pragma unroll
            for (int qi = 0; qi < 8; ++qi) {
                const bool gt = key[qi] > T[qi], eq = key[qi] == T[qi];
                const unsigned long long meq = __ballot(eq);
                const int need = 16 - __popcll(__ballot(gt));
                const unsigned long long mk = __ballot(gt || (eq && lane_rank(meq) < need));
                if (lane == 0) selm[qi] = mk;
            }
        }
        unsigned long long sm[2];
#pragma unroll
        for (int g = 0; g < 2; ++g) sm[g] = selm[g * 4 + (fr >> 2)];
        bf16x8 qrot[2][2];
#pragma unroll
        for (int g = 0; g < 2; ++g)
#pragma unroll
            for (int ks = 0; ks < 2; ++ks) qrot[g][ks] = *(const bf16x8*)(p.QRb + (size_t)TOKG(g) * 512 + (grp * 4 + (fr & 3)) * 64 + ks * 32 + fq * 8);
        {
            const bf16_t* kb = p.Pb + (size_t)b * SEQ * LDPB + O_KS + grp * 64; const bf16_t* vb = p.Pb + (size_t)b * SEQ * LDPB + O_VS + grp * 64;
            AtState<64> st; st.init();
            at_run<64>(lds, kb, vb, LDPB, 0, qb + 1, tid, [&](int i, lds_cptr Kb, lds_cptr Vb) {
                const bool b0 = (sm[0] >> i) & 1ull, b1 = (sm[1] >> i) & 1ull;
                { const int d0 = TQ(0) - i * 64, d1 = TQ(1) - i * 64;
                    if (i < qb) at_tile<64, 1>(st, Kb, Vb, qrot, fr, fq, [=](int g) { return g ? b1 : b0; }, AtNoEl());
                    else at_tile<64, 3>(st, Kb, Vb, qrot, fr, fq, [=](int g) { return g ? b1 : b0; }, [=](int g, int kk, int r) { return 16 * kk + 4 * fq + r <= (g ? d1 : d0); }); }
            });
            at_finish(st);
#pragma unroll
            for (int g = 0; g < 2; ++g) { const float sc = p.GATES[(size_t)TOKG(g) * 24 + (grp * 4 + (fr & 3)) * 3 + 1] / st.l[g];
#pragma unroll
                for (int n = 0; n < 4; ++n)
#pragma unroll
                    for (int r = 0; r < 4; ++r) accl[((g * 4 + n) * 4 + r) * 64] += st.o[g][n][r] * sc; }
        }
        {
            const bf16_t* kb = p.Pb + (size_t)b * SEQ * LDPB + O_KW + grp * 64; const bf16_t* vb = p.Pb + (size_t)b * SEQ * LDPB + O_VW + grp * 64;
            AtState<64> st; st.init();
            at_run<64>(lds, kb, vb, LDPB, (qb >= 8 ? qb - 8 : 0), qb + 1, tid, [&](int i, lds_cptr Kb, lds_cptr Vb) {
                const int d0 = TQ(0) - i * 64 - 4 * fq, d1 = TQ(1) - i * 64 - 4 * fq;
                if (i == qb || (qb >= 8 && i == qb - 8)) {
                    const int hi0 = (i == qb) ? d0 : 64, hi1 = (i == qb) ? d1 : 64, lo0 = (i == qb) ? -1 : d0 - 512, lo1 = (i == qb) ? -1 : d1 - 512;
                    at_tile<64, 2>(st, Kb, Vb, qrot, fr, fq, AtNoRow(), [=](int g, int kk, int r) { const int kx = 16 * kk + r; return kx <= (g ? hi1 : hi0) && kx > (g ? lo1 : lo0); });
                } else at_tile<64, 0>(st, Kb, Vb, qrot, fr, fq, AtNoRow(), AtNoEl());
            });
            at_finish(st);
#pragma unroll
            for (int g = 0; g < 2; ++g) { const float sc = p.GATES[(size_t)TOKG(g) * 24 + (grp * 4 + (fr & 3)) * 3 + 2] / st.l[g];
                bf16_t* dst = p.Ob + (size_t)TOKG(g) * DM + 512 + (grp * 4 + (fr & 3)) * 64 + 4 * fq;
#pragma unroll
                for (int n = 0; n < 4; ++n) { f32x4 o;
#pragma unroll
                    for (int r = 0; r < 4; ++r) o[r] = accl[((g * 4 + n) * 4 + r) * 64] + st.o[g][n][r] * sc;
                    u32x2 wv; wv.x = pk2(o[0], o[1]); wv.y = pk2(o[2], o[3]); *(u32x2*)(dst + n * 16) = wv; } }
        }
    }
#undef TQ
#undef TOKG
}

__device__ __forceinline__ unsigned pk_cnt_gt(unsigned acc, unsigned h, unsigned cm1, unsigned one2) {
    unsigned d;
    asm("v_pk_sub_u16 %0, %1, %2 clamp" : "=v"(d) : "v"(h), "v"(cm1));
    asm("v_pk_min_u16 %0, %1, %2" : "=v"(d) : "v"(d), "v"(one2));
    asm("v_pk_add_u16 %0, %1, %2" : "=v"(acc) : "v"(acc), "v"(d));
    return acc;
}
__device__ __forceinline__ int wave_total(int c) {
    int tot = 0;
#pragma unroll
    for (int bb = 0; bb < 7; ++bb) tot += __popcll(__ballot((c >> bb) & 1)) << bb;
    return tot;
}
#define SEL_CHUNKS(BODY) do { \
    _Pragma("unroll") for (int i = 0; i < 16; ++i) BODY(i) \
    if (tl >= 16) { _Pragma("unroll") for (int i = 16; i < 32; ++i) BODY(i) \
        if (tl >= 32) { _Pragma("unroll") for (int i = 32; i < 48; ++i) BODY(i) \
            if (tl >= 48) { _Pragma("unroll") for (int i = 48; i < 64; ++i) BODY(i) } } } } while (0)
__device__ __forceinline__ void ph_dsa_select(const Params& p, LAS unsigned char* lds, unsigned long long* BM) {
    const int tid = tid_(), lane = tid & 63, w = tid >> 6, fr = lane & 15, fq = lane >> 4;
    const int G = gridDim.x, c = blockIdx.x;
    LAS unsigned* sc = (LAS unsigned*)lds;
#define SEL_UNIT(LL, B, T0) do { if (G == 256) { const int rnd_ = (LL) >> 8, x_ = c & 7, j_ = c >> 3, idx_ = (rnd_ >> 1) * 32 + j_; B = x_; T0 = ((rnd_ & 1) ? (511 - idx_) : idx_) * 8; } \
        else { B = (LL) >> 9; T0 = ((LL) & 511) * 8; } } while (0)
#define SEL_LOADQ(B, T0) do { _Pragma("unroll") for (int g = 0; g < 2; ++g) { const size_t tokq_ = (size_t)(B) * SEQ + (T0) + g * 4 + (fr >> 2); \
        _Pragma("unroll") for (int ks = 0; ks < 2; ++ks) iq[g][ks] = *(const bf16x8*)(p.Pb + tokq_ * LDPB + E_IQ + (fr & 3) * 64 + ks * 32 + fq * 8); \
        iwv[g] = *(const float4*)(p.IW + ((size_t)(B) * SEQ + (T0) + g * 4 + fq) * 4); } } while (0)
#define SEL_LOADK(B, NSUB, SUB0, J0, J1) do { _Pragma("unroll") for (int j = J0; j < J1; ++j) { const int sub_ = ((SUB0) + 8 * j < (NSUB)) ? (SUB0) + 8 * j : (SUB0); \
        const bf16_t* kr_ = p.Pb + (size_t)((B) * SEQ + sub_ * 16 + fr) * LDPB + E_IK + fq * 8; \
        kf[j][0] = *(const bf16x8*)kr_; kf[j][1] = *(const bf16x8*)(kr_ + 32); } } while (0)
    bf16x8 iq[2][2]; float4 iwv[2]; bf16x8 kf[8][2];
    bool have = false;
    for (int L = c; L < 4096; L += G) {
        int b, t0; SEL_UNIT(L, b, t0);
        const int t = t0 + w; const size_t tok = (size_t)b * SEQ + t; const int ntile = (t >> 6) + 1;
        if (t0 + 7 < 256) {
            const int rem = t - lane * 64;
            const unsigned long long wd = (rem >= 63) ? ~0ull : (rem >= 0 ? ((1ull << (rem + 1)) - 1ull) : 0ull);
            if (lane < ntile) BM[tok * 64 + lane] = wd;
            continue;
        }
        const int nsub = (t0 + 8 + 15) >> 4;
        if (!have) { SEL_LOADQ(b, t0); SEL_LOADK(b, nsub, w, 0, 2); }
        have = false;
        SEL_LOADK(b, nsub, w, 2, 8);
        __syncthreads();
        for (int sub0 = w; sub0 < nsub; sub0 += 64) {
#pragma unroll
            for (int j = 0; j < 8; ++j) {
                const int sub = sub0 + 8 * j;
                if (sub < nsub) {
#pragma unroll
                    for (int g = 0; g < 2; ++g) {
                        f32x4 s = Z4_;
                        s = __builtin_amdgcn_mfma_f32_16x16x32_bf16(iq[g][0], kf[j][0], s, 0, 0, 0);
                        s = __builtin_amdgcn_mfma_f32_16x16x32_bf16(iq[g][1], kf[j][1], s, 0, 0, 0);
                        const int q = g * 4 + fq, key = sub * 16 + fr;
                        const float v = (iwv[g].x * fmaxf(s[0], 0.f) + iwv[g].y * fmaxf(s[1], 0.f)) + (iwv[g].z * fmaxf(s[2], 0.f) + iwv[g].w * fmaxf(s[3], 0.f));
                        const unsigned u = __builtin_bit_cast(unsigned, v);
                        const unsigned ks2 = (u & 0x80000000u) ? ~u : (u | 0x80000000u);
                        sc[q * 4096 + key] = (key <= t0 + q) ? ks2 : 0u;
                    }
                }
            }
            if (sub0 + 64 < nsub) SEL_LOADK(b, nsub, sub0 + 64, 0, 8);
        }
        __syncthreads();
        unsigned long long myword = 0ull;
        {
            const int tl = __builtin_amdgcn_readfirstlane(t >> 6);
            unsigned kreg[64];
#pragma unroll
            for (int i = 0; i < 64; ++i) kreg[i] = sc[w * 4096 + i * 64 + lane];
            __builtin_amdgcn_sched_barrier(0);
#pragma unroll
            for (int i = 0; i < 64; ++i) kreg[i] = (i * 64 + lane <= t) ? kreg[i] : 0u;
            unsigned T = 0u; bool exact = false; int need = 0;
            {
                LAS unsigned* hist = (LAS unsigned*)(lds + 131072) + w * 256;
                unsigned prefix = 0u, pmask = 0u; int remaining = 256;
                {
                    unsigned T8 = 0u; int acc_tot = t + 1, above = 0;
#pragma nounroll
                    for (int bit = 7; bit >= 0; --bit) {
                        const unsigned cand = (T8 | (1u << bit)) << 24;
                        int cnt = 0;
#define SEL_CNT(i) { cnt += (kreg[i] >= cand) ? 1 : 0; }
                        SEL_CHUNKS(SEL_CNT);
#undef SEL_CNT
                        const int tot = wave_total(cnt);
                        if (tot >= 256) { T8 |= 1u << bit; acc_tot = tot; } else above = tot;
                    }
                    remaining = 256 - above; prefix = T8 << 24; pmask = 0xff000000u;
                    exact = (acc_tot - above == remaining);
                }
                if (!exact) for (int pass = 1; pass < 4; ++pass) {
                    const int shift = 24 - 8 * pass;
#pragma unroll
                    for (int j = 0; j < 4; ++j) hist[lane + 64 * j] = 0u;
#define SEL_HIST(i) { const unsigned k = kreg[i]; if ((k & pmask) == prefix && k != 0u) __hip_atomic_fetch_add(&hist[(k >> shift) & 255u], 1u, __ATOMIC_RELAXED, __HIP_MEMORY_SCOPE_WORKGROUP); }
                    SEL_CHUNKS(SEL_HIST);
#undef SEL_HIST
                    unsigned cj[4]; unsigned sl = 0u;
#pragma unroll
                    for (int j = 0; j < 4; ++j) { cj[j] = hist[255 - 4 * lane - j]; sl += cj[j]; }
                    unsigned incl = 0u;
#pragma unroll
                    for (int bb = 0; bb < 13; ++bb) { const unsigned long long mb = __ballot((sl >> bb) & 1u); incl += (unsigned)(lane_rank(mb) + ((sl >> bb) & 1u)) << bb; }
                    const unsigned excl = incl - sl;
                    const bool cross = (excl < (unsigned)remaining) && ((unsigned)remaining <= incl);
                    unsigned dig = 0u, above = excl, cbin = 0u;
                    { unsigned accv = excl; bool found = false;
#pragma unroll
                      for (int j = 0; j < 4; ++j) { if (!found && accv + cj[j] >= (unsigned)remaining) { dig = 255u - 4u * lane - j; above = accv; cbin = cj[j]; found = true; } accv += cj[j]; } }
                    const unsigned long long mc = __ballot(cross);
                    const int src = mc ? __builtin_ctzll(mc) : 0;
                    dig = (unsigned)__builtin_amdgcn_readlane((int)dig, src); above = (unsigned)__builtin_amdgcn_readlane((int)above, src); cbin = (unsigned)__builtin_amdgcn_readlane((int)cbin, src);
                    prefix |= dig << shift; pmask |= 0xffu << shift; remaining -= (int)above;
                    if ((int)cbin == remaining) { exact = true; break; }
                }
                T = prefix; need = remaining;
            }
            if (exact) {
#define SEL_EX(i) { const unsigned long long msel = __ballot(kreg[i] >= T); if (lane == i) myword = msel; }
                SEL_CHUNKS(SEL_EX);
#undef SEL_EX
            } else {
                int taken = 0;
#define SEL_TIE(i) { const bool gt = kreg[i] > T, eq = kreg[i] == T; const unsigned long long meq = __ballot(eq); const bool sel = gt || (eq && (taken + lane_rank(meq) < need)); \
                    const unsigned long long msel = __ballot(sel); if (lane == i) myword = msel; taken += __popcll(meq); }
                SEL_CHUNKS(SEL_TIE);
#undef SEL_TIE
            }
        }
        if (lane < ntile) BM[tok * 64 + lane] = myword;
    }
#undef SEL_UNIT
#undef SEL_LOADQ
#undef SEL_LOADK
}
__device__ __forceinline__ void ph_dsa_attn(const Params& p, LAS unsigned char* lds, const unsigned long long* BM) {
    const int tid = tid_(), lane = tid & 63, w = tid >> 6, fr = lane & 15, fq = lane >> 4;
    const int G = gridDim.x, c = blockIdx.x;
    for (int L = c; L < 1024; L += G) {
        int qb, stream;
        if (G == 256) { const int rnd = L >> 8, x = c & 7, j = c >> 3;
            stream = 2 * x + (rnd >> 1); qb = (rnd & 1) ? 63 - j : j; }
        else { const int rnd = L / G; const int u = ((rnd & 1) && (1024 % G == 0)) ? rnd * G + (G - 1 - (L - rnd * G)) : L; qb = u & 63; stream = u >> 6; }
        const int grp = stream & 1, b = stream >> 1;
        const int tw = qb * 64 + w * 8, head = grp * 4 + (fr & 3);
#define TOKD(g) ((size_t)b * SEQ + tw + (g) * 4 + (fr >> 2))
        bf16x8 q[2][2];
#pragma unroll
        for (int g = 0; g < 2; ++g)
#pragma unroll
            for (int ks = 0; ks < 2; ++ks) q[g][ks] = *(const bf16x8*)(p.Pb + TOKD(g) * LDPB + E_BQ + head * 64 + ks * 32 + fq * 8);
        const bf16_t* kb = p.Pb + (size_t)b * SEQ * LDPB + E_BK + grp * 64; const bf16_t* vb = p.Pb + (size_t)b * SEQ * LDPB + E_BV + grp * 64;
        AtState<64> st; st.init();
        unsigned long long wn0 = BM[TOKD(0) * 64], wn1 = BM[TOKD(1) * 64];
        at_run_pp<64>(lds, st, kb, vb, LDPB, 0, qb + 1, tid, fr, fq, [&](int i, lds_cptr Kb, bf16x8 (&pf)[2][2]) {
            const unsigned long long w0 = wn0, w1 = wn1;
            if (i < qb) { wn0 = BM[TOKD(0) * 64 + i + 1]; wn1 = BM[TOKD(1) * 64 + i + 1]; }
            { const unsigned long long x0 = w0 >> (4 * fq), x1 = w1 >> (4 * fq);
                const int l0 = (int)(unsigned)x0, h0 = (int)(unsigned)(x0 >> 32), l1 = (int)(unsigned)x1, h1 = (int)(unsigned)(x1 >> 32);
                at_tile_sp<64, 4>(st, Kb, q, fr, fq, AtNoRow(), [=](int g, int kk, int r) { const int bit = 16 * kk + r;
                    int mres; const int wsel = (bit < 32) ? (g ? l1 : l0) : (g ? h1 : h0);
                    asm("v_bfe_i32 %0, %1, %2, 1" : "=v"(mres) : "v"(wsel), "n"(bit & 31)); return mres; }, pf); }
        });
        at_finish(st);
#pragma unroll
        for (int g = 0; g < 2; ++g) { const float inv = 1.f / st.l[g]; bf16_t* dst = p.Ob + TOKD(g) * DM + 512 + head * 64 + 4 * fq;
#pragma unroll
            for (int n = 0; n < 4; ++n) { const f32x4 o = st.o[g][n] * inv; u32x2 wv; wv.x = pk2(o[0], o[1]); wv.y = pk2(o[2], o[3]); *(u32x2*)(dst + n * 16) = wv; } }
#undef TOKD
    }
}

#define XB_TMO      128
#define XB_XCNT(j)  (256  + 64 * (j))
#define XB_XSUB(j)  (1280 + 64 * (j))
#define XB_XGEN(j)  (2304 + 64 * (j))
#define XB_TOP      3328
#define XB_TOPGEN   3392
#define XCD_BAR_WORDS 3456
#define XB_SPIN_CAP (1u << 24)
__device__ __forceinline__ unsigned xb_ld(unsigned* p)              { return __hip_atomic_load(p, __ATOMIC_RELAXED, __HIP_MEMORY_SCOPE_AGENT); }
__device__ __forceinline__ unsigned xb_add(unsigned* p, unsigned v) { return __hip_atomic_fetch_add(p, v, __ATOMIC_RELAXED, __HIP_MEMORY_SCOPE_AGENT); }
__device__ __forceinline__ unsigned xb_xcc_id() { return (unsigned)__builtin_amdgcn_s_getreg((3 << 11) | 20) & 0xFu; }
#define XB_SPIN(cond, bar) do { unsigned _sp = 0; while (cond) { __builtin_amdgcn_s_sleep(1); \
    if ((++_sp & 255u) == 0u) { if (xb_ld(&(bar)[XB_TMO])) break; if (_sp > XB_SPIN_CAP) { atomicAdd(&(bar)[XB_TMO], 1u); break; } } } } while (0)
struct XcdBarrier { unsigned* bar; unsigned x; volatile LAS unsigned* st; };
__device__ __forceinline__ XcdBarrier xcd_barrier_post(unsigned* bar, volatile LAS unsigned* st) {
    XcdBarrier b; b.bar = bar; b.x = xb_xcc_id(); b.st = st;
    if (threadIdx.x == 0) (void)xb_add(&bar[XB_XCNT(b.x)], 1u);
    return b;
}
__device__ __forceinline__ void xcd_barrier_complete(unsigned* bar, unsigned x, unsigned& nloc, unsigned& nx) {
    const unsigned G = gridDim.x * gridDim.y * gridDim.z;
    unsigned sum, cnt, mine, sp = 0u;
    for (;;) {
        sum = 0u; cnt = 0u; mine = 0u;
#pragma unroll
        for (unsigned j = 0; j < 16; ++j) { const unsigned c = xb_ld(&bar[XB_XCNT(j)]); sum += c; cnt += (c > 0u) ? 1u : 0u; mine = (j == x) ? c : mine; }
        if (sum == G) break;
        __builtin_amdgcn_s_sleep(1);
        if ((++sp & 255u) == 0u) { if (xb_ld(&bar[XB_TMO])) break; if (sp > XB_SPIN_CAP) { atomicAdd(&bar[XB_TMO], 1u); break; } }
    }
    nloc = mine > 0u ? mine : 1u; nx = cnt > 0u ? cnt : 1u;
}
__device__ __forceinline__ void xcd_barrier(unsigned* bar_in, volatile LAS unsigned* st) {
    asm volatile("s_waitcnt vmcnt(0)" ::: "memory");
    __syncthreads();
    if (threadIdx.x == 0) {
        unsigned* bar = bar_in; asm volatile("" : "+s"(bar));
        const unsigned x = xb_xcc_id();
        __builtin_amdgcn_s_waitcnt(0);
        unsigned nloc = st[0], nx = st[1];
        if (nloc == 0u) { xcd_barrier_complete(bar, x, nloc, nx); st[0] = nloc; st[1] = nx; }
        const unsigned old = xb_add(&bar[XB_XSUB(x)], 1u);
        const unsigned gen = old / nloc;
        if (old + 1u == (gen + 1u) * nloc) {
            __builtin_amdgcn_fence(__ATOMIC_RELEASE, "agent");
            asm volatile("s_waitcnt vmcnt(0)" ::: "memory");
            const unsigned og = xb_add(&bar[XB_TOP], 1u);
            const unsigned tg = og / nx;
            if (og + 1u == (tg + 1u) * nx) xb_add(&bar[XB_TOPGEN], 1u);
            else XB_SPIN(xb_ld(&bar[XB_TOPGEN]) == tg, bar);
            __builtin_amdgcn_fence(__ATOMIC_ACQUIRE, "agent");
            xb_add(&bar[XB_XGEN(x)], 1u);
            asm volatile("s_waitcnt vmcnt(0)" ::: "memory");
        } else {
            XB_SPIN(xb_ld(&bar[XB_XGEN(x)]) == gen, bar);
            __builtin_amdgcn_fence(__ATOMIC_ACQUIRE, "agent");
            asm volatile("s_waitcnt vmcnt(0)" ::: "memory");
        }
    }
    __syncthreads();
}

__global__ void __launch_bounds__(NT, 2) mega(Params p) {
    extern __shared__ __attribute__((aligned(16))) float lds[];
    PG8_LAS unsigned char* ldsL = (PG8_LAS unsigned char*)lds;
    volatile LAS unsigned* xst = (volatile LAS unsigned*)(lds + LDS_BYTES / 4);
    if (threadIdx.x == 0) { xst[0] = 0u; xst[1] = 0u; xst[2] = 0u; xst[3] = 0u; }
    __syncthreads();
    (void)xcd_barrier_post(p.bar, xst);
#define GRID_BAR() xcd_barrier(p.bar, xst)
    const int G = gridDim.x, cB = blockIdx.x;
    const float* const xin0 = p.in[IN_X];
    ph_init(p, lds);
    GRID_BAR();
    for (int l = 0; l < 4; ++l) {
        const int li = l >> 1;
        if ((l & 1) == 0) {
            {
                pg8::Gemm g{p.Xb, p.WinE + (size_t)li * NP_EVEN * DM, NTOK, NP_EVEN, DM}; pg8::StaticOrder S; S.init(NTOK, NP_EVEN, G, cB);
                EpiInEven E{p.Pb, p.IW, p.ropecs};
                pg8::gemm_phase<EpiInEven, pg8::StaticOrder, true, true>(ldsL, g, S, E);
            }
            GRID_BAR();
            ph_diff_mfma(p, (LAS unsigned char*)lds, li);
            __syncthreads();
            ph_dsa_select(p, (LAS unsigned char*)lds, p.BM);
            GRID_BAR();
            ph_dsa_attn(p, (LAS unsigned char*)lds, p.BM);
            GRID_BAR();
            {
                pg8::Gemm g{p.Ob, p.WoutE + (size_t)li * DM * DM, NTOK, DM, DM}; pg8::StaticOrder S; S.init(NTOK, DM, G, cB);
                EpiY E{(bf16_t*)p.Y};
                pg8::gemm_phase<EpiY, pg8::StaticOrder, true, true>(ldsL, g, S, E);
            }
            GRID_BAR();
        } else {
            {
                pg8::Gemm g{p.Xb, p.WinO + (size_t)li * NP_ODD * DM, NTOK, NP_ODD, DM}; pg8::StaticOrder S; S.init(NTOK, NP_ODD, G, cB);
                EpiInOdd E{p.Pb, p.QRb, p.GATES, p.ropecs, p.in[IN_NSA_GATE_B] + li * 24};
                pg8::gemm_phase<EpiInOdd, pg8::StaticOrder, true, true>(ldsL, g, S, E);
            }
            GRID_BAR();
            ph_kmean(p, lds);
            ph_cmp_build(p, li);
            GRID_BAR();
            {
                pg8::Gemm g{p.Ac, p.W1T + (size_t)li * 2 * 256 * 2048, 8192, 256, 2048}; ListOrder S{32, G, cB};
                EpiGeluH E{p.Hc};
                pg8::gemm_phase<EpiGeluH, ListOrder, true, true>(ldsL, g, S, E);
            }
            __syncthreads();
            ph_moba_mfma(p, (LAS unsigned char*)lds, li);
            GRID_BAR();
            {
                pg8::Gemm g{p.Hc, p.W2T + (size_t)li * 2 * 256 * 256, 8192, 256, 256}; ListOrder S{32, G, cB};
                EpiCmp E{p.CMP};
                pg8::gemm_phase<EpiCmp, ListOrder, true, true>(ldsL, g, S, E);
            }
            GRID_BAR();
            ph_nsa_mfma(p, (LAS unsigned char*)lds, p.CMP, p.CMP + (size_t)4096 * 64);
            GRID_BAR();
            {
                pg8::Gemm g{p.Ob, p.WoutO + (size_t)li * DM * DM, NTOK, DM, DM}; pg8::StaticOrder S; S.init(NTOK, DM, G, cB);
                EpiY E{(bf16_t*)p.Y};
                pg8::gemm_phase<EpiY, pg8::StaticOrder, true, true>(ldsL, g, S, E);
            }
            GRID_BAR();
        }
        if (l & 1) ph_ln_router(p, p.in[IN_LN_MIX_G] + l * DM, p.in[IN_LN_MIX_B] + l * DM, li, lds);
        else if (l == 0) ph_ln<0, 0>(p, p.in[IN_LN_MIX_G] + l * DM, p.in[IN_LN_MIX_B] + l * DM, xin0, p.X, p.Xb, false);
        else ph_ln<0, 1>(p, p.in[IN_LN_MIX_G] + l * DM, p.in[IN_LN_MIX_B] + l * DM, xin0, p.X, p.Xb, false);
        GRID_BAR();
        if ((l & 1) == 0) {
            {
                pg8::Gemm g{p.Xb, p.WguD + (size_t)li * 2 * F_DENSE * DM, NTOK, 2 * F_DENSE, DM}; pg8::StaticOrder S; S.init(NTOK, 2 * F_DENSE, G, cB);
                EpiGU E{p.H, F_DENSE, 2 * F_DENSE / 256, 0};
                pg8::gemm_phase<EpiGU, pg8::StaticOrder, true, true>(ldsL, g, S, E);
            }
            GRID_BAR();
            {
                pg8::Gemm g{p.H, p.WdD + (size_t)li * DM * F_DENSE, NTOK, DM, F_DENSE}; pg8::StaticOrder S; S.init(NTOK, DM, G, cB);
                EpiY E{(bf16_t*)p.Y};
                pg8::gemm_phase<EpiY, pg8::StaticOrder, true, true>(ldsL, g, S, E);
            }
            GRID_BAR();
            ph_ln<0, 1>(p, p.in[IN_LN_FFN_G] + l * DM, p.in[IN_LN_FFN_B] + l * DM, xin0, p.X, p.Xb, false);
            GRID_BAR();
        } else {
            ph_slots(p, lds);
            GRID_BAR();
            __syncthreads();
            for (int i = tid_(); i < NTILE256; i += NT) ((LAS int*)((LAS unsigned char*)lds + MOE_TE_LDS))[i] = p.tile_e[i];
            __syncthreads();
#pragma unroll 1
            for (int hf = 0; hf < 3; ++hf) {
                const int t0 = hf * 128, ntr = (hf < 2) ? 128 : NTILE256 - 256;
                if (G == 256) {
                    EpiGU E{p.Hm, F_EXPERT, 2 * F_EXPERT / 256, t0};
#pragma unroll 1
                    for (int rb = 0; rb < (hf < 2 ? 2 : 1); ++rb) {
                        pg8::Gemm g{p.Xb, p.WguM, NSLOT, 2 * F_EXPERT, DM}; MoeOrderG S{t0, ntr, 2 * F_EXPERT / 256, G, cB, rb, p.slot_tok};
                        pg8::gemm_phase<EpiGU, MoeOrderG, true, true>(ldsL, g, S, E);
                        __syncthreads();
                    }
                } else {
                    pg8::Gemm g{p.Xs, p.WguM, NSLOT, 2 * F_EXPERT, DM}; MoeOrder S{t0, ntr, 2 * F_EXPERT / 256, G, cB};
                    EpiGU E{p.Hm, F_EXPERT, 2 * F_EXPERT / 256, t0};
                    pg8::gemm_phase<EpiGU, MoeOrder, true, true>(ldsL, g, S, E);
                }
                GRID_BAR();
                if (hf < 2) {
                    pg8::Gemm g{p.Hm - (size_t)t0 * 256 * F_EXPERT, p.WdM, NSLOT, DM, F_EXPERT}; MoeOrder S{t0, ntr, DM / 256, G, cB};
                    EpiDownMoe E{p.Ys, p.slot_gate};
                    pg8::gemm_phase<EpiDownMoe, MoeOrder, true, true>(ldsL, g, S, E);
                } else {
                    pg8::Gemm g{p.Hm - (size_t)t0 * 256 * F_EXPERT, p.WdM, NSLOT, DM, MOE_KSL_K, F_EXPERT}; TailOrder S{G, cB};
                    EpiDownTail E{p.Yp, p.slot_gate};
                    pg8::gemm_phase<EpiDownTail, TailOrder, true, true>(ldsL, g, S, E);
                }
                GRID_BAR();
            }
            ph_ln<1, 1>(p, p.in[IN_LN_FFN_G] + l * DM, p.in[IN_LN_FFN_B] + l * DM, xin0, p.X, p.Xb, l == 3);
            GRID_BAR();
        }
    }
    if (xb_ld(&p.bar[XB_TMO])) { for (int i = blockIdx.x * NT + threadIdx.x; i < NTOK * DM; i += gridDim.x * NT) p.X[i] = __builtin_nanf(""); }
}

extern "C" void kernel_launch(void* const* d_in, const int* in_sizes, int n_in, void* d_out, int out_size, void* d_ws, size_t ws_size, hipStream_t stream) {
    Params p; memset(&p, 0, sizeof(p));
    for (int i = 0; i < 23; ++i) p.in[i] = (const float*)d_in[i];
    p.X = (float*)d_out;
    unsigned char* w = (unsigned char*)d_ws; size_t off = 0;
    auto take = [&](size_t bytes) { unsigned char* r = w + off; off += (bytes + 255) / 256 * 256; return r; };
    p.bar = (unsigned*)take(16384);
    p.ropecs = (float*)take(4096 * 32 * 2 * 4);
    p.IW = (float*)take((size_t)NTOK * 4 * 4);
    p.BM = (unsigned long long*)take((size_t)NTOK * 64 * 8);
    p.GATES = (float*)take((size_t)NTOK * 24 * 4);
    p.kmean = (float*)take(8 * 16 * 8 * 64 * 4);
    p.cmpk = (float*)take(8 * 256 * 2 * 64 * 4);
    p.cmpv = (float*)take(8 * 256 * 2 * 64 * 4);
    p.tok_e = (int*)take(NTOK * 2 * 4);
    p.tok_g = (float*)take(NTOK * 2 * 4);
    p.tok_slot = (int*)take(NTOK * 2 * 4);
    p.slot_tok = (int*)take(NSLOT * 4);
    p.slot_gate = (float*)take(NSLOT * 4);
    p.chunk_cnt = (int*)take(256 * 8 * 4);
    p.tile_e = (int*)take(NTILE256 * 4);
    p.W1T = (bf16_t*)take((size_t)2 * 2 * 256 * 2048 * 2);
    p.W2T = (bf16_t*)take((size_t)2 * 2 * 256 * 256 * 2);
    p.CMP = (bf16_t*)take((size_t)8192 * 64 * 2);
    p.WinE = (bf16_t*)take((size_t)2 * NP_EVEN * DM * 2);
    p.WoutE = (bf16_t*)take((size_t)2 * DM * DM * 2);
    p.WguD = (bf16_t*)take((size_t)2 * 2 * F_DENSE * DM * 2);
    p.WdD = (bf16_t*)take((size_t)2 * DM * F_DENSE * 2);
    p.WinO = (bf16_t*)take((size_t)2 * NP_ODD * DM * 2);
    p.WoutO = (bf16_t*)take((size_t)2 * DM * DM * 2);
    p.WguM = (bf16_t*)take((size_t)N_EXP * 2 * F_EXPERT * DM * 2);
    p.WdM = (bf16_t*)take((size_t)N_EXP * DM * F_EXPERT * 2);
    p.Xb = (bf16_t*)take((size_t)(NTOK + 1) * DM * 2);
    unsigned char* R = w + off;
    {   size_t o = 0; auto tk = [&](size_t bytes) { unsigned char* r = R + o; o += (bytes + 255) / 256 * 256; return r; };
        p.Pb = (bf16_t*)tk((size_t)NTOK * LDPB * 2); p.H = p.Pb;
        p.Ob = (bf16_t*)tk((size_t)NTOK * DM * 2);
        p.QRb = (bf16_t*)tk((size_t)NTOK * 512 * 2);
        p.Y = (float*)tk((size_t)NTOK * DM * 4);
        p.Ac = (bf16_t*)p.Y; p.Hc = p.Ac + (size_t)2 * 4096 * 2048; }
    {   size_t o = 0; auto tk = [&](size_t bytes) { unsigned char* r = R + o; o += (bytes + 255) / 256 * 256; return r; };
        p.Xs = (bf16_t*)tk((size_t)NSLOT * DM * 2);
        p.Hm = (bf16_t*)tk((size_t)MOE_HALF_TILES * 256 * F_EXPERT * 2);
        p.Ys = (bf16_t*)tk((size_t)NSLOT * DM * 2);
        p.Yp = p.Hm + (size_t)16 * 256 * F_EXPERT; }
    p.lam_init[0] = (float)(0.8 - 0.6 * exp(-0.3 * 0.0));
    p.lam_init[1] = (float)(0.8 - 0.6 * exp(-0.3 * 2.0));
    constexpr int kDynLds = LDS_BYTES + 16;
    static int grid = 0;
    if (!grid) {
        int dev = 0, cus = 0, per_cu = 0;
        (void)hipGetDevice(&dev);
        (void)hipDeviceGetAttribute(&cus, hipDeviceAttributeMultiprocessorCount, dev);
        (void)hipFuncSetAttribute((const void*)mega, hipFuncAttributeMaxDynamicSharedMemorySize, kDynLds);
        (void)hipOccupancyMaxActiveBlocksPerMultiprocessor(&per_cu, (const void*)mega, NT, kDynLds);
        if (cus <= 0) cus = 256;
        grid = cus;
    }
    (void)hipMemsetAsync(p.bar, 0, XCD_BAR_WORDS * sizeof(unsigned), stream);
    mega<<<grid, NT, kDynLds, stream>>>(p);
}
```

```cpp
#include <hip/hip_runtime.h>
#include <stdint.h>
#include <string.h>
#include <math.h>

__device__ __forceinline__ int tid_() { int t = threadIdx.x; asm volatile("" : "+v"(t)); return t; }
__device__ __forceinline__ float zero1_() { float z = 0.f; asm volatile("" : "+v"(z)); return z; }
namespace pg8 {
#define PG8_LAS __attribute__((address_space(3)))
typedef unsigned short bf16_t;
typedef short bf16x8 __attribute__((ext_vector_type(8)));
typedef float f32x4 __attribute__((ext_vector_type(4)));
typedef unsigned u32x4 __attribute__((ext_vector_type(4)));
constexpr int BM = 256, BK = 64, HALF = 128, HTB = HALF * BK * 2  , STAGE_BYTES = 8 * HTB, NXCD = 8, WGM = 8;

__host__ __device__ __forceinline__ int lds_byte(int r, int c) { const int st = (r >> 4) * 2 + (c >> 5), rr = r & 15, cc = c & 31, ob = rr * 64 + cc * 2; return st * 1024 + (ob ^ (((ob >> 9) & 1) << 5)); }
__host__ __device__ __forceinline__ void stage_rc(int b, int& R, int& C) { const int st = b / 1024, sb = b % 1024, swz = sb ^ (((sb >> 9) & 1) << 5); R = (st >> 1) * 16 + swz / 64; C = (st & 1) * 32 + (swz % 64) / 2; }
__host__ __device__ __forceinline__ int perm32(int rho) { const int n = rho >> 4, i = rho & 15; return 8 * (i >> 2) + 4 * n + (i & 3); }

struct Unit { int pm, pn, ko; };
struct Gemm { const bf16_t* A; const bf16_t* Bt; int M, N, K, ld; };

struct StaticOrder {
    static constexpr bool KSPLIT = false, GATHER_A = false;
    int nM, nN, nwg, G, c;
    __host__ __device__ void init(int M, int N, int G_, int c_) { nM = M / BM; nN = N / BM; nwg = nM * nN; G = G_; c = c_; }
    __host__ __device__ bool next(int i, Unit& u) const {
        const long L = (long)i * G + c; if (L >= nwg) return false;
        int wgid = (int)L; { const int q = nwg / NXCD, r = nwg % NXCD, xcd = wgid % NXCD, off = wgid / NXCD; wgid = (xcd < r ? xcd * (q + 1) : r * (q + 1) + (xcd - r) * q) + off; }
        const int nig = WGM * nN, gid = wgid / nig, fm = gid * WGM, gsz = (nM - fm) < WGM ? (nM - fm) : WGM;
        u.pm = fm + ((wgid % nig) % gsz); u.pn = (wgid % nig) / gsz; return true;
    }
    __device__ __forceinline__ void a_ready(const Unit&) const {}
    __device__ __forceinline__ void done(const Unit&) const {}
};

__device__ __forceinline__ unsigned cvt_pk_bf16(float lo, float hi) { unsigned r; asm volatile("v_cvt_pk_bf16_f32 %0, %1, %2" : "=v"(r) : "v"(lo), "v"(hi)); return r; }
typedef float f32x2 __attribute__((ext_vector_type(2)));
template <class Epi, class Sched, bool ALIGN_EPI = false, bool SP2 = false>
__device__ __forceinline__ void gemm_phase(PG8_LAS unsigned char* lds, const Gemm g, const Sched& S, const Epi& E) {
    const int tid = tid_(), wid = __builtin_amdgcn_readfirstlane(tid >> 6), lane = tid & 63, wr = wid >> 2, wc = wid & 3, fr = lane & 15, fq = lane >> 4;
    const int K = g.K, nt = K / BK, LD = g.ld ? g.ld : K;
    unsigned voffA[2], voffB[2];
#pragma unroll
    for (int i = 0; i < 2; ++i) { int R, C; stage_rc(tid * 16 + i * 8192, R, C); const int Rb = Epi::PERM ? ((R & ~31) + perm32(R & 31)) : R;
        voffA[i] = (unsigned)(R * LD + C) * 2u; voffB[i] = (unsigned)(Rb * LD + C) * 2u; }
    const size_t kstep = (size_t)(BK * 2);
    const size_t hstep = (size_t)HALF * LD * 2;
    const size_t tstep = 2 * hstep;
    const unsigned ldsw = (unsigned)wid * 1024u;
    const int aoff = lds_byte(wr * 64 + fr, fq * 8), boff = lds_byte(wc * 32 + fr, fq * 8);
#define PG8_SA(b, h) (((b) * 2 + (h)) * HTB)
#define PG8_SB(b, h) ((4 + (b) * 2 + (h)) * HTB)
#define PG8_STAGE(bufoff, gbase, voff) do { _Pragma("unroll") for (int _i = 0; _i < 2; ++_i) \
        __builtin_amdgcn_global_load_lds((const unsigned*)((const char*)(gbase) + (voff)[_i]), (PG8_LAS unsigned*)(lds + (bufoff) + ldsw + _i * 8192), 16, 0, 0); } while (0)
#define PG8_LDA(dst, b, h) do { _Pragma("unroll") for (int m = 0; m < 4; ++m) _Pragma("unroll") for (int k = 0; k < 2; ++k) dst[m][k] = *(const PG8_LAS bf16x8*)(lds + PG8_SA(b, h) + aoff + m * 2048 + k * 1024); } while (0)
#define PG8_LDB(dst, b, h) do { _Pragma("unroll") for (int n = 0; n < 2; ++n) _Pragma("unroll") for (int k = 0; k < 2; ++k) dst[n][k] = *(const PG8_LAS bf16x8*)(lds + PG8_SB(b, h) + boff + n * 2048 + k * 1024); } while (0)
#define PG8_MMA(ai, bj, At, Bt) do { __builtin_amdgcn_s_setprio(1); _Pragma("unroll") for (int m = 0; m < 4; ++m) _Pragma("unroll") for (int n = 0; n < 2; ++n) _Pragma("unroll") for (int k = 0; k < 2; ++k) \
        acc[ai][bj][m][n] = __builtin_amdgcn_mfma_f32_16x16x32_bf16(Bt[n][k], At[m][k], acc[ai][bj][m][n], 0, 0, 0); __builtin_amdgcn_s_setprio(0); } while (0)
#define PG8_WAIT_V(n) asm volatile("s_waitcnt vmcnt(" #n ")" ::: "memory")
#define PG8_WAIT_L(n) asm volatile("s_waitcnt lgkmcnt(" #n ")" ::: "memory")
#define PG8_BAR __builtin_amdgcn_s_barrier()
#define PG8_SCHED __builtin_amdgcn_sched_barrier(0)
    Unit cur, nxt; int ui = 0;
    if (!S.next(0, cur)) return;
    unsigned voffA1[2]; size_t hstepA = hstep;
#pragma unroll
    for (int i = 0; i < 2; ++i) voffA1[i] = voffA[i];
    if constexpr (Sched::GATHER_A) {
        hstepA = 0;
#pragma unroll
        for (int i = 0; i < 2; ++i) { int R, C; stage_rc(tid * 16 + i * 8192, R, C);
            voffA[i] = (unsigned)(S.arow(cur.pm * 256 + R) * LD + C) * 2u; voffA1[i] = (unsigned)(S.arow(cur.pm * 256 + 128 + R) * LD + C) * 2u; }
    }
    f32x4 acc[2][2][4][2];
#pragma unroll
    for (int a = 0; a < 2; ++a)
#pragma unroll
        for (int b = 0; b < 2; ++b)
#pragma unroll
            for (int m = 0; m < 4; ++m)
#pragma unroll
                for (int n = 0; n < 2; ++n) acc[a][b][m][n] = ([]() { const float z = zero1_(); return (f32x4){z, z, z, z}; }());
    bf16x8 At[4][2], B0[2][2], B1[2][2];
    const char* cA = (const char*)g.A + (Sched::GATHER_A ? (size_t)0 : (size_t)cur.pm * tstep); const char* cB = (const char*)g.Bt + (size_t)cur.pn * tstep;
    if constexpr (Sched::KSPLIT) { cA += (size_t)cur.ko * 2; cB += (size_t)cur.ko * 2; }
    S.a_ready(cur);
    if constexpr (SP2) {
        PG8_STAGE(PG8_SB(0, 0), cB, voffB); PG8_STAGE(PG8_SB(0, 1), cB + hstep, voffB); PG8_STAGE(PG8_SA(0, 0), cA, voffA); PG8_STAGE(PG8_SA(0, 1), cA + hstepA, voffA1);
        if (wr == 1) PG8_BAR;
        PG8_WAIT_V(2); PG8_BAR;
        PG8_STAGE(PG8_SB(1, 0), cB + kstep, voffB); PG8_STAGE(PG8_SA(1, 0), cA + kstep, voffA); PG8_STAGE(PG8_SB(1, 1), cB + hstep + kstep, voffB);
        PG8_WAIT_V(6); PG8_BAR;
    } else {
        PG8_STAGE(PG8_SB(0, 0), cB, voffB); PG8_STAGE(PG8_SA(0, 0), cA, voffA); PG8_STAGE(PG8_SB(0, 1), cB + hstep, voffB); PG8_STAGE(PG8_SA(0, 1), cA + hstepA, voffA1);
        if (wr == 1) PG8_BAR;
        PG8_WAIT_V(4); PG8_BAR;
        PG8_STAGE(PG8_SB(1, 0), cB + kstep, voffB); PG8_STAGE(PG8_SA(1, 0), cA + kstep, voffA); PG8_STAGE(PG8_SB(1, 1), cB + hstep + kstep, voffB);
        PG8_WAIT_V(6); PG8_BAR;
    }
    for (;;) {
        const bool has_next = S.next(ui + 1, nxt);
        const char* nA = has_next ? (const char*)g.A + (Sched::GATHER_A ? (size_t)0 : (size_t)nxt.pm * tstep) : cA; const char* nB = has_next ? (const char*)g.Bt + (size_t)nxt.pn * tstep : cB;
        if constexpr (Sched::KSPLIT) { if (has_next) { nA += (size_t)nxt.ko * 2; nB += (size_t)nxt.ko * 2; } }
        for (int t = 0; t < nt; t += 2) {
            const bool last = (t == nt - 2);
            const char* a1 = cA + (size_t)(t + 1) * kstep;
            const char* a2 = last ? nA : cA + (size_t)(t + 2) * kstep; const char* b2 = last ? nB : cB + (size_t)(t + 2) * kstep;
            const char* a3 = a2 + kstep; const char* b3 = b2 + kstep;
            if (last && has_next) S.a_ready(nxt);
            if constexpr (SP2) {
            PG8_LDB(B0, 0, 0); PG8_LDB(B1, 0, 1); PG8_SCHED; PG8_LDA(At, 0, 0); PG8_STAGE(PG8_SA(1, 1), a1 + hstepA, voffA1);
            PG8_WAIT_V(8); PG8_WAIT_L(0); PG8_BAR; PG8_MMA(0, 0, At, B0); PG8_MMA(0, 1, At, B1); PG8_BAR; PG8_SCHED;
            PG8_LDA(At, 0, 1); PG8_STAGE(PG8_SB(0, 0), b2, voffB); PG8_STAGE(PG8_SB(0, 1), b2 + hstep, voffB); PG8_STAGE(PG8_SA(0, 0), a2, voffA);
            PG8_WAIT_V(8); PG8_WAIT_L(0); PG8_BAR; PG8_MMA(1, 0, At, B0); PG8_MMA(1, 1, At, B1); PG8_BAR; PG8_SCHED;
            PG8_LDB(B0, 1, 0); PG8_LDB(B1, 1, 1); PG8_SCHED; PG8_LDA(At, 1, 0); PG8_STAGE(PG8_SA(0, 1), a2 + hstepA, voffA1);
            PG8_WAIT_V(8); PG8_WAIT_L(0); PG8_BAR; PG8_MMA(0, 0, At, B0); PG8_MMA(0, 1, At, B1); PG8_BAR; PG8_SCHED;
            PG8_LDA(At, 1, 1); PG8_STAGE(PG8_SB(1, 0), b3, voffB); PG8_STAGE(PG8_SB(1, 1), b3 + hstep, voffB); PG8_STAGE(PG8_SA(1, 0), a3, voffA);
            PG8_WAIT_V(8); PG8_WAIT_L(0); PG8_BAR; PG8_MMA(1, 0, At, B0); PG8_MMA(1, 1, At, B1); PG8_BAR; PG8_SCHED;
            } else {
            PG8_LDB(B0, 0, 0); PG8_SCHED; PG8_LDA(At, 0, 0); PG8_STAGE(PG8_SA(1, 1), a1 + hstepA, voffA1);
            PG8_WAIT_L(8); PG8_BAR; PG8_WAIT_L(0); PG8_MMA(0, 0, At, B0); PG8_BAR; PG8_SCHED;
            PG8_LDB(B1, 0, 1); PG8_STAGE(PG8_SB(0, 0), b2, voffB);
            PG8_BAR; PG8_WAIT_L(0); PG8_MMA(0, 1, At, B1); PG8_BAR;
            PG8_LDA(At, 0, 1); PG8_STAGE(PG8_SA(0, 0), a2, voffA);
            PG8_BAR; PG8_WAIT_L(0); PG8_MMA(1, 0, At, B0); PG8_BAR; PG8_SCHED;
            PG8_STAGE(PG8_SB(0, 1), b2 + hstep, voffB);
            PG8_WAIT_V(6); PG8_BAR; PG8_MMA(1, 1, At, B1); PG8_BAR;
            PG8_LDB(B0, 1, 0); PG8_SCHED; PG8_LDA(At, 1, 0); PG8_STAGE(PG8_SA(0, 1), a2 + hstepA, voffA1);
            PG8_WAIT_L(8); PG8_BAR; PG8_WAIT_L(0); PG8_MMA(0, 0, At, B0); PG8_BAR; PG8_SCHED;
            PG8_LDB(B1, 1, 1); PG8_STAGE(PG8_SB(1, 0), b3, voffB);
            PG8_BAR; PG8_WAIT_L(0); PG8_MMA(0, 1, At, B1); PG8_BAR;
            PG8_LDA(At, 1, 1); PG8_STAGE(PG8_SA(1, 0), a3, voffA);
            PG8_BAR; PG8_WAIT_L(0); PG8_MMA(1, 0, At, B0); PG8_BAR; PG8_SCHED;
            PG8_STAGE(PG8_SB(1, 1), b3 + hstep, voffB);
            PG8_WAIT_V(6); PG8_BAR; PG8_MMA(1, 1, At, B1); PG8_BAR;
            }
        }
        if constexpr (ALIGN_EPI) { if (wr == 0) PG8_BAR; }
        if constexpr (!Epi::AFTER_DRAIN) { E(acc, cur, wr, wc, fr, fq); S.done(cur); }
        if (!has_next) break;
#pragma unroll
        for (int a = 0; a < 2; ++a)
#pragma unroll
            for (int b = 0; b < 2; ++b)
#pragma unroll
                for (int m = 0; m < 4; ++m)
#pragma unroll
                    for (int n = 0; n < 2; ++n) acc[a][b][m][n] = ([]() { const float z = zero1_(); return (f32x4){z, z, z, z}; }());
        cur = nxt; cA = nA; cB = nB; ++ui;
        if constexpr (ALIGN_EPI) { if (wr == 1) PG8_BAR; }
    }
    PG8_WAIT_V(0);
    if constexpr (!ALIGN_EPI) { if (wr == 0) PG8_BAR; }
    PG8_BAR;
    if constexpr (Epi::AFTER_DRAIN) { E.fused(acc, cur, wr, wc, fr, fq, lds, wid, lane); S.done(cur); }
#undef PG8_SA
#undef PG8_SB
#undef PG8_STAGE
#undef PG8_LDA
#undef PG8_LDB
#undef PG8_MMA
#undef PG8_WAIT_V
#undef PG8_WAIT_L
#undef PG8_BAR
#undef PG8_SCHED
}
}
using pg8::bf16_t; using pg8::f32x4; using pg8::Unit;
typedef unsigned u32x2 __attribute__((ext_vector_type(2)));

#define NT 512
#define Z4_ ([]() { const float z = zero1_(); return (f32x4){z, z, z, z}; }())
#define LAS __attribute__((address_space(3)))
constexpr int NTOK = 32768, DM = 1024, SEQ = 4096;
constexpr int LDPB = 3072;
constexpr float ALPHA = 1.681792830507429f;
constexpr float LN_EPS = 1e-5f;
constexpr int E_AQ = 0, E_AK = 512, E_AV = 1024, E_BQ = 1536, E_BK = 2048, E_BV = 2176, E_IQ = 2304, E_IK = 2560, E_IW = 2624, P_EVEN = 2628, NP_EVEN = 2816;
constexpr int O_CQ = 0, O_CK = 512, O_CV = 1024, O_DQ = 1536, O_KC = 2048, O_VC = 2176, O_KS = 2304, O_VS = 2432, O_KW = 2560, O_VW = 2688, O_DG = 2816, P_ODD = 2840, NP_ODD = 3072;
constexpr int F_DENSE = 2816, F_EXPERT = 3584, N_EXP = 8;
constexpr int NSLOT = 65536 + 8 * 256;
constexpr int NTILE256 = NSLOT / 256;
constexpr int MOE_HALF_TILES = NTILE256 / 2;
constexpr int LDS_BYTES = 147456;

__constant__ float c_inv[32] = {1.0f, 0.7498942613601685f, 0.5623413324356079f, 0.4216965138912201f, 0.3162277638912201f, 0.23713737726211548f, 0.17782793939113617f, 0.133352130651474f,
    0.10000000149011612f, 0.07498941570520401f, 0.05623413249850273f, 0.04216965287923813f, 0.03162277489900589f, 0.023713737726211548f, 0.017782794311642647f, 0.01333521492779255f,
    0.009999999776482582f, 0.007498941849917173f, 0.005623413249850273f, 0.0042169648222625256f, 0.003162277629598975f, 0.00237137358635664f, 0.0017782794311642647f, 0.0013335214462131262f,
    0.0010000000474974513f, 0.0007498942431993783f, 0.000562341301701963f, 0.0004216965171508491f, 0.0003162277571391314f, 0.00023713737027719617f, 0.00017782794020604342f, 0.0001333521504420787f};

struct Params {
    const float* in[23];
    float* X;
    bf16_t* Xb;
    bf16_t* Pb;
    bf16_t* Ob;
    bf16_t* QRb;
    float* Y;
    bf16_t* H;
    bf16_t* Xs;
    bf16_t* Hm;
    bf16_t* Ys;
    bf16_t* Yp;
    bf16_t* W1T; bf16_t* W2T;
    bf16_t* Ac; bf16_t* Hc; bf16_t* CMP;
    bf16_t* WinE; bf16_t* WoutE; bf16_t* WguD; bf16_t* WdD; bf16_t* WinO; bf16_t* WoutO; bf16_t* WguM; bf16_t* WdM;
    float* ropecs;
    float* IW;
    unsigned long long* BM;
    float* GATES;
    float* kmean;
    float* cmpk;
    float* cmpv;
    int* tok_e; float* tok_g; int* tok_slot; int* slot_tok; float* slot_gate; int* chunk_cnt; int* tile_e;
    unsigned* bar;
    float lam_init[2];
};

enum { IN_X = 0, IN_EV_WIN, IN_EV_WOUT, IN_DIF_LAMBDA, IN_DIF_SUBLN, IN_FFD_WG, IN_FFD_WU, IN_FFD_WD, IN_OD_WIN, IN_OD_WOUT, IN_NSA_GATE_B, IN_NSA_PE, IN_NSA_W1, IN_NSA_W2,
       IN_MOE_WR, IN_MOE_BR, IN_MOE_WG, IN_MOE_WU, IN_MOE_WD, IN_LN_MIX_G, IN_LN_MIX_B, IN_LN_FFN_G, IN_LN_FFN_B };

__device__ __forceinline__ float bf2f(bf16_t u) { return __builtin_bit_cast(float, (unsigned)u << 16); }
__device__ __forceinline__ unsigned pk2(float lo, float hi) { return pg8::cvt_pk_bf16(lo, hi); }
__device__ __forceinline__ bf16_t f2bf(float f) { return (bf16_t)(pg8::cvt_pk_bf16(f, 0.f) & 0xffffu); }
__device__ __forceinline__ float wave_max(float v) {
#pragma unroll
    for (int o = 32; o >= 1; o >>= 1) v = fmaxf(v, __shfl_xor(v, o));
    return v;
}
__device__ __forceinline__ float wave_sum(float v) {
#pragma unroll
    for (int o = 32; o >= 1; o >>= 1) v += __shfl_xor(v, o);
    return v;
}
__device__ __forceinline__ int wave_sumi(int v) {
#pragma unroll
    for (int o = 32; o >= 1; o >>= 1) v += __shfl_xor(v, o);
    return v;
}
__device__ __forceinline__ float rl_f(float v, int l) { return __builtin_bit_cast(float, __builtin_amdgcn_readlane(__builtin_bit_cast(int, v), l)); }
__device__ __forceinline__ int lane_rank(unsigned long long m) { return __builtin_amdgcn_mbcnt_hi((unsigned)(m >> 32), __builtin_amdgcn_mbcnt_lo((unsigned)m, 0)); }

#define EPI_LOOP_BEGIN \
    _Pragma("unroll") for (int ai = 0; ai < 2; ++ai) _Pragma("unroll") for (int m = 0; m < 4; ++m) { const int rloc = ai * 128 + wr * 64 + m * 16 + fr; \
    _Pragma("unroll") for (int bj = 0; bj < 2; ++bj) _Pragma("unroll") for (int n = 0; n < 2; ++n) { const int cloc = bj * 128 + wc * 32 + n * 16 + fq * 4; const f32x4 v = acc[ai][bj][m][n];
#define EPI_LOOP_END } }

struct EpiInEven {
    static constexpr bool PERM = false, AFTER_DRAIN = false;
    bf16_t* Pb; float* IW; const float* cs;
    __device__ __forceinline__ void operator()(const f32x4 (&acc)[2][2][4][2], const Unit& u, int wr, int wc, int fr, int fq) const {
        EPI_LOOP_BEGIN
            const int row = u.pm * 256 + rloc, c0 = u.pn * 256 + cloc, pos = row & (SEQ - 1);
            if (c0 < P_EVEN) {
                if (c0 == E_IW) { *(f32x4*)(IW + (size_t)row * 4) = v; }
                else {
                    f32x4 o = v;
                    const bool rope = (c0 < 1024) || (c0 >= 1536 && c0 < 2176) || (c0 >= 2304 && c0 < 2624);
                    if (rope) { const f32x4 t = *(const f32x4*)(cs + ((size_t)pos * 32 + ((c0 & 63) >> 1)) * 2);
                        o[0] = v[0] * t[0] - v[1] * t[1]; o[1] = v[1] * t[0] + v[0] * t[1]; o[2] = v[2] * t[2] - v[3] * t[3]; o[3] = v[3] * t[2] + v[2] * t[3]; }
                    u32x2 w; w.x = pk2(o[0], o[1]); w.y = pk2(o[2], o[3]);
                    *(u32x2*)(Pb + (size_t)row * LDPB + c0) = w;
                }
            }
        EPI_LOOP_END
    }
};
struct EpiInOdd {
    static constexpr bool PERM = false, AFTER_DRAIN = false;
    bf16_t* Pb; bf16_t* QRb; float* G; const float* cs; const float* gb;
    __device__ __forceinline__ void operator()(const f32x4 (&acc)[2][2][4][2], const Unit& u, int wr, int wc, int fr, int fq) const {
        EPI_LOOP_BEGIN
            const int row = u.pm * 256 + rloc, c0 = u.pn * 256 + cloc, pos = row & (SEQ - 1);
            if (c0 < P_ODD) {
                if (c0 >= O_DG) {
                    const int j = c0 - O_DG; f32x4 o;
#pragma unroll
                    for (int e = 0; e < 4; ++e) o[e] = 1.f / (1.f + expf(-(v[e] + gb[j + e])));
                    *(f32x4*)(G + (size_t)row * 24 + j) = o;
                } else {
                    const bool isq = (c0 >= O_DQ && c0 < O_KC);
                    const bool rope = (c0 < 1024) || isq || (c0 >= O_KS && c0 < O_VS) || (c0 >= O_KW && c0 < O_VW);
                    f32x4 o = v;
                    if (rope) { const f32x4 t = *(const f32x4*)(cs + ((size_t)pos * 32 + ((c0 & 63) >> 1)) * 2);
                        o[0] = v[0] * t[0] - v[1] * t[1]; o[1] = v[1] * t[0] + v[0] * t[1]; o[2] = v[2] * t[2] - v[3] * t[3]; o[3] = v[3] * t[2] + v[2] * t[3]; }
                    u32x2 w; w.x = pk2(o[0], o[1]); w.y = pk2(o[2], o[3]);
                    if (isq) { *(u32x2*)(QRb + (size_t)row * 512 + (c0 - O_DQ)) = w; w.x = pk2(v[0], v[1]); w.y = pk2(v[2], v[3]); }
                    *(u32x2*)(Pb + (size_t)row * LDPB + c0) = w;
                }
            }
        EPI_LOOP_END
    }
};
struct EpiY {
    static constexpr bool PERM = false, AFTER_DRAIN = false;
    bf16_t* Y;
    __device__ __forceinline__ void operator()(const f32x4 (&acc)[2][2][4][2], const Unit& u, int wr, int wc, int fr, int fq) const {
        EPI_LOOP_BEGIN
            u32x2 w; w.x = pk2(v[0], v[1]); w.y = pk2(v[2], v[3]);
            *(u32x2*)(Y + (size_t)(u.pm * 256 + rloc) * DM + u.pn * 256 + cloc) = w;
        EPI_LOOP_END
    }
};
struct EpiGU {
    static constexpr bool PERM = false, AFTER_DRAIN = false;
    bf16_t* H; int ldh; int npn; int row_tile0;
    __device__ __forceinline__ void operator()(const f32x4 (&acc)[2][2][4][2], const Unit& u, int wr, int wc, int fr, int fq) const {
        const int pnl = u.pn % npn;
#pragma unroll
        for (int ai = 0; ai < 2; ++ai)
#pragma unroll
            for (int m = 0; m < 4; ++m) { const int rloc = ai * 128 + wr * 64 + m * 16 + fr;
                bf16_t* hrow = H + (size_t)((u.pm - row_tile0) * 256 + rloc) * ldh;
#pragma unroll
                for (int bj = 0; bj < 2; ++bj) { const f32x4 g = acc[ai][bj][m][0], uu = acc[ai][bj][m][1];
                    const int unit0 = (pnl * 256 + bj * 128 + wc * 32) / 2 + fq * 4;
                    f32x4 o;
#pragma unroll
                    for (int e = 0; e < 4; ++e) o[e] = g[e] * __builtin_amdgcn_rcpf(1.f + __expf(-g[e])) * uu[e];
                    u32x2 w; w.x = pk2(o[0], o[1]); w.y = pk2(o[2], o[3]);
                    *(u32x2*)(hrow + unit0) = w; } }
    }
};
struct EpiDownMoe {
    static constexpr bool PERM = false, AFTER_DRAIN = false;
    bf16_t* Ys; const float* sg;
    __device__ __forceinline__ void operator()(const f32x4 (&acc)[2][2][4][2], const Unit& u, int wr, int wc, int fr, int fq) const {
        const int pnl = u.pn & 3;
#pragma unroll
        for (int ai = 0; ai < 2; ++ai)
#pragma unroll
            for (int m = 0; m < 4; ++m) { const int slot = u.pm * 256 + ai * 128 + wr * 64 + m * 16 + fr; const float gt = sg[slot];
#pragma unroll
                for (int bj = 0; bj < 2; ++bj)
#pragma unroll
                    for (int n = 0; n < 2; ++n) { const f32x4 v = acc[ai][bj][m][n] * gt; const int c0 = pnl * 256 + bj * 128 + wc * 32 + n * 16 + fq * 4;
                        u32x2 w; w.x = pk2(v[0], v[1]); w.y = pk2(v[2], v[3]);
                        *(u32x2*)(Ys + (size_t)slot * DM + c0) = w; } }
    }
};
struct EpiGeluH {
    static constexpr bool PERM = false, AFTER_DRAIN = false;
    bf16_t* Hc;
    __device__ __forceinline__ void operator()(const f32x4 (&acc)[2][2][4][2], const Unit& u, int wr, int wc, int fr, int fq) const {
        EPI_LOOP_BEGIN
            f32x4 o;
#pragma unroll
            for (int e = 0; e < 4; ++e) { const float x = v[e], uu = 0.7978845608028654f * (x + 0.044715f * x * x * x); o[e] = x - x * __builtin_amdgcn_rcpf(1.f + __expf(2.f * uu)); }
            u32x2 w; w.x = pk2(o[0], o[1]); w.y = pk2(o[2], o[3]);
            *(u32x2*)(Hc + (size_t)(u.pm * 256 + rloc) * 256 + cloc) = w;
        EPI_LOOP_END
    }
};
struct EpiCmp {
    static constexpr bool PERM = false, AFTER_DRAIN = false;
    bf16_t* C;
    __device__ __forceinline__ void operator()(const f32x4 (&acc)[2][2][4][2], const Unit& u, int wr, int wc, int fr, int fq) const {
        EPI_LOOP_BEGIN
            if (cloc < 64) { u32x2 w; w.x = pk2(v[0], v[1]); w.y = pk2(v[2], v[3]); *(u32x2*)(C + (size_t)(u.pm * 256 + rloc) * 64 + cloc) = w; }
        EPI_LOOP_END
    }
};
struct ListOrder {
    static constexpr bool KSPLIT = false, GATHER_A = false;
    int n, G, c;
    __device__ __forceinline__ bool next(int i, Unit& u) const { const int L = i * G + c; if (L >= n) return false; u.pm = L; u.pn = L >> 4; return true; }
    __device__ __forceinline__ void a_ready(const Unit&) const {}
    __device__ __forceinline__ void done(const Unit&) const {}
};
constexpr int MOE_TE_LDS = 139264;
struct MoeOrder {
    static constexpr bool KSPLIT = false, GATHER_A = false;
    int t0, ntr, npn, G, c;
    __device__ __forceinline__ bool next(int i, Unit& u) const {
        extern __shared__ __attribute__((aligned(16))) float lds_dyn_[];
        int tm, pl;
        if (G == 256 && ntr == 128) {
            const int x = c & 7, j = c >> 3, ncb = npn >> 2, nrounds = 2 * ncb;
            if (i >= nrounds) return false;
            const int rb = i / ncb, cb = i - rb * ncb;
            tm = t0 + 16 * x + 8 * rb + (j >> 2); pl = 4 * cb + (j & 3);
        } else {
            const int L = i * G + c; if (L >= ntr * npn) return false;
            tm = t0 + L / npn; pl = L % npn;
        }
        const int e = ((const LAS int*)((LAS unsigned char*)lds_dyn_ + MOE_TE_LDS))[tm];
        if (e < 0) return false;
        u.pm = tm; u.pn = e * npn + pl; return true;
    }
    __device__ __forceinline__ void a_ready(const Unit&) const {}
    __device__ __forceinline__ void done(const Unit&) const {}
};
struct MoeOrderG {
    static constexpr bool KSPLIT = false, GATHER_A = true;
    int t0, ntr, npn, G, c, rb; const int* slot_tok;
    __device__ __forceinline__ int arow(int slot) const { const int t = slot_tok[slot]; return t < 0 ? NTOK : t; }
    __device__ __forceinline__ bool next(int i, Unit& u) const {
        extern __shared__ __attribute__((aligned(16))) float lds_dyn_[];
        int tm, pl;
        if (ntr == 128) { const int x = c & 7, j = c >> 3, ncb = npn >> 2; if (i >= ncb) return false; tm = t0 + 16 * x + 8 * rb + (j >> 2); pl = 4 * i + (j & 3); }
        else { if (i > 0 || c >= ntr * npn) return false; tm = t0 + c / npn; pl = c % npn; }
        const int e = ((const LAS int*)((LAS unsigned char*)lds_dyn_ + MOE_TE_LDS))[tm];
        if (e < 0) return false;
        u.pm = tm; u.pn = e * npn + pl; return true;
    }
    __device__ __forceinline__ void a_ready(const Unit&) const {}
    __device__ __forceinline__ void done(const Unit&) const {}
};
constexpr int MOE_TAIL_T0 = 256, MOE_TAIL_TILES = NTILE256 - 256, MOE_KSL = 7, MOE_KSL_K = F_EXPERT / MOE_KSL;
struct TailOrder {
    static constexpr bool KSPLIT = true, GATHER_A = false;
    int G, c;
    __device__ __forceinline__ bool next(int i, Unit& u) const {
        extern __shared__ __attribute__((aligned(16))) float lds_dyn_[];
        const int L = i * G + c; if (L >= MOE_TAIL_TILES * 4 * MOE_KSL) return false;
        const int sl = L / (MOE_TAIL_TILES * 4), rem = L - sl * (MOE_TAIL_TILES * 4), tm = MOE_TAIL_T0 + (rem >> 2), pl = rem & 3;
        const int e = ((const LAS int*)((LAS unsigned char*)lds_dyn_ + MOE_TE_LDS))[tm];
        if (e < 0) return false;
        u.pm = tm; u.pn = e * 4 + pl; u.ko = sl * MOE_KSL_K; return true;
    }
    __device__ __forceinline__ void a_ready(const Unit&) const {}
    __device__ __forceinline__ void done(const Unit&) const {}
};
struct EpiDownTail {
    static constexpr bool PERM = false, AFTER_DRAIN = false;
    bf16_t* Yp; const float* sg;
    __device__ __forceinline__ void operator()(const f32x4 (&acc)[2][2][4][2], const Unit& u, int wr, int wc, int fr, int fq) const {
        const int pnl = u.pn & 3, sl = u.ko / MOE_KSL_K;
#pragma unroll
        for (int ai = 0; ai < 2; ++ai)
#pragma unroll
            for (int m = 0; m < 4; ++m) { const int slot = u.pm * 256 + ai * 128 + wr * 64 + m * 16 + fr; const float gt = sg[slot];
                bf16_t* row = Yp + ((size_t)sl * (MOE_TAIL_TILES * 256) + (slot - MOE_TAIL_T0 * 256)) * DM;
#pragma unroll
                for (int bj = 0; bj < 2; ++bj)
#pragma unroll
                    for (int n = 0; n < 2; ++n) { const f32x4 v = acc[ai][bj][m][n] * gt; const int c0 = pnl * 256 + bj * 128 + wc * 32 + n * 16 + fq * 4;
                        u32x2 w; w.x = pk2(v[0], v[1]); w.y = pk2(v[2], v[3]);
                        *(u32x2*)(row + c0) = w; } }
    }
};

template <class F>
__device__ __forceinline__ void convert_T(bf16_t* dst, int Nphys, int K, int ld, F rowsrc, long gid, long gstride) {
    const long total = (long)Nphys * (K >> 3);
    for (long idx0 = gid; idx0 < total; idx0 += 4 * gstride) {
        float v[4][8]; int nn[4], kk[4]; bool ok[4];
#pragma unroll
        for (int u = 0; u < 4; ++u) {
            const long idx = idx0 + u * gstride; ok[u] = idx < total;
            const long idc = ok[u] ? idx : idx0;
            nn[u] = (int)(idc % Nphys); kk[u] = (int)(idc / Nphys);
            const float* s = rowsrc(nn[u]);
            if (s) {
#pragma unroll
                for (int i = 0; i < 8; ++i) v[u][i] = s[(size_t)(kk[u] * 8 + i) * ld];
            } else {
#pragma unroll
                for (int i = 0; i < 8; ++i) v[u][i] = 0.f;
            }
        }
#pragma unroll
        for (int u = 0; u < 4; ++u) if (ok[u]) {
            uint4 w; w.x = pk2(v[u][0], v[u][1]); w.y = pk2(v[u][2], v[u][3]); w.z = pk2(v[u][4], v[u][5]); w.w = pk2(v[u][6], v[u][7]);
            *(uint4*)(dst + (size_t)nn[u] * K + kk[u] * 8) = w;
        }
    }
}
__device__ __forceinline__ int rope_nat(int n) { const int w = n & 63; return (n & ~63) + (w >> 1) + 32 * (w & 1); }

__device__ __forceinline__ void sincos_d(double a, double& s, double& c) {
    const double n = rint(a * 0.6366197723675814);
    double y = fma(-n, 1.5707963267948966, a); y = fma(-n, 6.123233995736766e-17, y);
    const int q = ((int)n) & 3;
    const double y2 = y * y;
    const double sp = y * (1.0 + y2 * (-1.0 / 6 + y2 * (1.0 / 120 + y2 * (-1.0 / 5040 + y2 * (1.0 / 362880 + y2 * (-1.0 / 39916800 + y2 * (1.0 / 6227020800.0)))))));
    const double cp = 1.0 + y2 * (-0.5 + y2 * (1.0 / 24 + y2 * (-1.0 / 720 + y2 * (1.0 / 40320 + y2 * (-1.0 / 3628800 + y2 * (1.0 / 479001600.0 + y2 * (-1.0 / 87178291200.0)))))));
    s = (q == 0) ? sp : (q == 1) ? cp : (q == 2) ? -sp : -cp;
    c = (q == 0) ? cp : (q == 1) ? -sp : (q == 2) ? -cp : sp;
}

template <class F>
__device__ __forceinline__ void convert_tiles(bf16_t* dst, int Nphys, int K, int ld, F src8, float* ldsf, int tile0, int tile_step) {
    const int tid = tid_();
    bf16_t* lt = (bf16_t*)ldsf;
    const int nkt = K >> 6, ntiles = (Nphys >> 7) * nkt;
    const int kl = tid >> 4, c = tid & 15;
    const int rn = tid >> 2, rq = tid & 3;
    float4 a0, a1, b0, b1;
#define CT_LOAD(tl, A0, A1, B0, B1) do { const int nt_ = (tl) / nkt, kt_ = (tl) - nt_ * nkt; const float* s_ = src8(nt_ * 128, c) + (size_t)(kt_ * 64 + kl) * ld; \
        A0 = *(const float4*)s_; A1 = *(const float4*)(s_ + 4); B0 = *(const float4*)(s_ + (size_t)32 * ld); B1 = *(const float4*)(s_ + (size_t)32 * ld + 4); } while (0)
    if (tile0 < ntiles) CT_LOAD(tile0, a0, a1, b0, b1);
    for (int tile = tile0; tile < ntiles; tile += tile_step) {
        const int nt = tile / nkt, kt = tile - nt * nkt, n0 = nt * 128, k0 = kt * 64;
        float4 na0 = a0, na1 = a1, nb0 = b0, nb1 = b1;
        if (tile + tile_step < ntiles) CT_LOAD(tile + tile_step, na0, na1, nb0, nb1);
        __syncthreads();
        const float va[8] = {a0.x, a0.y, a0.z, a0.w, a1.x, a1.y, a1.z, a1.w}, vb[8] = {b0.x, b0.y, b0.z, b0.w, b1.x, b1.y, b1.z, b1.w};
#pragma unroll
        for (int e = 0; e < 8; ++e) { lt[(8 * c + e) * 72 + kl] = f2bf(va[e]); lt[(8 * c + e) * 72 + kl + 32] = f2bf(vb[e]); }
        __syncthreads();
        const uint4 w0 = *(const uint4*)(lt + rn * 72 + rq * 16), w1 = *(const uint4*)(lt + rn * 72 + rq * 16 + 8);
        bf16_t* d = dst + (size_t)(n0 + rn) * K + k0 + rq * 16;
        *(uint4*)d = w0; *(uint4*)(d + 8) = w1;
        a0 = na0; a1 = na1; b0 = nb0; b1 = nb1;
    }
#undef CT_LOAD
}

__device__ __forceinline__ int rot_tile0(int rot, int G) { const int r = (int)blockIdx.x - rot % G; return r < 0 ? r + G : r; }
__device__ __forceinline__ void ph_init(const Params& p, float* lds) {
    const int tid = tid_();
    const long gid = (long)blockIdx.x * NT + tid, gs = (long)gridDim.x * NT;
    int rot = 0;
    for (long i = gid; i < 4096 * 32; i += gs) {
        const int pos = (int)(i >> 5), f = (int)(i & 31);
        const float angf = (float)pos * c_inv[f];
        double s, c; sincos_d((double)angf, s, c);
        p.ropecs[2 * i] = (float)c; p.ropecs[2 * i + 1] = (float)s;
    }
    if (gid < DM / 2) ((unsigned*)(p.Xb + (size_t)NTOK * DM))[gid] = 0u;
    const float4* xs = (const float4*)p.in[IN_X]; u32x2* xb = (u32x2*)p.Xb;
    for (long i = gid; i < (long)NTOK * DM / 4; i += 4 * gs) {
        float4 v[4];
#pragma unroll
        for (int u = 0; u < 4; ++u) { const long j = i + u * gs; v[u] = xs[j < (long)NTOK * DM / 4 ? j : i]; }
#pragma unroll
        for (int u = 0; u < 4; ++u) { const long j = i + u * gs; if (j < (long)NTOK * DM / 4) { u32x2 w; w.x = pk2(v[u].x, v[u].y); w.y = pk2(v[u].z, v[u].w); xb[j] = w; } }
    }
#pragma unroll 1
    for (int li = 0; li < 2; ++li) {
        { const float* W = p.in[IN_EV_WIN] + (size_t)li * DM * P_EVEN;
          convert_T(p.WinE + (size_t)li * NP_EVEN * DM, NP_EVEN, DM, P_EVEN, [=](int n) -> const float* {
              if (n >= P_EVEN) return nullptr;
              const bool rope = (n < 1024) || (n >= 1536 && n < 2176) || (n >= 2304 && n < 2624);
              return W + (rope ? rope_nat(n) : n); }, gid, gs); }
        { const float* W = p.in[IN_OD_WIN] + (size_t)li * DM * P_ODD;
          convert_T(p.WinO + (size_t)li * NP_ODD * DM, NP_ODD, DM, P_ODD, [=](int n) -> const float* {
              if (n >= P_ODD) return nullptr;
              const bool rope = (n < 1024) || (n >= O_DQ && n < O_KC) || (n >= O_KS && n < O_VS) || (n >= O_KW && n < O_VW);
              return W + (rope ? rope_nat(n) : n); }, gid, gs); }
        { const float* W = p.in[IN_EV_WOUT] + (size_t)li * DM * DM;
          convert_tiles(p.WoutE + (size_t)li * DM * DM, DM, DM, DM, [=](int n0, int c) -> const float* { return W + n0 + 8 * c; }, lds, rot_tile0(rot, gridDim.x), gridDim.x); rot += 128; }
        { const float* W = p.in[IN_OD_WOUT] + (size_t)li * DM * DM;
          convert_tiles(p.WoutO + (size_t)li * DM * DM, DM, DM, DM, [=](int n0, int c) -> const float* { return W + n0 + 8 * c; }, lds, rot_tile0(rot, gridDim.x), gridDim.x); rot += 128; }
        { const float* Wg = p.in[IN_FFD_WG] + (size_t)li * DM * F_DENSE; const float* Wu = p.in[IN_FFD_WU] + (size_t)li * DM * F_DENSE; const long dWu = (const char*)Wu - (const char*)Wg;
          convert_tiles(p.WguD + (size_t)li * 2 * F_DENSE * DM, 2 * F_DENSE, DM, F_DENSE, [=](int n0, int c) -> const float* {
              const int unit0 = n0 / 2 + (c >> 2) * 16 + (c & 1) * 8; return (const float*)((const char*)Wg + ((c & 2) ? dWu : 0l)) + unit0; }, lds, rot_tile0(rot, gridDim.x), gridDim.x); rot += 704; }
        { const float* W = p.in[IN_FFD_WD] + (size_t)li * F_DENSE * DM;
          convert_tiles(p.WdD + (size_t)li * DM * F_DENSE, DM, F_DENSE, DM, [=](int n0, int c) -> const float* { return W + n0 + 8 * c; }, lds, rot_tile0(rot, gridDim.x), gridDim.x); rot += 352; }
#pragma unroll 1
        for (int which = 0; which < 2; ++which) {
            const float* W1 = p.in[IN_NSA_W1] + (size_t)(li * 2 + which) * 2048 * 256;
            convert_tiles(p.W1T + (size_t)(li * 2 + which) * 256 * 2048, 256, 2048, 256, [=](int n0, int c) -> const float* { return W1 + n0 + 8 * c; }, lds, rot_tile0(rot, gridDim.x), gridDim.x); rot += 64;
            const float* W2 = p.in[IN_NSA_W2] + (size_t)(li * 2 + which) * 256 * 64;
            convert_T(p.W2T + (size_t)(li * 2 + which) * 256 * 256, 256, 256, 64, [=](int n) -> const float* { if (n >= 64) return nullptr; return W2 + (which ? n : rope_nat(n)); }, gid, gs);
        }
    }
}
__device__ __forceinline__ void ph_convert_moe(const Params& p, int li, float* lds) {
    const float* Wg = p.in[IN_MOE_WG] + (size_t)li * N_EXP * DM * F_EXPERT; const float* Wu = p.in[IN_MOE_WU] + (size_t)li * N_EXP * DM * F_EXPERT; const long dWu = (const char*)Wu - (const char*)Wg;
    convert_tiles(p.WguM, N_EXP * 2 * F_EXPERT, DM, F_EXPERT, [=](int n0, int c) -> const float* {
        const int e = n0 / (2 * F_EXPERT), unit0 = (n0 % (2 * F_EXPERT)) / 2 + (c >> 2) * 16 + (c & 1) * 8;
        return (const float*)((const char*)Wg + ((c & 2) ? dWu : 0l)) + (size_t)e * DM * F_EXPERT + unit0; }, lds, blockIdx.x, gridDim.x);
    const float* Wd = p.in[IN_MOE_WD] + (size_t)li * N_EXP * F_EXPERT * DM;
    convert_tiles(p.WdM, N_EXP * DM, F_EXPERT, DM, [=](int n0, int c) -> const float* { return Wd + (size_t)(n0 >> 10) * F_EXPERT * DM + (n0 & 1023) + 8 * c; }, lds, blockIdx.x, gridDim.x);
}

struct CvJob {
    const float* Wg; long dWu; const float* Wd; bf16_t* dgu; bf16_t* ddn; bf16_t* lt0;
    int t, tend, step_, par; bool pend; bf16_t* pdst;
    float4 a0, a1, b0, b1;
    static constexpr int NT1 = (N_EXP * 2 * F_EXPERT / 128) * (DM / 64), NT2 = (N_EXP * DM / 128) * (F_EXPERT / 64);
    __device__ __forceinline__ void load(int tl, int tid) {
        const int kl = tid >> 4, c = tid & 15; const float* s_; size_t ld;
        if (tl < NT1) { const int nt = tl >> 4, kt = tl & 15, n0 = nt * 128; const int e = n0 / (2 * F_EXPERT), unit0 = (n0 % (2 * F_EXPERT)) / 2 + (c >> 2) * 16 + (c & 1) * 8;
            ld = F_EXPERT; s_ = (const float*)((const char*)Wg + ((c & 2) ? dWu : 0l)) + (size_t)e * DM * F_EXPERT + unit0 + (size_t)(kt * 64 + kl) * ld; }
        else { const int t2 = tl - NT1, nt = t2 / (F_EXPERT / 64), kt = t2 - nt * (F_EXPERT / 64), n0 = nt * 128;
            ld = DM; s_ = Wd + (size_t)(n0 >> 10) * F_EXPERT * DM + (n0 & 1023) + 8 * c + (size_t)(kt * 64 + kl) * ld; }
        a0 = *(const float4*)s_; a1 = *(const float4*)(s_ + 4); b0 = *(const float4*)(s_ + 32 * ld); b1 = *(const float4*)(s_ + 32 * ld + 4);
    }
    __device__ __forceinline__ void init(const Params& p, int li, float* ldsf, int tid) {
        Wg = p.in[IN_MOE_WG] + (size_t)li * N_EXP * DM * F_EXPERT; const float* Wu = p.in[IN_MOE_WU] + (size_t)li * N_EXP * DM * F_EXPERT; dWu = (const char*)Wu - (const char*)Wg;
        Wd = p.in[IN_MOE_WD] + (size_t)li * N_EXP * F_EXPERT * DM; dgu = p.WguM; ddn = p.WdM; lt0 = (bf16_t*)ldsf;
        t = blockIdx.x; step_ = gridDim.x; tend = NT1 + NT2; par = 0; pend = false; pdst = dgu;
        if (t < tend) load(t, tid);
    }
    __device__ __forceinline__ void step(int tid) {
        const int kl = tid >> 4, c = tid & 15, rn = tid >> 2, rq = tid & 3;
        if (pend) { const bf16_t* lt = lt0 + (par ^ 1) * (128 * 72);
            const uint4 w0 = *(const uint4*)(lt + rn * 72 + rq * 16), w1 = *(const uint4*)(lt + rn * 72 + rq * 16 + 8);
            *(uint4*)pdst = w0; *(uint4*)(pdst + 8) = w1; }
        if (t < tend) {
            bf16_t* lt = lt0 + par * (128 * 72);
            const float va[8] = {a0.x, a0.y, a0.z, a0.w, a1.x, a1.y, a1.z, a1.w}, vb[8] = {b0.x, b0.y, b0.z, b0.w, b1.x, b1.y, b1.z, b1.w};
#pragma unroll
            for (int e = 0; e < 8; ++e) { lt[(8 * c + e) * 72 + kl] = f2bf(va[e]); lt[(8 * c + e) * 72 + kl + 32] = f2bf(vb[e]); }
            if (t < NT1) { const int nt = t >> 4, kt = t & 15; pdst = dgu + (size_t)(nt * 128 + rn) * DM + kt * 64 + rq * 16; }
            else { const int t2 = t - NT1, nt = t2 / (F_EXPERT / 64), kt = t2 - nt * (F_EXPERT / 64); pdst = ddn + (size_t)(nt * 128 + rn) * F_EXPERT + kt * 64 + rq * 16; }
            pend = true; t += step_;
            if (t < tend) load(t, tid);
        } else pend = false;
        par ^= 1;
    }
    __device__ __forceinline__ void finish(int tid) { while (pend || t < tend) { __syncthreads(); step(tid); } }
};

__device__ __forceinline__ void ph_kmean(const Params& p, float* lds) {
    const int tid = tid_(), ch = tid & 7, kg = tid >> 3;
    for (int item = blockIdx.x; item < 8 * 16 * 8; item += gridDim.x) {
        const int h = item & 7, blk = (item >> 3) & 15, b = item >> 7;
        float s[8] = {0.f, 0.f, 0.f, 0.f, 0.f, 0.f, 0.f, 0.f};
        uint4 kv[4];
#pragma unroll
        for (int j = 0; j < 4; ++j) kv[j] = *(const uint4*)(p.Pb + (size_t)(b * SEQ + blk * 256 + kg * 4 + j) * LDPB + O_CK + h * 64 + ch * 8);
#pragma unroll
        for (int j = 0; j < 4; ++j) {
            s[0] += __builtin_bit_cast(float, kv[j].x << 16); s[1] += __builtin_bit_cast(float, kv[j].x & 0xffff0000u);
            s[2] += __builtin_bit_cast(float, kv[j].y << 16); s[3] += __builtin_bit_cast(float, kv[j].y & 0xffff0000u);
            s[4] += __builtin_bit_cast(float, kv[j].z << 16); s[5] += __builtin_bit_cast(float, kv[j].z & 0xffff0000u);
            s[6] += __builtin_bit_cast(float, kv[j].w << 16); s[7] += __builtin_bit_cast(float, kv[j].w & 0xffff0000u);
        }
#pragma unroll
        for (int e = 0; e < 8; ++e) { s[e] += __shfl_xor(s[e], 8); s[e] += __shfl_xor(s[e], 16); s[e] += __shfl_xor(s[e], 32); }
        __syncthreads();
        if ((tid & 63) < 8) {
#pragma unroll
            for (int e = 0; e < 8; ++e) lds[(tid >> 6) * 64 + ch * 8 + e] = s[e];
        }
        __syncthreads();
        if (tid < 64) { float a = 0.f;
#pragma unroll
            for (int q = 0; q < 8; ++q) a += lds[q * 64 + tid];
            p.kmean[(size_t)item * 64 + tid] = a * (1.f / 256.f); }
    }
}

__device__ __forceinline__ void ph_cmp_build(const Params& p, int li) {
    const int tid = tid_();
    const long gs = (long)gridDim.x * NT;
    for (long idx0 = (long)blockIdx.x * NT + tid; idx0 < 2l * 4096 * 256; idx0 += 4 * gs) {
      pg8::u32x4 kvv[4];
#pragma unroll
      for (int u = 0; u < 4; ++u) {
        const long idx = (idx0 + u * gs < 2l * 4096 * 256) ? idx0 + u * gs : idx0;
        const int ch = (int)(idx & 255), m = (int)((idx >> 8) & 4095), which = (int)(idx >> 20);
        const int i = (m & 255) < 255 ? (m & 255) : 0, bg = m >> 8, b = bg >> 1, g = bg & 1, t = ch >> 3, d0 = (ch & 7) * 8;
        kvv[u] = *(const pg8::u32x4*)(p.Pb + (size_t)(b * SEQ + 16 * i + t) * LDPB + (which ? O_VC : O_KC) + g * 64 + d0);
      }
#pragma unroll
      for (int u = 0; u < 4; ++u) {
        const long idx = idx0 + u * gs;
        if (idx >= 2l * 4096 * 256) continue;
        const int ch = (int)(idx & 255), m = (int)((idx >> 8) & 4095), which = (int)(idx >> 20);
        const int i = m & 255, t = ch >> 3, d0 = (ch & 7) * 8;
        uint4 w = make_uint4(0u, 0u, 0u, 0u);
        if (i < 255) {
            uint4 kv; kv.x = kvv[u].x; kv.y = kvv[u].y; kv.z = kvv[u].z; kv.w = kvv[u].w;
            const float* pe = p.in[IN_NSA_PE] + (size_t)(li * 2 + which) * 2048 + t * 64 + d0;
            const float4 e0 = *(const float4*)pe, e1 = *(const float4*)(pe + 4);
            w.x = pk2(__builtin_bit_cast(float, kv.x << 16) + e0.x, __builtin_bit_cast(float, kv.x & 0xffff0000u) + e0.y);
            w.y = pk2(__builtin_bit_cast(float, kv.y << 16) + e0.z, __builtin_bit_cast(float, kv.y & 0xffff0000u) + e0.w);
            w.z = pk2(__builtin_bit_cast(float, kv.z << 16) + e1.x, __builtin_bit_cast(float, kv.z & 0xffff0000u) + e1.y);
            w.w = pk2(__builtin_bit_cast(float, kv.w << 16) + e1.z, __builtin_bit_cast(float, kv.w & 0xffff0000u) + e1.w);
        }
        *(uint4*)(p.Ac + ((size_t)(which * 4096 + m) * 2048 + ch * 8)) = w;
      }
    }
}

typedef unsigned u32x8v __attribute__((ext_vector_type(8)));
typedef float f32x16v __attribute__((ext_vector_type(16)));
__device__ __forceinline__ u32x8v ld_row8(const bf16_t* row, int lane) {
    const u32x2* r = (const u32x2*)row; const u32x2 a = r[lane], b = r[64 + lane], c = r[128 + lane], d = r[192 + lane];
    return (u32x8v){a.x, a.y, b.x, b.y, c.x, c.y, d.x, d.y};
}
__device__ __forceinline__ f32x16v ld_row16f(const float* row, int lane) {
    const float4* r = (const float4*)row; const float4 a = r[lane], b = r[64 + lane], c = r[128 + lane], d = r[192 + lane];
    return (f32x16v){a.x, a.y, a.z, a.w, b.x, b.y, b.z, b.w, c.x, c.y, c.z, c.w, d.x, d.y, d.z, d.w};
}
__device__ __forceinline__ float bf_el(const u32x8v v, int i) { const unsigned u = v[i >> 1]; return __builtin_bit_cast(float, (i & 1) ? (u & 0xffff0000u) : (u << 16)); }
__device__ __forceinline__ u32x8v ld_slot8(const Params& p, int slot_v, int lane) {
    const int slot = __builtin_amdgcn_readfirstlane(slot_v);
    if (slot < MOE_TAIL_T0 * 256) return ld_row8(p.Ys + (size_t)slot * DM, lane);
    u32x8v part[MOE_KSL];
#pragma unroll
    for (int sl = 0; sl < MOE_KSL; ++sl) part[sl] = ld_row8(p.Yp + ((size_t)sl * (MOE_TAIL_TILES * 256) + (slot - MOE_TAIL_T0 * 256)) * DM, lane);
    u32x8v o;
#pragma unroll
    for (int j = 0; j < 8; ++j) {
        float lo = 0.f, hi = 0.f;
#pragma unroll
        for (int sl = 0; sl < MOE_KSL; ++sl) { lo += __builtin_bit_cast(float, part[sl][j] << 16); hi += __builtin_bit_cast(float, part[sl][j] & 0xffff0000u); }
        o[j] = pk2(lo, hi);
    }
    return o;
}
template <int MODE, int XSRC>
__device__ __forceinline__ void ph_ln(const Params& p, const float* gam, const float* bet, const float* Xin, float* Xout, bf16_t* Xbout, const bool wf32) {
    const int lane = tid_() & 63, wid = tid_() >> 6;
    const int stride = gridDim.x * 8;
    int t = blockIdx.x * 8 + wid;
    if (t < NTOK) {
        f32x16v xf, xfn; u32x8v xb8, xbn, ya, yan, yb, ybn;
        int n0 = 0, n1 = 0;
#define LN_LOAD(tt, S0, S1, XF, XB, YA, YB) do { \
        if (XSRC == 0) XF = ld_row16f(Xin + (size_t)(tt) * DM, lane); else XB = ld_row8(Xbout + (size_t)(tt) * DM, lane); \
        if (MODE == 0) YA = ld_row8((const bf16_t*)p.Y + (size_t)(tt) * DM, lane); \
        else { YA = ld_slot8(p, S0, lane); YB = ld_slot8(p, S1, lane); } } while (0)
        {
            int s0 = 0, s1 = 0;
            if (MODE == 1) { s0 = p.tok_slot[2 * t]; s1 = p.tok_slot[2 * t + 1]; const int tn = (t + stride < NTOK) ? t + stride : t; n0 = p.tok_slot[2 * tn]; n1 = p.tok_slot[2 * tn + 1]; }
            LN_LOAD(t, s0, s1, xf, xb8, ya, yb);
        }
        for (; t < NTOK; t += stride) {
            const int tn = (t + stride < NTOK) ? t + stride : t;
            LN_LOAD(tn, n0, n1, xfn, xbn, yan, ybn);
            int m0 = 0, m1 = 0;
            if (MODE == 1) { const int t2 = (tn + stride < NTOK) ? tn + stride : tn; m0 = p.tok_slot[2 * t2]; m1 = p.tok_slot[2 * t2 + 1]; }
            f32x16v v; float s = 0.f;
#pragma unroll
            for (int c = 0; c < 4; ++c) {
#pragma unroll
                for (int e = 0; e < 4; ++e) {
                    const int i = c * 4 + e;
                    const float x = (XSRC == 0) ? xf[i] : bf_el(xb8, i);
                    const float y = (MODE == 0) ? bf_el(ya, i) : bf_el(ya, i) + bf_el(yb, i);
                    v[i] = ALPHA * x + y;
                }
                s += (v[c * 4] + v[c * 4 + 1]) + (v[c * 4 + 2] + v[c * 4 + 3]);
            }
            const float mu = wave_sum(s) * (1.f / 1024.f);
            float q = 0.f;
#pragma unroll
            for (int c = 0; c < 4; ++c) { const float a = v[c * 4] - mu, b2 = v[c * 4 + 1] - mu, c2 = v[c * 4 + 2] - mu, d2 = v[c * 4 + 3] - mu; q += (a * a + b2 * b2) + (c2 * c2 + d2 * d2); }
            const float var = wave_sum(q) * (1.f / 1024.f);
            const float rs = 1.0f / sqrtf(var + LN_EPS);
            u32x2* xb = (u32x2*)(Xbout + (size_t)t * DM); float4* xo = (float4*)(Xout + (size_t)t * DM);
#pragma unroll
            for (int c = 0; c < 4; ++c) {
                const float4 gg = ((const float4*)gam)[c * 64 + lane], bb = ((const float4*)bet)[c * 64 + lane];
                float4 o; o.x = (v[c * 4] - mu) * rs * gg.x + bb.x; o.y = (v[c * 4 + 1] - mu) * rs * gg.y + bb.y; o.z = (v[c * 4 + 2] - mu) * rs * gg.z + bb.z; o.w = (v[c * 4 + 3] - mu) * rs * gg.w + bb.w;
                if (wf32) xo[c * 64 + lane] = o;
                u32x2 w; w.x = pk2(o.x, o.y); w.y = pk2(o.z, o.w); xb[c * 64 + lane] = w;
            }
            xf = xfn; xb8 = xbn; ya = yan; yb = ybn; n0 = m0; n1 = m1;
        }
#undef LN_LOAD
    }
}

__device__ __forceinline__ void ph_ln_router(const Params& p, const float* gam, const float* bet, int li, float* lds) {
    const int tid = tid_(), lane = tid & 63, wid = tid >> 6;
    int* lcnt = (int*)lds;
    const float* wr = p.in[IN_MOE_WR] + (size_t)li * 1024 * 8;
    const float* br = p.in[IN_MOE_BR] + li * 8;
    for (int chunk = blockIdx.x; chunk < 256; chunk += gridDim.x) {
        __syncthreads();
        if (tid < 8) lcnt[tid] = 0;
        __syncthreads();
        u32x8v xb8 = ld_row8(p.Xb + (size_t)(chunk * 128 + wid * 16) * DM, lane), ya = ld_row8((const bf16_t*)p.Y + (size_t)(chunk * 128 + wid * 16) * DM, lane);
        for (int q = 0; q < 16; ++q) {
            const int t = chunk * 128 + wid * 16 + q;
            const int tn = (q < 15) ? t + 1 : t;
            const u32x8v xbn = ld_row8(p.Xb + (size_t)tn * DM, lane), yan = ld_row8((const bf16_t*)p.Y + (size_t)tn * DM, lane);
            float4 v[4]; float s = 0.f;
#pragma unroll
            for (int c = 0; c < 4; ++c) {
                v[c].x = ALPHA * bf_el(xb8, c * 4) + bf_el(ya, c * 4); v[c].y = ALPHA * bf_el(xb8, c * 4 + 1) + bf_el(ya, c * 4 + 1);
                v[c].z = ALPHA * bf_el(xb8, c * 4 + 2) + bf_el(ya, c * 4 + 2); v[c].w = ALPHA * bf_el(xb8, c * 4 + 3) + bf_el(ya, c * 4 + 3);
                s += (v[c].x + v[c].y) + (v[c].z + v[c].w);
            }
            xb8 = xbn; ya = yan;
            const float mu = wave_sum(s) * (1.f / 1024.f);
            float qq = 0.f;
#pragma unroll
            for (int c = 0; c < 4; ++c) { const float a = v[c].x - mu, b2 = v[c].y - mu, c2 = v[c].z - mu, d2 = v[c].w - mu; qq += (a * a + b2 * b2) + (c2 * c2 + d2 * d2); }
            const float var = wave_sum(qq) * (1.f / 1024.f);
            const float rs = 1.0f / sqrtf(var + LN_EPS);
            u32x2* xb = (u32x2*)(p.Xb + (size_t)t * DM);
            float a[8] = {0.f, 0.f, 0.f, 0.f, 0.f, 0.f, 0.f, 0.f};
#pragma unroll
            for (int c = 0; c < 4; ++c) {
                const float4 gg = ((const float4*)gam)[c * 64 + lane], bb = ((const float4*)bet)[c * 64 + lane];
                float4 o; o.x = (v[c].x - mu) * rs * gg.x + bb.x; o.y = (v[c].y - mu) * rs * gg.y + bb.y; o.z = (v[c].z - mu) * rs * gg.z + bb.z; o.w = (v[c].w - mu) * rs * gg.w + bb.w;
                u32x2 w; w.x = pk2(o.x, o.y); w.y = pk2(o.z, o.w); xb[c * 64 + lane] = w;
                const float ov[4] = {o.x, o.y, o.z, o.w};
                const float* wk = wr + (size_t)((c * 64 + lane) * 4) * 8;
#pragma unroll
                for (int j = 0; j < 4; ++j) { const float4 w0 = *(const float4*)(wk + j * 8), w1 = *(const float4*)(wk + j * 8 + 4);
                    a[0] += ov[j] * w0.x; a[1] += ov[j] * w0.y; a[2] += ov[j] * w0.z; a[3] += ov[j] * w0.w; a[4] += ov[j] * w1.x; a[5] += ov[j] * w1.y; a[6] += ov[j] * w1.z; a[7] += ov[j] * w1.w; }
            }
            {
                float b4[4], b2[2], b1;
                const bool up1 = lane & 1, up2 = lane & 2, up4 = lane & 4;
#pragma unroll
                for (int e = 0; e < 4; ++e) { const float keep = up1 ? a[e + 4] : a[e], send = up1 ? a[e] : a[e + 4]; b4[e] = keep + __shfl_xor(send, 1); }
#pragma unroll
                for (int e = 0; e < 2; ++e) { const float keep = up2 ? b4[e + 2] : b4[e], send = up2 ? b4[e] : b4[e + 2]; b2[e] = keep + __shfl_xor(send, 2); }
                { const float keep = up4 ? b2[1] : b2[0], send = up4 ? b2[0] : b2[1]; b1 = keep + __shfl_xor(send, 4); }
                b1 += __shfl_xor(b1, 8); b1 += __shfl_xor(b1, 16); b1 += __shfl_xor(b1, 32);
#pragma unroll
                for (int e = 0; e < 8; ++e) { const int src = ((e >> 2) & 1) | (e & 2) | ((e & 1) << 2); a[e] = __shfl(b1, src) + br[e]; }
            }
            int e1 = 0; float l1 = a[0];
#pragma unroll
            for (int e = 1; e < 8; ++e) if (a[e] > l1) { l1 = a[e]; e1 = e; }
            int e2 = -1; float l2 = -INFINITY;
#pragma unroll
            for (int e = 0; e < 8; ++e) if (e != e1 && a[e] > l2) { l2 = a[e]; e2 = e; }
            const float ex = expf(l2 - l1);
            if (lane == 0) {
                p.tok_e[2 * t] = e1; p.tok_e[2 * t + 1] = e2;
                p.tok_g[2 * t] = 1.f / (1.f + ex); p.tok_g[2 * t + 1] = ex / (1.f + ex);
                atomicAdd(&lcnt[e1], 1); atomicAdd(&lcnt[e2], 1);
            }
        }
        __syncthreads();
        if (tid < 8) p.chunk_cnt[chunk * 8 + tid] = lcnt[tid];
    }
}
__device__ __forceinline__ void ph_slots(const Params& p, float* lds) {
    const int tid = tid_();
    int* lbase = (int*)lds;
    int* lpad = lbase + 8;
    int* ltot = lpad + 16;
    int* lent = ltot + 8;
    int* lslot = lent + 256;
    for (int chunk = blockIdx.x; chunk < 256; chunk += gridDim.x) {
        __syncthreads();
        {
            int* lcc = lslot + 256;
            const int4 v4 = ((const int4*)p.chunk_cnt)[tid]; ((int4*)lcc)[tid] = v4;
            if (tid < 256) lent[tid] = p.tok_e[chunk * 256 + tid];
            __syncthreads();
            {
                const int e = tid >> 6, ln = tid & 63; int tot = 0, before = 0;
#pragma unroll
                for (int q = 0; q < 4; ++q) { const int cc = ln * 4 + q, v = lcc[cc * 8 + e]; tot += v; before += (cc < chunk) ? v : 0; }
#pragma unroll
                for (int o = 32; o >= 1; o >>= 1) { tot += __shfl_xor(tot, o); before += __shfl_xor(before, o); }
                if (ln == 0) { lbase[e] = before; ltot[e] = tot; }
            }
        }
        __syncthreads();
        if (tid == 0) { int acc = 0; for (int e = 0; e < 8; ++e) { lpad[e] = acc; acc += (ltot[e] + 255) / 256 * 256; } lpad[8] = acc; }
        __syncthreads();
        {
            int* lwc = lslot + 256 + 2048;
            const int wv = tid >> 6, ln = tid & 63;
            int my_e = -1, my_rank = 0;
            if (tid < 256) {
                my_e = lent[tid];
#pragma unroll
                for (int e = 0; e < 8; ++e) { const unsigned long long mb = __ballot(my_e == e); if (my_e == e) my_rank = lane_rank(mb); if (ln == 0) lwc[wv * 8 + e] = __popcll(mb); }
            }
            __syncthreads();
            if (tid < 256) { int r = lpad[my_e] + lbase[my_e] + my_rank; for (int q = 0; q < wv; ++q) r += lwc[q * 8 + my_e]; lslot[tid] = r; }
        }
        __syncthreads();
        if (tid < 256) {
            const int slot = lslot[tid], tk = chunk * 128 + (tid >> 1);
            p.slot_tok[slot] = tk; p.slot_gate[slot] = p.tok_g[chunk * 256 + tid]; p.tok_slot[chunk * 256 + tid] = slot;
        }
        if (gridDim.x != 256)
        for (int idx0 = tid; idx0 < 256 * 128; idx0 += 8 * NT) {
            pg8::u32x4 v[8];
#pragma unroll
            for (int u = 0; u < 8; ++u) { const int idx = idx0 + u * NT, e = idx >> 7, piece = idx & 127; v[u] = ((const pg8::u32x4*)p.Xb)[(size_t)(chunk * 128 + (e >> 1)) * 128 + piece]; }
#pragma unroll
            for (int u = 0; u < 8; ++u) { const int idx = idx0 + u * NT, e = idx >> 7, piece = idx & 127; ((pg8::u32x4*)p.Xs)[(size_t)lslot[e] * 128 + piece] = v[u]; }
        }
        if (chunk < 8) {
            const int s0 = lpad[chunk] + ltot[chunk], s1 = lpad[chunk + 1];
            if (gridDim.x != 256) for (int idx = tid; idx < (s1 - s0) * 128; idx += NT) ((uint4*)p.Xs)[(size_t)(s0 + (idx >> 7)) * 128 + (idx & 127)] = make_uint4(0u, 0u, 0u, 0u);
            for (int s = s0 + tid; s < s1; s += NT) { p.slot_tok[s] = -1; p.slot_gate[s] = 0.f; }
        }
        if (chunk == 8 && tid < NTILE256) {
            const int s0 = tid * 256; int e = -1;
            for (int q = 0; q < 8; ++q) if (s0 >= lpad[q] && s0 < lpad[q + 1]) e = q;
            p.tile_e[tid] = e;
        }
    }
}

typedef short bf16x8 __attribute__((ext_vector_type(8)));
typedef short s16x4 __attribute__((ext_vector_type(4)));
typedef __attribute__((address_space(3))) const unsigned char* lds_cptr;
__device__ __forceinline__ s16x4 vtr(lds_cptr p) { return __builtin_bit_cast(s16x4, __builtin_amdgcn_ds_read_tr16_b64_v4i16((__attribute__((address_space(3))) s16x4*)p)); }
__device__ __forceinline__ bf16x8 cat8(s16x4 lo, s16x4 hi) { bf16x8 r; r[0] = lo[0]; r[1] = lo[1]; r[2] = lo[2]; r[3] = lo[3]; r[4] = hi[0]; r[5] = hi[1]; r[6] = hi[2]; r[7] = hi[3]; return r; }
constexpr int AT_KP = 160;
template <int VD> struct AtL { static constexpr int VP = VD * 2 + 32, KB = 64 * AT_KP, VB = 64 * VP, BUF = KB + VB; };
constexpr float AT_SCALE2 = 0.125f * 1.4426950408889634f;

template <int VD> struct AtState {
    f32x4 o[2][VD / 16]; float m[2], l[2];
    __device__ __forceinline__ void init() {
#pragma unroll
        for (int g = 0; g < 2; ++g) { m[g] = -1e30f; l[g] = 0.f;
#pragma unroll
            for (int n = 0; n < VD / 16; ++n) o[g][n] = Z4_; }
    }
};
typedef float f32x2 __attribute__((ext_vector_type(2)));
__device__ __forceinline__ float max3f_(float a, float b, float c) { float r; asm("v_max3_f32 %0, %1, %2, %3" : "=v"(r) : "v"(a), "v"(b), "v"(c)); return r; }
__device__ __forceinline__ float max2f_(float a, float b) { float r; asm("v_max_f32_e32 %0, %1, %2" : "=v"(r) : "v"(a), "v"(b)); return r; }
__device__ __forceinline__ float xmax16(float v) { const unsigned u = __builtin_bit_cast(unsigned, v); const auto r = __builtin_amdgcn_permlane16_swap(u, u, false, false);
    return max2f_(__builtin_bit_cast(float, r[0]), __builtin_bit_cast(float, r[1])); }
__device__ __forceinline__ float xmax32(float v) { const unsigned u = __builtin_bit_cast(unsigned, v); const auto r = __builtin_amdgcn_permlane32_swap(u, u, false, false);
    return max2f_(__builtin_bit_cast(float, r[0]), __builtin_bit_cast(float, r[1])); }
template <int VD, int MODE, class RowOk, class Allow>
__device__ __forceinline__ void at_tile(AtState<VD>& st, lds_cptr Kb, lds_cptr Vb, const bf16x8 (&q)[2][2], int fr, int fq, RowOk rowok, Allow allow) {
    f32x4 s[2][4];
    bf16x8 kn0 = *(const __attribute__((address_space(3))) bf16x8*)(Kb + fr * AT_KP + fq * 16);
    bf16x8 kn1 = *(const __attribute__((address_space(3))) bf16x8*)(Kb + fr * AT_KP + 64 + fq * 16);
#pragma unroll
    for (int kk = 0; kk < 4; ++kk) {
        const bf16x8 kf0 = kn0, kf1 = kn1;
        if (kk < 3) { kn0 = *(const __attribute__((address_space(3))) bf16x8*)(Kb + (16 * (kk + 1) + fr) * AT_KP + fq * 16);
                      kn1 = *(const __attribute__((address_space(3))) bf16x8*)(Kb + (16 * (kk + 1) + fr) * AT_KP + 64 + fq * 16); }
#pragma unroll
        for (int g = 0; g < 2; ++g) s[g][kk] = __builtin_amdgcn_mfma_f32_16x16x32_bf16(kf0, q[g][0], (f32x4){0.f, 0.f, 0.f, 0.f}, 0, 0, 0);
#pragma unroll
        for (int g = 0; g < 2; ++g) s[g][kk] = __builtin_amdgcn_mfma_f32_16x16x32_bf16(kf1, q[g][1], s[g][kk], 0, 0, 0);
    }
    bf16x8 pf[2][2];
#pragma unroll
    for (int g = 0; g < 2; ++g) {
        float mloc = fmaxf(fmaxf(s[g][0][0], s[g][0][1]), s[g][0][2]);
        mloc = fmaxf(fmaxf(mloc, s[g][0][3]), s[g][1][0]);
        mloc = fmaxf(fmaxf(mloc, s[g][1][1]), s[g][1][2]);
        mloc = fmaxf(fmaxf(mloc, s[g][1][3]), s[g][2][0]);
        mloc = fmaxf(fmaxf(mloc, s[g][2][1]), s[g][2][2]);
        mloc = fmaxf(fmaxf(mloc, s[g][2][3]), s[g][3][0]);
        mloc = fmaxf(fmaxf(mloc, s[g][3][1]), s[g][3][2]);
        mloc = fmaxf(mloc, s[g][3][3]);
        mloc = xmax16(mloc); mloc = xmax32(mloc);
        float mn = max2f_(st.m[g], mloc * AT_SCALE2);
        float cadd;
        if (MODE & 1) { const bool ro = rowok(g); mn = ro ? mn : st.m[g]; cadd = ro ? -mn : -INFINITY; } else cadd = -mn;
        const float alpha = __builtin_amdgcn_exp2f(st.m[g] - mn);
        st.m[g] = mn;
        float ls = 0.f;
#pragma unroll
        for (int kk = 0; kk < 4; ++kk)
#pragma unroll
            for (int r = 0; r < 4; ++r) {
                float pv = __builtin_amdgcn_exp2f(__builtin_fmaf(s[g][kk][r], AT_SCALE2, cadd));
                if (MODE & 2) pv = allow(g, kk, r) ? pv : 0.f;
                if (MODE & 4) pv = __builtin_bit_cast(float, __builtin_bit_cast(int, pv) & allow(g, kk, r));
                s[g][kk][r] = pv; ls += pv;
            }
        st.l[g] = st.l[g] * alpha + ls;
#pragma unroll
        for (int n = 0; n < VD / 16; ++n) st.o[g][n] = st.o[g][n] * alpha;
#pragma unroll
        for (int sp = 0; sp < 2; ++sp) {
            const unsigned w0 = pk2(s[g][2 * sp][0], s[g][2 * sp][1]), w1 = pk2(s[g][2 * sp][2], s[g][2 * sp][3]);
            const unsigned w2 = pk2(s[g][2 * sp + 1][0], s[g][2 * sp + 1][1]), w3 = pk2(s[g][2 * sp + 1][2], s[g][2 * sp + 1][3]);
            pf[g][sp] = __builtin_bit_cast(bf16x8, (pg8::u32x4){w0, w1, w2, w3});
        }
    }
    {
        const lds_cptr vp0 = Vb + (4 * fq + (fr >> 2)) * AtL<VD>::VP + (4 * (fr & 3)) * 2;
        bf16x8 vn = cat8(vtr(vp0), vtr(vp0 + 16 * AtL<VD>::VP));
#pragma unroll
        for (int st_ = 0; st_ < VD / 8; ++st_) {
            const int n = st_ >> 1, sp = st_ & 1;
            const bf16x8 vf = vn;
            if (st_ + 1 < VD / 8) { const int n2 = (st_ + 1) >> 1, sp2 = (st_ + 1) & 1;
                const lds_cptr vp = Vb + (32 * sp2 + 4 * fq + (fr >> 2)) * AtL<VD>::VP + (n2 * 16 + 4 * (fr & 3)) * 2;
                vn = cat8(vtr(vp), vtr(vp + 16 * AtL<VD>::VP)); }
#pragma unroll
            for (int g = 0; g < 2; ++g) st.o[g][n] = __builtin_amdgcn_mfma_f32_16x16x32_bf16(vf, pf[g][sp], st.o[g][n], 0, 0, 0);
        }
    }
}
struct AtNoRow { __device__ __forceinline__ bool operator()(int) const { return true; } };
struct AtNoEl { __device__ __forceinline__ bool operator()(int, int, int) const { return true; } };
template <int VD> struct AtStage {
    pg8::u32x4 k, v[VD / 64];
    __device__ __forceinline__ void load(const bf16_t* kbase, const bf16_t* vbase, int key0, int tid) {
        const int row = tid >> 3, ch = tid & 7;
        k = *(const pg8::u32x4*)(kbase + (size_t)(key0 + row) * LDPB + ch * 8);
#pragma unroll
        for (int i = 0; i < VD / 64; ++i) v[i] = *(const pg8::u32x4*)(vbase + (size_t)(key0 + row) * LDPB + (ch + 8 * i) * 8);
    }
    __device__ __forceinline__ void store(LAS unsigned char* buf, int tid) const {
        const int row = tid >> 3, ch = tid & 7;
        *(LAS pg8::u32x4*)(buf + row * AT_KP + ch * 16) = k;
#pragma unroll
        for (int i = 0; i < VD / 64; ++i) *(LAS pg8::u32x4*)(buf + AtL<VD>::KB + row * AtL<VD>::VP + (ch + 8 * i) * 16) = v[i];
    }
};
template <int VD>
__device__ __forceinline__ void at_finish(AtState<VD>& st) {
#pragma unroll
    for (int g = 0; g < 2; ++g) { float l = st.l[g]; l += __shfl_xor(l, 16); l += __shfl_xor(l, 32); st.l[g] = l; }
}


template <int VD> struct AtStageP {
    pg8::u32x4 k, v[VD / 64];
    __device__ __forceinline__ void load(const bf16_t* kbase, const bf16_t* vbase, int pitch, int key0, int tid) {
        const int row = tid >> 3, ch = tid & 7;
        k = *(const pg8::u32x4*)(kbase + (size_t)(key0 + row) * pitch + ch * 8);
#pragma unroll
        for (int i = 0; i < VD / 64; ++i) v[i] = *(const pg8::u32x4*)(vbase + (size_t)(key0 + row) * pitch + (ch + 8 * i) * 8);
    }
    __device__ __forceinline__ void store(LAS unsigned char* buf, int tid) const {
        const int row = tid >> 3, ch = tid & 7;
        *(LAS pg8::u32x4*)(buf + row * AT_KP + ch * 16) = k;
#pragma unroll
        for (int i = 0; i < VD / 64; ++i) *(LAS pg8::u32x4*)(buf + AtL<VD>::KB + row * AtL<VD>::VP + (ch + 8 * i) * 16) = v[i];
    }
};
template <int VD, class Fn>
__device__ __forceinline__ void at_run(LAS unsigned char* lds, const bf16_t* kbase, const bf16_t* vbase, int pitch, int tile_lo, int tile_hi, int tid, Fn fn) {
    if (tile_lo >= tile_hi) return;
    AtStageP<VD> sg; sg.load(kbase, vbase, pitch, tile_lo * 64, tid);
    __syncthreads();
    for (int i = tile_lo; i < tile_hi; ++i) {
        LAS unsigned char* buf = lds + ((i - tile_lo) & 1) * AtL<VD>::BUF;
        sg.store(buf, tid);
        __syncthreads();
        if (i + 1 < tile_hi) sg.load(kbase, vbase, pitch, (i + 1) * 64, tid);
        fn(i, (lds_cptr)buf, (lds_cptr)buf + AtL<VD>::KB);
    }
}
template <int VD, class Fn>
__device__ __forceinline__ void at_run_side(LAS unsigned char* lds, const bf16_t* kbase, const bf16_t* vbase, int pitch, int tile_lo, int tile_hi, int tid, CvJob& job, Fn fn) {
    if (tile_lo >= tile_hi) return;
    AtStageP<VD> sg; sg.load(kbase, vbase, pitch, tile_lo * 64, tid);
    __syncthreads();
    for (int i = tile_lo; i < tile_hi; ++i) {
        LAS unsigned char* buf = lds + ((i - tile_lo) & 1) * AtL<VD>::BUF;
        sg.store(buf, tid);
        __syncthreads();
        job.step(tid);
        if (i + 1 < tile_hi) sg.load(kbase, vbase, pitch, (i + 1) * 64, tid);
        fn(i, (lds_cptr)buf, (lds_cptr)buf + AtL<VD>::KB);
    }
}
template <int VD>
__device__ __forceinline__ void at_scores(f32x4 (&s)[2][4], lds_cptr Kb, const bf16x8 (&q)[2][2], int fr, int fq) {
#pragma unroll
    for (int kk = 0; kk < 4; ++kk) {
        const bf16x8 kf0 = *(const __attribute__((address_space(3))) bf16x8*)(Kb + (16 * kk + fr) * AT_KP + fq * 16);
        const bf16x8 kf1 = *(const __attribute__((address_space(3))) bf16x8*)(Kb + (16 * kk + fr) * AT_KP + 64 + fq * 16);
#pragma unroll
        for (int g = 0; g < 2; ++g) s[g][kk] = __builtin_amdgcn_mfma_f32_16x16x32_bf16(kf0, q[g][0], (f32x4){0.f, 0.f, 0.f, 0.f}, 0, 0, 0);
#pragma unroll
        for (int g = 0; g < 2; ++g) s[g][kk] = __builtin_amdgcn_mfma_f32_16x16x32_bf16(kf1, q[g][1], s[g][kk], 0, 0, 0);
    }
}

__device__ __forceinline__ void ph_diff_mfma(const Params& p, LAS unsigned char* lds, int li) {
    const int tid = tid_(), lane = tid & 63, w = tid >> 6, fr = lane & 15, fq = lane >> 4;
    const int G = gridDim.x, c = blockIdx.x;
    const float* lp = p.in[IN_DIF_LAMBDA] + li * 256;
    const float d01 = wave_sum(lp[lane] * lp[64 + lane]), d23 = wave_sum(lp[128 + lane] * lp[192 + lane]);
    const float lam_init = li ? p.lam_init[1] : p.lam_init[0];
    const float lam = expf(d01) - expf(d23) + lam_init;
    const float* subln = p.in[IN_DIF_SUBLN] + li * 128;
    LAS unsigned* oal = (LAS unsigned*)(lds + 2 * AtL<128>::BUF) + w * 2048 + lane;
    for (int L = c; L < 512; L += G) {
        int qb, b, h;
        if (G == 256) { const int rnd = L >> 8, x = c & 7, j = c >> 3; b = x; h = j >> 3; qb = rnd ? 15 - (j & 7) : (j & 7); }
        else { const int rnd = L / G; const int u = ((rnd & 1) && (512 % G == 0)) ? rnd * G + (G - 1 - (L - rnd * G)) : L; qb = u & 15; h = (u >> 4) & 3; b = u >> 6; }
        const bf16_t* vbase = p.Pb + (size_t)b * SEQ * LDPB + E_AV + h * 128;
        const int t0 = qb * 256 + w * 32;
#pragma unroll 1
        for (int jm = 0; jm < 2; ++jm) {
            const int hj = 2 * h + jm;
            const bf16_t* kbase = p.Pb + (size_t)b * SEQ * LDPB + E_AK + hj * 64;
            bf16x8 q[2][2];
#pragma unroll
            for (int g = 0; g < 2; ++g)
#pragma unroll
                for (int ks = 0; ks < 2; ++ks) q[g][ks] = *(const bf16x8*)(p.Pb + (size_t)(b * SEQ + t0 + g * 16 + fr) * LDPB + E_AQ + hj * 64 + ks * 32 + fq * 8);
            AtState<128> st; st.init();
            at_run<128>(lds, kbase, vbase, LDPB, 0, 4 * qb + 4, tid, [&](int i, lds_cptr Kb, lds_cptr Vb) {
                const int key0 = i * 64;
                if (key0 <= t0 + 31) {
                    if (key0 + 63 <= t0) at_tile<128, 0>(st, Kb, Vb, q, fr, fq, AtNoRow(), AtNoEl());
                    else { const int tq0 = t0 + fr - key0 - 4 * fq; at_tile<128, 2>(st, Kb, Vb, q, fr, fq, AtNoRow(), [=](int g, int kk, int r) { return 16 * kk + r <= tq0 + g * 16; }); }
                }
            });
            at_finish(st);
            if (jm == 0) {
#pragma unroll
                for (int g = 0; g < 2; ++g) { const float inv = 1.f / st.l[g];
#pragma unroll
                    for (int n = 0; n < 8; ++n) { const f32x4 o = st.o[g][n] * inv; oal[((g * 8 + n) * 2) * 64] = pk2(o[0], o[1]); oal[((g * 8 + n) * 2 + 1) * 64] = pk2(o[2], o[3]); } }
            } else {
#pragma unroll
                for (int g = 0; g < 2; ++g) { const float inv = 1.f / st.l[g];
                    float ss = 0.f;
#pragma unroll
                    for (int n = 0; n < 8; ++n) {
                        const f32x4 ob = st.o[g][n] * inv;
                        const unsigned b01 = pk2(ob[0], ob[1]), b23 = pk2(ob[2], ob[3]);
                        const unsigned a01 = oal[((g * 8 + n) * 2) * 64], a23 = oal[((g * 8 + n) * 2 + 1) * 64];
                        f32x4 r;
                        r[0] = __builtin_bit_cast(float, a01 << 16) - lam * __builtin_bit_cast(float, b01 << 16);
                        r[1] = __builtin_bit_cast(float, a01 & 0xffff0000u) - lam * __builtin_bit_cast(float, b01 & 0xffff0000u);
                        r[2] = __builtin_bit_cast(float, a23 << 16) - lam * __builtin_bit_cast(float, b23 << 16);
                        r[3] = __builtin_bit_cast(float, a23 & 0xffff0000u) - lam * __builtin_bit_cast(float, b23 & 0xffff0000u);
                        st.o[g][n] = r;
                        ss += (r[0] * r[0] + r[1] * r[1]) + (r[2] * r[2] + r[3] * r[3]);
                    }
                    ss += __shfl_xor(ss, 16); ss += __shfl_xor(ss, 32);
                    const float sc = (1.0f / sqrtf(ss * (1.f / 128.f) + LN_EPS)) * (1.f - lam_init);
                    bf16_t* dst = p.Ob + (size_t)(b * SEQ + t0 + g * 16 + fr) * DM + h * 128 + 4 * fq;
#pragma unroll
                    for (int n = 0; n < 8; ++n) { const float4 sw = *(const float4*)(subln + n * 16 + 4 * fq); const f32x4 r = st.o[g][n];
                        u32x2 wv; wv.x = pk2(r[0] * sc * sw.x, r[1] * sc * sw.y); wv.y = pk2(r[2] * sc * sw.z, r[3] * sc * sw.w); *(u32x2*)(dst + n * 16) = wv; }
                }
            }
        }
    }
}

__device__ __forceinline__ float quad_xor1(float x) { return __builtin_bit_cast(float, __builtin_amdgcn_update_dpp(0, __builtin_bit_cast(int, x), 0xB1, 0xf, 0xf, false)); }
__device__ __forceinline__ float quad_xor2(float x) { return __builtin_bit_cast(float, __builtin_amdgcn_update_dpp(0, __builtin_bit_cast(int, x), 0x4E, 0xf, 0xf, false)); }
__device__ __forceinline__ void ph_moba_mfma(const Params& p, LAS unsigned char* lds, int li) {
    const int tid = tid_(), lane = tid & 63, w = tid >> 6, fr = lane & 15, fq = lane >> 4;
    CvJob job; job.init(p, li, (float*)((unsigned char*)lds + 65536), tid);
    const int G = gridDim.x, c = blockIdx.x;
    LAS unsigned* lmask = (LAS unsigned*)(lds + 40960);
#define MB_E(k, isb, qbv) ((unsigned long long)(((isb) << 4) | (qbv)) << (5 * (k)))
    unsigned long long code = 0ull; int nun = 0, sA = 0, sB = 0;
    if (G == 256) {
        if (c < 32) { sA = c; nun = 3; code = MB_E(0, 0, 15) | MB_E(1, 0, 8) | MB_E(2, 0, 1); }
        else {
            const int c2 = c - 32, pidx = c2 / 7, grp = c2 - pidx * 7; sA = pidx; sB = pidx + 32;
            if (grp == 0) { nun = 3; code = MB_E(0, 1, 15) | MB_E(1, 1, 14) | MB_E(2, 0, 4); }
            else if (grp == 1) { nun = 3; code = MB_E(0, 0, 14) | MB_E(1, 0, 13) | MB_E(2, 1, 6); }
            else if (grp == 2) { nun = 3; code = MB_E(0, 1, 13) | MB_E(1, 1, 12) | MB_E(2, 1, 8); }
            else if (grp == 3) { nun = 3; code = MB_E(0, 0, 12) | MB_E(1, 0, 11) | MB_E(2, 0, 10); }
            else if (grp == 4) { nun = 4; code = MB_E(0, 1, 11) | MB_E(1, 1, 10) | MB_E(2, 0, 7) | MB_E(3, 0, 3); }
            else if (grp == 5) { nun = 4; code = MB_E(0, 0, 9) | MB_E(1, 1, 9) | MB_E(2, 1, 7) | MB_E(3, 0, 6); }
            else { nun = 9; code = MB_E(0, 0, 5) | MB_E(1, 1, 5) | MB_E(2, 1, 4) | MB_E(3, 1, 3) | MB_E(4, 0, 2) | MB_E(5, 1, 2) | MB_E(6, 1, 1) | MB_E(7, 0, 0) | MB_E(8, 1, 0); }
        }
    } else nun = (c < 1024) ? (1024 - c + G - 1) / G : 0;
#undef MB_E
    for (int ui = 0; ui < nun; ++ui) {
        int qb, stream;
        if (G == 256) { const int e = (int)(code >> (5 * ui)) & 31; stream = (e & 16) ? sB : sA; qb = e & 15; }
        else { const int L = c + ui * G; const int rnd = L / G; const int u = ((rnd & 1) && (1024 % G == 0)) ? rnd * G + (G - 1 - (L - rnd * G)) : L; qb = u & 15; stream = u >> 4; }
        const int h = stream & 7, b = stream >> 3;
        const bf16_t* kbase = p.Pb + (size_t)b * SEQ * LDPB + O_CK + h * 64;
        const bf16_t* vbase = p.Pb + (size_t)b * SEQ * LDPB + O_CV + h * 64;
        const int t0 = qb * 256 + w * 32;
        bf16x8 q[2][2];
#pragma unroll
        for (int g = 0; g < 2; ++g)
#pragma unroll
            for (int ks = 0; ks < 2; ++ks) q[g][ks] = *(const bf16x8*)(p.Pb + (size_t)(b * SEQ + t0 + g * 16 + fr) * LDPB + O_CQ + h * 64 + ks * 32 + fq * 8);
        unsigned msk[2];
        {
            bf16x8 kmf[2];
#pragma unroll
            for (int ks = 0; ks < 2; ++ks) { const float* km = p.kmean + (size_t)((b * 16 + fr) * 8 + h) * 64 + ks * 32 + fq * 8;
                const float4 a0 = *(const float4*)km, a1 = *(const float4*)(km + 4);
                kmf[ks] = __builtin_bit_cast(bf16x8, (pg8::u32x4){pk2(a0.x, a0.y), pk2(a0.z, a0.w), pk2(a1.x, a1.y), pk2(a1.z, a1.w)}); }
            LAS float* lg = (LAS float*)(lds + 40960) + w * 512;
#pragma unroll
            for (int g = 0; g < 2; ++g) {
                f32x4 gs = Z4_;
                gs = __builtin_amdgcn_mfma_f32_16x16x32_bf16(kmf[0], q[g][0], gs, 0, 0, 0);
                gs = __builtin_amdgcn_mfma_f32_16x16x32_bf16(kmf[1], q[g][1], gs, 0, 0, 0);
                *(LAS f32x4*)(lg + (g * 16 + fr) * 16 + 4 * fq) = gs;
            }
#pragma unroll
            for (int g = 0; g < 2; ++g) {
                float gv[16];
#pragma unroll
                for (int c4 = 0; c4 < 4; ++c4) { const f32x4 t4 = *(const LAS f32x4*)(lg + (g * 16 + fr) * 16 + 4 * c4);
#pragma unroll
                    for (int e = 0; e < 4; ++e) gv[4 * c4 + e] = (4 * c4 + e < qb) ? t4[e] : -INFINITY; }
                unsigned m = 0u;
#pragma unroll
                for (int pick = 0; pick < 3; ++pick) {
                    float best = -INFINITY; int bi = -1;
#pragma unroll
                    for (int n = 0; n < 16; ++n) if (gv[n] > best) { best = gv[n]; bi = n; }
                    if (bi >= 0) m |= 1u << bi;
#pragma unroll
                    for (int n = 0; n < 16; ++n) gv[n] = (n == bi) ? -INFINITY : gv[n];
                }
                msk[g] = m;
            }
        }
        AtState<64> st; st.init();
        at_run_side<64>(lds, kbase, vbase, LDPB, 0, 4 * qb + 4, tid, job, [&](int i, lds_cptr Kb, lds_cptr Vb) {
            const int n = i >> 2, key0 = i * 64;
            if (n < qb) {
                const bool b0 = (msk[0] >> n) & 1u, b1 = (msk[1] >> n) & 1u;
                at_tile<64, 1>(st, Kb, Vb, q, fr, fq, [=](int g) { return g ? b1 : b0; }, AtNoEl());
            } else if (key0 <= t0 + 31) {
                const int tq0 = t0 + fr - key0 - 4 * fq;
                if (key0 + 63 <= t0) at_tile<64, 0>(st, Kb, Vb, q, fr, fq, AtNoRow(), AtNoEl());
                else at_tile<64, 2>(st, Kb, Vb, q, fr, fq, AtNoRow(), [=](int g, int kk, int r) { return 16 * kk + r <= tq0 + g * 16; });
            }
        });
        at_finish(st);
#pragma unroll
        for (int g = 0; g < 2; ++g) { const float inv = 1.f / st.l[g]; bf16_t* dst = p.Ob + (size_t)(b * SEQ + t0 + g * 16 + fr) * DM + h * 64 + 4 * fq;
#pragma unroll
            for (int n = 0; n < 4; ++n) { const f32x4 o = st.o[g][n] * inv; u32x2 wv; wv.x = pk2(o[0], o[1]); wv.y = pk2(o[2], o[3]); *(u32x2*)(dst + n * 16) = wv; } }
    }
    job.finish(tid);
}

__device__ __forceinline__ void ph_nsa_mfma(const Params& p, LAS unsigned char* lds, const bf16_t* cmpkb, const bf16_t* cmpvb) {
    const int tid = tid_(), lane = tid & 63, w = tid >> 6, fr = lane & 15, fq = lane >> 4;
    const int G = gridDim.x, c = blockIdx.x;
    LAS float* impA = (LAS float*)(lds + 40960) + w * 1024;
    LAS float* impB = impA + 512;
    LAS unsigned long long* selm = (LAS unsigned long long*)(lds + 73728) + w * 8;
    static_assert(2 * AtL<64>::BUF <= 40960, "NSA LDS map");
    for (int L = c; L < 1024; L += G) {
        int qb, stream;
        if (G == 256) { const int rnd = L >> 8, x = c & 7, j = c >> 3;
            stream = 2 * x + (rnd >> 1); qb = (rnd & 1) ? 63 - j : j; }
        else { const int rnd = L / G; const int u = ((rnd & 1) && (1024 % G == 0)) ? rnd * G + (G - 1 - (L - rnd * G)) : L; qb = u & 63; stream = u >> 6; }
        const int grp = stream & 1, b = stream >> 1;
        const int tw = qb * 64 + w * 8;
#define TQ(g) (tw + (g) * 4 + (fr >> 2))
#define TOKG(g) (b * SEQ + TQ(g))
        bf16x8 qraw[2][2];
#pragma unroll
        for (int g = 0; g < 2; ++g) {
            const int head = grp * 4 + (fr & 3);
#pragma unroll
            for (int ks = 0; ks < 2; ++ks) qraw[g][ks] = *(const bf16x8*)(p.Pb + (size_t)TOKG(g) * LDPB + O_DQ + head * 64 + ks * 32 + fq * 8);
        }
        LAS float* accl = (LAS float*)(lds + 75776) + w * 2048 + lane;
        const bf16_t* ck = cmpkb + (size_t)(b * 2 + grp) * 256 * 64; const bf16_t* cv = cmpvb + (size_t)(b * 2 + grp) * 256 * 64;
        int nv[2];
#pragma unroll
        for (int g = 0; g < 2; ++g) nv[g] = (TQ(g) >= 31) ? ((TQ(g) - 31) >> 4) + 1 : 0;
        const int nvmax_w = (tw + 7 >= 31) ? ((tw + 7 - 31) >> 4) + 1 : 0;
        const int nvmax_b = (qb * 64 + 63 >= 31) ? ((qb * 64 + 63 - 31) >> 4) + 1 : 0;
        const int ncmp_tiles = (nvmax_b + 63) >> 6;
        float mfin[2], linv[2];
        {
            AtState<64> st; st.init();
            at_run<64>(lds, ck, cv, 64, 0, ncmp_tiles, tid, [&](int i, lds_cptr Kb, lds_cptr Vb) {
                if (i * 64 < nvmax_w) { const int n0 = nv[0] - i * 64, n1 = nv[1] - i * 64;
                    at_tile<64, 2>(st, Kb, Vb, qraw, fr, fq, AtNoRow(), [=](int g, int kk, int r) { return 16 * kk + 4 * fq + r < (g ? n1 : n0); }); }
            });
            at_finish(st);
#pragma unroll
            for (int g = 0; g < 2; ++g) { mfin[g] = st.m[g]; linv[g] = st.l[g] > 0.f ? 1.f / st.l[g] : 0.f;
#pragma unroll
                for (int n = 0; n < 4; ++n) { const f32x4 o = st.o[g][n] * (linv[g] * p.GATES[(size_t)TOKG(g) * 24 + (grp * 4 + (fr & 3)) * 3]);
#pragma unroll
                    for (int r = 0; r < 4; ++r) accl[((g * 4 + n) * 4 + r) * 64] = o[r]; } }
        }
        for (int e = lane; e < 512; e += 64) { impA[e] = 0.f; impB[e] = 0.f; }
        at_run<64>(lds, ck, cv, 64, 0, ncmp_tiles, tid, [&](int i, lds_cptr Kb, lds_cptr) {
            if (i * 64 < nvmax_w) {
                f32x4 s[2][4]; at_scores<64>(s, Kb, qraw, fr, fq);
#pragma unroll
                for (int g = 0; g < 2; ++g)
#pragma unroll
                    for (int kk = 0; kk < 4; ++kk) {
                        float a = 0.f, last = 0.f;
#pragma unroll
                        for (int r = 0; r < 4; ++r) { const int n = i * 64 + 16 * kk + 4 * fq + r;
                            const float pv = (n < nv[g]) ? __builtin_amdgcn_exp2f(s[g][kk][r] * AT_SCALE2 - mfin[g]) * linv[g] : 0.f; a += pv; last = pv; }
                        a += quad_xor1(a); a += quad_xor2(a); last += quad_xor1(last); last += quad_xor2(last);
                        const int j = 16 * i + 4 * kk + fq, qi = g * 4 + (fr >> 2);
                        if ((fr & 3) == 0) { impA[qi * 64 + j] = a; if (j + 1 < 64) impB[qi * 64 + j + 1] = last; }
                    }
            }
        });
        {
            unsigned key[8], T[8];
#pragma unroll
            for (int qi = 0; qi < 8; ++qi) {
                const float imp = impA[qi * 64 + lane] + impB[qi * 64 + lane];
                const bool causal = lane <= qb, forced = (lane == 0) || (lane >= qb - 1 && causal);
                const float val = forced ? 1e30f : (causal ? imp : -1e30f);
                const unsigned u = __builtin_bit_cast(unsigned, val);
                key[qi] = (u & 0x80000000u) ? ~u : (u | 0x80000000u); T[qi] = 0u;
            }
#pragma nounroll
            for (int bit = 31; bit >= 0; --bit) {
#pragma unroll
                for (int qi = 0; qi < 8; ++qi) { const unsigned cand = T[qi] | (1u << bit); if (__popcll(__ballot(key[qi] >= cand)) >= 16) T[qi] = cand; }
            }
#pragma unroll
            for (int qi = 0; qi < 8; ++qi) {
                const bool gt = key[qi] > T[qi], eq = key[qi] == T[qi];
                const unsigned long long meq = __ballot(eq);
                const int need = 16 - __popcll(__ballot(gt));
                const unsigned long long mk = __ballot(gt || (eq && lane_rank(meq) < need));
                if (lane == 0) selm[qi] = mk;
            }
        }
        unsigned long long sm[2];
#pragma unroll
        for (int g = 0; g < 2; ++g) sm[g] = selm[g * 4 + (fr >> 2)];
        bf16x8 qrot[2][2];
#pragma unroll
        for (int g = 0; g < 2; ++g)
#pragma unroll
            for (int ks = 0; ks < 2; ++ks) qrot[g][ks] = *(const bf16x8*)(p.QRb + (size_t)TOKG(g) * 512 + (grp * 4 + (fr & 3)) * 64 + ks * 32 + fq * 8);
        {
            const bf16_t* kb = p.Pb + (size_t)b * SEQ * LDPB + O_KS + grp * 64; const bf16_t* vb = p.Pb + (size_t)b * SEQ * LDPB + O_VS + grp * 64;
            AtState<64> st; st.init();
            at_run<64>(lds, kb, vb, LDPB, 0, qb + 1, tid, [&](int i, lds_cptr Kb, lds_cptr Vb) {
                const bool b0 = (sm[0] >> i) & 1ull, b1 = (sm[1] >> i) & 1ull;
                { const int d0 = TQ(0) - i * 64, d1 = TQ(1) - i * 64;
                    if (i < qb) at_tile<64, 1>(st, Kb, Vb, qrot, fr, fq, [=](int g) { return g ? b1 : b0; }, AtNoEl());
                    else at_tile<64, 3>(st, Kb, Vb, qrot, fr, fq, [=](int g) { return g ? b1 : b0; }, [=](int g, int kk, int r) { return 16 * kk + 4 * fq + r <= (g ? d1 : d0); }); }
            });
            at_finish(st);
#pragma unroll
            for (int g = 0; g < 2; ++g) { const float sc = p.GATES[(size_t)TOKG(g) * 24 + (grp * 4 + (fr & 3)) * 3 + 1] / st.l[g];
#pragma unroll
                for (int n = 0; n < 4; ++n)
#pragma unroll
                    for (int r = 0; r < 4; ++r) accl[((g * 4 + n) * 4 + r) * 64] += st.o[g][n][r] * sc; }
        }
        {
            const bf16_t* kb = p.Pb + (size_t)b * SEQ * LDPB + O_KW + grp * 64; const bf16_t* vb = p.Pb + (size_t)b * SEQ * LDPB + O_VW + grp * 64;
            AtState<64> st; st.init();
            at_run<64>(lds, kb, vb, LDPB, (qb >= 8 ? qb - 8 : 0), qb + 1, tid, [&](int i, lds_cptr Kb, lds_cptr Vb) {
                const int d0 = TQ(0) - i * 64 - 4 * fq, d1 = TQ(1) - i * 64 - 4 * fq;
                if (i == qb || (qb >= 8 && i == qb - 8)) {
                    const int hi0 = (i == qb) ? d0 : 64, hi1 = (i == qb) ? d1 : 64, lo0 = (i == qb) ? -1 : d0 - 512, lo1 = (i == qb) ? -1 : d1 - 512;
                    at_tile<64, 2>(st, Kb, Vb, qrot, fr, fq, AtNoRow(), [=](int g, int kk, int r) { const int kx = 16 * kk + r; return kx <= (g ? hi1 : hi0) && kx > (g ? lo1 : lo0); });
                } else at_tile<64, 0>(st, Kb, Vb, qrot, fr, fq, AtNoRow(), AtNoEl());
            });
            at_finish(st);
#pragma unroll
            for (int g = 0; g < 2; ++g) { const float sc = p.GATES[(size_t)TOKG(g) * 24 + (grp * 4 + (fr & 3)) * 3 + 2] / st.l[g];
                bf16_t* dst = p.Ob + (size_t)TOKG(g) * DM + 512 + (grp * 4 + (fr & 3)) * 64 + 4 * fq;
#pragma unroll
                for (int n = 0; n < 4; ++n) { f32x4 o;
#pragma unroll
                    for (int r = 0; r < 4; ++r) o[r] = accl[((g * 4 + n) * 4 + r) * 64] + st.o[g][n][r] * sc;
                    u32x2 wv; wv.x = pk2(o[0], o[1]); wv.y = pk2(o[2], o[3]); *(u32x2*)(dst + n * 16) = wv; } }
        }
    }
#undef TQ
#undef TOKG
}

__device__ __forceinline__ unsigned pk_cnt_gt(unsigned acc, unsigned h, unsigned cm1, unsigned one2) {
    unsigned d;
    asm("v_pk_sub_u16 %0, %1, %2 clamp" : "=v"(d) : "v"(h), "v"(cm1));
    asm("v_pk_min_u16 %0, %1, %2" : "=v"(d) : "v"(d), "v"(one2));
    asm("v_pk_add_u16 %0, %1, %2" : "=v"(acc) : "v"(acc), "v"(d));
    return acc;
}
__device__ __forceinline__ int wave_total(int c) {
    int tot = 0;
#pragma unroll
    for (int bb = 0; bb < 7; ++bb) tot += __popcll(__ballot((c >> bb) & 1)) << bb;
    return tot;
}
#define SEL_CHUNKS(BODY) do { \
    _Pragma("unroll") for (int i = 0; i < 16; ++i) BODY(i) \
    if (tl >= 16) { _Pragma("unroll") for (int i = 16; i < 32; ++i) BODY(i) \
        if (tl >= 32) { _Pragma("unroll") for (int i = 32; i < 48; ++i) BODY(i) \
            if (tl >= 48) { _Pragma("unroll") for (int i = 48; i < 64; ++i) BODY(i) } } } } while (0)
__device__ __forceinline__ void ph_dsa_select(const Params& p, LAS unsigned char* lds, unsigned long long* BM) {
    const int tid = tid_(), lane = tid & 63, w = tid >> 6, fr = lane & 15, fq = lane >> 4;
    const int G = gridDim.x, c = blockIdx.x;
    LAS unsigned* sc = (LAS unsigned*)lds;
#define SEL_UNIT(LL, B, T0) do { if (G == 256) { const int rnd_ = (LL) >> 8, x_ = c & 7, j_ = c >> 3, idx_ = (rnd_ >> 1) * 32 + j_; B = x_; T0 = ((rnd_ & 1) ? (511 - idx_) : idx_) * 8; } \
        else { B = (LL) >> 9; T0 = ((LL) & 511) * 8; } } while (0)
#define SEL_LOADQ(B, T0) do { _Pragma("unroll") for (int g = 0; g < 2; ++g) { const size_t tokq_ = (size_t)(B) * SEQ + (T0) + g * 4 + (fr >> 2); \
        _Pragma("unroll") for (int ks = 0; ks < 2; ++ks) iq[g][ks] = *(const bf16x8*)(p.Pb + tokq_ * LDPB + E_IQ + (fr & 3) * 64 + ks * 32 + fq * 8); \
        iwv[g] = *(const float4*)(p.IW + ((size_t)(B) * SEQ + (T0) + g * 4 + fq) * 4); } } while (0)
#define SEL_LOADK(B, NSUB, SUB0, J0, J1) do { _Pragma("unroll") for (int j = J0; j < J1; ++j) { const int sub_ = ((SUB0) + 8 * j < (NSUB)) ? (SUB0) + 8 * j : (SUB0); \
        const bf16_t* kr_ = p.Pb + (size_t)((B) * SEQ + sub_ * 16 + fr) * LDPB + E_IK + fq * 8; \
        kf[j][0] = *(const bf16x8*)kr_; kf[j][1] = *(const bf16x8*)(kr_ + 32); } } while (0)
    bf16x8 iq[2][2]; float4 iwv[2]; bf16x8 kf[8][2];
    bool have = false;
    for (int L = c; L < 4096; L += G) {
        int b, t0; SEL_UNIT(L, b, t0);
        const int t = t0 + w; const size_t tok = (size_t)b * SEQ + t; const int ntile = (t >> 6) + 1;
        if (t0 + 7 < 256) {
            const int rem = t - lane * 64;
            const unsigned long long wd = (rem >= 63) ? ~0ull : (rem >= 0 ? ((1ull << (rem + 1)) - 1ull) : 0ull);
            if (lane < ntile) BM[tok * 64 + lane] = wd;
            continue;
        }
        const int nsub = (t0 + 8 + 15) >> 4;
        if (!have) { SEL_LOADQ(b, t0); SEL_LOADK(b, nsub, w, 0, 2); }
        have = false;
        SEL_LOADK(b, nsub, w, 2, 8);
        __syncthreads();
        for (int sub0 = w; sub0 < nsub; sub0 += 64) {
#pragma unroll
            for (int j = 0; j < 8; ++j) {
                const int sub = sub0 + 8 * j;
                if (sub < nsub) {
#pragma unroll
                    for (int g = 0; g < 2; ++g) {
                        f32x4 s = Z4_;
                        s = __builtin_amdgcn_mfma_f32_16x16x32_bf16(iq[g][0], kf[j][0], s, 0, 0, 0);
                        s = __builtin_amdgcn_mfma_f32_16x16x32_bf16(iq[g][1], kf[j][1], s, 0, 0, 0);
                        const int q = g * 4 + fq, key = sub * 16 + fr;
                        const float v = (iwv[g].x * fmaxf(s[0], 0.f) + iwv[g].y * fmaxf(s[1], 0.f)) + (iwv[g].z * fmaxf(s[2], 0.f) + iwv[g].w * fmaxf(s[3], 0.f));
                        const unsigned u = __builtin_bit_cast(unsigned, v);
                        const unsigned ks2 = (u & 0x80000000u) ? ~u : (u | 0x80000000u);
                        sc[q * 4096 + key] = (key <= t0 + q) ? ks2 : 0u;
                    }
                }
            }
            if (sub0 + 64 < nsub) SEL_LOADK(b, nsub, sub0 + 64, 0, 8);
        }
        __syncthreads();
        unsigned long long myword = 0ull;
        {
            const int tl = __builtin_amdgcn_readfirstlane(t >> 6);
            unsigned kreg[64];
#pragma unroll
            for (int i = 0; i < 64; ++i) kreg[i] = sc[w * 4096 + i * 64 + lane];
            __builtin_amdgcn_sched_barrier(0);
#pragma unroll
            for (int i = 0; i < 64; ++i) kreg[i] = (i * 64 + lane <= t) ? kreg[i] : 0u;
            unsigned T = 0u; bool exact = false; int need = 0;
            {
                LAS unsigned* hist = (LAS unsigned*)(lds + 131072) + w * 256;
                unsigned prefix = 0u, pmask = 0u; int remaining = 256;
                {
                    unsigned T8 = 0u; int acc_tot = t + 1, above = 0;
#pragma nounroll
                    for (int bit = 7; bit >= 0; --bit) {
                        const unsigned cand = (T8 | (1u << bit)) << 24;
                        int cnt = 0;
#define SEL_CNT(i) { cnt += (kreg[i] >= cand) ? 1 : 0; }
                        SEL_CHUNKS(SEL_CNT);
#undef SEL_CNT
                        const int tot = wave_total(cnt);
                        if (tot >= 256) { T8 |= 1u << bit; acc_tot = tot; } else above = tot;
                    }
                    remaining = 256 - above; prefix = T8 << 24; pmask = 0xff000000u;
                    exact = (acc_tot - above == remaining);
                }
                if (!exact) for (int pass = 1; pass < 4; ++pass) {
                    const int shift = 24 - 8 * pass;
#pragma unroll
                    for (int j = 0; j < 4; ++j) hist[lane + 64 * j] = 0u;
#define SEL_HIST(i) { const unsigned k = kreg[i]; if ((k & pmask) == prefix && k != 0u) __hip_atomic_fetch_add(&hist[(k >> shift) & 255u], 1u, __ATOMIC_RELAXED, __HIP_MEMORY_SCOPE_WORKGROUP); }
                    SEL_CHUNKS(SEL_HIST);
#undef SEL_HIST
                    unsigned cj[4]; unsigned sl = 0u;
#pragma unroll
                    for (int j = 0; j < 4; ++j) { cj[j] = hist[255 - 4 * lane - j]; sl += cj[j]; }
                    unsigned incl = 0u;
#pragma unroll
                    for (int bb = 0; bb < 13; ++bb) { const unsigned long long mb = __ballot((sl >> bb) & 1u); incl += (unsigned)(lane_rank(mb) + ((sl >> bb) & 1u)) << bb; }
                    const unsigned excl = incl - sl;
                    const bool cross = (excl < (unsigned)remaining) && ((unsigned)remaining <= incl);
                    unsigned dig = 0u, above = excl, cbin = 0u;
                    { unsigned accv = excl; bool found = false;
#pragma unroll
                      for (int j = 0; j < 4; ++j) { if (!found && accv + cj[j] >= (unsigned)remaining) { dig = 255u - 4u * lane - j; above = accv; cbin = cj[j]; found = true; } accv += cj[j]; } }
                    const unsigned long long mc = __ballot(cross);
                    const int src = mc ? __builtin_ctzll(mc) : 0;
                    dig = (unsigned)__builtin_amdgcn_readlane((int)dig, src); above = (unsigned)__builtin_amdgcn_readlane((int)above, src); cbin = (unsigned)__builtin_amdgcn_readlane((int)cbin, src);
                    prefix |= dig << shift; pmask |= 0xffu << shift; remaining -= (int)above;
                    if ((int)cbin == remaining) { exact = true; break; }
                }
                T = prefix; need = remaining;
            }
            if (exact) {
#define SEL_EX(i) { const unsigned long long msel = __ballot(kreg[i] >= T); if (lane == i) myword = msel; }
                SEL_CHUNKS(SEL_EX);
#undef SEL_EX
            } else {
                int taken = 0;
#define SEL_TIE(i) { const bool gt = kreg[i] > T, eq = kreg[i] == T; const unsigned long long meq = __ballot(eq); const bool sel = gt || (eq && (taken + lane_rank(meq) < need)); \
                    const unsigned long long msel = __ballot(sel); if (lane == i) myword = msel; taken += __popcll(meq); }
                SEL_CHUNKS(SEL_TIE);
#undef SEL_TIE
            }
        }
        if (lane < ntile) BM[tok * 64 + lane] = myword;
    }
#undef SEL_UNIT
#undef SEL_LOADQ
#undef SEL_LOADK
}
__device__ __forceinline__ void ph_dsa_attn(const Params& p, LAS unsigned char* lds, const unsigned long long* BM) {
    const int tid = tid_(), lane = tid & 63, w = tid >> 6, fr = lane & 15, fq = lane >> 4;
    const int G = gridDim.x, c = blockIdx.x;
    for (int L = c; L < 1024; L += G) {
        int qb, stream;
        if (G == 256) { const int rnd = L >> 8, x = c & 7, j = c >> 3;
            stream = 2 * x + (rnd >> 1); qb = (rnd & 1) ? 63 - j : j; }
        else { const int rnd = L / G; const int u = ((rnd & 1) && (1024 % G == 0)) ? rnd * G + (G - 1 - (L - rnd * G)) : L; qb = u & 63; stream = u >> 6; }
        const int grp = stream & 1, b = stream >> 1;
        const int tw = qb * 64 + w * 8, head = grp * 4 + (fr & 3);
#define TOKD(g) ((size_t)b * SEQ + tw + (g) * 4 + (fr >> 2))
        bf16x8 q[2][2];
#pragma unroll
        for (int g = 0; g < 2; ++g)
#pragma unroll
            for (int ks = 0; ks < 2; ++ks) q[g][ks] = *(const bf16x8*)(p.Pb + TOKD(g) * LDPB + E_BQ + head * 64 + ks * 32 + fq * 8);
        const bf16_t* kb = p.Pb + (size_t)b * SEQ * LDPB + E_BK + grp * 64; const bf16_t* vb = p.Pb + (size_t)b * SEQ * LDPB + E_BV + grp * 64;
        AtState<64> st; st.init();
        unsigned long long wn0 = BM[TOKD(0) * 64], wn1 = BM[TOKD(1) * 64];
        at_run<64>(lds, kb, vb, LDPB, 0, qb + 1, tid, [&](int i, lds_cptr Kb, lds_cptr Vb) {
            const unsigned long long w0 = wn0, w1 = wn1;
            if (i < qb) { wn0 = BM[TOKD(0) * 64 + i + 1]; wn1 = BM[TOKD(1) * 64 + i + 1]; }
            { const unsigned long long x0 = w0 >> (4 * fq), x1 = w1 >> (4 * fq);
                const int l0 = (int)(unsigned)x0, h0 = (int)(unsigned)(x0 >> 32), l1 = (int)(unsigned)x1, h1 = (int)(unsigned)(x1 >> 32);
                at_tile<64, 4>(st, Kb, Vb, q, fr, fq, AtNoRow(), [=](int g, int kk, int r) { const int bit = 16 * kk + r;
                    int mres; const int wsel = (bit < 32) ? (g ? l1 : l0) : (g ? h1 : h0);
                    asm("v_bfe_i32 %0, %1, %2, 1" : "=v"(mres) : "v"(wsel), "n"(bit & 31)); return mres; }); }
        });
        at_finish(st);
#pragma unroll
        for (int g = 0; g < 2; ++g) { const float inv = 1.f / st.l[g]; bf16_t* dst = p.Ob + TOKD(g) * DM + 512 + head * 64 + 4 * fq;
#pragma unroll
            for (int n = 0; n < 4; ++n) { const f32x4 o = st.o[g][n] * inv; u32x2 wv; wv.x = pk2(o[0], o[1]); wv.y = pk2(o[2], o[3]); *(u32x2*)(dst + n * 16) = wv; } }
#undef TOKD
    }
}

#define XB_TMO      128
#define XB_XCNT(j)  (256  + 64 * (j))
#define XB_XSUB(j)  (1280 + 64 * (j))
#define XB_XGEN(j)  (2304 + 64 * (j))
#define XB_TOP      3328
#define XB_TOPGEN   3392
#define XCD_BAR_WORDS 3456
#define XB_SPIN_CAP (1u << 24)
__device__ __forceinline__ unsigned xb_ld(unsigned* p)              { return __hip_atomic_load(p, __ATOMIC_RELAXED, __HIP_MEMORY_SCOPE_AGENT); }
__device__ __forceinline__ unsigned xb_add(unsigned* p, unsigned v) { return __hip_atomic_fetch_add(p, v, __ATOMIC_RELAXED, __HIP_MEMORY_SCOPE_AGENT); }
__device__ __forceinline__ unsigned xb_xcc_id() { return (unsigned)__builtin_amdgcn_s_getreg((3 << 11) | 20) & 0xFu; }
#define XB_SPIN(cond, bar) do { unsigned _sp = 0; while (cond) { __builtin_amdgcn_s_sleep(1); \
    if ((++_sp & 255u) == 0u) { if (xb_ld(&(bar)[XB_TMO])) break; if (_sp > XB_SPIN_CAP) { atomicAdd(&(bar)[XB_TMO], 1u); break; } } } } while (0)
struct XcdBarrier { unsigned* bar; unsigned x; volatile LAS unsigned* st; };
__device__ __forceinline__ XcdBarrier xcd_barrier_post(unsigned* bar, volatile LAS unsigned* st) {
    XcdBarrier b; b.bar = bar; b.x = xb_xcc_id(); b.st = st;
    if (threadIdx.x == 0) (void)xb_add(&bar[XB_XCNT(b.x)], 1u);
    return b;
}
__device__ __forceinline__ void xcd_barrier_complete(unsigned* bar, unsigned x, unsigned& nloc, unsigned& nx) {
    const unsigned G = gridDim.x * gridDim.y * gridDim.z;
    unsigned sum, cnt, mine, sp = 0u;
    for (;;) {
        sum = 0u; cnt = 0u; mine = 0u;
#pragma unroll
        for (unsigned j = 0; j < 16; ++j) { const unsigned c = xb_ld(&bar[XB_XCNT(j)]); sum += c; cnt += (c > 0u) ? 1u : 0u; mine = (j == x) ? c : mine; }
        if (sum == G) break;
        __builtin_amdgcn_s_sleep(1);
        if ((++sp & 255u) == 0u) { if (xb_ld(&bar[XB_TMO])) break; if (sp > XB_SPIN_CAP) { atomicAdd(&bar[XB_TMO], 1u); break; } }
    }
    nloc = mine > 0u ? mine : 1u; nx = cnt > 0u ? cnt : 1u;
}
__device__ __forceinline__ void xcd_barrier(unsigned* bar_in, volatile LAS unsigned* st) {
    asm volatile("s_waitcnt vmcnt(0)" ::: "memory");
    __syncthreads();
    if (threadIdx.x == 0) {
        unsigned* bar = bar_in; asm volatile("" : "+s"(bar));
        const unsigned x = xb_xcc_id();
        __builtin_amdgcn_s_waitcnt(0);
        unsigned nloc = st[0], nx = st[1];
        if (nloc == 0u) { xcd_barrier_complete(bar, x, nloc, nx); st[0] = nloc; st[1] = nx; }
        const unsigned old = xb_add(&bar[XB_XSUB(x)], 1u);
        const unsigned gen = old / nloc;
        if (old + 1u == (gen + 1u) * nloc) {
            __builtin_amdgcn_fence(__ATOMIC_RELEASE, "agent");
            asm volatile("s_waitcnt vmcnt(0)" ::: "memory");
            const unsigned og = xb_add(&bar[XB_TOP], 1u);
            const unsigned tg = og / nx;
            if (og + 1u == (tg + 1u) * nx) xb_add(&bar[XB_TOPGEN], 1u);
            else XB_SPIN(xb_ld(&bar[XB_TOPGEN]) == tg, bar);
            __builtin_amdgcn_fence(__ATOMIC_ACQUIRE, "agent");
            xb_add(&bar[XB_XGEN(x)], 1u);
            asm volatile("s_waitcnt vmcnt(0)" ::: "memory");
        } else {
            XB_SPIN(xb_ld(&bar[XB_XGEN(x)]) == gen, bar);
            __builtin_amdgcn_fence(__ATOMIC_ACQUIRE, "agent");
            asm volatile("s_waitcnt vmcnt(0)" ::: "memory");
        }
    }
    __syncthreads();
}

__global__ void __launch_bounds__(NT, 2) mega(Params p) {
    extern __shared__ __attribute__((aligned(16))) float lds[];
    PG8_LAS unsigned char* ldsL = (PG8_LAS unsigned char*)lds;
    volatile LAS unsigned* xst = (volatile LAS unsigned*)(lds + LDS_BYTES / 4);
    if (threadIdx.x == 0) { xst[0] = 0u; xst[1] = 0u; xst[2] = 0u; xst[3] = 0u; }
    __syncthreads();
    (void)xcd_barrier_post(p.bar, xst);
#define GRID_BAR() xcd_barrier(p.bar, xst)
    const int G = gridDim.x, cB = blockIdx.x;
    const float* const xin0 = p.in[IN_X];
    ph_init(p, lds);
    GRID_BAR();
    for (int l = 0; l < 4; ++l) {
        const int li = l >> 1;
        if ((l & 1) == 0) {
            {
                pg8::Gemm g{p.Xb, p.WinE + (size_t)li * NP_EVEN * DM, NTOK, NP_EVEN, DM}; pg8::StaticOrder S; S.init(NTOK, NP_EVEN, G, cB);
                EpiInEven E{p.Pb, p.IW, p.ropecs};
                pg8::gemm_phase<EpiInEven, pg8::StaticOrder, true, true>(ldsL, g, S, E);
            }
            GRID_BAR();
            ph_diff_mfma(p, (LAS unsigned char*)lds, li);
            __syncthreads();
            ph_dsa_select(p, (LAS unsigned char*)lds, p.BM);
            GRID_BAR();
            ph_dsa_attn(p, (LAS unsigned char*)lds, p.BM);
            GRID_BAR();
            {
                pg8::Gemm g{p.Ob, p.WoutE + (size_t)li * DM * DM, NTOK, DM, DM}; pg8::StaticOrder S; S.init(NTOK, DM, G, cB);
                EpiY E{(bf16_t*)p.Y};
                pg8::gemm_phase<EpiY, pg8::StaticOrder, true, true>(ldsL, g, S, E);
            }
            GRID_BAR();
        } else {
            {
                pg8::Gemm g{p.Xb, p.WinO + (size_t)li * NP_ODD * DM, NTOK, NP_ODD, DM}; pg8::StaticOrder S; S.init(NTOK, NP_ODD, G, cB);
                EpiInOdd E{p.Pb, p.QRb, p.GATES, p.ropecs, p.in[IN_NSA_GATE_B] + li * 24};
                pg8::gemm_phase<EpiInOdd, pg8::StaticOrder, true, true>(ldsL, g, S, E);
            }
            GRID_BAR();
            ph_kmean(p, lds);
            ph_cmp_build(p, li);
            GRID_BAR();
            {
                pg8::Gemm g{p.Ac, p.W1T + (size_t)li * 2 * 256 * 2048, 8192, 256, 2048}; ListOrder S{32, G, cB};
                EpiGeluH E{p.Hc};
                pg8::gemm_phase<EpiGeluH, ListOrder, true, true>(ldsL, g, S, E);
            }
            __syncthreads();
            ph_moba_mfma(p, (LAS unsigned char*)lds, li);
            GRID_BAR();
            {
                pg8::Gemm g{p.Hc, p.W2T + (size_t)li * 2 * 256 * 256, 8192, 256, 256}; ListOrder S{32, G, cB};
                EpiCmp E{p.CMP};
                pg8::gemm_phase<EpiCmp, ListOrder, true, true>(ldsL, g, S, E);
            }
            GRID_BAR();
            ph_nsa_mfma(p, (LAS unsigned char*)lds, p.CMP, p.CMP + (size_t)4096 * 64);
            GRID_BAR();
            {
                pg8::Gemm g{p.Ob, p.WoutO + (size_t)li * DM * DM, NTOK, DM, DM}; pg8::StaticOrder S; S.init(NTOK, DM, G, cB);
                EpiY E{(bf16_t*)p.Y};
                pg8::gemm_phase<EpiY, pg8::StaticOrder, true, true>(ldsL, g, S, E);
            }
            GRID_BAR();
        }
        if (l & 1) ph_ln_router(p, p.in[IN_LN_MIX_G] + l * DM, p.in[IN_LN_MIX_B] + l * DM, li, lds);
        else if (l == 0) ph_ln<0, 0>(p, p.in[IN_LN_MIX_G] + l * DM, p.in[IN_LN_MIX_B] + l * DM, xin0, p.X, p.Xb, false);
        else ph_ln<0, 1>(p, p.in[IN_LN_MIX_G] + l * DM, p.in[IN_LN_MIX_B] + l * DM, xin0, p.X, p.Xb, false);
        GRID_BAR();
        if ((l & 1) == 0) {
            {
                pg8::Gemm g{p.Xb, p.WguD + (size_t)li * 2 * F_DENSE * DM, NTOK, 2 * F_DENSE, DM}; pg8::StaticOrder S; S.init(NTOK, 2 * F_DENSE, G, cB);
                EpiGU E{p.H, F_DENSE, 2 * F_DENSE / 256, 0};
                pg8::gemm_phase<EpiGU, pg8::StaticOrder, true, true>(ldsL, g, S, E);
            }
            GRID_BAR();
            {
                pg8::Gemm g{p.H, p.WdD + (size_t)li * DM * F_DENSE, NTOK, DM, F_DENSE}; pg8::StaticOrder S; S.init(NTOK, DM, G, cB);
                EpiY E{(bf16_t*)p.Y};
                pg8::gemm_phase<EpiY, pg8::StaticOrder, true, true>(ldsL, g, S, E);
            }
            GRID_BAR();
            ph_ln<0, 1>(p, p.in[IN_LN_FFN_G] + l * DM, p.in[IN_LN_FFN_B] + l * DM, xin0, p.X, p.Xb, false);
            GRID_BAR();
        } else {
            ph_slots(p, lds);
            GRID_BAR();
            __syncthreads();
            for (int i = tid_(); i < NTILE256; i += NT) ((LAS int*)((LAS unsigned char*)lds + MOE_TE_LDS))[i] = p.tile_e[i];
            __syncthreads();
#pragma unroll 1
            for (int hf = 0; hf < 3; ++hf) {
                const int t0 = hf * 128, ntr = (hf < 2) ? 128 : NTILE256 - 256;
                if (G == 256) {
                    EpiGU E{p.Hm, F_EXPERT, 2 * F_EXPERT / 256, t0};
#pragma unroll 1
                    for (int rb = 0; rb < (hf < 2 ? 2 : 1); ++rb) {
                        pg8::Gemm g{p.Xb, p.WguM, NSLOT, 2 * F_EXPERT, DM}; MoeOrderG S{t0, ntr, 2 * F_EXPERT / 256, G, cB, rb, p.slot_tok};
                        pg8::gemm_phase<EpiGU, MoeOrderG, true, true>(ldsL, g, S, E);
                        __syncthreads();
                    }
                } else {
                    pg8::Gemm g{p.Xs, p.WguM, NSLOT, 2 * F_EXPERT, DM}; MoeOrder S{t0, ntr, 2 * F_EXPERT / 256, G, cB};
                    EpiGU E{p.Hm, F_EXPERT, 2 * F_EXPERT / 256, t0};
                    pg8::gemm_phase<EpiGU, MoeOrder, true, true>(ldsL, g, S, E);
                }
                GRID_BAR();
                if (hf < 2) {
                    pg8::Gemm g{p.Hm - (size_t)t0 * 256 * F_EXPERT, p.WdM, NSLOT, DM, F_EXPERT}; MoeOrder S{t0, ntr, DM / 256, G, cB};
                    EpiDownMoe E{p.Ys, p.slot_gate};
                    pg8::gemm_phase<EpiDownMoe, MoeOrder, true, true>(ldsL, g, S, E);
                } else {
                    pg8::Gemm g{p.Hm - (size_t)t0 * 256 * F_EXPERT, p.WdM, NSLOT, DM, MOE_KSL_K, F_EXPERT}; TailOrder S{G, cB};
                    EpiDownTail E{p.Yp, p.slot_gate};
                    pg8::gemm_phase<EpiDownTail, TailOrder, true, true>(ldsL, g, S, E);
                }
                GRID_BAR();
            }
            ph_ln<1, 1>(p, p.in[IN_LN_FFN_G] + l * DM, p.in[IN_LN_FFN_B] + l * DM, xin0, p.X, p.Xb, l == 3);
            GRID_BAR();
        }
    }
    if (xb_ld(&p.bar[XB_TMO])) { for (int i = blockIdx.x * NT + threadIdx.x; i < NTOK * DM; i += gridDim.x * NT) p.X[i] = __builtin_nanf(""); }
}

extern "C" void kernel_launch(void* const* d_in, const int* in_sizes, int n_in, void* d_out, int out_size, void* d_ws, size_t ws_size, hipStream_t stream) {
    Params p; memset(&p, 0, sizeof(p));
    for (int i = 0; i < 23; ++i) p.in[i] = (const float*)d_in[i];
    p.X = (float*)d_out;
    unsigned char* w = (unsigned char*)d_ws; size_t off = 0;
    auto take = [&](size_t bytes) { unsigned char* r = w + off; off += (bytes + 255) / 256 * 256; return r; };
    p.bar = (unsigned*)take(16384);
    p.ropecs = (float*)take(4096 * 32 * 2 * 4);
    p.IW = (float*)take((size_t)NTOK * 4 * 4);
    p.BM = (unsigned long long*)take((size_t)NTOK * 64 * 8);
    p.GATES = (float*)take((size_t)NTOK * 24 * 4);
    p.kmean = (float*)take(8 * 16 * 8 * 64 * 4);
    p.cmpk = (float*)take(8 * 256 * 2 * 64 * 4);
    p.cmpv = (float*)take(8 * 256 * 2 * 64 * 4);
    p.tok_e = (int*)take(NTOK * 2 * 4);
    p.tok_g = (float*)take(NTOK * 2 * 4);
    p.tok_slot = (int*)take(NTOK * 2 * 4);
    p.slot_tok = (int*)take(NSLOT * 4);
    p.slot_gate = (float*)take(NSLOT * 4);
    p.chunk_cnt = (int*)take(256 * 8 * 4);
    p.tile_e = (int*)take(NTILE256 * 4);
    p.W1T = (bf16_t*)take((size_t)2 * 2 * 256 * 2048 * 2);
    p.W2T = (bf16_t*)take((size_t)2 * 2 * 256 * 256 * 2);
    p.CMP = (bf16_t*)take((size_t)8192 * 64 * 2);
    p.WinE = (bf16_t*)take((size_t)2 * NP_EVEN * DM * 2);
    p.WoutE = (bf16_t*)take((size_t)2 * DM * DM * 2);
    p.WguD = (bf16_t*)take((size_t)2 * 2 * F_DENSE * DM * 2);
    p.WdD = (bf16_t*)take((size_t)2 * DM * F_DENSE * 2);
    p.WinO = (bf16_t*)take((size_t)2 * NP_ODD * DM * 2);
    p.WoutO = (bf16_t*)take((size_t)2 * DM * DM * 2);
    p.WguM = (bf16_t*)take((size_t)N_EXP * 2 * F_EXPERT * DM * 2);
    p.WdM = (bf16_t*)take((size_t)N_EXP * DM * F_EXPERT * 2);
    p.Xb = (bf16_t*)take((size_t)(NTOK + 1) * DM * 2);
    unsigned char* R = w + off;
    {   size_t o = 0; auto tk = [&](size_t bytes) { unsigned char* r = R + o; o += (bytes + 255) / 256 * 256; return r; };
        p.Pb = (bf16_t*)tk((size_t)NTOK * LDPB * 2); p.H = p.Pb;
        p.Ob = (bf16_t*)tk((size_t)NTOK * DM * 2);
        p.QRb = (bf16_t*)tk((size_t)NTOK * 512 * 2);
        p.Y = (float*)tk((size_t)NTOK * DM * 4);
        p.Ac = (bf16_t*)p.Y; p.Hc = p.Ac + (size_t)2 * 4096 * 2048; }
    {   size_t o = 0; auto tk = [&](size_t bytes) { unsigned char* r = R + o; o += (bytes + 255) / 256 * 256; return r; };
        p.Xs = (bf16_t*)tk((size_t)NSLOT * DM * 2);
        p.Hm = (bf16_t*)tk((size_t)MOE_HALF_TILES * 256 * F_EXPERT * 2);
        p.Ys = (bf16_t*)tk((size_t)NSLOT * DM * 2);
        p.Yp = p.Hm + (size_t)16 * 256 * F_EXPERT; }
    p.lam_init[0] = (float)(0.8 - 0.6 * exp(-0.3 * 0.0));
    p.lam_init[1] = (float)(0.8 - 0.6 * exp(-0.3 * 2.0));
    constexpr int kDynLds = LDS_BYTES + 16;
    static int grid = 0;
    if (!grid) {
        int dev = 0, cus = 0, per_cu = 0;
        (void)hipGetDevice(&dev);
        (void)hipDeviceGetAttribute(&cus, hipDeviceAttributeMultiprocessorCount, dev);
        (void)hipFuncSetAttribute((const void*)mega, hipFuncAttributeMaxDynamicSharedMemorySize, kDynLds);
        (void)hipOccupancyMaxActiveBlocksPerMultiprocessor(&per_cu, (const void*)mega, NT, kDynLds);
        if (cus <= 0) cus = 256;
        grid = cus;
    }
    (void)hipMemsetAsync(p.bar, 0, XCD_BAR_WORDS * sizeof(unsigned), stream);
    mega<<<grid, NT, kDynLds, stream>>>(p);
}
```

```cpp
#include <hip/hip_runtime.h>
#include <stdint.h>
#include <string.h>
#include <math.h>

__device__ __forceinline__ int tid_() { int t = threadIdx.x; asm volatile("" : "+v"(t)); return t; }
__device__ __forceinline__ float zero1_() { float z = 0.f; asm volatile("" : "+v"(z)); return z; }
namespace pg8 {
#define PG8_LAS __attribute__((address_space(3)))
typedef unsigned short bf16_t;
typedef short bf16x8 __attribute__((ext_vector_type(8)));
typedef float f32x4 __attribute__((ext_vector_type(4)));
typedef unsigned u32x4 __attribute__((ext_vector_type(4)));
constexpr int BM = 256, BK = 64, HALF = 128, HTB = HALF * BK * 2  , STAGE_BYTES = 8 * HTB, NXCD = 8, WGM = 8;

__host__ __device__ __forceinline__ int lds_byte(int r, int c) { const int st = (r >> 4) * 2 + (c >> 5), rr = r & 15, cc = c & 31, ob = rr * 64 + cc * 2; return st * 1024 + (ob ^ (((ob >> 9) & 1) << 5)); }
__host__ __device__ __forceinline__ void stage_rc(int b, int& R, int& C) { const int st = b / 1024, sb = b % 1024, swz = sb ^ (((sb >> 9) & 1) << 5); R = (st >> 1) * 16 + swz / 64; C = (st & 1) * 32 + (swz % 64) / 2; }
__host__ __device__ __forceinline__ int perm32(int rho) { const int n = rho >> 4, i = rho & 15; return 8 * (i >> 2) + 4 * n + (i & 3); }

struct Unit { int pm, pn, ko; };
struct Gemm { const bf16_t* A; const bf16_t* Bt; int M, N, K, ld; };

struct StaticOrder {
    static constexpr bool KSPLIT = false, GATHER_A = false;
    int nM, nN, nwg, G, c;
    __host__ __device__ void init(int M, int N, int G_, int c_) { nM = M / BM; nN = N / BM; nwg = nM * nN; G = G_; c = c_; }
    __host__ __device__ bool next(int i, Unit& u) const {
        const long L = (long)i * G + c; if (L >= nwg) return false;
        int wgid = (int)L; { const int q = nwg / NXCD, r = nwg % NXCD, xcd = wgid % NXCD, off = wgid / NXCD; wgid = (xcd < r ? xcd * (q + 1) : r * (q + 1) + (xcd - r) * q) + off; }
        const int nig = WGM * nN, gid = wgid / nig, fm = gid * WGM, gsz = (nM - fm) < WGM ? (nM - fm) : WGM;
        u.pm = fm + ((wgid % nig) % gsz); u.pn = (wgid % nig) / gsz; return true;
    }
    __device__ __forceinline__ void a_ready(const Unit&) const {}
    __device__ __forceinline__ void done(const Unit&) const {}
};

__device__ __forceinline__ unsigned cvt_pk_bf16(float lo, float hi) { unsigned r; asm volatile("v_cvt_pk_bf16_f32 %0, %1, %2" : "=v"(r) : "v"(lo), "v"(hi)); return r; }
typedef float f32x2 __attribute__((ext_vector_type(2)));
template <class Epi, class Sched, bool ALIGN_EPI = false, bool SP2 = false>
__device__ __forceinline__ void gemm_phase(PG8_LAS unsigned char* lds, const Gemm g, const Sched& S, const Epi& E) {
    const int tid = tid_(), wid = __builtin_amdgcn_readfirstlane(tid >> 6), lane = tid & 63, wr = wid >> 2, wc = wid & 3, fr = lane & 15, fq = lane >> 4;
    const int K = g.K, nt = K / BK, LD = g.ld ? g.ld : K;
    unsigned voffA[2], voffB[2];
#pragma unroll
    for (int i = 0; i < 2; ++i) { int R, C; stage_rc(tid * 16 + i * 8192, R, C); const int Rb = Epi::PERM ? ((R & ~31) + perm32(R & 31)) : R;
        voffA[i] = (unsigned)(R * LD + C) * 2u; voffB[i] = (unsigned)(Rb * LD + C) * 2u; }
    const size_t kstep = (size_t)(BK * 2);
    const size_t hstep = (size_t)HALF * LD * 2;
    const size_t tstep = 2 * hstep;
    const unsigned ldsw = (unsigned)wid * 1024u;
    const int aoff = lds_byte(wr * 64 + fr, fq * 8), boff = lds_byte(wc * 32 + fr, fq * 8);
#define PG8_SA(b, h) (((b) * 2 + (h)) * HTB)
#define PG8_SB(b, h) ((4 + (b) * 2 + (h)) * HTB)
#define PG8_STAGE(bufoff, gbase, voff) do { _Pragma("unroll") for (int _i = 0; _i < 2; ++_i) \
        __builtin_amdgcn_global_load_lds((const unsigned*)((const char*)(gbase) + (voff)[_i]), (PG8_LAS unsigned*)(lds + (bufoff) + ldsw + _i * 8192), 16, 0, 0); } while (0)
#define PG8_LDA(dst, b, h) do { _Pragma("unroll") for (int m = 0; m < 4; ++m) _Pragma("unroll") for (int k = 0; k < 2; ++k) dst[m][k] = *(const PG8_LAS bf16x8*)(lds + PG8_SA(b, h) + aoff + m * 2048 + k * 1024); } while (0)
#define PG8_LDB(dst, b, h) do { _Pragma("unroll") for (int n = 0; n < 2; ++n) _Pragma("unroll") for (int k = 0; k < 2; ++k) dst[n][k] = *(const PG8_LAS bf16x8*)(lds + PG8_SB(b, h) + boff + n * 2048 + k * 1024); } while (0)
#define PG8_MMA(ai, bj, At, Bt) do { __builtin_amdgcn_s_setprio(1); _Pragma("unroll") for (int m = 0; m < 4; ++m) _Pragma("unroll") for (int n = 0; n < 2; ++n) _Pragma("unroll") for (int k = 0; k < 2; ++k) \
        acc[ai][bj][m][n] = __builtin_amdgcn_mfma_f32_16x16x32_bf16(Bt[n][k], At[m][k], acc[ai][bj][m][n], 0, 0, 0); __builtin_amdgcn_s_setprio(0); } while (0)
#define PG8_WAIT_V(n) asm volatile("s_waitcnt vmcnt(" #n ")" ::: "memory")
#define PG8_WAIT_L(n) asm volatile("s_waitcnt lgkmcnt(" #n ")" ::: "memory")
#define PG8_BAR __builtin_amdgcn_s_barrier()
#define PG8_SCHED __builtin_amdgcn_sched_barrier(0)
    Unit cur, nxt; int ui = 0;
    if (!S.next(0, cur)) return;
    unsigned voffA1[2]; size_t hstepA = hstep;
#pragma unroll
    for (int i = 0; i < 2; ++i) voffA1[i] = voffA[i];
    if constexpr (Sched::GATHER_A) {
        hstepA = 0;
#pragma unroll
        for (int i = 0; i < 2; ++i) { int R, C; stage_rc(tid * 16 + i * 8192, R, C);
            voffA[i] = (unsigned)(S.arow(cur.pm * 256 + R) * LD + C) * 2u; voffA1[i] = (unsigned)(S.arow(cur.pm * 256 + 128 + R) * LD + C) * 2u; }
    }
    f32x4 acc[2][2][4][2];
#pragma unroll
    for (int a = 0; a < 2; ++a)
#pragma unroll
        for (int b = 0; b < 2; ++b)
#pragma unroll
            for (int m = 0; m < 4; ++m)
#pragma unroll
                for (int n = 0; n < 2; ++n) acc[a][b][m][n] = ([]() { const float z = zero1_(); return (f32x4){z, z, z, z}; }());
    bf16x8 At[4][2], B0[2][2], B1[2][2];
    const char* cA = (const char*)g.A + (Sched::GATHER_A ? (size_t)0 : (size_t)cur.pm * tstep); const char* cB = (const char*)g.Bt + (size_t)cur.pn * tstep;
    if constexpr (Sched::KSPLIT) { cA += (size_t)cur.ko * 2; cB += (size_t)cur.ko * 2; }
    S.a_ready(cur);
    if constexpr (SP2) {
        PG8_STAGE(PG8_SB(0, 0), cB, voffB); PG8_STAGE(PG8_SB(0, 1), cB + hstep, voffB); PG8_STAGE(PG8_SA(0, 0), cA, voffA); PG8_STAGE(PG8_SA(0, 1), cA + hstepA, voffA1);
        if (wr == 1) PG8_BAR;
        PG8_WAIT_V(2); PG8_BAR;
        PG8_STAGE(PG8_SB(1, 0), cB + kstep, voffB); PG8_STAGE(PG8_SA(1, 0), cA + kstep, voffA); PG8_STAGE(PG8_SB(1, 1), cB + hstep + kstep, voffB);
        PG8_WAIT_V(6); PG8_BAR;
    } else {
        PG8_STAGE(PG8_SB(0, 0), cB, voffB); PG8_STAGE(PG8_SA(0, 0), cA, voffA); PG8_STAGE(PG8_SB(0, 1), cB + hstep, voffB); PG8_STAGE(PG8_SA(0, 1), cA + hstepA, voffA1);
        if (wr == 1) PG8_BAR;
        PG8_WAIT_V(4); PG8_BAR;
        PG8_STAGE(PG8_SB(1, 0), cB + kstep, voffB); PG8_STAGE(PG8_SA(1, 0), cA + kstep, voffA); PG8_STAGE(PG8_SB(1, 1), cB + hstep + kstep, voffB);
        PG8_WAIT_V(6); PG8_BAR;
    }
    for (;;) {
        const bool has_next = S.next(ui + 1, nxt);
        const char* nA = has_next ? (const char*)g.A + (Sched::GATHER_A ? (size_t)0 : (size_t)nxt.pm * tstep) : cA; const char* nB = has_next ? (const char*)g.Bt + (size_t)nxt.pn * tstep : cB;
        if constexpr (Sched::KSPLIT) { if (has_next) { nA += (size_t)nxt.ko * 2; nB += (size_t)nxt.ko * 2; } }
        for (int t = 0; t < nt; t += 2) {
            const bool last = (t == nt - 2);
            const char* a1 = cA + (size_t)(t + 1) * kstep;
            const char* a2 = last ? nA : cA + (size_t)(t + 2) * kstep; const char* b2 = last ? nB : cB + (size_t)(t + 2) * kstep;
            const char* a3 = a2 + kstep; const char* b3 = b2 + kstep;
            if (last && has_next) S.a_ready(nxt);
            if constexpr (SP2) {
            PG8_LDB(B0, 0, 0); PG8_LDB(B1, 0, 1); PG8_SCHED; PG8_LDA(At, 0, 0); PG8_STAGE(PG8_SA(1, 1), a1 + hstepA, voffA1);
            PG8_WAIT_V(8); PG8_WAIT_L(0); PG8_BAR; PG8_MMA(0, 0, At, B0); PG8_MMA(0, 1, At, B1); PG8_BAR; PG8_SCHED;
            PG8_LDA(At, 0, 1); PG8_STAGE(PG8_SB(0, 0), b2, voffB); PG8_STAGE(PG8_SB(0, 1), b2 + hstep, voffB); PG8_STAGE(PG8_SA(0, 0), a2, voffA);
            PG8_WAIT_V(8); PG8_WAIT_L(0); PG8_BAR; PG8_MMA(1, 0, At, B0); PG8_MMA(1, 1, At, B1); PG8_BAR; PG8_SCHED;
            PG8_LDB(B0, 1, 0); PG8_LDB(B1, 1, 1); PG8_SCHED; PG8_LDA(At, 1, 0); PG8_STAGE(PG8_SA(0, 1), a2 + hstepA, voffA1);
            PG8_WAIT_V(8); PG8_WAIT_L(0); PG8_BAR; PG8_MMA(0, 0, At, B0); PG8_MMA(0, 1, At, B1); PG8_BAR; PG8_SCHED;
            PG8_LDA(At, 1, 1); PG8_STAGE(PG8_SB(1, 0), b3, voffB); PG8_STAGE(PG8_SB(1, 1), b3 + hstep, voffB); PG8_STAGE(PG8_SA(1, 0), a3, voffA);
            PG8_WAIT_V(8); PG8_WAIT_L(0); PG8_BAR; PG8_MMA(1, 0, At, B0); PG8_MMA(1, 1, At, B1); PG8_BAR; PG8_SCHED;
            } else {
            PG8_LDB(B0, 0, 0); PG8_SCHED; PG8_LDA(At, 0, 0); PG8_STAGE(PG8_SA(1, 1), a1 + hstepA, voffA1);
            PG8_WAIT_L(8); PG8_BAR; PG8_WAIT_L(0); PG8_MMA(0, 0, At, B0); PG8_BAR; PG8_SCHED;
            PG8_LDB(B1, 0, 1); PG8_STAGE(PG8_SB(0, 0), b2, voffB);
            PG8_BAR; PG8_WAIT_L(0); PG8_MMA(0, 1, At, B1); PG8_BAR;
            PG8_LDA(At, 0, 1); PG8_STAGE(PG8_SA(0, 0), a2, voffA);
            PG8_BAR; PG8_WAIT_L(0); PG8_MMA(1, 0, At, B0); PG8_BAR; PG8_SCHED;
            PG8_STAGE(PG8_SB(0, 1), b2 + hstep, voffB);
            PG8_WAIT_V(6); PG8_BAR; PG8_MMA(1, 1, At, B1); PG8_BAR;
            PG8_LDB(B0, 1, 0); PG8_SCHED; PG8_LDA(At, 1, 0); PG8_STAGE(PG8_SA(0, 1), a2 + hstepA, voffA1);
            PG8_WAIT_L(8); PG8_BAR; PG8_WAIT_L(0); PG8_MMA(0, 0, At, B0); PG8_BAR; PG8_SCHED;
            PG8_LDB(B1, 1, 1); PG8_STAGE(PG8_SB(1, 0), b3, voffB);
            PG8_BAR; PG8_WAIT_L(0); PG8_MMA(0, 1, At, B1); PG8_BAR;
            PG8_LDA(At, 1, 1); PG8_STAGE(PG8_SA(1, 0), a3, voffA);
            PG8_BAR; PG8_WAIT_L(0); PG8_MMA(1, 0, At, B0); PG8_BAR; PG8_SCHED;
            PG8_STAGE(PG8_SB(1, 1), b3 + hstep, voffB);
            PG8_WAIT_V(6); PG8_BAR; PG8_MMA(1, 1, At, B1); PG8_BAR;
            }
        }
        if constexpr (ALIGN_EPI) { if (wr == 0) PG8_BAR; }
        if constexpr (!Epi::AFTER_DRAIN) { E(acc, cur, wr, wc, fr, fq); S.done(cur); }
        if (!has_next) break;
#pragma unroll
        for (int a = 0; a < 2; ++a)
#pragma unroll
            for (int b = 0; b < 2; ++b)
#pragma unroll
                for (int m = 0; m < 4; ++m)
#pragma unroll
                    for (int n = 0; n < 2; ++n) acc[a][b][m][n] = ([]() { const float z = zero1_(); return (f32x4){z, z, z, z}; }());
        cur = nxt; cA = nA; cB = nB; ++ui;
        if constexpr (ALIGN_EPI) { if (wr == 1) PG8_BAR; }
    }
    PG8_WAIT_V(0);
    if constexpr (!ALIGN_EPI) { if (wr == 0) PG8_BAR; }
    PG8_BAR;
    if constexpr (Epi::AFTER_DRAIN) { E.fused(acc, cur, wr, wc, fr, fq, lds, wid, lane); S.done(cur); }
#undef PG8_SA
#undef PG8_SB
#undef PG8_STAGE
#undef PG8_LDA
#undef PG8_LDB
#undef PG8_MMA
#undef PG8_WAIT_V
#undef PG8_WAIT_L
#undef PG8_BAR
#undef PG8_SCHED
}
}
using pg8::bf16_t; using pg8::f32x4; using pg8::Unit;
typedef unsigned u32x2 __attribute__((ext_vector_type(2)));

#define NT 512
#define Z4_ ([]() { const float z = zero1_(); return (f32x4){z, z, z, z}; }())
#define LAS __attribute__((address_space(3)))
constexpr int NTOK = 32768, DM = 1024, SEQ = 4096;
constexpr int LDPB = 3072;
constexpr float ALPHA = 1.681792830507429f;
constexpr float LN_EPS = 1e-5f;
constexpr int E_AQ = 0, E_AK = 512, E_AV = 1024, E_BQ = 1536, E_BK = 2048, E_BV = 2176, E_IQ = 2304, E_IK = 2560, E_IW = 2624, P_EVEN = 2628, NP_EVEN = 2816;
constexpr int O_CQ = 0, O_CK = 512, O_CV = 1024, O_DQ = 1536, O_KC = 2048, O_VC = 2176, O_KS = 2304, O_VS = 2432, O_KW = 2560, O_VW = 2688, O_DG = 2816, P_ODD = 2840, NP_ODD = 3072;
constexpr int F_DENSE = 2816, F_EXPERT = 3584, N_EXP = 8;
constexpr int NSLOT = 65536 + 8 * 256;
constexpr int NTILE256 = NSLOT / 256;
constexpr int MOE_HALF_TILES = NTILE256 / 2;
constexpr int LDS_BYTES = 147456;

__constant__ float c_inv[32] = {1.0f, 0.7498942613601685f, 0.5623413324356079f, 0.4216965138912201f, 0.3162277638912201f, 0.23713737726211548f, 0.17782793939113617f, 0.133352130651474f,
    0.10000000149011612f, 0.07498941570520401f, 0.05623413249850273f, 0.04216965287923813f, 0.03162277489900589f, 0.023713737726211548f, 0.017782794311642647f, 0.01333521492779255f,
    0.009999999776482582f, 0.007498941849917173f, 0.005623413249850273f, 0.0042169648222625256f, 0.003162277629598975f, 0.00237137358635664f, 0.0017782794311642647f, 0.0013335214462131262f,
    0.0010000000474974513f, 0.0007498942431993783f, 0.000562341301701963f, 0.0004216965171508491f, 0.0003162277571391314f, 0.00023713737027719617f, 0.00017782794020604342f, 0.0001333521504420787f};

struct Params {
    const float* in[23];
    float* X;
    bf16_t* Xb;
    bf16_t* Pb;
    bf16_t* Ob;
    bf16_t* QRb;
    float* Y;
    bf16_t* H;
    bf16_t* Xs;
    bf16_t* Hm;
    bf16_t* Ys;
    bf16_t* Yp;
    bf16_t* W1T; bf16_t* W2T;
    bf16_t* Ac; bf16_t* Hc; bf16_t* CMP;
    bf16_t* WinE; bf16_t* WoutE; bf16_t* WguD; bf16_t* WdD; bf16_t* WinO; bf16_t* WoutO; bf16_t* WguM; bf16_t* WdM;
    float* ropecs;
    float* IW;
    unsigned long long* BM;
    float* GATES;
    float* kmean;
    float* cmpk;
    float* cmpv;
    int* tok_e; float* tok_g; int* tok_slot; int* slot_tok; float* slot_gate; int* chunk_cnt; int* tile_e;
    unsigned* bar;
    float lam_init[2];
};

enum { IN_X = 0, IN_EV_WIN, IN_EV_WOUT, IN_DIF_LAMBDA, IN_DIF_SUBLN, IN_FFD_WG, IN_FFD_WU, IN_FFD_WD, IN_OD_WIN, IN_OD_WOUT, IN_NSA_GATE_B, IN_NSA_PE, IN_NSA_W1, IN_NSA_W2,
       IN_MOE_WR, IN_MOE_BR, IN_MOE_WG, IN_MOE_WU, IN_MOE_WD, IN_LN_MIX_G, IN_LN_MIX_B, IN_LN_FFN_G, IN_LN_FFN_B };

__device__ __forceinline__ float bf2f(bf16_t u) { return __builtin_bit_cast(float, (unsigned)u << 16); }
__device__ __forceinline__ unsigned pk2(float lo, float hi) { return pg8::cvt_pk_bf16(lo, hi); }
__device__ __forceinline__ bf16_t f2bf(float f) { return (bf16_t)(pg8::cvt_pk_bf16(f, 0.f) & 0xffffu); }
__device__ __forceinline__ float wave_max(float v) {
#pragma unroll
    for (int o = 32; o >= 1; o >>= 1) v = fmaxf(v, __shfl_xor(v, o));
    return v;
}
__device__ __forceinline__ float wave_sum(float v) {
#pragma unroll
    for (int o = 32; o >= 1; o >>= 1) v += __shfl_xor(v, o);
    return v;
}
__device__ __forceinline__ int wave_sumi(int v) {
#pragma unroll
    for (int o = 32; o >= 1; o >>= 1) v += __shfl_xor(v, o);
    return v;
}
__device__ __forceinline__ float rl_f(float v, int l) { return __builtin_bit_cast(float, __builtin_amdgcn_readlane(__builtin_bit_cast(int, v), l)); }
__device__ __forceinline__ int lane_rank(unsigned long long m) { return __builtin_amdgcn_mbcnt_hi((unsigned)(m >> 32), __builtin_amdgcn_mbcnt_lo((unsigned)m, 0)); }

#define EPI_LOOP_BEGIN \
    _Pragma("unroll") for (int ai = 0; ai < 2; ++ai) _Pragma("unroll") for (int m = 0; m < 4; ++m) { const int rloc = ai * 128 + wr * 64 + m * 16 + fr; \
    _Pragma("unroll") for (int bj = 0; bj < 2; ++bj) _Pragma("unroll") for (int n = 0; n < 2; ++n) { const int cloc = bj * 128 + wc * 32 + n * 16 + fq * 4; const f32x4 v = acc[ai][bj][m][n];
#define EPI_LOOP_END } }

struct EpiInEven {
    static constexpr bool PERM = false, AFTER_DRAIN = false;
    bf16_t* Pb; float* IW; const float* cs;
    __device__ __forceinline__ void operator()(const f32x4 (&acc)[2][2][4][2], const Unit& u, int wr, int wc, int fr, int fq) const {
        EPI_LOOP_BEGIN
            const int row = u.pm * 256 + rloc, c0 = u.pn * 256 + cloc, pos = row & (SEQ - 1);
            if (c0 < P_EVEN) {
                if (c0 == E_IW) { *(f32x4*)(IW + (size_t)row * 4) = v; }
                else {
                    f32x4 o = v;
                    const bool rope = (c0 < 1024) || (c0 >= 1536 && c0 < 2176) || (c0 >= 2304 && c0 < 2624);
                    if (rope) { const f32x4 t = *(const f32x4*)(cs + ((size_t)pos * 32 + ((c0 & 63) >> 1)) * 2);
                        o[0] = v[0] * t[0] - v[1] * t[1]; o[1] = v[1] * t[0] + v[0] * t[1]; o[2] = v[2] * t[2] - v[3] * t[3]; o[3] = v[3] * t[2] + v[2] * t[3]; }
                    u32x2 w; w.x = pk2(o[0], o[1]); w.y = pk2(o[2], o[3]);
                    *(u32x2*)(Pb + (size_t)row * LDPB + c0) = w;
                }
            }
        EPI_LOOP_END
    }
};
struct EpiInOdd {
    static constexpr bool PERM = false, AFTER_DRAIN = false;
    bf16_t* Pb; bf16_t* QRb; float* G; const float* cs; const float* gb;
    __device__ __forceinline__ void operator()(const f32x4 (&acc)[2][2][4][2], const Unit& u, int wr, int wc, int fr, int fq) const {
        EPI_LOOP_BEGIN
            const int row = u.pm * 256 + rloc, c0 = u.pn * 256 + cloc, pos = row & (SEQ - 1);
            if (c0 < P_ODD) {
                if (c0 >= O_DG) {
                    const int j = c0 - O_DG; f32x4 o;
#pragma unroll
                    for (int e = 0; e < 4; ++e) o[e] = 1.f / (1.f + expf(-(v[e] + gb[j + e])));
                    *(f32x4*)(G + (size_t)row * 24 + j) = o;
                } else {
                    const bool isq = (c0 >= O_DQ && c0 < O_KC);
                    const bool rope = (c0 < 1024) || isq || (c0 >= O_KS && c0 < O_VS) || (c0 >= O_KW && c0 < O_VW);
                    f32x4 o = v;
                    if (rope) { const f32x4 t = *(const f32x4*)(cs + ((size_t)pos * 32 + ((c0 & 63) >> 1)) * 2);
                        o[0] = v[0] * t[0] - v[1] * t[1]; o[1] = v[1] * t[0] + v[0] * t[1]; o[2] = v[2] * t[2] - v[3] * t[3]; o[3] = v[3] * t[2] + v[2] * t[3]; }
                    u32x2 w; w.x = pk2(o[0], o[1]); w.y = pk2(o[2], o[3]);
                    if (isq) { *(u32x2*)(QRb + (size_t)row * 512 + (c0 - O_DQ)) = w; w.x = pk2(v[0], v[1]); w.y = pk2(v[2], v[3]); }
                    *(u32x2*)(Pb + (size_t)row * LDPB + c0) = w;
                }
            }
        EPI_LOOP_END
    }
};
struct EpiY {
    static constexpr bool PERM = false, AFTER_DRAIN = false;
    bf16_t* Y;
    __device__ __forceinline__ void operator()(const f32x4 (&acc)[2][2][4][2], const Unit& u, int wr, int wc, int fr, int fq) const {
        EPI_LOOP_BEGIN
            u32x2 w; w.x = pk2(v[0], v[1]); w.y = pk2(v[2], v[3]);
            *(u32x2*)(Y + (size_t)(u.pm * 256 + rloc) * DM + u.pn * 256 + cloc) = w;
        EPI_LOOP_END
    }
};
struct EpiGU {
    static constexpr bool PERM = false, AFTER_DRAIN = false;
    bf16_t* H; int ldh; int npn; int row_tile0;
    __device__ __forceinline__ void operator()(const f32x4 (&acc)[2][2][4][2], const Unit& u, int wr, int wc, int fr, int fq) const {
        const int pnl = u.pn % npn;
#pragma unroll
        for (int ai = 0; ai < 2; ++ai)
#pragma unroll
            for (int m = 0; m < 4; ++m) { const int rloc = ai * 128 + wr * 64 + m * 16 + fr;
                bf16_t* hrow = H + (size_t)((u.pm - row_tile0) * 256 + rloc) * ldh;
#pragma unroll
                for (int bj = 0; bj < 2; ++bj) { const f32x4 g = acc[ai][bj][m][0], uu = acc[ai][bj][m][1];
                    const int unit0 = (pnl * 256 + bj * 128 + wc * 32) / 2 + fq * 4;
                    f32x4 o;
#pragma unroll
                    for (int e = 0; e < 4; ++e) o[e] = g[e] * __builtin_amdgcn_rcpf(1.f + __expf(-g[e])) * uu[e];
                    u32x2 w; w.x = pk2(o[0], o[1]); w.y = pk2(o[2], o[3]);
                    *(u32x2*)(hrow + unit0) = w; } }
    }
};
struct EpiDownMoe {
    static constexpr bool PERM = false, AFTER_DRAIN = false;
    bf16_t* Ys; const float* sg;
    __device__ __forceinline__ void operator()(const f32x4 (&acc)[2][2][4][2], const Unit& u, int wr, int wc, int fr, int fq) const {
        const int pnl = u.pn & 3;
#pragma unroll
        for (int ai = 0; ai < 2; ++ai)
#pragma unroll
            for (int m = 0; m < 4; ++m) { const int slot = u.pm * 256 + ai * 128 + wr * 64 + m * 16 + fr; const float gt = sg[slot];
#pragma unroll
                for (int bj = 0; bj < 2; ++bj)
#pragma unroll
                    for (int n = 0; n < 2; ++n) { const f32x4 v = acc[ai][bj][m][n] * gt; const int c0 = pnl * 256 + bj * 128 + wc * 32 + n * 16 + fq * 4;
                        u32x2 w; w.x = pk2(v[0], v[1]); w.y = pk2(v[2], v[3]);
                        *(u32x2*)(Ys + (size_t)slot * DM + c0) = w; } }
    }
};
struct EpiGeluH {
    static constexpr bool PERM = false, AFTER_DRAIN = false;
    bf16_t* Hc;
    __device__ __forceinline__ void operator()(const f32x4 (&acc)[2][2][4][2], const Unit& u, int wr, int wc, int fr, int fq) const {
        EPI_LOOP_BEGIN
            f32x4 o;
#pragma unroll
            for (int e = 0; e < 4; ++e) { const float x = v[e], uu = 0.7978845608028654f * (x + 0.044715f * x * x * x); o[e] = x - x * __builtin_amdgcn_rcpf(1.f + __expf(2.f * uu)); }
            u32x2 w; w.x = pk2(o[0], o[1]); w.y = pk2(o[2], o[3]);
            *(u32x2*)(Hc + (size_t)(u.pm * 256 + rloc) * 256 + cloc) = w;
        EPI_LOOP_END
    }
};
struct EpiCmp {
    static constexpr bool PERM = false, AFTER_DRAIN = false;
    bf16_t* C;
    __device__ __forceinline__ void operator()(const f32x4 (&acc)[2][2][4][2], const Unit& u, int wr, int wc, int fr, int fq) const {
        EPI_LOOP_BEGIN
            if (cloc < 64) { u32x2 w; w.x = pk2(v[0], v[1]); w.y = pk2(v[2], v[3]); *(u32x2*)(C + (size_t)(u.pm * 256 + rloc) * 64 + cloc) = w; }
        EPI_LOOP_END
    }
};
struct ListOrder {
    static constexpr bool KSPLIT = false, GATHER_A = false;
    int n, G, c;
    __device__ __forceinline__ bool next(int i, Unit& u) const { const int L = i * G + c; if (L >= n) return false; u.pm = L; u.pn = L >> 4; return true; }
    __device__ __forceinline__ void a_ready(const Unit&) const {}
    __device__ __forceinline__ void done(const Unit&) const {}
};
constexpr int MOE_TE_LDS = 139264;
struct MoeOrder {
    static constexpr bool KSPLIT = false, GATHER_A = false;
    int t0, ntr, npn, G, c;
    __device__ __forceinline__ bool next(int i, Unit& u) const {
        extern __shared__ __attribute__((aligned(16))) float lds_dyn_[];
        int tm, pl;
        if (G == 256 && ntr == 128) {
            const int x = c & 7, j = c >> 3, ncb = npn >> 2, nrounds = 2 * ncb;
            if (i >= nrounds) return false;
            const int rb = i / ncb, cb = i - rb * ncb;
            tm = t0 + 16 * x + 8 * rb + (j >> 2); pl = 4 * cb + (j & 3);
        } else {
            const int L = i * G + c; if (L >= ntr * npn) return false;
            tm = t0 + L / npn; pl = L % npn;
        }
        const int e = ((const LAS int*)((LAS unsigned char*)lds_dyn_ + MOE_TE_LDS))[tm];
        if (e < 0) return false;
        u.pm = tm; u.pn = e * npn + pl; return true;
    }
    __device__ __forceinline__ void a_ready(const Unit&) const {}
    __device__ __forceinline__ void done(const Unit&) const {}
};
struct MoeOrderG {
    static constexpr bool KSPLIT = false, GATHER_A = true;
    int t0, ntr, npn, G, c, rb; const int* slot_tok;
    __device__ __forceinline__ int arow(int slot) const { const int t = slot_tok[slot]; return t < 0 ? NTOK : t; }
    __device__ __forceinline__ bool next(int i, Unit& u) const {
        extern __shared__ __attribute__((aligned(16))) float lds_dyn_[];
        int tm, pl;
        if (ntr == 128) { const int x = c & 7, j = c >> 3, ncb = npn >> 2; if (i >= ncb) return false; tm = t0 + 16 * x + 8 * rb + (j >> 2); pl = 4 * i + (j & 3); }
        else { if (i > 0 || c >= ntr * npn) return false; tm = t0 + c / npn; pl = c % npn; }
        const int e = ((const LAS int*)((LAS unsigned char*)lds_dyn_ + MOE_TE_LDS))[tm];
        if (e < 0) return false;
        u.pm = tm; u.pn = e * npn + pl; return true;
    }
    __device__ __forceinline__ void a_ready(const Unit&) const {}
    __device__ __forceinline__ void done(const Unit&) const {}
};
constexpr int MOE_TAIL_T0 = 256, MOE_TAIL_TILES = NTILE256 - 256, MOE_KSL = 7, MOE_KSL_K = F_EXPERT / MOE_KSL;
struct TailOrder {
    static constexpr bool KSPLIT = true, GATHER_A = false;
    int G, c;
    __device__ __forceinline__ bool next(int i, Unit& u) const {
        extern __shared__ __attribute__((aligned(16))) float lds_dyn_[];
        const int L = i * G + c; if (L >= MOE_TAIL_TILES * 4 * MOE_KSL) return false;
        const int sl = L / (MOE_TAIL_TILES * 4), rem = L - sl * (MOE_TAIL_TILES * 4), tm = MOE_TAIL_T0 + (rem >> 2), pl = rem & 3;
        const int e = ((const LAS int*)((LAS unsigned char*)lds_dyn_ + MOE_TE_LDS))[tm];
        if (e < 0) return false;
        u.pm = tm; u.pn = e * 4 + pl; u.ko = sl * MOE_KSL_K; return true;
    }
    __device__ __forceinline__ void a_ready(const Unit&) const {}
    __device__ __forceinline__ void done(const Unit&) const {}
};
struct EpiDownTail {
    static constexpr bool PERM = false, AFTER_DRAIN = false;
    bf16_t* Yp; const float* sg;
    __device__ __forceinline__ void operator()(const f32x4 (&acc)[2][2][4][2], const Unit& u, int wr, int wc, int fr, int fq) const {
        const int pnl = u.pn & 3, sl = u.ko / MOE_KSL_K;
#pragma unroll
        for (int ai = 0; ai < 2; ++ai)
#pragma unroll
            for (int m = 0; m < 4; ++m) { const int slot = u.pm * 256 + ai * 128 + wr * 64 + m * 16 + fr; const float gt = sg[slot];
                bf16_t* row = Yp + ((size_t)sl * (MOE_TAIL_TILES * 256) + (slot - MOE_TAIL_T0 * 256)) * DM;
#pragma unroll
                for (int bj = 0; bj < 2; ++bj)
#pragma unroll
                    for (int n = 0; n < 2; ++n) { const f32x4 v = acc[ai][bj][m][n] * gt; const int c0 = pnl * 256 + bj * 128 + wc * 32 + n * 16 + fq * 4;
                        u32x2 w; w.x = pk2(v[0], v[1]); w.y = pk2(v[2], v[3]);
                        *(u32x2*)(row + c0) = w; } }
    }
};

template <class F>
__device__ __forceinline__ void convert_T(bf16_t* dst, int Nphys, int K, int ld, F rowsrc, long gid, long gstride) {
    const long total = (long)Nphys * (K >> 3);
    for (long idx0 = gid; idx0 < total; idx0 += 4 * gstride) {
        float v[4][8]; int nn[4], kk[4]; bool ok[4];
#pragma unroll
        for (int u = 0; u < 4; ++u) {
            const long idx = idx0 + u * gstride; ok[u] = idx < total;
            const long idc = ok[u] ? idx : idx0;
            nn[u] = (int)(idc % Nphys); kk[u] = (int)(idc / Nphys);
            const float* s = rowsrc(nn[u]);
            if (s) {
#pragma unroll
                for (int i = 0; i < 8; ++i) v[u][i] = s[(size_t)(kk[u] * 8 + i) * ld];
            } else {
#pragma unroll
                for (int i = 0; i < 8; ++i) v[u][i] = 0.f;
            }
        }
#pragma unroll
        for (int u = 0; u < 4; ++u) if (ok[u]) {
            uint4 w; w.x = pk2(v[u][0], v[u][1]); w.y = pk2(v[u][2], v[u][3]); w.z = pk2(v[u][4], v[u][5]); w.w = pk2(v[u][6], v[u][7]);
            *(uint4*)(dst + (size_t)nn[u] * K + kk[u] * 8) = w;
        }
    }
}
__device__ __forceinline__ int rope_nat(int n) { const int w = n & 63; return (n & ~63) + (w >> 1) + 32 * (w & 1); }

__device__ __forceinline__ void sincos_d(double a, double& s, double& c) {
    const double n = rint(a * 0.6366197723675814);
    double y = fma(-n, 1.5707963267948966, a); y = fma(-n, 6.123233995736766e-17, y);
    const int q = ((int)n) & 3;
    const double y2 = y * y;
    const double sp = y * (1.0 + y2 * (-1.0 / 6 + y2 * (1.0 / 120 + y2 * (-1.0 / 5040 + y2 * (1.0 / 362880 + y2 * (-1.0 / 39916800 + y2 * (1.0 / 6227020800.0)))))));
    const double cp = 1.0 + y2 * (-0.5 + y2 * (1.0 / 24 + y2 * (-1.0 / 720 + y2 * (1.0 / 40320 + y2 * (-1.0 / 3628800 + y2 * (1.0 / 479001600.0 + y2 * (-1.0 / 87178291200.0)))))));
    s = (q == 0) ? sp : (q == 1) ? cp : (q == 2) ? -sp : -cp;
    c = (q == 0) ? cp : (q == 1) ? -sp : (q == 2) ? -cp : sp;
}

template <class F>
__device__ __forceinline__ void convert_tiles(bf16_t* dst, int Nphys, int K, int ld, F src8, float* ldsf, int tile0, int tile_step) {
    const int tid = tid_();
    bf16_t* lt = (bf16_t*)ldsf;
    const int nkt = K >> 6, ntiles = (Nphys >> 7) * nkt;
    const int kl = tid >> 4, c = tid & 15;
    const int rn = tid >> 2, rq = tid & 3;
    float4 a0, a1, b0, b1;
#define CT_LOAD(tl, A0, A1, B0, B1) do { const int nt_ = (tl) / nkt, kt_ = (tl) - nt_ * nkt; const float* s_ = src8(nt_ * 128, c) + (size_t)(kt_ * 64 + kl) * ld; \
        A0 = *(const float4*)s_; A1 = *(const float4*)(s_ + 4); B0 = *(const float4*)(s_ + (size_t)32 * ld); B1 = *(const float4*)(s_ + (size_t)32 * ld + 4); } while (0)
    if (tile0 < ntiles) CT_LOAD(tile0, a0, a1, b0, b1);
    for (int tile = tile0; tile < ntiles; tile += tile_step) {
        const int nt = tile / nkt, kt = tile - nt * nkt, n0 = nt * 128, k0 = kt * 64;
        float4 na0 = a0, na1 = a1, nb0 = b0, nb1 = b1;
        if (tile + tile_step < ntiles) CT_LOAD(tile + tile_step, na0, na1, nb0, nb1);
        __syncthreads();
        const float va[8] = {a0.x, a0.y, a0.z, a0.w, a1.x, a1.y, a1.z, a1.w}, vb[8] = {b0.x, b0.y, b0.z, b0.w, b1.x, b1.y, b1.z, b1.w};
#pragma unroll
        for (int e = 0; e < 8; ++e) { lt[(8 * c + e) * 72 + kl] = f2bf(va[e]); lt[(8 * c + e) * 72 + kl + 32] = f2bf(vb[e]); }
        __syncthreads();
        const uint4 w0 = *(const uint4*)(lt + rn * 72 + rq * 16), w1 = *(const uint4*)(lt + rn * 72 + rq * 16 + 8);
        bf16_t* d = dst + (size_t)(n0 + rn) * K + k0 + rq * 16;
        *(uint4*)d = w0; *(uint4*)(d + 8) = w1;
        a0 = na0; a1 = na1; b0 = nb0; b1 = nb1;
    }
#undef CT_LOAD
}

__device__ __forceinline__ int rot_tile0(int rot, int G) { const int r = (int)blockIdx.x - rot % G; return r < 0 ? r + G : r; }
__device__ __forceinline__ void ph_init(const Params& p, float* lds) {
    const int tid = tid_();
    const long gid = (long)blockIdx.x * NT + tid, gs = (long)gridDim.x * NT;
    int rot = 0;
    for (long i = gid; i < 4096 * 32; i += gs) {
        const int pos = (int)(i >> 5), f = (int)(i & 31);
        const float angf = (float)pos * c_inv[f];
        double s, c; sincos_d((double)angf, s, c);
        p.ropecs[2 * i] = (float)c; p.ropecs[2 * i + 1] = (float)s;
    }
    if (gid < DM / 2) ((unsigned*)(p.Xb + (size_t)NTOK * DM))[gid] = 0u;
    const float4* xs = (const float4*)p.in[IN_X]; u32x2* xb = (u32x2*)p.Xb;
    for (long i = gid; i < (long)NTOK * DM / 4; i += 4 * gs) {
        float4 v[4];
#pragma unroll
        for (int u = 0; u < 4; ++u) { const long j = i + u * gs; v[u] = xs[j < (long)NTOK * DM / 4 ? j : i]; }
#pragma unroll
        for (int u = 0; u < 4; ++u) { const long j = i + u * gs; if (j < (long)NTOK * DM / 4) { u32x2 w; w.x = pk2(v[u].x, v[u].y); w.y = pk2(v[u].z, v[u].w); xb[j] = w; } }
    }
#pragma unroll 1
    for (int li = 0; li < 2; ++li) {
        { const float* W = p.in[IN_EV_WIN] + (size_t)li * DM * P_EVEN;
          convert_T(p.WinE + (size_t)li * NP_EVEN * DM, NP_EVEN, DM, P_EVEN, [=](int n) -> const float* {
              if (n >= P_EVEN) return nullptr;
              const bool rope = (n < 1024) || (n >= 1536 && n < 2176) || (n >= 2304 && n < 2624);
              return W + (rope ? rope_nat(n) : n); }, gid, gs); }
        { const float* W = p.in[IN_OD_WIN] + (size_t)li * DM * P_ODD;
          convert_T(p.WinO + (size_t)li * NP_ODD * DM, NP_ODD, DM, P_ODD, [=](int n) -> const float* {
              if (n >= P_ODD) return nullptr;
              const bool rope = (n < 1024) || (n >= O_DQ && n < O_KC) || (n >= O_KS && n < O_VS) || (n >= O_KW && n < O_VW);
              return W + (rope ? rope_nat(n) : n); }, gid, gs); }
        { const float* W = p.in[IN_EV_WOUT] + (size_t)li * DM * DM;
          convert_tiles(p.WoutE + (size_t)li * DM * DM, DM, DM, DM, [=](int n0, int c) -> const float* { return W + n0 + 8 * c; }, lds, rot_tile0(rot, gridDim.x), gridDim.x); rot += 128; }
        { const float* W = p.in[IN_OD_WOUT] + (size_t)li * DM * DM;
          convert_tiles(p.WoutO + (size_t)li * DM * DM, DM, DM, DM, [=](int n0, int c) -> const float* { return W + n0 + 8 * c; }, lds, rot_tile0(rot, gridDim.x), gridDim.x); rot += 128; }
        { const float* Wg = p.in[IN_FFD_WG] + (size_t)li * DM * F_DENSE; const float* Wu = p.in[IN_FFD_WU] + (size_t)li * DM * F_DENSE; const long dWu = (const char*)Wu - (const char*)Wg;
          convert_tiles(p.WguD + (size_t)li * 2 * F_DENSE * DM, 2 * F_DENSE, DM, F_DENSE, [=](int n0, int c) -> const float* {
              const int unit0 = n0 / 2 + (c >> 2) * 16 + (c & 1) * 8; return (const float*)((const char*)Wg + ((c & 2) ? dWu : 0l)) + unit0; }, lds, rot_tile0(rot, gridDim.x), gridDim.x); rot += 704; }
        { const float* W = p.in[IN_FFD_WD] + (size_t)li * F_DENSE * DM;
          convert_tiles(p.WdD + (size_t)li * DM * F_DENSE, DM, F_DENSE, DM, [=](int n0, int c) -> const float* { return W + n0 + 8 * c; }, lds, rot_tile0(rot, gridDim.x), gridDim.x); rot += 352; }
#pragma unroll 1
        for (int which = 0; which < 2; ++which) {
            const float* W1 = p.in[IN_NSA_W1] + (size_t)(li * 2 + which) * 2048 * 256;
            convert_tiles(p.W1T + (size_t)(li * 2 + which) * 256 * 2048, 256, 2048, 256, [=](int n0, int c) -> const float* { return W1 + n0 + 8 * c; }, lds, rot_tile0(rot, gridDim.x), gridDim.x); rot += 64;
            const float* W2 = p.in[IN_NSA_W2] + (size_t)(li * 2 + which) * 256 * 64;
            convert_T(p.W2T + (size_t)(li * 2 + which) * 256 * 256, 256, 256, 64, [=](int n) -> const float* { if (n >= 64) return nullptr; return W2 + (which ? n : rope_nat(n)); }, gid, gs);
        }
    }
}
__device__ __forceinline__ void ph_convert_moe(const Params& p, int li, float* lds) {
    const float* Wg = p.in[IN_MOE_WG] + (size_t)li * N_EXP * DM * F_EXPERT; const float* Wu = p.in[IN_MOE_WU] + (size_t)li * N_EXP * DM * F_EXPERT; const long dWu = (const char*)Wu - (const char*)Wg;
    convert_tiles(p.WguM, N_EXP * 2 * F_EXPERT, DM, F_EXPERT, [=](int n0, int c) -> const float* {
        const int e = n0 / (2 * F_EXPERT), unit0 = (n0 % (2 * F_EXPERT)) / 2 + (c >> 2) * 16 + (c & 1) * 8;
        return (const float*)((const char*)Wg + ((c & 2) ? dWu : 0l)) + (size_t)e * DM * F_EXPERT + unit0; }, lds, blockIdx.x, gridDim.x);
    const float* Wd = p.in[IN_MOE_WD] + (size_t)li * N_EXP * F_EXPERT * DM;
    convert_tiles(p.WdM, N_EXP * DM, F_EXPERT, DM, [=](int n0, int c) -> const float* { return Wd + (size_t)(n0 >> 10) * F_EXPERT * DM + (n0 & 1023) + 8 * c; }, lds, blockIdx.x, gridDim.x);
}

struct CvJob {
    const float* Wg; long dWu; const float* Wd; bf16_t* dgu; bf16_t* ddn; bf16_t* lt0;
    int t, tend, step_, par; bool pend; bf16_t* pdst;
    float4 a0, a1, b0, b1;
    static constexpr int NT1 = (N_EXP * 2 * F_EXPERT / 128) * (DM / 64), NT2 = (N_EXP * DM / 128) * (F_EXPERT / 64);
    __device__ __forceinline__ void load(int tl, int tid) {
        const int kl = tid >> 4, c = tid & 15; const float* s_; size_t ld;
        if (tl < NT1) { const int nt = tl >> 4, kt = tl & 15, n0 = nt * 128; const int e = n0 / (2 * F_EXPERT), unit0 = (n0 % (2 * F_EXPERT)) / 2 + (c >> 2) * 16 + (c & 1) * 8;
            ld = F_EXPERT; s_ = (const float*)((const char*)Wg + ((c & 2) ? dWu : 0l)) + (size_t)e * DM * F_EXPERT + unit0 + (size_t)(kt * 64 + kl) * ld; }
        else { const int t2 = tl - NT1, nt = t2 / (F_EXPERT / 64), kt = t2 - nt * (F_EXPERT / 64), n0 = nt * 128;
            ld = DM; s_ = Wd + (size_t)(n0 >> 10) * F_EXPERT * DM + (n0 & 1023) + 8 * c + (size_t)(kt * 64 + kl) * ld; }
        a0 = *(const float4*)s_; a1 = *(const float4*)(s_ + 4); b0 = *(const float4*)(s_ + 32 * ld); b1 = *(const float4*)(s_ + 32 * ld + 4);
    }
    __device__ __forceinline__ void init(const Params& p, int li, float* ldsf, int tid) {
        Wg = p.in[IN_MOE_WG] + (size_t)li * N_EXP * DM * F_EXPERT; const float* Wu = p.in[IN_MOE_WU] + (size_t)li * N_EXP * DM * F_EXPERT; dWu = (const char*)Wu - (const char*)Wg;
        Wd = p.in[IN_MOE_WD] + (size_t)li * N_EXP * F_EXPERT * DM; dgu = p.WguM; ddn = p.WdM; lt0 = (bf16_t*)ldsf;
        t = blockIdx.x; step_ = gridDim.x; tend = NT1 + NT2; par = 0; pend = false; pdst = dgu;
        if (t < tend) load(t, tid);
    }
    __device__ __forceinline__ void step(int tid) {
        const int kl = tid >> 4, c = tid & 15, rn = tid >> 2, rq = tid & 3;
        if (pend) { const bf16_t* lt = lt0 + (par ^ 1) * (128 * 72);
            const uint4 w0 = *(const uint4*)(lt + rn * 72 + rq * 16), w1 = *(const uint4*)(lt + rn * 72 + rq * 16 + 8);
            *(uint4*)pdst = w0; *(uint4*)(pdst + 8) = w1; }
        if (t < tend) {
            bf16_t* lt = lt0 + par * (128 * 72);
            const float va[8] = {a0.x, a0.y, a0.z, a0.w, a1.x, a1.y, a1.z, a1.w}, vb[8] = {b0.x, b0.y, b0.z, b0.w, b1.x, b1.y, b1.z, b1.w};
#pragma unroll
            for (int e = 0; e < 8; ++e) { lt[(8 * c + e) * 72 + kl] = f2bf(va[e]); lt[(8 * c + e) * 72 + kl + 32] = f2bf(vb[e]); }
            if (t < NT1) { const int nt = t >> 4, kt = t & 15; pdst = dgu + (size_t)(nt * 128 + rn) * DM + kt * 64 + rq * 16; }
            else { const int t2 = t - NT1, nt = t2 / (F_EXPERT / 64), kt = t2 - nt * (F_EXPERT / 64); pdst = ddn + (size_t)(nt * 128 + rn) * F_EXPERT + kt * 64 + rq * 16; }
            pend = true; t += step_;
            if (t < tend) load(t, tid);
        } else pend = false;
        par ^= 1;
    }
    __device__ __forceinline__ void finish(int tid) { while (pend || t < tend) { __syncthreads(); step(tid); } }
};

__device__ __forceinline__ void ph_kmean(const Params& p, float* lds) {
    const int tid = tid_(), ch = tid & 7, kg = tid >> 3;
    for (int item = blockIdx.x; item < 8 * 16 * 8; item += gridDim.x) {
        const int h = item & 7, blk = (item >> 3) & 15, b = item >> 7;
        float s[8] = {0.f, 0.f, 0.f, 0.f, 0.f, 0.f, 0.f, 0.f};
        uint4 kv[4];
#pragma unroll
        for (int j = 0; j < 4; ++j) kv[j] = *(const uint4*)(p.Pb + (size_t)(b * SEQ + blk * 256 + kg * 4 + j) * LDPB + O_CK + h * 64 + ch * 8);
#pragma unroll
        for (int j = 0; j < 4; ++j) {
            s[0] += __builtin_bit_cast(float, kv[j].x << 16); s[1] += __builtin_bit_cast(float, kv[j].x & 0xffff0000u);
            s[2] += __builtin_bit_cast(float, kv[j].y << 16); s[3] += __builtin_bit_cast(float, kv[j].y & 0xffff0000u);
            s[4] += __builtin_bit_cast(float, kv[j].z << 16); s[5] += __builtin_bit_cast(float, kv[j].z & 0xffff0000u);
            s[6] += __builtin_bit_cast(float, kv[j].w << 16); s[7] += __builtin_bit_cast(float, kv[j].w & 0xffff0000u);
        }
#pragma unroll
        for (int e = 0; e < 8; ++e) { s[e] += __shfl_xor(s[e], 8); s[e] += __shfl_xor(s[e], 16); s[e] += __shfl_xor(s[e], 32); }
        __syncthreads();
        if ((tid & 63) < 8) {
#pragma unroll
            for (int e = 0; e < 8; ++e) lds[(tid >> 6) * 64 + ch * 8 + e] = s[e];
        }
        __syncthreads();
        if (tid < 64) { float a = 0.f;
#pragma unroll
            for (int q = 0; q < 8; ++q) a += lds[q * 64 + tid];
            p.kmean[(size_t)item * 64 + tid] = a * (1.f / 256.f); }
    }
}

__device__ __forceinline__ void ph_cmp_build(const Params& p, int li) {
    const int tid = tid_();
    const long gs = (long)gridDim.x * NT;
    for (long idx0 = (long)blockIdx.x * NT + tid; idx0 < 2l * 4096 * 256; idx0 += 4 * gs) {
      pg8::u32x4 kvv[4];
#pragma unroll
      for (int u = 0; u < 4; ++u) {
        const long idx = (idx0 + u * gs < 2l * 4096 * 256) ? idx0 + u * gs : idx0;
        const int ch = (int)(idx & 255), m = (int)((idx >> 8) & 4095), which = (int)(idx >> 20);
        const int i = (m & 255) < 255 ? (m & 255) : 0, bg = m >> 8, b = bg >> 1, g = bg & 1, t = ch >> 3, d0 = (ch & 7) * 8;
        kvv[u] = *(const pg8::u32x4*)(p.Pb + (size_t)(b * SEQ + 16 * i + t) * LDPB + (which ? O_VC : O_KC) + g * 64 + d0);
      }
#pragma unroll
      for (int u = 0; u < 4; ++u) {
        const long idx = idx0 + u * gs;
        if (idx >= 2l * 4096 * 256) continue;
        const int ch = (int)(idx & 255), m = (int)((idx >> 8) & 4095), which = (int)(idx >> 20);
        const int i = m & 255, t = ch >> 3, d0 = (ch & 7) * 8;
        uint4 w = make_uint4(0u, 0u, 0u, 0u);
        if (i < 255) {
            uint4 kv; kv.x = kvv[u].x; kv.y = kvv[u].y; kv.z = kvv[u].z; kv.w = kvv[u].w;
            const float* pe = p.in[IN_NSA_PE] + (size_t)(li * 2 + which) * 2048 + t * 64 + d0;
            const float4 e0 = *(const float4*)pe, e1 = *(const float4*)(pe + 4);
            w.x = pk2(__builtin_bit_cast(float, kv.x << 16) + e0.x, __builtin_bit_cast(float, kv.x & 0xffff0000u) + e0.y);
            w.y = pk2(__builtin_bit_cast(float, kv.y << 16) + e0.z, __builtin_bit_cast(float, kv.y & 0xffff0000u) + e0.w);
            w.z = pk2(__builtin_bit_cast(float, kv.z << 16) + e1.x, __builtin_bit_cast(float, kv.z & 0xffff0000u) + e1.y);
            w.w = pk2(__builtin_bit_cast(float, kv.w << 16) + e1.z, __builtin_bit_cast(float, kv.w & 0xffff0000u) + e1.w);
        }
        *(uint4*)(p.Ac + ((size_t)(which * 4096 + m) * 2048 + ch * 8)) = w;
      }
    }
}

typedef unsigned u32x8v __attribute__((ext_vector_type(8)));
typedef float f32x16v __attribute__((ext_vector_type(16)));
__device__ __forceinline__ u32x8v ld_row8(const bf16_t* row, int lane) {
    const u32x2* r = (const u32x2*)row; const u32x2 a = r[lane], b = r[64 + lane], c = r[128 + lane], d = r[192 + lane];
    return (u32x8v){a.x, a.y, b.x, b.y, c.x, c.y, d.x, d.y};
}
__device__ __forceinline__ f32x16v ld_row16f(const float* row, int lane) {
    const float4* r = (const float4*)row; const float4 a = r[lane], b = r[64 + lane], c = r[128 + lane], d = r[192 + lane];
    return (f32x16v){a.x, a.y, a.z, a.w, b.x, b.y, b.z, b.w, c.x, c.y, c.z, c.w, d.x, d.y, d.z, d.w};
}
__device__ __forceinline__ float bf_el(const u32x8v v, int i) { const unsigned u = v[i >> 1]; return __builtin_bit_cast(float, (i & 1) ? (u & 0xffff0000u) : (u << 16)); }
__device__ __forceinline__ u32x8v ld_slot8(const Params& p, int slot_v, int lane) {
    const int slot = __builtin_amdgcn_readfirstlane(slot_v);
    if (slot < MOE_TAIL_T0 * 256) return ld_row8(p.Ys + (size_t)slot * DM, lane);
    u32x8v part[MOE_KSL];
#pragma unroll
    for (int sl = 0; sl < MOE_KSL; ++sl) part[sl] = ld_row8(p.Yp + ((size_t)sl * (MOE_TAIL_TILES * 256) + (slot - MOE_TAIL_T0 * 256)) * DM, lane);
    u32x8v o;
#pragma unroll
    for (int j = 0; j < 8; ++j) {
        float lo = 0.f, hi = 0.f;
#pragma unroll
        for (int sl = 0; sl < MOE_KSL; ++sl) { lo += __builtin_bit_cast(float, part[sl][j] << 16); hi += __builtin_bit_cast(float, part[sl][j] & 0xffff0000u); }
        o[j] = pk2(lo, hi);
    }
    return o;
}
template <int MODE, int XSRC>
__device__ __forceinline__ void ph_ln(const Params& p, const float* gam, const float* bet, const float* Xin, float* Xout, bf16_t* Xbout, const bool wf32) {
    const int lane = tid_() & 63, wid = tid_() >> 6;
    const int stride = gridDim.x * 8;
    int t = blockIdx.x * 8 + wid;
    if (t < NTOK) {
        f32x16v xf, xfn; u32x8v xb8, xbn, ya, yan, yb, ybn;
        int n0 = 0, n1 = 0;
#define LN_LOAD(tt, S0, S1, XF, XB, YA, YB) do { \
        if (XSRC == 0) XF = ld_row16f(Xin + (size_t)(tt) * DM, lane); else XB = ld_row8(Xbout + (size_t)(tt) * DM, lane); \
        if (MODE == 0) YA = ld_row8((const bf16_t*)p.Y + (size_t)(tt) * DM, lane); \
        else { YA = ld_slot8(p, S0, lane); YB = ld_slot8(p, S1, lane); } } while (0)
        {
            int s0 = 0, s1 = 0;
            if (MODE == 1) { s0 = p.tok_slot[2 * t]; s1 = p.tok_slot[2 * t + 1]; const int tn = (t + stride < NTOK) ? t + stride : t; n0 = p.tok_slot[2 * tn]; n1 = p.tok_slot[2 * tn + 1]; }
            LN_LOAD(t, s0, s1, xf, xb8, ya, yb);
        }
        for (; t < NTOK; t += stride) {
            const int tn = (t + stride < NTOK) ? t + stride : t;
            LN_LOAD(tn, n0, n1, xfn, xbn, yan, ybn);
            int m0 = 0, m1 = 0;
            if (MODE == 1) { const int t2 = (tn + stride < NTOK) ? tn + stride : tn; m0 = p.tok_slot[2 * t2]; m1 = p.tok_slot[2 * t2 + 1]; }
            f32x16v v; float s = 0.f;
#pragma unroll
            for (int c = 0; c < 4; ++c) {
#pragma unroll
                for (int e = 0; e < 4; ++e) {
                    const int i = c * 4 + e;
                    const float x = (XSRC == 0) ? xf[i] : bf_el(xb8, i);
                    const float y = (MODE == 0) ? bf_el(ya, i) : bf_el(ya, i) + bf_el(yb, i);
                    v[i] = ALPHA * x + y;
                }
                s += (v[c * 4] + v[c * 4 + 1]) + (v[c * 4 + 2] + v[c * 4 + 3]);
            }
            const float mu = wave_sum(s) * (1.f / 1024.f);
            float q = 0.f;
#pragma unroll
            for (int c = 0; c < 4; ++c) { const float a = v[c * 4] - mu, b2 = v[c * 4 + 1] - mu, c2 = v[c * 4 + 2] - mu, d2 = v[c * 4 + 3] - mu; q += (a * a + b2 * b2) + (c2 * c2 + d2 * d2); }
            const float var = wave_sum(q) * (1.f / 1024.f);
            const float rs = 1.0f / sqrtf(var + LN_EPS);
            u32x2* xb = (u32x2*)(Xbout + (size_t)t * DM); float4* xo = (float4*)(Xout + (size_t)t * DM);
#pragma unroll
            for (int c = 0; c < 4; ++c) {
                const float4 gg = ((const float4*)gam)[c * 64 + lane], bb = ((const float4*)bet)[c * 64 + lane];
                float4 o; o.x = (v[c * 4] - mu) * rs * gg.x + bb.x; o.y = (v[c * 4 + 1] - mu) * rs * gg.y + bb.y; o.z = (v[c * 4 + 2] - mu) * rs * gg.z + bb.z; o.w = (v[c * 4 + 3] - mu) * rs * gg.w + bb.w;
                if (wf32) xo[c * 64 + lane] = o;
                u32x2 w; w.x = pk2(o.x, o.y); w.y = pk2(o.z, o.w); xb[c * 64 + lane] = w;
            }
            xf = xfn; xb8 = xbn; ya = yan; yb = ybn; n0 = m0; n1 = m1;
        }
#undef LN_LOAD
    }
}

__device__ __forceinline__ void ph_ln_router(const Params& p, const float* gam, const float* bet, int li, float* lds) {
    const int tid = tid_(), lane = tid & 63, wid = tid >> 6;
    int* lcnt = (int*)lds;
    const float* wr = p.in[IN_MOE_WR] + (size_t)li * 1024 * 8;
    const float* br = p.in[IN_MOE_BR] + li * 8;
    for (int chunk = blockIdx.x; chunk < 256; chunk += gridDim.x) {
        __syncthreads();
        if (tid < 8) lcnt[tid] = 0;
        __syncthreads();
        u32x8v xb8 = ld_row8(p.Xb + (size_t)(chunk * 128 + wid * 16) * DM, lane), ya = ld_row8((const bf16_t*)p.Y + (size_t)(chunk * 128 + wid * 16) * DM, lane);
        for (int q = 0; q < 16; ++q) {
            const int t = chunk * 128 + wid * 16 + q;
            const int tn = (q < 15) ? t + 1 : t;
            const u32x8v xbn = ld_row8(p.Xb + (size_t)tn * DM, lane), yan = ld_row8((const bf16_t*)p.Y + (size_t)tn * DM, lane);
            float4 v[4]; float s = 0.f;
#pragma unroll
            for (int c = 0; c < 4; ++c) {
                v[c].x = ALPHA * bf_el(xb8, c * 4) + bf_el(ya, c * 4); v[c].y = ALPHA * bf_el(xb8, c * 4 + 1) + bf_el(ya, c * 4 + 1);
                v[c].z = ALPHA * bf_el(xb8, c * 4 + 2) + bf_el(ya, c * 4 + 2); v[c].w = ALPHA * bf_el(xb8, c * 4 + 3) + bf_el(ya, c * 4 + 3);
                s += (v[c].x + v[c].y) + (v[c].z + v[c].w);
            }
            xb8 = xbn; ya = yan;
            const float mu = wave_sum(s) * (1.f / 1024.f);
            float qq = 0.f;
#pragma unroll
            for (int c = 0; c < 4; ++c) { const float a = v[c].x - mu, b2 = v[c].y - mu, c2 = v[c].z - mu, d2 = v[c].w - mu; qq += (a * a + b2 * b2) + (c2 * c2 + d2 * d2); }
            const float var = wave_sum(qq) * (1.f / 1024.f);
            const float rs = 1.0f / sqrtf(var + LN_EPS);
            u32x2* xb = (u32x2*)(p.Xb + (size_t)t * DM);
            float a[8] = {0.f, 0.f, 0.f, 0.f, 0.f, 0.f, 0.f, 0.f};
#pragma unroll
            for (int c = 0; c < 4; ++c) {
                const float4 gg = ((const float4*)gam)[c * 64 + lane], bb = ((const float4*)bet)[c * 64 + lane];
                float4 o; o.x = (v[c].x - mu) * rs * gg.x + bb.x; o.y = (v[c].y - mu) * rs * gg.y + bb.y; o.z = (v[c].z - mu) * rs * gg.z + bb.z; o.w = (v[c].w - mu) * rs * gg.w + bb.w;
                u32x2 w; w.x = pk2(o.x, o.y); w.y = pk2(o.z, o.w); xb[c * 64 + lane] = w;
                const float ov[4] = {o.x, o.y, o.z, o.w};
                const float* wk = wr + (size_t)((c * 64 + lane) * 4) * 8;
#pragma unroll
                for (int j = 0; j < 4; ++j) { const float4 w0 = *(const float4*)(wk + j * 8), w1 = *(const float4*)(wk + j * 8 + 4);
                    a[0] += ov[j] * w0.x; a[1] += ov[j] * w0.y; a[2] += ov[j] * w0.z; a[3] += ov[j] * w0.w; a[4] += ov[j] * w1.x; a[5] += ov[j] * w1.y; a[6] += ov[j] * w1.z; a[7] += ov[j] * w1.w; }
            }
            {
                float b4[4], b2[2], b1;
                const bool up1 = lane & 1, up2 = lane & 2, up4 = lane & 4;
#pragma unroll
                for (int e = 0; e < 4; ++e) { const float keep = up1 ? a[e + 4] : a[e], send = up1 ? a[e] : a[e + 4]; b4[e] = keep + __shfl_xor(send, 1); }
#pragma unroll
                for (int e = 0; e < 2; ++e) { const float keep = up2 ? b4[e + 2] : b4[e], send = up2 ? b4[e] : b4[e + 2]; b2[e] = keep + __shfl_xor(send, 2); }
                { const float keep = up4 ? b2[1] : b2[0], send = up4 ? b2[0] : b2[1]; b1 = keep + __shfl_xor(send, 4); }
                b1 += __shfl_xor(b1, 8); b1 += __shfl_xor(b1, 16); b1 += __shfl_xor(b1, 32);
#pragma unroll
                for (int e = 0; e < 8; ++e) { const int src = ((e >> 2) & 1) | (e & 2) | ((e & 1) << 2); a[e] = __shfl(b1, src) + br[e]; }
            }
            int e1 = 0; float l1 = a[0];
#pragma unroll
            for (int e = 1; e < 8; ++e) if (a[e] > l1) { l1 = a[e]; e1 = e; }
            int e2 = -1; float l2 = -INFINITY;
#pragma unroll
            for (int e = 0; e < 8; ++e) if (e != e1 && a[e] > l2) { l2 = a[e]; e2 = e; }
            const float ex = expf(l2 - l1);
            if (lane == 0) {
                p.tok_e[2 * t] = e1; p.tok_e[2 * t + 1] = e2;
                p.tok_g[2 * t] = 1.f / (1.f + ex); p.tok_g[2 * t + 1] = ex / (1.f + ex);
                atomicAdd(&lcnt[e1], 1); atomicAdd(&lcnt[e2], 1);
            }
        }
        __syncthreads();
        if (tid < 8) p.chunk_cnt[chunk * 8 + tid] = lcnt[tid];
    }
}
__device__ __forceinline__ void ph_slots(const Params& p, float* lds) {
    const int tid = tid_();
    int* lbase = (int*)lds;
    int* lpad = lbase + 8;
    int* ltot = lpad + 16;
    int* lent = ltot + 8;
    int* lslot = lent + 256;
    for (int chunk = blockIdx.x; chunk < 256; chunk += gridDim.x) {
        __syncthreads();
        {
            int* lcc = lslot + 256;
            const int4 v4 = ((const int4*)p.chunk_cnt)[tid]; ((int4*)lcc)[tid] = v4;
            if (tid < 256) lent[tid] = p.tok_e[chunk * 256 + tid];
            __syncthreads();
            {
                const int e = tid >> 6, ln = tid & 63; int tot = 0, before = 0;
#pragma unroll
                for (int q = 0; q < 4; ++q) { const int cc = ln * 4 + q, v = lcc[cc * 8 + e]; tot += v; before += (cc < chunk) ? v : 0; }
#pragma unroll
                for (int o = 32; o >= 1; o >>= 1) { tot += __shfl_xor(tot, o); before += __shfl_xor(before, o); }
                if (ln == 0) { lbase[e] = before; ltot[e] = tot; }
            }
        }
        __syncthreads();
        if (tid == 0) { int acc = 0; for (int e = 0; e < 8; ++e) { lpad[e] = acc; acc += (ltot[e] + 255) / 256 * 256; } lpad[8] = acc; }
        __syncthreads();
        {
            int* lwc = lslot + 256 + 2048;
            const int wv = tid >> 6, ln = tid & 63;
            int my_e = -1, my_rank = 0;
            if (tid < 256) {
                my_e = lent[tid];
#pragma unroll
                for (int e = 0; e < 8; ++e) { const unsigned long long mb = __ballot(my_e == e); if (my_e == e) my_rank = lane_rank(mb); if (ln == 0) lwc[wv * 8 + e] = __popcll(mb); }
            }
            __syncthreads();
            if (tid < 256) { int r = lpad[my_e] + lbase[my_e] + my_rank; for (int q = 0; q < wv; ++q) r += lwc[q * 8 + my_e]; lslot[tid] = r; }
        }
        __syncthreads();
        if (tid < 256) {
            const int slot = lslot[tid], tk = chunk * 128 + (tid >> 1);
            p.slot_tok[slot] = tk; p.slot_gate[slot] = p.tok_g[chunk * 256 + tid]; p.tok_slot[chunk * 256 + tid] = slot;
        }
        if (gridDim.x != 256)
        for (int idx0 = tid; idx0 < 256 * 128; idx0 += 8 * NT) {
            pg8::u32x4 v[8];
#pragma unroll
            for (int u = 0; u < 8; ++u) { const int idx = idx0 + u * NT, e = idx >> 7, piece = idx & 127; v[u] = ((const pg8::u32x4*)p.Xb)[(size_t)(chunk * 128 + (e >> 1)) * 128 + piece]; }
#pragma unroll
            for (int u = 0; u < 8; ++u) { const int idx = idx0 + u * NT, e = idx >> 7, piece = idx & 127; ((pg8::u32x4*)p.Xs)[(size_t)lslot[e] * 128 + piece] = v[u]; }
        }
        if (chunk < 8) {
            const int s0 = lpad[chunk] + ltot[chunk], s1 = lpad[chunk + 1];
            if (gridDim.x != 256) for (int idx = tid; idx < (s1 - s0) * 128; idx += NT) ((uint4*)p.Xs)[(size_t)(s0 + (idx >> 7)) * 128 + (idx & 127)] = make_uint4(0u, 0u, 0u, 0u);
            for (int s = s0 + tid; s < s1; s += NT) { p.slot_tok[s] = -1; p.slot_gate[s] = 0.f; }
        }
        if (chunk == 8 && tid < NTILE256) {
            const int s0 = tid * 256; int e = -1;
            for (int q = 0; q < 8; ++q) if (s0 >= lpad[q] && s0 < lpad[q + 1]) e = q;
            p.tile_e[tid] = e;
        }
    }
}

typedef short bf16x8 __attribute__((ext_vector_type(8)));
typedef short s16x4 __attribute__((ext_vector_type(4)));
typedef __attribute__((address_space(3))) const unsigned char* lds_cptr;
__device__ __forceinline__ s16x4 vtr(lds_cptr p) { return __builtin_bit_cast(s16x4, __builtin_amdgcn_ds_read_tr16_b64_v4i16((__attribute__((address_space(3))) s16x4*)p)); }
__device__ __forceinline__ bf16x8 cat8(s16x4 lo, s16x4 hi) { bf16x8 r; r[0] = lo[0]; r[1] = lo[1]; r[2] = lo[2]; r[3] = lo[3]; r[4] = hi[0]; r[5] = hi[1]; r[6] = hi[2]; r[7] = hi[3]; return r; }
constexpr int AT_KP = 160;
template <int VD> struct AtL { static constexpr int VP = VD * 2 + 32, KB = 64 * AT_KP, VB = 64 * VP, BUF = KB + VB; };
constexpr float AT_SCALE2 = 0.125f * 1.4426950408889634f;

template <int VD> struct AtState {
    f32x4 o[2][VD / 16]; float m[2], l[2];
    __device__ __forceinline__ void init() {
#pragma unroll
        for (int g = 0; g < 2; ++g) { m[g] = -1e30f; l[g] = 0.f;
#pragma unroll
            for (int n = 0; n < VD / 16; ++n) o[g][n] = Z4_; }
    }
};
typedef float f32x2 __attribute__((ext_vector_type(2)));
__device__ __forceinline__ float max3f_(float a, float b, float c) { float r; asm("v_max3_f32 %0, %1, %2, %3" : "=v"(r) : "v"(a), "v"(b), "v"(c)); return r; }
__device__ __forceinline__ float max2f_(float a, float b) { float r; asm("v_max_f32_e32 %0, %1, %2" : "=v"(r) : "v"(a), "v"(b)); return r; }
__device__ __forceinline__ float xmax16(float v) { const unsigned u = __builtin_bit_cast(unsigned, v); const auto r = __builtin_amdgcn_permlane16_swap(u, u, false, false);
    return max2f_(__builtin_bit_cast(float, r[0]), __builtin_bit_cast(float, r[1])); }
__device__ __forceinline__ float xmax32(float v) { const unsigned u = __builtin_bit_cast(unsigned, v); const auto r = __builtin_amdgcn_permlane32_swap(u, u, false, false);
    return max2f_(__builtin_bit_cast(float, r[0]), __builtin_bit_cast(float, r[1])); }
template <int VD, int MODE, class RowOk, class Allow>
__device__ __forceinline__ void at_tile(AtState<VD>& st, lds_cptr Kb, lds_cptr Vb, const bf16x8 (&q)[2][2], int fr, int fq, RowOk rowok, Allow allow) {
    f32x4 s[2][4];
    bf16x8 kn0 = *(const __attribute__((address_space(3))) bf16x8*)(Kb + fr * AT_KP + fq * 16);
    bf16x8 kn1 = *(const __attribute__((address_space(3))) bf16x8*)(Kb + fr * AT_KP + 64 + fq * 16);
#pragma unroll
    for (int kk = 0; kk < 4; ++kk) {
        const bf16x8 kf0 = kn0, kf1 = kn1;
        if (kk < 3) { kn0 = *(const __attribute__((address_space(3))) bf16x8*)(Kb + (16 * (kk + 1) + fr) * AT_KP + fq * 16);
                      kn1 = *(const __attribute__((address_space(3))) bf16x8*)(Kb + (16 * (kk + 1) + fr) * AT_KP + 64 + fq * 16); }
#pragma unroll
        for (int g = 0; g < 2; ++g) s[g][kk] = __builtin_amdgcn_mfma_f32_16x16x32_bf16(kf0, q[g][0], (f32x4){0.f, 0.f, 0.f, 0.f}, 0, 0, 0);
#pragma unroll
        for (int g = 0; g < 2; ++g) s[g][kk] = __builtin_amdgcn_mfma_f32_16x16x32_bf16(kf1, q[g][1], s[g][kk], 0, 0, 0);
    }
    const lds_cptr vp0 = Vb + (4 * fq + (fr >> 2)) * AtL<VD>::VP + (4 * (fr & 3)) * 2;
    bf16x8 vn = cat8(vtr(vp0), vtr(vp0 + 16 * AtL<VD>::VP));
    bf16x8 pf[2][2];
#pragma unroll
    for (int g = 0; g < 2; ++g) {
        float mloc = fmaxf(fmaxf(s[g][0][0], s[g][0][1]), s[g][0][2]);
        mloc = fmaxf(fmaxf(mloc, s[g][0][3]), s[g][1][0]);
        mloc = fmaxf(fmaxf(mloc, s[g][1][1]), s[g][1][2]);
        mloc = fmaxf(fmaxf(mloc, s[g][1][3]), s[g][2][0]);
        mloc = fmaxf(fmaxf(mloc, s[g][2][1]), s[g][2][2]);
        mloc = fmaxf(fmaxf(mloc, s[g][2][3]), s[g][3][0]);
        mloc = fmaxf(fmaxf(mloc, s[g][3][1]), s[g][3][2]);
        mloc = fmaxf(mloc, s[g][3][3]);
        mloc = xmax16(mloc); mloc = xmax32(mloc);
        float mn = max2f_(st.m[g], mloc * AT_SCALE2);
        float cadd;
        if (MODE & 1) { const bool ro = rowok(g); mn = ro ? mn : st.m[g]; cadd = ro ? -mn : -INFINITY; } else cadd = -mn;
        const float alpha = __builtin_amdgcn_exp2f(st.m[g] - mn);
        st.m[g] = mn;
        float ls = 0.f;
#pragma unroll
        for (int kk = 0; kk < 4; ++kk)
#pragma unroll
            for (int r = 0; r < 4; ++r) {
                float pv = __builtin_amdgcn_exp2f(__builtin_fmaf(s[g][kk][r], AT_SCALE2, cadd));
                if (MODE & 2) pv = allow(g, kk, r) ? pv : 0.f;
                if (MODE & 4) pv = __builtin_bit_cast(float, __builtin_bit_cast(int, pv) & allow(g, kk, r));
                s[g][kk][r] = pv; ls += pv;
            }
        st.l[g] = st.l[g] * alpha + ls;
#pragma unroll
        for (int n = 0; n < VD / 16; ++n) st.o[g][n] = st.o[g][n] * alpha;
#pragma unroll
        for (int sp = 0; sp < 2; ++sp) {
            const unsigned w0 = pk2(s[g][2 * sp][0], s[g][2 * sp][1]), w1 = pk2(s[g][2 * sp][2], s[g][2 * sp][3]);
            const unsigned w2 = pk2(s[g][2 * sp + 1][0], s[g][2 * sp + 1][1]), w3 = pk2(s[g][2 * sp + 1][2], s[g][2 * sp + 1][3]);
            pf[g][sp] = __builtin_bit_cast(bf16x8, (pg8::u32x4){w0, w1, w2, w3});
        }
    }
    {
#pragma unroll
        for (int st_ = 0; st_ < VD / 8; ++st_) {
            const int n = st_ >> 1, sp = st_ & 1;
            const bf16x8 vf = vn;
            if (st_ + 1 < VD / 8) { const int n2 = (st_ + 1) >> 1, sp2 = (st_ + 1) & 1;
                const lds_cptr vp = Vb + (32 * sp2 + 4 * fq + (fr >> 2)) * AtL<VD>::VP + (n2 * 16 + 4 * (fr & 3)) * 2;
                vn = cat8(vtr(vp), vtr(vp + 16 * AtL<VD>::VP)); }
#pragma unroll
            for (int g = 0; g < 2; ++g) st.o[g][n] = __builtin_amdgcn_mfma_f32_16x16x32_bf16(vf, pf[g][sp], st.o[g][n], 0, 0, 0);
        }
    }
}
struct AtNoRow { __device__ __forceinline__ bool operator()(int) const { return true; } };
struct AtNoEl { __device__ __forceinline__ bool operator()(int, int, int) const { return true; } };
template <int VD> struct AtStage {
    pg8::u32x4 k, v[VD / 64];
    __device__ __forceinline__ void load(const bf16_t* kbase, const bf16_t* vbase, int key0, int tid) {
        const int row = tid >> 3, ch = tid & 7;
        k = *(const pg8::u32x4*)(kbase + (size_t)(key0 + row) * LDPB + ch * 8);
#pragma unroll
        for (int i = 0; i < VD / 64; ++i) v[i] = *(const pg8::u32x4*)(vbase + (size_t)(key0 + row) * LDPB + (ch + 8 * i) * 8);
    }
    __device__ __forceinline__ void store(LAS unsigned char* buf, int tid) const {
        const int row = tid >> 3, ch = tid & 7;
        *(LAS pg8::u32x4*)(buf + row * AT_KP + ch * 16) = k;
#pragma unroll
        for (int i = 0; i < VD / 64; ++i) *(LAS pg8::u32x4*)(buf + AtL<VD>::KB + row * AtL<VD>::VP + (ch + 8 * i) * 16) = v[i];
    }
};
template <int VD>
__device__ __forceinline__ void at_finish(AtState<VD>& st) {
#pragma unroll
    for (int g = 0; g < 2; ++g) { float l = st.l[g]; l += __shfl_xor(l, 16); l += __shfl_xor(l, 32); st.l[g] = l; }
}


template <int VD> struct AtStageP {
    pg8::u32x4 k, v[VD / 64];
    __device__ __forceinline__ void load(const bf16_t* kbase, const bf16_t* vbase, int pitch, int key0, int tid) {
        const int row = tid >> 3, ch = tid & 7;
        k = *(const pg8::u32x4*)(kbase + (size_t)(key0 + row) * pitch + ch * 8);
#pragma unroll
        for (int i = 0; i < VD / 64; ++i) v[i] = *(const pg8::u32x4*)(vbase + (size_t)(key0 + row) * pitch + (ch + 8 * i) * 8);
    }
    __device__ __forceinline__ void store(LAS unsigned char* buf, int tid) const {
        const int row = tid >> 3, ch = tid & 7;
        *(LAS pg8::u32x4*)(buf + row * AT_KP + ch * 16) = k;
#pragma unroll
        for (int i = 0; i < VD / 64; ++i) *(LAS pg8::u32x4*)(buf + AtL<VD>::KB + row * AtL<VD>::VP + (ch + 8 * i) * 16) = v[i];
    }
};
template <int VD, class Fn>
__device__ __forceinline__ void at_run(LAS unsigned char* lds, const bf16_t* kbase, const bf16_t* vbase, int pitch, int tile_lo, int tile_hi, int tid, Fn fn) {
    if (tile_lo >= tile_hi) return;
    AtStageP<VD> sg; sg.load(kbase, vbase, pitch, tile_lo * 64, tid);
    __syncthreads();
    for (int i = tile_lo; i < tile_hi; ++i) {
        LAS unsigned char* buf = lds + ((i - tile_lo) & 1) * AtL<VD>::BUF;
        sg.store(buf, tid);
        __syncthreads();
        if (i + 1 < tile_hi) sg.load(kbase, vbase, pitch, (i + 1) * 64, tid);
        fn(i, (lds_cptr)buf, (lds_cptr)buf + AtL<VD>::KB);
    }
}
template <int VD, class Fn>
__device__ __forceinline__ void at_run_side(LAS unsigned char* lds, const bf16_t* kbase, const bf16_t* vbase, int pitch, int tile_lo, int tile_hi, int tid, CvJob& job, Fn fn) {
    if (tile_lo >= tile_hi) return;
    AtStageP<VD> sg; sg.load(kbase, vbase, pitch, tile_lo * 64, tid);
    __syncthreads();
    for (int i = tile_lo; i < tile_hi; ++i) {
        LAS unsigned char* buf = lds + ((i - tile_lo) & 1) * AtL<VD>::BUF;
        sg.store(buf, tid);
        __syncthreads();
        job.step(tid);
        if (i + 1 < tile_hi) sg.load(kbase, vbase, pitch, (i + 1) * 64, tid);
        fn(i, (lds_cptr)buf, (lds_cptr)buf + AtL<VD>::KB);
    }
}
template <int VD>
__device__ __forceinline__ void at_scores(f32x4 (&s)[2][4], lds_cptr Kb, const bf16x8 (&q)[2][2], int fr, int fq) {
    bf16x8 kn0 = *(const __attribute__((address_space(3))) bf16x8*)(Kb + fr * AT_KP + fq * 16);
    bf16x8 kn1 = *(const __attribute__((address_space(3))) bf16x8*)(Kb + fr * AT_KP + 64 + fq * 16);
#pragma unroll
    for (int kk = 0; kk < 4; ++kk) {
        const bf16x8 kf0 = kn0, kf1 = kn1;
        if (kk < 3) { kn0 = *(const __attribute__((address_space(3))) bf16x8*)(Kb + (16 * (kk + 1) + fr) * AT_KP + fq * 16);
                      kn1 = *(const __attribute__((address_space(3))) bf16x8*)(Kb + (16 * (kk + 1) + fr) * AT_KP + 64 + fq * 16); }
#pragma unroll
        for (int g = 0; g < 2; ++g) s[g][kk] = __builtin_amdgcn_mfma_f32_16x16x32_bf16(kf0, q[g][0], (f32x4){0.f, 0.f, 0.f, 0.f}, 0, 0, 0);
#pragma unroll
        for (int g = 0; g < 2; ++g) s[g][kk] = __builtin_amdgcn_mfma_f32_16x16x32_bf16(kf1, q[g][1], s[g][kk], 0, 0, 0);
    }
}

__device__ __forceinline__ void ph_diff_mfma(const Params& p, LAS unsigned char* lds, int li) {
    const int tid = tid_(), lane = tid & 63, w = tid >> 6, fr = lane & 15, fq = lane >> 4;
    const int G = gridDim.x, c = blockIdx.x;
    const float* lp = p.in[IN_DIF_LAMBDA] + li * 256;
    const float d01 = wave_sum(lp[lane] * lp[64 + lane]), d23 = wave_sum(lp[128 + lane] * lp[192 + lane]);
    const float lam_init = li ? p.lam_init[1] : p.lam_init[0];
    const float lam = expf(d01) - expf(d23) + lam_init;
    const float* subln = p.in[IN_DIF_SUBLN] + li * 128;
    LAS unsigned* oal = (LAS unsigned*)(lds + 2 * AtL<128>::BUF) + w * 2048 + lane;
    for (int L = c; L < 512; L += G) {
        int qb, b, h;
        if (G == 256) { const int rnd = L >> 8, x = c & 7, j = c >> 3; b = x; h = j >> 3; qb = rnd ? 15 - (j & 7) : (j & 7); }
        else { const int rnd = L / G; const int u = ((rnd & 1) && (512 % G == 0)) ? rnd * G + (G - 1 - (L - rnd * G)) : L; qb = u & 15; h = (u >> 4) & 3; b = u >> 6; }
        const bf16_t* vbase = p.Pb + (size_t)b * SEQ * LDPB + E_AV + h * 128;
        const int t0 = qb * 256 + w * 32;
#pragma unroll 1
        for (int jm = 0; jm < 2; ++jm) {
            const int hj = 2 * h + jm;
            const bf16_t* kbase = p.Pb + (size_t)b * SEQ * LDPB + E_AK + hj * 64;
            bf16x8 q[2][2];
#pragma unroll
            for (int g = 0; g < 2; ++g)
#pragma unroll
                for (int ks = 0; ks < 2; ++ks) q[g][ks] = *(const bf16x8*)(p.Pb + (size_t)(b * SEQ + t0 + g * 16 + fr) * LDPB + E_AQ + hj * 64 + ks * 32 + fq * 8);
            AtState<128> st; st.init();
            at_run<128>(lds, kbase, vbase, LDPB, 0, 4 * qb + 4, tid, [&](int i, lds_cptr Kb, lds_cptr Vb) {
                const int key0 = i * 64;
                if (key0 <= t0 + 31) {
                    if (key0 + 63 <= t0) at_tile<128, 0>(st, Kb, Vb, q, fr, fq, AtNoRow(), AtNoEl());
                    else { const int tq0 = t0 + fr - key0 - 4 * fq; at_tile<128, 2>(st, Kb, Vb, q, fr, fq, AtNoRow(), [=](int g, int kk, int r) { return 16 * kk + r <= tq0 + g * 16; }); }
                }
            });
            at_finish(st);
            if (jm == 0) {
#pragma unroll
                for (int g = 0; g < 2; ++g) { const float inv = 1.f / st.l[g];
#pragma unroll
                    for (int n = 0; n < 8; ++n) { const f32x4 o = st.o[g][n] * inv; oal[((g * 8 + n) * 2) * 64] = pk2(o[0], o[1]); oal[((g * 8 + n) * 2 + 1) * 64] = pk2(o[2], o[3]); } }
            } else {
#pragma unroll
                for (int g = 0; g < 2; ++g) { const float inv = 1.f / st.l[g];
                    float ss = 0.f;
#pragma unroll
                    for (int n = 0; n < 8; ++n) {
                        const f32x4 ob = st.o[g][n] * inv;
                        const unsigned b01 = pk2(ob[0], ob[1]), b23 = pk2(ob[2], ob[3]);
                        const unsigned a01 = oal[((g * 8 + n) * 2) * 64], a23 = oal[((g * 8 + n) * 2 + 1) * 64];
                        f32x4 r;
                        r[0] = __builtin_bit_cast(float, a01 << 16) - lam * __builtin_bit_cast(float, b01 << 16);
                        r[1] = __builtin_bit_cast(float, a01 & 0xffff0000u) - lam * __builtin_bit_cast(float, b01 & 0xffff0000u);
                        r[2] = __builtin_bit_cast(float, a23 << 16) - lam * __builtin_bit_cast(float, b23 << 16);
                        r[3] = __builtin_bit_cast(float, a23 & 0xffff0000u) - lam * __builtin_bit_cast(float, b23 & 0xffff0000u);
                        st.o[g][n] = r;
                        ss += (r[0] * r[0] + r[1] * r[1]) + (r[2] * r[2] + r[3] * r[3]);
                    }
                    ss += __shfl_xor(ss, 16); ss += __shfl_xor(ss, 32);
                    const float sc = (1.0f / sqrtf(ss * (1.f / 128.f) + LN_EPS)) * (1.f - lam_init);
                    bf16_t* dst = p.Ob + (size_t)(b * SEQ + t0 + g * 16 + fr) * DM + h * 128 + 4 * fq;
#pragma unroll
                    for (int n = 0; n < 8; ++n) { const float4 sw = *(const float4*)(subln + n * 16 + 4 * fq); const f32x4 r = st.o[g][n];
                        u32x2 wv; wv.x = pk2(r[0] * sc * sw.x, r[1] * sc * sw.y); wv.y = pk2(r[2] * sc * sw.z, r[3] * sc * sw.w); *(u32x2*)(dst + n * 16) = wv; }
                }
            }
        }
    }
}

__device__ __forceinline__ float quad_xor1(float x) { return __builtin_bit_cast(float, __builtin_amdgcn_update_dpp(0, __builtin_bit_cast(int, x), 0xB1, 0xf, 0xf, false)); }
__device__ __forceinline__ float quad_xor2(float x) { return __builtin_bit_cast(float, __builtin_amdgcn_update_dpp(0, __builtin_bit_cast(int, x), 0x4E, 0xf, 0xf, false)); }
__device__ __forceinline__ void ph_moba_mfma(const Params& p, LAS unsigned char* lds, int li) {
    const int tid = tid_(), lane = tid & 63, w = tid >> 6, fr = lane & 15, fq = lane >> 4;
    CvJob job; job.init(p, li, (float*)((unsigned char*)lds + 65536), tid);
    const int G = gridDim.x, c = blockIdx.x;
    LAS unsigned* lmask = (LAS unsigned*)(lds + 40960);
#define MB_E(k, isb, qbv) ((unsigned long long)(((isb) << 4) | (qbv)) << (5 * (k)))
    unsigned long long code = 0ull; int nun = 0, sA = 0, sB = 0;
    if (G == 256) {
        if (c < 32) { sA = c; nun = 3; code = MB_E(0, 0, 15) | MB_E(1, 0, 8) | MB_E(2, 0, 1); }
        else {
            const int c2 = c - 32, pidx = c2 / 7, grp = c2 - pidx * 7; sA = pidx; sB = pidx + 32;
            if (grp == 0) { nun = 3; code = MB_E(0, 1, 15) | MB_E(1, 1, 14) | MB_E(2, 0, 4); }
            else if (grp == 1) { nun = 3; code = MB_E(0, 0, 14) | MB_E(1, 0, 13) | MB_E(2, 1, 6); }
            else if (grp == 2) { nun = 3; code = MB_E(0, 1, 13) | MB_E(1, 1, 12) | MB_E(2, 1, 8); }
            else if (grp == 3) { nun = 3; code = MB_E(0, 0, 12) | MB_E(1, 0, 11) | MB_E(2, 0, 10); }
            else if (grp == 4) { nun = 4; code = MB_E(0, 1, 11) | MB_E(1, 1, 10) | MB_E(2, 0, 7) | MB_E(3, 0, 3); }
            else if (grp == 5) { nun = 4; code = MB_E(0, 0, 9) | MB_E(1, 1, 9) | MB_E(2, 1, 7) | MB_E(3, 0, 6); }
            else { nun = 9; code = MB_E(0, 0, 5) | MB_E(1, 1, 5) | MB_E(2, 1, 4) | MB_E(3, 1, 3) | MB_E(4, 0, 2) | MB_E(5, 1, 2) | MB_E(6, 1, 1) | MB_E(7, 0, 0) | MB_E(8, 1, 0); }
        }
    } else nun = (c < 1024) ? (1024 - c + G - 1) / G : 0;
#undef MB_E
    for (int ui = 0; ui < nun; ++ui) {
        int qb, stream;
        if (G == 256) { const int e = (int)(code >> (5 * ui)) & 31; stream = (e & 16) ? sB : sA; qb = e & 15; }
        else { const int L = c + ui * G; const int rnd = L / G; const int u = ((rnd & 1) && (1024 % G == 0)) ? rnd * G + (G - 1 - (L - rnd * G)) : L; qb = u & 15; stream = u >> 4; }
        const int h = stream & 7, b = stream >> 3;
        const bf16_t* kbase = p.Pb + (size_t)b * SEQ * LDPB + O_CK + h * 64;
        const bf16_t* vbase = p.Pb + (size_t)b * SEQ * LDPB + O_CV + h * 64;
        const int t0 = qb * 256 + w * 32;
        bf16x8 q[2][2];
#pragma unroll
        for (int g = 0; g < 2; ++g)
#pragma unroll
            for (int ks = 0; ks < 2; ++ks) q[g][ks] = *(const bf16x8*)(p.Pb + (size_t)(b * SEQ + t0 + g * 16 + fr) * LDPB + O_CQ + h * 64 + ks * 32 + fq * 8);
        unsigned msk[2];
        {
            bf16x8 kmf[2];
#pragma unroll
            for (int ks = 0; ks < 2; ++ks) { const float* km = p.kmean + (size_t)((b * 16 + fr) * 8 + h) * 64 + ks * 32 + fq * 8;
                const float4 a0 = *(const float4*)km, a1 = *(const float4*)(km + 4);
                kmf[ks] = __builtin_bit_cast(bf16x8, (pg8::u32x4){pk2(a0.x, a0.y), pk2(a0.z, a0.w), pk2(a1.x, a1.y), pk2(a1.z, a1.w)}); }
            LAS float* lg = (LAS float*)(lds + 40960) + w * 512;
#pragma unroll
            for (int g = 0; g < 2; ++g) {
                f32x4 gs = Z4_;
                gs = __builtin_amdgcn_mfma_f32_16x16x32_bf16(kmf[0], q[g][0], gs, 0, 0, 0);
                gs = __builtin_amdgcn_mfma_f32_16x16x32_bf16(kmf[1], q[g][1], gs, 0, 0, 0);
                *(LAS f32x4*)(lg + (g * 16 + fr) * 16 + 4 * fq) = gs;
            }
#pragma unroll
            for (int g = 0; g < 2; ++g) {
                float gv[16];
#pragma unroll
                for (int c4 = 0; c4 < 4; ++c4) { const f32x4 t4 = *(const LAS f32x4*)(lg + (g * 16 + fr) * 16 + 4 * c4);
#pragma unroll
                    for (int e = 0; e < 4; ++e) gv[4 * c4 + e] = (4 * c4 + e < qb) ? t4[e] : -INFINITY; }
                unsigned m = 0u;
#pragma unroll
                for (int pick = 0; pick < 3; ++pick) {
                    float best = -INFINITY; int bi = -1;
#pragma unroll
                    for (int n = 0; n < 16; ++n) if (gv[n] > best) { best = gv[n]; bi = n; }
                    if (bi >= 0) m |= 1u << bi;
#pragma unroll
                    for (int n = 0; n < 16; ++n) gv[n] = (n == bi) ? -INFINITY : gv[n];
                }
                msk[g] = m;
            }
        }
        AtState<64> st; st.init();
        at_run_side<64>(lds, kbase, vbase, LDPB, 0, 4 * qb + 4, tid, job, [&](int i, lds_cptr Kb, lds_cptr Vb) {
            const int n = i >> 2, key0 = i * 64;
            if (n < qb) {
                const bool b0 = (msk[0] >> n) & 1u, b1 = (msk[1] >> n) & 1u;
                at_tile<64, 1>(st, Kb, Vb, q, fr, fq, [=](int g) { return g ? b1 : b0; }, AtNoEl());
            } else if (key0 <= t0 + 31) {
                const int tq0 = t0 + fr - key0 - 4 * fq;
                if (key0 + 63 <= t0) at_tile<64, 0>(st, Kb, Vb, q, fr, fq, AtNoRow(), AtNoEl());
                else at_tile<64, 2>(st, Kb, Vb, q, fr, fq, AtNoRow(), [=](int g, int kk, int r) { return 16 * kk + r <= tq0 + g * 16; });
            }
        });
        at_finish(st);
#pragma unroll
        for (int g = 0; g < 2; ++g) { const float inv = 1.f / st.l[g]; bf16_t* dst = p.Ob + (size_t)(b * SEQ + t0 + g * 16 + fr) * DM + h * 64 + 4 * fq;
#pragma unroll
            for (int n = 0; n < 4; ++n) { const f32x4 o = st.o[g][n] * inv; u32x2 wv; wv.x = pk2(o[0], o[1]); wv.y = pk2(o[2], o[3]); *(u32x2*)(dst + n * 16) = wv; } }
    }
    job.finish(tid);
}

__device__ __forceinline__ void ph_nsa_mfma(const Params& p, LAS unsigned char* lds, const bf16_t* cmpkb, const bf16_t* cmpvb) {
    const int tid = tid_(), lane = tid & 63, w = tid >> 6, fr = lane & 15, fq = lane >> 4;
    const int G = gridDim.x, c = blockIdx.x;
    LAS float* impA = (LAS float*)(lds + 40960) + w * 1024;
    LAS float* impB = impA + 512;
    LAS unsigned long long* selm = (LAS unsigned long long*)(lds + 73728) + w * 8;
    static_assert(2 * AtL<64>::BUF <= 40960, "NSA LDS map");
    for (int L = c; L < 1024; L += G) {
        int qb, stream;
        if (G == 256) { const int rnd = L >> 8, x = c & 7, j = c >> 3;
            stream = 2 * x + (rnd >> 1); qb = (rnd & 1) ? 63 - j : j; }
        else { const int rnd = L / G; const int u = ((rnd & 1) && (1024 % G == 0)) ? rnd * G + (G - 1 - (L - rnd * G)) : L; qb = u & 63; stream = u >> 6; }
        const int grp = stream & 1, b = stream >> 1;
        const int tw = qb * 64 + w * 8;
#define TQ(g) (tw + (g) * 4 + (fr >> 2))
#define TOKG(g) (b * SEQ + TQ(g))
        bf16x8 qraw[2][2];
#pragma unroll
        for (int g = 0; g < 2; ++g) {
            const int head = grp * 4 + (fr & 3);
#pragma unroll
            for (int ks = 0; ks < 2; ++ks) qraw[g][ks] = *(const bf16x8*)(p.Pb + (size_t)TOKG(g) * LDPB + O_DQ + head * 64 + ks * 32 + fq * 8);
        }
        LAS float* accl = (LAS float*)(lds + 75776) + w * 2048 + lane;
        const bf16_t* ck = cmpkb + (size_t)(b * 2 + grp) * 256 * 64; const bf16_t* cv = cmpvb + (size_t)(b * 2 + grp) * 256 * 64;
        int nv[2];
#pragma unroll
        for (int g = 0; g < 2; ++g) nv[g] = (TQ(g) >= 31) ? ((TQ(g) - 31) >> 4) + 1 : 0;
        const int nvmax_w = (tw + 7 >= 31) ? ((tw + 7 - 31) >> 4) + 1 : 0;
        const int nvmax_b = (qb * 64 + 63 >= 31) ? ((qb * 64 + 63 - 31) >> 4) + 1 : 0;
        const int ncmp_tiles = (nvmax_b + 63) >> 6;
        float mfin[2], linv[2];
        {
            AtState<64> st; st.init();
            at_run<64>(lds, ck, cv, 64, 0, ncmp_tiles, tid, [&](int i, lds_cptr Kb, lds_cptr Vb) {
                if (i * 64 < nvmax_w) { const int n0 = nv[0] - i * 64, n1 = nv[1] - i * 64;
                    at_tile<64, 2>(st, Kb, Vb, qraw, fr, fq, AtNoRow(), [=](int g, int kk, int r) { return 16 * kk + 4 * fq + r < (g ? n1 : n0); }); }
            });
            at_finish(st);
#pragma unroll
            for (int g = 0; g < 2; ++g) { mfin[g] = st.m[g]; linv[g] = st.l[g] > 0.f ? 1.f / st.l[g] : 0.f;
#pragma unroll
                for (int n = 0; n < 4; ++n) { const f32x4 o = st.o[g][n] * (linv[g] * p.GATES[(size_t)TOKG(g) * 24 + (grp * 4 + (fr & 3)) * 3]);
#pragma unroll
                    for (int r = 0; r < 4; ++r) accl[((g * 4 + n) * 4 + r) * 64] = o[r]; } }
        }
        for (int e = lane; e < 512; e += 64) { impA[e] = 0.f; impB[e] = 0.f; }
        at_run<64>(lds, ck, cv, 64, 0, ncmp_tiles, tid, [&](int i, lds_cptr Kb, lds_cptr) {
            if (i * 64 < nvmax_w) {
                f32x4 s[2][4]; at_scores<64>(s, Kb, qraw, fr, fq);
#pragma unroll
                for (int g = 0; g < 2; ++g)
#pragma unroll
                    for (int kk = 0; kk < 4; ++kk) {
                        float a = 0.f, last = 0.f;
#pragma unroll
                        for (int r = 0; r < 4; ++r) { const int n = i * 64 + 16 * kk + 4 * fq + r;
                            const float pv = (n < nv[g]) ? __builtin_amdgcn_exp2f(s[g][kk][r] * AT_SCALE2 - mfin[g]) * linv[g] : 0.f; a += pv; last = pv; }
                        a += quad_xor1(a); a += quad_xor2(a); last += quad_xor1(last); last += quad_xor2(last);
                        const int j = 16 * i + 4 * kk + fq, qi = g * 4 + (fr >> 2);
                        if ((fr & 3) == 0) { impA[qi * 64 + j] = a; if (j + 1 < 64) impB[qi * 64 + j + 1] = last; }
                    }
            }
        });
        {
            unsigned key[8], T[8];
#pragma unroll
            for (int qi = 0; qi < 8; ++qi) {
                const float imp = impA[qi * 64 + lane] + impB[qi * 64 + lane];
                const bool causal = lane <= qb, forced = (lane == 0) || (lane >= qb - 1 && causal);
                const float val = forced ? 1e30f : (causal ? imp : -1e30f);
                const unsigned u = __builtin_bit_cast(unsigned, val);
                key[qi] = (u & 0x80000000u) ? ~u : (u | 0x80000000u); T[qi] = 0u;
            }
#pragma nounroll
            for (int bit = 31; bit >= 0; --bit) {
#pragma unroll
                for (int qi = 0; qi < 8; ++qi) { const unsigned cand = T[qi] | (1u << bit); if (__popcll(__ballot(key[qi] >= cand)) >= 16) T[qi] = cand; }
            }
#pragma unroll
            for (int qi = 0; qi < 8; ++qi) {
                const bool gt = key[qi] > T[qi], eq = key[qi] == T[qi];
                const unsigned long long meq = __ballot(eq);
                const int need = 16 - __popcll(__ballot(gt));
                const unsigned long long mk = __ballot(gt || (eq && lane_rank(meq) < need));
                if (lane == 0) selm[qi] = mk;
            }
        }
        unsigned long long sm[2];
#pragma unroll
        for (int g = 0; g < 2; ++g) sm[g] = selm[g * 4 + (fr >> 2)];
        bf16x8 qrot[2][2];
#pragma unroll
        for (int g = 0; g < 2; ++g)
#pragma unroll
            for (int ks = 0; ks < 2; ++ks) qrot[g][ks] = *(const bf16x8*)(p.QRb + (size_t)TOKG(g) * 512 + (grp * 4 + (fr & 3)) * 64 + ks * 32 + fq * 8);
        {
            const bf16_t* kb = p.Pb + (size_t)b * SEQ * LDPB + O_KS + grp * 64; const bf16_t* vb = p.Pb + (size_t)b * SEQ * LDPB + O_VS + grp * 64;
            AtState<64> st; st.init();
            at_run<64>(lds, kb, vb, LDPB, 0, qb + 1, tid, [&](int i, lds_cptr Kb, lds_cptr Vb) {
                const bool b0 = (sm[0] >> i) & 1ull, b1 = (sm[1] >> i) & 1ull;
                { const int d0 = TQ(0) - i * 64, d1 = TQ(1) - i * 64;
                    if (i < qb) at_tile<64, 1>(st, Kb, Vb, qrot, fr, fq, [=](int g) { return g ? b1 : b0; }, AtNoEl());
                    else at_tile<64, 3>(st, Kb, Vb, qrot, fr, fq, [=](int g) { return g ? b1 : b0; }, [=](int g, int kk, int r) { return 16 * kk + 4 * fq + r <= (g ? d1 : d0); }); }
            });
            at_finish(st);
#pragma unroll
            for (int g = 0; g < 2; ++g) { const float sc = p.GATES[(size_t)TOKG(g) * 24 + (grp * 4 + (fr & 3)) * 3 + 1] / st.l[g];
#pragma unroll
                for (int n = 0; n < 4; ++n)
#pragma unroll
                    for (int r = 0; r < 4; ++r) accl[((g * 4 + n) * 4 + r) * 64] += st.o[g][n][r] * sc; }
        }
        {
            const bf16_t* kb = p.Pb + (size_t)b * SEQ * LDPB + O_KW + grp * 64; const bf16_t* vb = p.Pb + (size_t)b * SEQ * LDPB + O_VW + grp * 64;
            AtState<64> st; st.init();
            at_run<64>(lds, kb, vb, LDPB, (qb >= 8 ? qb - 8 : 0), qb + 1, tid, [&](int i, lds_cptr Kb, lds_cptr Vb) {
                const int d0 = TQ(0) - i * 64 - 4 * fq, d1 = TQ(1) - i * 64 - 4 * fq;
                if (i == qb || (qb >= 8 && i == qb - 8)) {
                    const int hi0 = (i == qb) ? d0 : 64, hi1 = (i == qb) ? d1 : 64, lo0 = (i == qb) ? -1 : d0 - 512, lo1 = (i == qb) ? -1 : d1 - 512;
                    at_tile<64, 2>(st, Kb, Vb, qrot, fr, fq, AtNoRow(), [=](int g, int kk, int r) { const int kx = 16 * kk + r; return kx <= (g ? hi1 : hi0) && kx > (g ? lo1 : lo0); });
                } else at_tile<64, 0>(st, Kb, Vb, qrot, fr, fq, AtNoRow(), AtNoEl());
            });
            at_finish(st);
#pragma unroll
            for (int g = 0; g < 2; ++g) { const float sc = p.GATES[(size_t)TOKG(g) * 24 + (grp * 4 + (fr & 3)) * 3 + 2] / st.l[g];
                bf16_t* dst = p.Ob + (size_t)TOKG(g) * DM + 512 + (grp * 4 + (fr & 3)) * 64 + 4 * fq;
#pragma unroll
                for (int n = 0; n < 4; ++n) { f32x4 o;
#pragma unroll
                    for (int r = 0; r < 4; ++r) o[r] = accl[((g * 4 + n) * 4 + r) * 64] + st.o[g][n][r] * sc;
                    u32x2 wv; wv.x = pk2(o[0], o[1]); wv.y = pk2(o[2], o[3]); *(u32x2*)(dst + n * 16) = wv; } }
        }
    }
#undef TQ
#undef TOKG
}

__device__ __forceinline__ unsigned pk_cnt_gt(unsigned acc, unsigned h, unsigned cm1, unsigned one2) {
    unsigned d;
    asm("v_pk_sub_u16 %0, %1, %2 clamp" : "=v"(d) : "v"(h), "v"(cm1));
    asm("v_pk_min_u16 %0, %1, %2" : "=v"(d) : "v"(d), "v"(one2));
    asm("v_pk_add_u16 %0, %1, %2" : "=v"(acc) : "v"(acc), "v"(d));
    return acc;
}
__device__ __forceinline__ int wave_total(int c) {
    int tot = 0;
#pragma unroll
    for (int bb = 0; bb < 7; ++bb) tot += __popcll(__ballot((c >> bb) & 1)) << bb;
    return tot;
}
#define SEL_CHUNKS(BODY) do { \
    _Pragma("unroll") for (int i = 0; i < 16; ++i) BODY(i) \
    if (tl >= 16) { _Pragma("unroll") for (int i = 16; i < 32; ++i) BODY(i) \
        if (tl >= 32) { _Pragma("unroll") for (int i = 32; i < 48; ++i) BODY(i) \
            if (tl >= 48) { _Pragma("unroll") for (int i = 48; i < 64; ++i) BODY(i) } } } } while (0)
__device__ __forceinline__ void ph_dsa_select(const Params& p, LAS unsigned char* lds, unsigned long long* BM) {
    const int tid = tid_(), lane = tid & 63, w = tid >> 6, fr = lane & 15, fq = lane >> 4;
    const int G = gridDim.x, c = blockIdx.x;
    LAS unsigned* sc = (LAS unsigned*)lds;
#define SEL_UNIT(LL, B, T0) do { if (G == 256) { const int rnd_ = (LL) >> 8, x_ = c & 7, j_ = c >> 3, idx_ = (rnd_ >> 1) * 32 + j_; B = x_; T0 = ((rnd_ & 1) ? (511 - idx_) : idx_) * 8; } \
        else { B = (LL) >> 9; T0 = ((LL) & 511) * 8; } } while (0)
#define SEL_LOADQ(B, T0) do { _Pragma("unroll") for (int g = 0; g < 2; ++g) { const size_t tokq_ = (size_t)(B) * SEQ + (T0) + g * 4 + (fr >> 2); \
        _Pragma("unroll") for (int ks = 0; ks < 2; ++ks) iq[g][ks] = *(const bf16x8*)(p.Pb + tokq_ * LDPB + E_IQ + (fr & 3) * 64 + ks * 32 + fq * 8); \
        iwv[g] = *(const float4*)(p.IW + ((size_t)(B) * SEQ + (T0) + g * 4 + fq) * 4); } } while (0)
#define SEL_LOADK(B, NSUB, SUB0, J0, J1) do { _Pragma("unroll") for (int j = J0; j < J1; ++j) { const int sub_ = ((SUB0) + 8 * j < (NSUB)) ? (SUB0) + 8 * j : (SUB0); \
        const bf16_t* kr_ = p.Pb + (size_t)((B) * SEQ + sub_ * 16 + fr) * LDPB + E_IK + fq * 8; \
        kf[j][0] = *(const bf16x8*)kr_; kf[j][1] = *(const bf16x8*)(kr_ + 32); } } while (0)
    bf16x8 iq[2][2]; float4 iwv[2]; bf16x8 kf[8][2];
    bool have = false;
    for (int L = c; L < 4096; L += G) {
        int b, t0; SEL_UNIT(L, b, t0);
        const int t = t0 + w; const size_t tok = (size_t)b * SEQ + t; const int ntile = (t >> 6) + 1;
        if (t0 + 7 < 256) {
            const int rem = t - lane * 64;
            const unsigned long long wd = (rem >= 63) ? ~0ull : (rem >= 0 ? ((1ull << (rem + 1)) - 1ull) : 0ull);
            if (lane < ntile) BM[tok * 64 + lane] = wd;
            continue;
        }
        const int nsub = (t0 + 8 + 15) >> 4;
        if (!have) { SEL_LOADQ(b, t0); SEL_LOADK(b, nsub, w, 0, 2); }
        have = false;
        SEL_LOADK(b, nsub, w, 2, 8);
        __syncthreads();
        for (int sub0 = w; sub0 < nsub; sub0 += 64) {
#pragma unroll
            for (int j = 0; j < 8; ++j) {
                const int sub = sub0 + 8 * j;
                if (sub < nsub) {
#pragma unroll
                    for (int g = 0; g < 2; ++g) {
                        f32x4 s = Z4_;
                        s = __builtin_amdgcn_mfma_f32_16x16x32_bf16(iq[g][0], kf[j][0], s, 0, 0, 0);
                        s = __builtin_amdgcn_mfma_f32_16x16x32_bf16(iq[g][1], kf[j][1], s, 0, 0, 0);
                        const int q = g * 4 + fq, key = sub * 16 + fr;
                        const float v = (iwv[g].x * fmaxf(s[0], 0.f) + iwv[g].y * fmaxf(s[1], 0.f)) + (iwv[g].z * fmaxf(s[2], 0.f) + iwv[g].w * fmaxf(s[3], 0.f));
                        const unsigned u = __builtin_bit_cast(unsigned, v);
                        const unsigned ks2 = (u & 0x80000000u) ? ~u : (u | 0x80000000u);
                        sc[q * 4096 + key] = (key <= t0 + q) ? ks2 : 0u;
                    }
                }
            }
            if (sub0 + 64 < nsub) SEL_LOADK(b, nsub, sub0 + 64, 0, 8);
        }
        __syncthreads();
        unsigned long long myword = 0ull;
        {
            const int tl = __builtin_amdgcn_readfirstlane(t >> 6);
            unsigned kreg[64];
#pragma unroll
            for (int i = 0; i < 64; ++i) kreg[i] = sc[w * 4096 + i * 64 + lane];
            __builtin_amdgcn_sched_barrier(0);
#pragma unroll
            for (int i = 0; i < 64; ++i) kreg[i] = (i * 64 + lane <= t) ? kreg[i] : 0u;
            unsigned T = 0u; bool exact = false; int need = 0;
            {
                LAS unsigned* hist = (LAS unsigned*)(lds + 131072) + w * 256;
                unsigned prefix = 0u, pmask = 0u; int remaining = 256;
                {
                    unsigned T8 = 0u; int acc_tot = t + 1, above = 0;
#pragma nounroll
                    for (int bit = 7; bit >= 0; --bit) {
                        const unsigned cand = (T8 | (1u << bit)) << 24;
                        int cnt = 0;
#define SEL_CNT(i) { cnt += (kreg[i] >= cand) ? 1 : 0; }
                        SEL_CHUNKS(SEL_CNT);
#undef SEL_CNT
                        const int tot = wave_total(cnt);
                        if (tot >= 256) { T8 |= 1u << bit; acc_tot = tot; } else above = tot;
                    }
                    remaining = 256 - above; prefix = T8 << 24; pmask = 0xff000000u;
                    exact = (acc_tot - above == remaining);
                }
                if (!exact) for (int pass = 1; pass < 4; ++pass) {
                    const int shift = 24 - 8 * pass;
#pragma unroll
                    for (int j = 0; j < 4; ++j) hist[lane + 64 * j] = 0u;
#define SEL_HIST(i) { const unsigned k = kreg[i]; if ((k & pmask) == prefix && k != 0u) __hip_atomic_fetch_add(&hist[(k >> shift) & 255u], 1u, __ATOMIC_RELAXED, __HIP_MEMORY_SCOPE_WORKGROUP); }
                    SEL_CHUNKS(SEL_HIST);
#undef SEL_HIST
                    unsigned cj[4]; unsigned sl = 0u;
#pragma unroll
                    for (int j = 0; j < 4; ++j) { cj[j] = hist[255 - 4 * lane - j]; sl += cj[j]; }
                    unsigned incl = 0u;
#pragma unroll
                    for (int bb = 0; bb < 13; ++bb) { const unsigned long long mb = __ballot((sl >> bb) & 1u); incl += (unsigned)(lane_rank(mb) + ((sl >> bb) & 1u)) << bb; }
                    const unsigned excl = incl - sl;
                    const bool cross = (excl < (unsigned)remaining) && ((unsigned)remaining <= incl);
                    unsigned dig = 0u, above = excl, cbin = 0u;
                    { unsigned accv = excl; bool found = false;
#pragma unroll
                      for (int j = 0; j < 4; ++j) { if (!found && accv + cj[j] >= (unsigned)remaining) { dig = 255u - 4u * lane - j; above = accv; cbin = cj[j]; found = true; } accv += cj[j]; } }
                    const unsigned long long mc = __ballot(cross);
                    const int src = mc ? __builtin_ctzll(mc) : 0;
                    dig = (unsigned)__builtin_amdgcn_readlane((int)dig, src); above = (unsigned)__builtin_amdgcn_readlane((int)above, src); cbin = (unsigned)__builtin_amdgcn_readlane((int)cbin, src);
                    prefix |= dig << shift; pmask |= 0xffu << shift; remaining -= (int)above;
                    if ((int)cbin == remaining) { exact = true; break; }
                }
                T = prefix; need = remaining;
            }
            if (exact) {
#define SEL_EX(i) { const unsigned long long msel = __ballot(kreg[i] >= T); if (lane == i) myword = msel; }
                SEL_CHUNKS(SEL_EX);
#undef SEL_EX
            } else {
                int taken = 0;
#define SEL_TIE(i) { const bool gt = kreg[i] > T, eq = kreg[i] == T; const unsigned long long meq = __ballot(eq); const bool sel = gt || (eq && (taken + lane_rank(meq) < need)); \
                    const unsigned long long msel = __ballot(sel); if (lane == i) myword = msel; taken += __popcll(meq); }
                SEL_CHUNKS(SEL_TIE);
#undef SEL_TIE
            }
        }
        if (lane < ntile) BM[tok * 64 + lane] = myword;
    }
#undef SEL_UNIT
#undef SEL_LOADQ
#undef SEL_LOADK
}
__device__ __forceinline__ void ph_dsa_attn(const Params& p, LAS unsigned char* lds, const unsigned long long* BM) {
    const int tid = tid_(), lane = tid & 63, w = tid >> 6, fr = lane & 15, fq = lane >> 4;
    const int G = gridDim.x, c = blockIdx.x;
    for (int L = c; L < 1024; L += G) {
        int qb, stream;
        if (G == 256) { const int rnd = L >> 8, x = c & 7, j = c >> 3;
            stream = 2 * x + (rnd >> 1); qb = (rnd & 1) ? 63 - j : j; }
        else { const int rnd = L / G; const int u = ((rnd & 1) && (1024 % G == 0)) ? rnd * G + (G - 1 - (L - rnd * G)) : L; qb = u & 63; stream = u >> 6; }
        const int grp = stream & 1, b = stream >> 1;
        const int tw = qb * 64 + w * 8, head = grp * 4 + (fr & 3);
#define TOKD(g) ((size_t)b * SEQ + tw + (g) * 4 + (fr >> 2))
        bf16x8 q[2][2];
#pragma unroll
        for (int g = 0; g < 2; ++g)
#pragma unroll
            for (int ks = 0; ks < 2; ++ks) q[g][ks] = *(const bf16x8*)(p.Pb + TOKD(g) * LDPB + E_BQ + head * 64 + ks * 32 + fq * 8);
        const bf16_t* kb = p.Pb + (size_t)b * SEQ * LDPB + E_BK + grp * 64; const bf16_t* vb = p.Pb + (size_t)b * SEQ * LDPB + E_BV + grp * 64;
        AtState<64> st; st.init();
        unsigned long long wn0 = BM[TOKD(0) * 64], wn1 = BM[TOKD(1) * 64];
        at_run<64>(lds, kb, vb, LDPB, 0, qb + 1, tid, [&](int i, lds_cptr Kb, lds_cptr Vb) {
            const unsigned long long w0 = wn0, w1 = wn1;
            if (i < qb) { wn0 = BM[TOKD(0) * 64 + i + 1]; wn1 = BM[TOKD(1) * 64 + i + 1]; }
            { const unsigned long long x0 = w0 >> (4 * fq), x1 = w1 >> (4 * fq);
                const int l0 = (int)(unsigned)x0, h0 = (int)(unsigned)(x0 >> 32), l1 = (int)(unsigned)x1, h1 = (int)(unsigned)(x1 >> 32);
                at_tile<64, 4>(st, Kb, Vb, q, fr, fq, AtNoRow(), [=](int g, int kk, int r) { const int bit = 16 * kk + r;
                    int mres; const int wsel = (bit < 32) ? (g ? l1 : l0) : (g ? h1 : h0);
                    asm("v_bfe_i32 %0, %1, %2, 1" : "=v"(mres) : "v"(wsel), "n"(bit & 31)); return mres; }); }
        });
        at_finish(st);
#pragma unroll
        for (int g = 0; g < 2; ++g) { const float inv = 1.f / st.l[g]; bf16_t* dst = p.Ob + TOKD(g) * DM + 512 + head * 64 + 4 * fq;
#pragma unroll
            for (int n = 0; n < 4; ++n) { const f32x4 o = st.o[g][n] * inv; u32x2 wv; wv.x = pk2(o[0], o[1]); wv.y = pk2(o[2], o[3]); *(u32x2*)(dst + n * 16) = wv; } }
#undef TOKD
    }
}

#define XB_TMO      128
#define XB_XCNT(j)  (256  + 64 * (j))
#define XB_XSUB(j)  (1280 + 64 * (j))
#define XB_XGEN(j)  (2304 + 64 * (j))
#define XB_TOP      3328
#define XB_TOPGEN   3392
#define XCD_BAR_WORDS 3456
#define XB_SPIN_CAP (1u << 24)
__device__ __forceinline__ unsigned xb_ld(unsigned* p)              { return __hip_atomic_load(p, __ATOMIC_RELAXED, __HIP_MEMORY_SCOPE_AGENT); }
__device__ __forceinline__ unsigned xb_add(unsigned* p, unsigned v) { return __hip_atomic_fetch_add(p, v, __ATOMIC_RELAXED, __HIP_MEMORY_SCOPE_AGENT); }
__device__ __forceinline__ unsigned xb_xcc_id() { return (unsigned)__builtin_amdgcn_s_getreg((3 << 11) | 20) & 0xFu; }
#define XB_SPIN(cond, bar) do { unsigned _sp = 0; while (cond) { __builtin_amdgcn_s_sleep(1); \
    if ((++_sp & 255u) == 0u) { if (xb_ld(&(bar)[XB_TMO])) break; if (_sp > XB_SPIN_CAP) { atomicAdd(&(bar)[XB_TMO], 1u); break; } } } } while (0)
struct XcdBarrier { unsigned* bar; unsigned x; volatile LAS unsigned* st; };
__device__ __forceinline__ XcdBarrier xcd_barrier_post(unsigned* bar, volatile LAS unsigned* st) {
    XcdBarrier b; b.bar = bar; b.x = xb_xcc_id(); b.st = st;
    if (threadIdx.x == 0) (void)xb_add(&bar[XB_XCNT(b.x)], 1u);
    return b;
}
__device__ __forceinline__ void xcd_barrier_complete(unsigned* bar, unsigned x, unsigned& nloc, unsigned& nx) {
    const unsigned G = gridDim.x * gridDim.y * gridDim.z;
    unsigned sum, cnt, mine, sp = 0u;
    for (;;) {
        sum = 0u; cnt = 0u; mine = 0u;
#pragma unroll
        for (unsigned j = 0; j < 16; ++j) { const unsigned c = xb_ld(&bar[XB_XCNT(j)]); sum += c; cnt += (c > 0u) ? 1u : 0u; mine = (j == x) ? c : mine; }
        if (sum == G) break;
        __builtin_amdgcn_s_sleep(1);
        if ((++sp & 255u) == 0u) { if (xb_ld(&bar[XB_TMO])) break; if (sp > XB_SPIN_CAP) { atomicAdd(&bar[XB_TMO], 1u); break; } }
    }
    nloc = mine > 0u ? mine : 1u; nx = cnt > 0u ? cnt : 1u;
}
__device__ __forceinline__ void xcd_barrier(unsigned* bar_in, volatile LAS unsigned* st) {
    asm volatile("s_waitcnt vmcnt(0)" ::: "memory");
    __syncthreads();
    if (threadIdx.x == 0) {
        unsigned* bar = bar_in; asm volatile("" : "+s"(bar));
        const unsigned x = xb_xcc_id();
        __builtin_amdgcn_s_waitcnt(0);
        unsigned nloc = st[0], nx = st[1];
        if (nloc == 0u) { xcd_barrier_complete(bar, x, nloc, nx); st[0] = nloc; st[1] = nx; }
        const unsigned old = xb_add(&bar[XB_XSUB(x)], 1u);
        const unsigned gen = old / nloc;
        if (old + 1u == (gen + 1u) * nloc) {
            __builtin_amdgcn_fence(__ATOMIC_RELEASE, "agent");
            asm volatile("s_waitcnt vmcnt(0)" ::: "memory");
            const unsigned og = xb_add(&bar[XB_TOP], 1u);
            const unsigned tg = og / nx;
            if (og + 1u == (tg + 1u) * nx) xb_add(&bar[XB_TOPGEN], 1u);
            else XB_SPIN(xb_ld(&bar[XB_TOPGEN]) == tg, bar);
            __builtin_amdgcn_fence(__ATOMIC_ACQUIRE, "agent");
            xb_add(&bar[XB_XGEN(x)], 1u);
            asm volatile("s_waitcnt vmcnt(0)" ::: "memory");
        } else {
            XB_SPIN(xb_ld(&bar[XB_XGEN(x)]) == gen, bar);
            __builtin_amdgcn_fence(__ATOMIC_ACQUIRE, "agent");
            asm volatile("s_waitcnt vmcnt(0)" ::: "memory");
        }
    }
    __syncthreads();
}

__global__ void __launch_bounds__(NT, 2) mega(Params p) {
    extern __shared__ __attribute__((aligned(16))) float lds[];
    PG8_LAS unsigned char* ldsL = (PG8_LAS unsigned char*)lds;
    volatile LAS unsigned* xst = (volatile LAS unsigned*)(lds + LDS_BYTES / 4);
    if (threadIdx.x == 0) { xst[0] = 0u; xst[1] = 0u; xst[2] = 0u; xst[3] = 0u; }
    __syncthreads();
    (void)xcd_barrier_post(p.bar, xst);
#define GRID_BAR() xcd_barrier(p.bar, xst)
    const int G = gridDim.x, cB = blockIdx.x;
    const float* const xin0 = p.in[IN_X];
    ph_init(p, lds);
    GRID_BAR();
    for (int l = 0; l < 4; ++l) {
        const int li = l >> 1;
        if ((l & 1) == 0) {
            {
                pg8::Gemm g{p.Xb, p.WinE + (size_t)li * NP_EVEN * DM, NTOK, NP_EVEN, DM}; pg8::StaticOrder S; S.init(NTOK, NP_EVEN, G, cB);
                EpiInEven E{p.Pb, p.IW, p.ropecs};
                pg8::gemm_phase<EpiInEven, pg8::StaticOrder, true, true>(ldsL, g, S, E);
            }
            GRID_BAR();
            ph_diff_mfma(p, (LAS unsigned char*)lds, li);
            __syncthreads();
            ph_dsa_select(p, (LAS unsigned char*)lds, p.BM);
            GRID_BAR();
            ph_dsa_attn(p, (LAS unsigned char*)lds, p.BM);
            GRID_BAR();
            {
                pg8::Gemm g{p.Ob, p.WoutE + (size_t)li * DM * DM, NTOK, DM, DM}; pg8::StaticOrder S; S.init(NTOK, DM, G, cB);
                EpiY E{(bf16_t*)p.Y};
                pg8::gemm_phase<EpiY, pg8::StaticOrder, true, true>(ldsL, g, S, E);
            }
            GRID_BAR();
        } else {
            {
                pg8::Gemm g{p.Xb, p.WinO + (size_t)li * NP_ODD * DM, NTOK, NP_ODD, DM}; pg8::StaticOrder S; S.init(NTOK, NP_ODD, G, cB);
                EpiInOdd E{p.Pb, p.QRb, p.GATES, p.ropecs, p.in[IN_NSA_GATE_B] + li * 24};
                pg8::gemm_phase<EpiInOdd, pg8::StaticOrder, true, true>(ldsL, g, S, E);
            }
            GRID_BAR();
            ph_kmean(p, lds);
            ph_cmp_build(p, li);
            GRID_BAR();
            {
                pg8::Gemm g{p.Ac, p.W1T + (size_t)li * 2 * 256 * 2048, 8192, 256, 2048}; ListOrder S{32, G, cB};
                EpiGeluH E{p.Hc};
                pg8::gemm_phase<EpiGeluH, ListOrder, true, true>(ldsL, g, S, E);
            }
            __syncthreads();
            ph_moba_mfma(p, (LAS unsigned char*)lds, li);
            GRID_BAR();
            {
                pg8::Gemm g{p.Hc, p.W2T + (size_t)li * 2 * 256 * 256, 8192, 256, 256}; ListOrder S{32, G, cB};
                EpiCmp E{p.CMP};
                pg8::gemm_phase<EpiCmp, ListOrder, true, true>(ldsL, g, S, E);
            }
            GRID_BAR();
            ph_nsa_mfma(p, (LAS unsigned char*)lds, p.CMP, p.CMP + (size_t)4096 * 64);
            GRID_BAR();
            {
                pg8::Gemm g{p.Ob, p.WoutO + (size_t)li * DM * DM, NTOK, DM, DM}; pg8::StaticOrder S; S.init(NTOK, DM, G, cB);
                EpiY E{(bf16_t*)p.Y};
                pg8::gemm_phase<EpiY, pg8::StaticOrder, true, true>(ldsL, g, S, E);
            }
            GRID_BAR();
        }
        if (l & 1) ph_ln_router(p, p.in[IN_LN_MIX_G] + l * DM, p.in[IN_LN_MIX_B] + l * DM, li, lds);
        else if (l == 0) ph_ln<0, 0>(p, p.in[IN_LN_MIX_G] + l * DM, p.in[IN_LN_MIX_B] + l * DM, xin0, p.X, p.Xb, false);
        else ph_ln<0, 1>(p, p.in[IN_LN_MIX_G] + l * DM, p.in[IN_LN_MIX_B] + l * DM, xin0, p.X, p.Xb, false);
        GRID_BAR();
        if ((l & 1) == 0) {
            {
                pg8::Gemm g{p.Xb, p.WguD + (size_t)li * 2 * F_DENSE * DM, NTOK, 2 * F_DENSE, DM}; pg8::StaticOrder S; S.init(NTOK, 2 * F_DENSE, G, cB);
                EpiGU E{p.H, F_DENSE, 2 * F_DENSE / 256, 0};
                pg8::gemm_phase<EpiGU, pg8::StaticOrder, true, true>(ldsL, g, S, E);
            }
            GRID_BAR();
            {
                pg8::Gemm g{p.H, p.WdD + (size_t)li * DM * F_DENSE, NTOK, DM, F_DENSE}; pg8::StaticOrder S; S.init(NTOK, DM, G, cB);
                EpiY E{(bf16_t*)p.Y};
                pg8::gemm_phase<EpiY, pg8::StaticOrder, true, true>(ldsL, g, S, E);
            }
            GRID_BAR();
            ph_ln<0, 1>(p, p.in[IN_LN_FFN_G] + l * DM, p.in[IN_LN_FFN_B] + l * DM, xin0, p.X, p.Xb, false);
            GRID_BAR();
        } else {
            ph_slots(p, lds);
            GRID_BAR();
            __syncthreads();
            for (int i = tid_(); i < NTILE256; i += NT) ((LAS int*)((LAS unsigned char*)lds + MOE_TE_LDS))[i] = p.tile_e[i];
            __syncthreads();
#pragma unroll 1
            for (int hf = 0; hf < 3; ++hf) {
                const int t0 = hf * 128, ntr = (hf < 2) ? 128 : NTILE256 - 256;
                if (G == 256) {
                    EpiGU E{p.Hm, F_EXPERT, 2 * F_EXPERT / 256, t0};
#pragma unroll 1
                    for (int rb = 0; rb < (hf < 2 ? 2 : 1); ++rb) {
                        pg8::Gemm g{p.Xb, p.WguM, NSLOT, 2 * F_EXPERT, DM}; MoeOrderG S{t0, ntr, 2 * F_EXPERT / 256, G, cB, rb, p.slot_tok};
                        pg8::gemm_phase<EpiGU, MoeOrderG, true, true>(ldsL, g, S, E);
                        __syncthreads();
                    }
                } else {
                    pg8::Gemm g{p.Xs, p.WguM, NSLOT, 2 * F_EXPERT, DM}; MoeOrder S{t0, ntr, 2 * F_EXPERT / 256, G, cB};
                    EpiGU E{p.Hm, F_EXPERT, 2 * F_EXPERT / 256, t0};
                    pg8::gemm_phase<EpiGU, MoeOrder, true, true>(ldsL, g, S, E);
                }
                GRID_BAR();
                if (hf < 2) {
                    pg8::Gemm g{p.Hm - (size_t)t0 * 256 * F_EXPERT, p.WdM, NSLOT, DM, F_EXPERT}; MoeOrder S{t0, ntr, DM / 256, G, cB};
                    EpiDownMoe E{p.Ys, p.slot_gate};
                    pg8::gemm_phase<EpiDownMoe, MoeOrder, true, true>(ldsL, g, S, E);
                } else {
                    pg8::Gemm g{p.Hm - (size_t)t0 * 256 * F_EXPERT, p.WdM, NSLOT, DM, MOE_KSL_K, F_EXPERT}; TailOrder S{G, cB};
                    EpiDownTail E{p.Yp, p.slot_gate};
                    pg8::gemm_phase<EpiDownTail, TailOrder, true, true>(ldsL, g, S, E);
                }
                GRID_BAR();
            }
            ph_ln<1, 1>(p, p.in[IN_LN_FFN_G] + l * DM, p.in[IN_LN_FFN_B] + l * DM, xin0, p.X, p.Xb, l == 3);
            GRID_BAR();
        }
    }
    if (xb_ld(&p.bar[XB_TMO])) { for (int i = blockIdx.x * NT + threadIdx.x; i < NTOK * DM; i += gridDim.x * NT) p.X[i] = __builtin_nanf(""); }
}

extern "C" void kernel_launch(void* const* d_in, const int* in_sizes, int n_in, void* d_out, int out_size, void* d_ws, size_t ws_size, hipStream_t stream) {
    Params p; memset(&p, 0, sizeof(p));
    for (int i = 0; i < 23; ++i) p.in[i] = (const float*)d_in[i];
    p.X = (float*)d_out;
    unsigned char* w = (unsigned char*)d_ws; size_t off = 0;
    auto take = [&](size_t bytes) { unsigned char* r = w + off; off += (bytes + 255) / 256 * 256; return r; };
    p.bar = (unsigned*)take(16384);
    p.ropecs = (float*)take(4096 * 32 * 2 * 4);
    p.IW = (float*)take((size_t)NTOK * 4 * 4);
    p.BM = (unsigned long long*)take((size_t)NTOK * 64 * 8);
    p.GATES = (float*)take((size_t)NTOK * 24 * 4);
    p.kmean = (float*)take(8 * 16 * 8 * 64 * 4);
    p.cmpk = (float*)take(8 * 256 * 2 * 64 * 4);
    p.cmpv = (float*)take(8 * 256 * 2 * 64 * 4);
    p.tok_e = (int*)take(NTOK * 2 * 4);
    p.tok_g = (float*)take(NTOK * 2 * 4);
    p.tok_slot = (int*)take(NTOK * 2 * 4);
    p.slot_tok = (int*)take(NSLOT * 4);
    p.slot_gate = (float*)take(NSLOT * 4);
    p.chunk_cnt = (int*)take(256 * 8 * 4);
    p.tile_e = (int*)take(NTILE256 * 4);
    p.W1T = (bf16_t*)take((size_t)2 * 2 * 256 * 2048 * 2);
    p.W2T = (bf16_t*)take((size_t)2 * 2 * 256 * 256 * 2);
    p.CMP = (bf16_t*)take((size_t)8192 * 64 * 2);
    p.WinE = (bf16_t*)take((size_t)2 * NP_EVEN * DM * 2);
    p.WoutE = (bf16_t*)take((size_t)2 * DM * DM * 2);
    p.WguD = (bf16_t*)take((size_t)2 * 2 * F_DENSE * DM * 2);
    p.WdD = (bf16_t*)take((size_t)2 * DM * F_DENSE * 2);
    p.WinO = (bf16_t*)take((size_t)2 * NP_ODD * DM * 2);
    p.WoutO = (bf16_t*)take((size_t)2 * DM * DM * 2);
    p.WguM = (bf16_t*)take((size_t)N_EXP * 2 * F_EXPERT * DM * 2);
    p.WdM = (bf16_t*)take((size_t)N_EXP * DM * F_EXPERT * 2);
    p.Xb = (bf16_t*)take((size_t)(NTOK + 1) * DM * 2);
    unsigned char* R = w + off;
    {   size_t o = 0; auto tk = [&](size_t bytes) { unsigned char* r = R + o; o += (bytes + 255) / 256 * 256; return r; };
        p.Pb = (bf16_t*)tk((size_t)NTOK * LDPB * 2); p.H = p.Pb;
        p.Ob = (bf16_t*)tk((size_t)NTOK * DM * 2);
        p.QRb = (bf16_t*)tk((size_t)NTOK * 512 * 2);
        p.Y = (float*)tk((size_t)NTOK * DM * 4);
        p.Ac = (bf16_t*)p.Y; p.Hc = p.Ac + (size_t)2 * 4096 * 2048; }
    {   size_t o = 0; auto tk = [&](size_t bytes) { unsigned char* r = R + o; o += (bytes + 255) / 256 * 256; return r; };
        p.Xs = (bf16_t*)tk((size_t)NSLOT * DM * 2);
        p.Hm = (bf16_t*)tk((size_t)MOE_HALF_TILES * 256 * F_EXPERT * 2);
        p.Ys = (bf16_t*)tk((size_t)NSLOT * DM * 2);
        p.Yp = p.Hm + (size_t)16 * 256 * F_EXPERT; }
    p.lam_init[0] = (float)(0.8 - 0.6 * exp(-0.3 * 0.0));
    p.lam_init[1] = (float)(0.8 - 0.6 * exp(-0.3 * 2.0));
    constexpr int kDynLds = LDS_BYTES + 16;
    static int grid = 0;
    if (!grid) {
        int dev = 0, cus = 0, per_cu = 0;
        (void)hipGetDevice(&dev);
        (void)hipDeviceGetAttribute(&cus, hipDeviceAttributeMultiprocessorCount, dev);
        (void)hipFuncSetAttribute((const void*)mega, hipFuncAttributeMaxDynamicSharedMemorySize, kDynLds);
        (void)hipOccupancyMaxActiveBlocksPerMultiprocessor(&per_cu, (const void*)mega, NT, kDynLds);
        if (cus <= 0) cus = 256;
        grid = cus;
    }
    (void)hipMemsetAsync(p.bar, 0, XCD_BAR_WORDS * sizeof(unsigned), stream);
    mega<<<grid, NT, kDynLds, stream>>>(p);
}
```

```cpp
#include <hip/hip_runtime.h>
#include <stdint.h>
#include <string.h>
#include <math.h>

__device__ __forceinline__ int tid_() { int t = threadIdx.x; asm volatile("" : "+v"(t)); return t; }
__device__ __forceinline__ float zero1_() { float z = 0.f; asm volatile("" : "+v"(z)); return z; }
namespace pg8 {
#define PG8_LAS __attribute__((address_space(3)))
typedef unsigned short bf16_t;
typedef short bf16x8 __attribute__((ext_vector_type(8)));
typedef float f32x4 __attribute__((ext_vector_type(4)));
typedef unsigned u32x4 __attribute__((ext_vector_type(4)));
constexpr int BM = 256, BK = 64, HALF = 128, HTB = HALF * BK * 2  , STAGE_BYTES = 8 * HTB, NXCD = 8, WGM = 8;

__host__ __device__ __forceinline__ int lds_byte(int r, int c) { const int st = (r >> 4) * 2 + (c >> 5), rr = r & 15, cc = c & 31, ob = rr * 64 + cc * 2; return st * 1024 + (ob ^ (((ob >> 9) & 1) << 5)); }
__host__ __device__ __forceinline__ void stage_rc(int b, int& R, int& C) { const int st = b / 1024, sb = b % 1024, swz = sb ^ (((sb >> 9) & 1) << 5); R = (st >> 1) * 16 + swz / 64; C = (st & 1) * 32 + (swz % 64) / 2; }
__host__ __device__ __forceinline__ int perm32(int rho) { const int n = rho >> 4, i = rho & 15; return 8 * (i >> 2) + 4 * n + (i & 3); }

struct Unit { int pm, pn, ko; };
struct Gemm { const bf16_t* A; const bf16_t* Bt; int M, N, K, ld; };

struct StaticOrder {
    static constexpr bool KSPLIT = false, GATHER_A = false;
    int nM, nN, nwg, G, c;
    __host__ __device__ void init(int M, int N, int G_, int c_) { nM = M / BM; nN = N / BM; nwg = nM * nN; G = G_; c = c_; }
    __host__ __device__ bool next(int i, Unit& u) const {
        const long L = (long)i * G + c; if (L >= nwg) return false;
        int wgid = (int)L; { const int q = nwg / NXCD, r = nwg % NXCD, xcd = wgid % NXCD, off = wgid / NXCD; wgid = (xcd < r ? xcd * (q + 1) : r * (q + 1) + (xcd - r) * q) + off; }
        const int nig = WGM * nN, gid = wgid / nig, fm = gid * WGM, gsz = (nM - fm) < WGM ? (nM - fm) : WGM;
        u.pm = fm + ((wgid % nig) % gsz); u.pn = (wgid % nig) / gsz; return true;
    }
    __device__ __forceinline__ void a_ready(const Unit&) const {}
    __device__ __forceinline__ void done(const Unit&) const {}
};

__device__ __forceinline__ unsigned cvt_pk_bf16(float lo, float hi) { unsigned r; asm volatile("v_cvt_pk_bf16_f32 %0, %1, %2" : "=v"(r) : "v"(lo), "v"(hi)); return r; }
typedef float f32x2 __attribute__((ext_vector_type(2)));
template <class Epi, class Sched, bool ALIGN_EPI = false, bool SP2 = false>
__device__ __forceinline__ void gemm_phase(PG8_LAS unsigned char* lds, const Gemm g, const Sched& S, const Epi& E) {
    const int tid = tid_(), wid = __builtin_amdgcn_readfirstlane(tid >> 6), lane = tid & 63, wr = wid >> 2, wc = wid & 3, fr = lane & 15, fq = lane >> 4;
    const int K = g.K, nt = K / BK, LD = g.ld ? g.ld : K;
    unsigned voffA[2], voffB[2];
#pragma unroll
    for (int i = 0; i < 2; ++i) { int R, C; stage_rc(tid * 16 + i * 8192, R, C); const int Rb = Epi::PERM ? ((R & ~31) + perm32(R & 31)) : R;
        voffA[i] = (unsigned)(R * LD + C) * 2u; voffB[i] = (unsigned)(Rb * LD + C) * 2u; }
    const size_t kstep = (size_t)(BK * 2);
    const size_t hstep = (size_t)HALF * LD * 2;
    const size_t tstep = 2 * hstep;
    const unsigned ldsw = (unsigned)wid * 1024u;
    const int aoff = lds_byte(wr * 64 + fr, fq * 8), boff = lds_byte(wc * 32 + fr, fq * 8);
#define PG8_SA(b, h) (((b) * 2 + (h)) * HTB)
#define PG8_SB(b, h) ((4 + (b) * 2 + (h)) * HTB)
#define PG8_STAGE(bufoff, gbase, voff) do { _Pragma("unroll") for (int _i = 0; _i < 2; ++_i) \
        __builtin_amdgcn_global_load_lds((const unsigned*)((const char*)(gbase) + (voff)[_i]), (PG8_LAS unsigned*)(lds + (bufoff) + ldsw + _i * 8192), 16, 0, 0); } while (0)
#define PG8_LDA(dst, b, h) do { _Pragma("unroll") for (int m = 0; m < 4; ++m) _Pragma("unroll") for (int k = 0; k < 2; ++k) dst[m][k] = *(const PG8_LAS bf16x8*)(lds + PG8_SA(b, h) + aoff + m * 2048 + k * 1024); } while (0)
#define PG8_LDB(dst, b, h) do { _Pragma("unroll") for (int n = 0; n < 2; ++n) _Pragma("unroll") for (int k = 0; k < 2; ++k) dst[n][k] = *(const PG8_LAS bf16x8*)(lds + PG8_SB(b, h) + boff + n * 2048 + k * 1024); } while (0)
#define PG8_MMA(ai, bj, At, Bt) do { __builtin_amdgcn_s_setprio(1); _Pragma("unroll") for (int m = 0; m < 4; ++m) _Pragma("unroll") for (int n = 0; n < 2; ++n) _Pragma("unroll") for (int k = 0; k < 2; ++k) \
        acc[ai][bj][m][n] = __builtin_amdgcn_mfma_f32_16x16x32_bf16(Bt[n][k], At[m][k], acc[ai][bj][m][n], 0, 0, 0); __builtin_amdgcn_s_setprio(0); } while (0)
#define PG8_WAIT_V(n) asm volatile("s_waitcnt vmcnt(" #n ")" ::: "memory")
#define PG8_WAIT_L(n) asm volatile("s_waitcnt lgkmcnt(" #n ")" ::: "memory")
#define PG8_BAR __builtin_amdgcn_s_barrier()
#define PG8_SCHED __builtin_amdgcn_sched_barrier(0)
    Unit cur, nxt; int ui = 0;
    if (!S.next(0, cur)) return;
    unsigned voffA1[2]; size_t hstepA = hstep;
#pragma unroll
    for (int i = 0; i < 2; ++i) voffA1[i] = voffA[i];
    if constexpr (Sched::GATHER_A) {
        hstepA = 0;
#pragma unroll
        for (int i = 0; i < 2; ++i) { int R, C; stage_rc(tid * 16 + i * 8192, R, C);
            voffA[i] = (unsigned)(S.arow(cur.pm * 256 + R) * LD + C) * 2u; voffA1[i] = (unsigned)(S.arow(cur.pm * 256 + 128 + R) * LD + C) * 2u; }
    }
    f32x4 acc[2][2][4][2];
#pragma unroll
    for (int a = 0; a < 2; ++a)
#pragma unroll
        for (int b = 0; b < 2; ++b)
#pragma unroll
            for (int m = 0; m < 4; ++m)
#pragma unroll
                for (int n = 0; n < 2; ++n) acc[a][b][m][n] = ([]() { const float z = zero1_(); return (f32x4){z, z, z, z}; }());
    bf16x8 At[4][2], B0[2][2], B1[2][2];
    const char* cA = (const char*)g.A + (Sched::GATHER_A ? (size_t)0 : (size_t)cur.pm * tstep); const char* cB = (const char*)g.Bt + (size_t)cur.pn * tstep;
    if constexpr (Sched::KSPLIT) { cA += (size_t)cur.ko * 2; cB += (size_t)cur.ko * 2; }
    S.a_ready(cur);
    if constexpr (SP2) {
        PG8_STAGE(PG8_SB(0, 0), cB, voffB); PG8_STAGE(PG8_SB(0, 1), cB + hstep, voffB); PG8_STAGE(PG8_SA(0, 0), cA, voffA); PG8_STAGE(PG8_SA(0, 1), cA + hstepA, voffA1);
        if (wr == 1) PG8_BAR;
        PG8_WAIT_V(2); PG8_BAR;
        PG8_STAGE(PG8_SB(1, 0), cB + kstep, voffB); PG8_STAGE(PG8_SA(1, 0), cA + kstep, voffA); PG8_STAGE(PG8_SB(1, 1), cB + hstep + kstep, voffB);
        PG8_WAIT_V(6); PG8_BAR;
    } else {
        PG8_STAGE(PG8_SB(0, 0), cB, voffB); PG8_STAGE(PG8_SA(0, 0), cA, voffA); PG8_STAGE(PG8_SB(0, 1), cB + hstep, voffB); PG8_STAGE(PG8_SA(0, 1), cA + hstepA, voffA1);
        if (wr == 1) PG8_BAR;
        PG8_WAIT_V(4); PG8_BAR;
        PG8_STAGE(PG8_SB(1, 0), cB + kstep, voffB); PG8_STAGE(PG8_SA(1, 0), cA + kstep, voffA); PG8_STAGE(PG8_SB(1, 1), cB + hstep + kstep, voffB);
        PG8_WAIT_V(6); PG8_BAR;
    }
    for (;;) {
        const bool has_next = S.next(ui + 1, nxt);
        const char* nA = has_next ? (const char*)g.A + (Sched::GATHER_A ? (size_t)0 : (size_t)nxt.pm * tstep) : cA; const char* nB = has_next ? (const char*)g.Bt + (size_t)nxt.pn * tstep : cB;
        if constexpr (Sched::KSPLIT) { if (has_next) { nA += (size_t)nxt.ko * 2; nB += (size_t)nxt.ko * 2; } }
        for (int t = 0; t < nt; t += 2) {
            const bool last = (t == nt - 2);
            const char* a1 = cA + (size_t)(t + 1) * kstep;
            const char* a2 = last ? nA : cA + (size_t)(t + 2) * kstep; const char* b2 = last ? nB : cB + (size_t)(t + 2) * kstep;
            const char* a3 = a2 + kstep; const char* b3 = b2 + kstep;
            if (last && has_next) S.a_ready(nxt);
            if constexpr (SP2) {
            PG8_LDB(B0, 0, 0); PG8_LDB(B1, 0, 1); PG8_SCHED; PG8_LDA(At, 0, 0); PG8_STAGE(PG8_SA(1, 1), a1 + hstepA, voffA1);
            PG8_WAIT_V(8); PG8_WAIT_L(0); PG8_BAR; PG8_MMA(0, 0, At, B0); PG8_MMA(0, 1, At, B1); PG8_BAR; PG8_SCHED;
            PG8_LDA(At, 0, 1); PG8_STAGE(PG8_SB(0, 0), b2, voffB); PG8_STAGE(PG8_SB(0, 1), b2 + hstep, voffB); PG8_STAGE(PG8_SA(0, 0), a2, voffA);
            PG8_WAIT_V(8); PG8_WAIT_L(0); PG8_BAR; PG8_MMA(1, 0, At, B0); PG8_MMA(1, 1, At, B1); PG8_BAR; PG8_SCHED;
            PG8_LDB(B0, 1, 0); PG8_LDB(B1, 1, 1); PG8_SCHED; PG8_LDA(At, 1, 0); PG8_STAGE(PG8_SA(0, 1), a2 + hstepA, voffA1);
            PG8_WAIT_V(8); PG8_WAIT_L(0); PG8_BAR; PG8_MMA(0, 0, At, B0); PG8_MMA(0, 1, At, B1); PG8_BAR; PG8_SCHED;
            PG8_LDA(At, 1, 1); PG8_STAGE(PG8_SB(1, 0), b3, voffB); PG8_STAGE(PG8_SB(1, 1), b3 + hstep, voffB); PG8_STAGE(PG8_SA(1, 0), a3, voffA);
            PG8_WAIT_V(8); PG8_WAIT_L(0); PG8_BAR; PG8_MMA(1, 0, At, B0); PG8_MMA(1, 1, At, B1); PG8_BAR; PG8_SCHED;
            } else {
            PG8_LDB(B0, 0, 0); PG8_SCHED; PG8_LDA(At, 0, 0); PG8_STAGE(PG8_SA(1, 1), a1 + hstepA, voffA1);
            PG8_WAIT_L(8); PG8_BAR; PG8_WAIT_L(0); PG8_MMA(0, 0, At, B0); PG8_BAR; PG8_SCHED;
            PG8_LDB(B1, 0, 1); PG8_STAGE(PG8_SB(0, 0), b2, voffB);
            PG8_BAR; PG8_WAIT_L(0); PG8_MMA(0, 1, At, B1); PG8_BAR;
            PG8_LDA(At, 0, 1); PG8_STAGE(PG8_SA(0, 0), a2, voffA);
            PG8_BAR; PG8_WAIT_L(0); PG8_MMA(1, 0, At, B0); PG8_BAR; PG8_SCHED;
            PG8_STAGE(PG8_SB(0, 1), b2 + hstep, voffB);
            PG8_WAIT_V(6); PG8_BAR; PG8_MMA(1, 1, At, B1); PG8_BAR;
            PG8_LDB(B0, 1, 0); PG8_SCHED; PG8_LDA(At, 1, 0); PG8_STAGE(PG8_SA(0, 1), a2 + hstepA, voffA1);
            PG8_WAIT_L(8); PG8_BAR; PG8_WAIT_L(0); PG8_MMA(0, 0, At, B0); PG8_BAR; PG8_SCHED;
            PG8_LDB(B1, 1, 1); PG8_STAGE(PG8_SB(1, 0), b3, voffB);
            PG8_BAR; PG8_WAIT_L(0); PG8_MMA(0, 1, At, B1); PG8_BAR;
            PG8_LDA(At, 1, 1); PG8_STAGE(PG8_SA(1, 0), a3, voffA);
            PG8_BAR; PG8_WAIT_L(0); PG8_MMA(1, 0, At, B0); PG8_BAR; PG8_SCHED;
            PG8_STAGE(PG8_SB(1, 1), b3 + hstep, voffB);
            PG8_WAIT_V(6); PG8_BAR; PG8_MMA(1, 1, At, B1); PG8_BAR;
            }
        }
        if constexpr (ALIGN_EPI) { if (wr == 0) PG8_BAR; }
        if constexpr (!Epi::AFTER_DRAIN) { E(acc, cur, wr, wc, fr, fq); S.done(cur); }
        if (!has_next) break;
#pragma unroll
        for (int a = 0; a < 2; ++a)
#pragma unroll
            for (int b = 0; b < 2; ++b)
#pragma unroll
                for (int m = 0; m < 4; ++m)
#pragma unroll
                    for (int n = 0; n < 2; ++n) acc[a][b][m][n] = ([]() { const float z = zero1_(); return (f32x4){z, z, z, z}; }());
        cur = nxt; cA = nA; cB = nB; ++ui;
        if constexpr (ALIGN_EPI) { if (wr == 1) PG8_BAR; }
    }
    PG8_WAIT_V(0);
    if constexpr (!ALIGN_EPI) { if (wr == 0) PG8_BAR; }
    PG8_BAR;
    if constexpr (Epi::AFTER_DRAIN) { E.fused(acc, cur, wr, wc, fr, fq, lds, wid, lane); S.done(cur); }
#undef PG8_SA
#undef PG8_SB
#undef PG8_STAGE
#undef PG8_LDA
#undef PG8_LDB
#undef PG8_MMA
#undef PG8_WAIT_V
#undef PG8_WAIT_L
#undef PG8_BAR
#undef PG8_SCHED
}
}
using pg8::bf16_t; using pg8::f32x4; using pg8::Unit;
typedef unsigned u32x2 __attribute__((ext_vector_type(2)));

#define NT 512
#define Z4_ ([]() { const float z = zero1_(); return (f32x4){z, z, z, z}; }())
#define LAS __attribute__((address_space(3)))
constexpr int NTOK = 32768, DM = 1024, SEQ = 4096;
constexpr int LDPB = 3072;
constexpr float ALPHA = 1.681792830507429f;
constexpr float LN_EPS = 1e-5f;
constexpr int E_AQ = 0, E_AK = 512, E_AV = 1024, E_BQ = 1536, E_BK = 2048, E_BV = 2176, E_IQ = 2304, E_IK = 2560, E_IW = 2624, P_EVEN = 2628, NP_EVEN = 2816;
constexpr int O_CQ = 0, O_CK = 512, O_CV = 1024, O_DQ = 1536, O_KC = 2048, O_VC = 2176, O_KS = 2304, O_VS = 2432, O_KW = 2560, O_VW = 2688, O_DG = 2816, P_ODD = 2840, NP_ODD = 3072;
constexpr int F_DENSE = 2816, F_EXPERT = 3584, N_EXP = 8;
constexpr int NSLOT = 65536 + 8 * 256;
constexpr int NTILE256 = NSLOT / 256;
constexpr int MOE_HALF_TILES = NTILE256 / 2;
constexpr int LDS_BYTES = 147456;

__constant__ float c_inv[32] = {1.0f, 0.7498942613601685f, 0.5623413324356079f, 0.4216965138912201f, 0.3162277638912201f, 0.23713737726211548f, 0.17782793939113617f, 0.133352130651474f,
    0.10000000149011612f, 0.07498941570520401f, 0.05623413249850273f, 0.04216965287923813f, 0.03162277489900589f, 0.023713737726211548f, 0.017782794311642647f, 0.01333521492779255f,
    0.009999999776482582f, 0.007498941849917173f, 0.005623413249850273f, 0.0042169648222625256f, 0.003162277629598975f, 0.00237137358635664f, 0.0017782794311642647f, 0.0013335214462131262f,
    0.0010000000474974513f, 0.0007498942431993783f, 0.000562341301701963f, 0.0004216965171508491f, 0.0003162277571391314f, 0.00023713737027719617f, 0.00017782794020604342f, 0.0001333521504420787f};

struct Params {
    const float* in[23];
    float* X;
    bf16_t* Xb;
    bf16_t* Pb;
    bf16_t* Ob;
    bf16_t* QRb;
    float* Y;
    bf16_t* H;
    bf16_t* Xs;
    bf16_t* Hm;
    bf16_t* Ys;
    bf16_t* Yp;
    bf16_t* W1T; bf16_t* W2T;
    bf16_t* Ac; bf16_t* Hc; bf16_t* CMP;
    bf16_t* WinE; bf16_t* WoutE; bf16_t* WguD; bf16_t* WdD; bf16_t* WinO; bf16_t* WoutO; bf16_t* WguM; bf16_t* WdM;
    float* ropecs;
    float* IW;
    unsigned long long* BM;
    float* GATES;
    float* kmean;
    float* cmpk;
    float* cmpv;
    int* tok_e; float* tok_g; int* tok_slot; int* slot_tok; float* slot_gate; int* chunk_cnt; int* tile_e;
    unsigned* bar;
    float lam_init[2];
};

enum { IN_X = 0, IN_EV_WIN, IN_EV_WOUT, IN_DIF_LAMBDA, IN_DIF_SUBLN, IN_FFD_WG, IN_FFD_WU, IN_FFD_WD, IN_OD_WIN, IN_OD_WOUT, IN_NSA_GATE_B, IN_NSA_PE, IN_NSA_W1, IN_NSA_W2,
       IN_MOE_WR, IN_MOE_BR, IN_MOE_WG, IN_MOE_WU, IN_MOE_WD, IN_LN_MIX_G, IN_LN_MIX_B, IN_LN_FFN_G, IN_LN_FFN_B };

__device__ __forceinline__ float bf2f(bf16_t u) { return __builtin_bit_cast(float, (unsigned)u << 16); }
__device__ __forceinline__ unsigned pk2(float lo, float hi) { return pg8::cvt_pk_bf16(lo, hi); }
__device__ __forceinline__ bf16_t f2bf(float f) { return (bf16_t)(pg8::cvt_pk_bf16(f, 0.f) & 0xffffu); }
__device__ __forceinline__ float wave_max(float v) {
#pragma unroll
    for (int o = 32; o >= 1; o >>= 1) v = fmaxf(v, __shfl_xor(v, o));
    return v;
}
__device__ __forceinline__ float wave_sum(float v) {
#pragma unroll
    for (int o = 32; o >= 1; o >>= 1) v += __shfl_xor(v, o);
    return v;
}
__device__ __forceinline__ int wave_sumi(int v) {
#pragma unroll
    for (int o = 32; o >= 1; o >>= 1) v += __shfl_xor(v, o);
    return v;
}
__device__ __forceinline__ float rl_f(float v, int l) { return __builtin_bit_cast(float, __builtin_amdgcn_readlane(__builtin_bit_cast(int, v), l)); }
__device__ __forceinline__ int lane_rank(unsigned long long m) { return __builtin_amdgcn_mbcnt_hi((unsigned)(m >> 32), __builtin_amdgcn_mbcnt_lo((unsigned)m, 0)); }

#define EPI_LOOP_BEGIN \
    _Pragma("unroll") for (int ai = 0; ai < 2; ++ai) _Pragma("unroll") for (int m = 0; m < 4; ++m) { const int rloc = ai * 128 + wr * 64 + m * 16 + fr; \
    _Pragma("unroll") for (int bj = 0; bj < 2; ++bj) _Pragma("unroll") for (int n = 0; n < 2; ++n) { const int cloc = bj * 128 + wc * 32 + n * 16 + fq * 4; const f32x4 v = acc[ai][bj][m][n];
#define EPI_LOOP_END } }

struct EpiInEven {
    static constexpr bool PERM = false, AFTER_DRAIN = false;
    bf16_t* Pb; float* IW; const float* cs;
    __device__ __forceinline__ void operator()(const f32x4 (&acc)[2][2][4][2], const Unit& u, int wr, int wc, int fr, int fq) const {
        EPI_LOOP_BEGIN
            const int row = u.pm * 256 + rloc, c0 = u.pn * 256 + cloc, pos = row & (SEQ - 1);
            if (c0 < P_EVEN) {
                if (c0 == E_IW) { *(f32x4*)(IW + (size_t)row * 4) = v; }
                else {
                    f32x4 o = v;
                    const bool rope = (c0 < 1024) || (c0 >= 1536 && c0 < 2176) || (c0 >= 2304 && c0 < 2624);
                    if (rope) { const f32x4 t = *(const f32x4*)(cs + ((size_t)pos * 32 + ((c0 & 63) >> 1)) * 2);
                        o[0] = v[0] * t[0] - v[1] * t[1]; o[1] = v[1] * t[0] + v[0] * t[1]; o[2] = v[2] * t[2] - v[3] * t[3]; o[3] = v[3] * t[2] + v[2] * t[3]; }
                    u32x2 w; w.x = pk2(o[0], o[1]); w.y = pk2(o[2], o[3]);
                    *(u32x2*)(Pb + (size_t)row * LDPB + c0) = w;
                }
            }
        EPI_LOOP_END
    }
};
struct EpiInOdd {
    static constexpr bool PERM = false, AFTER_DRAIN = false;
    bf16_t* Pb; bf16_t* QRb; float* G; const float* cs; const float* gb;
    __device__ __forceinline__ void operator()(const f32x4 (&acc)[2][2][4][2], const Unit& u, int wr, int wc, int fr, int fq) const {
        EPI_LOOP_BEGIN
            const int row = u.pm * 256 + rloc, c0 = u.pn * 256 + cloc, pos = row & (SEQ - 1);
            if (c0 < P_ODD) {
                if (c0 >= O_DG) {
                    const int j = c0 - O_DG; f32x4 o;
#pragma unroll
                    for (int e = 0; e < 4; ++e) o[e] = 1.f / (1.f + expf(-(v[e] + gb[j + e])));
                    *(f32x4*)(G + (size_t)row * 24 + j) = o;
                } else {
                    const bool isq = (c0 >= O_DQ && c0 < O_KC);
                    const bool rope = (c0 < 1024) || isq || (c0 >= O_KS && c0 < O_VS) || (c0 >= O_KW && c0 < O_VW);
                    f32x4 o = v;
                    if (rope) { const f32x4 t = *(const f32x4*)(cs + ((size_t)pos * 32 + ((c0 & 63) >> 1)) * 2);
                        o[0] = v[0] * t[0] - v[1] * t[1]; o[1] = v[1] * t[0] + v[0] * t[1]; o[2] = v[2] * t[2] - v[3] * t[3]; o[3] = v[3] * t[2] + v[2] * t[3]; }
                    u32x2 w; w.x = pk2(o[0], o[1]); w.y = pk2(o[2], o[3]);
                    if (isq) { *(u32x2*)(QRb + (size_t)row * 512 + (c0 - O_DQ)) = w; w.x = pk2(v[0], v[1]); w.y = pk2(v[2], v[3]); }
                    *(u32x2*)(Pb + (size_t)row * LDPB + c0) = w;
                }
            }
        EPI_LOOP_END
    }
};
struct EpiY {
    static constexpr bool PERM = false, AFTER_DRAIN = false;
    bf16_t* Y;
    __device__ __forceinline__ void operator()(const f32x4 (&acc)[2][2][4][2], const Unit& u, int wr, int wc, int fr, int fq) const {
        EPI_LOOP_BEGIN
            u32x2 w; w.x = pk2(v[0], v[1]); w.y = pk2(v[2], v[3]);
            *(u32x2*)(Y + (size_t)(u.pm * 256 + rloc) * DM + u.pn * 256 + cloc) = w;
        EPI_LOOP_END
    }
};
struct EpiGU {
    static constexpr bool PERM = false, AFTER_DRAIN = false;
    bf16_t* H; int ldh; int npn; int row_tile0;
    __device__ __forceinline__ void operator()(const f32x4 (&acc)[2][2][4][2], const Unit& u, int wr, int wc, int fr, int fq) const {
        const int pnl = u.pn % npn;
#pragma unroll
        for (int ai = 0; ai < 2; ++ai)
#pragma unroll
            for (int m = 0; m < 4; ++m) { const int rloc = ai * 128 + wr * 64 + m * 16 + fr;
                bf16_t* hrow = H + (size_t)((u.pm - row_tile0) * 256 + rloc) * ldh;
#pragma unroll
                for (int bj = 0; bj < 2; ++bj) { const f32x4 g = acc[ai][bj][m][0], uu = acc[ai][bj][m][1];
                    const int unit0 = (pnl * 256 + bj * 128 + wc * 32) / 2 + fq * 4;
                    f32x4 o;
#pragma unroll
                    for (int e = 0; e < 4; ++e) o[e] = g[e] * __builtin_amdgcn_rcpf(1.f + __expf(-g[e])) * uu[e];
                    u32x2 w; w.x = pk2(o[0], o[1]); w.y = pk2(o[2], o[3]);
                    *(u32x2*)(hrow + unit0) = w; } }
    }
};
struct EpiDownMoe {
    static constexpr bool PERM = false, AFTER_DRAIN = false;
    bf16_t* Ys; const float* sg;
    __device__ __forceinline__ void operator()(const f32x4 (&acc)[2][2][4][2], const Unit& u, int wr, int wc, int fr, int fq) const {
        const int pnl = u.pn & 3;
        float gts[2][4];
#pragma unroll
        for (int ai = 0; ai < 2; ++ai)
#pragma unroll
            for (int m = 0; m < 4; ++m) gts[ai][m] = sg[u.pm * 256 + ai * 128 + wr * 64 + m * 16 + fr];
#pragma unroll
        for (int ai = 0; ai < 2; ++ai)
#pragma unroll
            for (int m = 0; m < 4; ++m) { const int slot = u.pm * 256 + ai * 128 + wr * 64 + m * 16 + fr; const float gt = gts[ai][m];
#pragma unroll
                for (int bj = 0; bj < 2; ++bj)
#pragma unroll
                    for (int n = 0; n < 2; ++n) { const f32x4 v = acc[ai][bj][m][n] * gt; const int c0 = pnl * 256 + bj * 128 + wc * 32 + n * 16 + fq * 4;
                        u32x2 w; w.x = pk2(v[0], v[1]); w.y = pk2(v[2], v[3]);
                        *(u32x2*)(Ys + (size_t)slot * DM + c0) = w; } }
    }
};
struct EpiGeluH {
    static constexpr bool PERM = false, AFTER_DRAIN = false;
    bf16_t* Hc;
    __device__ __forceinline__ void operator()(const f32x4 (&acc)[2][2][4][2], const Unit& u, int wr, int wc, int fr, int fq) const {
        EPI_LOOP_BEGIN
            f32x4 o;
#pragma unroll
            for (int e = 0; e < 4; ++e) { const float x = v[e], uu = 0.7978845608028654f * (x + 0.044715f * x * x * x); o[e] = x - x * __builtin_amdgcn_rcpf(1.f + __expf(2.f * uu)); }
            u32x2 w; w.x = pk2(o[0], o[1]); w.y = pk2(o[2], o[3]);
            *(u32x2*)(Hc + (size_t)(u.pm * 256 + rloc) * 256 + cloc) = w;
        EPI_LOOP_END
    }
};
struct EpiCmp {
    static constexpr bool PERM = false, AFTER_DRAIN = false;
    bf16_t* C;
    __device__ __forceinline__ void operator()(const f32x4 (&acc)[2][2][4][2], const Unit& u, int wr, int wc, int fr, int fq) const {
        EPI_LOOP_BEGIN
            if (cloc < 64) { u32x2 w; w.x = pk2(v[0], v[1]); w.y = pk2(v[2], v[3]); *(u32x2*)(C + (size_t)(u.pm * 256 + rloc) * 64 + cloc) = w; }
        EPI_LOOP_END
    }
};
struct ListOrder {
    static constexpr bool KSPLIT = false, GATHER_A = false;
    int n, G, c;
    __device__ __forceinline__ bool next(int i, Unit& u) const { const int L = i * G + c; if (L >= n) return false; u.pm = L; u.pn = L >> 4; return true; }
    __device__ __forceinline__ void a_ready(const Unit&) const {}
    __device__ __forceinline__ void done(const Unit&) const {}
};
constexpr int MOE_TE_LDS = 139264;
struct MoeOrder {
    static constexpr bool KSPLIT = false, GATHER_A = false;
    int t0, ntr, npn, G, c;
    __device__ __forceinline__ bool next(int i, Unit& u) const {
        extern __shared__ __attribute__((aligned(16))) float lds_dyn_[];
        int tm, pl;
        if (G == 256 && ntr == 128) {
            const int x = c & 7, j = c >> 3, ncb = npn >> 2, nrounds = 2 * ncb;
            if (i >= nrounds) return false;
            const int rb = i / ncb, cb = i - rb * ncb;
            tm = t0 + 16 * x + 8 * rb + (j >> 2); pl = 4 * cb + (j & 3);
        } else {
            const int L = i * G + c; if (L >= ntr * npn) return false;
            tm = t0 + L / npn; pl = L % npn;
        }
        const int e = ((const LAS int*)((LAS unsigned char*)lds_dyn_ + MOE_TE_LDS))[tm];
        if (e < 0) return false;
        u.pm = tm; u.pn = e * npn + pl; return true;
    }
    __device__ __forceinline__ void a_ready(const Unit&) const {}
    __device__ __forceinline__ void done(const Unit&) const {}
};
struct MoeOrderG {
    static constexpr bool KSPLIT = false, GATHER_A = true;
    int t0, ntr, npn, G, c, rb; const int* slot_tok;
    __device__ __forceinline__ int arow(int slot) const { const int t = slot_tok[slot]; return t < 0 ? NTOK : t; }
    __device__ __forceinline__ bool next(int i, Unit& u) const {
        extern __shared__ __attribute__((aligned(16))) float lds_dyn_[];
        int tm, pl;
        if (ntr == 128) { const int x = c & 7, j = c >> 3, ncb = npn >> 2; if (i >= ncb) return false; tm = t0 + 16 * x + 8 * rb + (j >> 2); pl = 4 * i + (j & 3); }
        else { if (i > 0 || c >= ntr * npn) return false; tm = t0 + c / npn; pl = c % npn; }
        const int e = ((const LAS int*)((LAS unsigned char*)lds_dyn_ + MOE_TE_LDS))[tm];
        if (e < 0) return false;
        u.pm = tm; u.pn = e * npn + pl; return true;
    }
    __device__ __forceinline__ void a_ready(const Unit&) const {}
    __device__ __forceinline__ void done(const Unit&) const {}
};
constexpr int MOE_TAIL_T0 = 256, MOE_TAIL_TILES = NTILE256 - 256, MOE_KSL = 7, MOE_KSL_K = F_EXPERT / MOE_KSL;
struct TailOrder {
    static constexpr bool KSPLIT = true, GATHER_A = false;
    int G, c;
    __device__ __forceinline__ bool next(int i, Unit& u) const {
        extern __shared__ __attribute__((aligned(16))) float lds_dyn_[];
        const int L = i * G + c; if (L >= MOE_TAIL_TILES * 4 * MOE_KSL) return false;
        const int sl = L / (MOE_TAIL_TILES * 4), rem = L - sl * (MOE_TAIL_TILES * 4), tm = MOE_TAIL_T0 + (rem >> 2), pl = rem & 3;
        const int e = ((const LAS int*)((LAS unsigned char*)lds_dyn_ + MOE_TE_LDS))[tm];
        if (e < 0) return false;
        u.pm = tm; u.pn = e * 4 + pl; u.ko = sl * MOE_KSL_K; return true;
    }
    __device__ __forceinline__ void a_ready(const Unit&) const {}
    __device__ __forceinline__ void done(const Unit&) const {}
};
struct EpiDownTail {
    static constexpr bool PERM = false, AFTER_DRAIN = false;
    bf16_t* Yp; const float* sg;
    __device__ __forceinline__ void operator()(const f32x4 (&acc)[2][2][4][2], const Unit& u, int wr, int wc, int fr, int fq) const {
        const int pnl = u.pn & 3, sl = u.ko / MOE_KSL_K;
        float gts[2][4];
#pragma unroll
        for (int ai = 0; ai < 2; ++ai)
#pragma unroll
            for (int m = 0; m < 4; ++m) gts[ai][m] = sg[u.pm * 256 + ai * 128 + wr * 64 + m * 16 + fr];
#pragma unroll
        for (int ai = 0; ai < 2; ++ai)
#pragma unroll
            for (int m = 0; m < 4; ++m) { const int slot = u.pm * 256 + ai * 128 + wr * 64 + m * 16 + fr; const float gt = gts[ai][m];
                bf16_t* row = Yp + ((size_t)sl * (MOE_TAIL_TILES * 256) + (slot - MOE_TAIL_T0 * 256)) * DM;
#pragma unroll
                for (int bj = 0; bj < 2; ++bj)
#pragma unroll
                    for (int n = 0; n < 2; ++n) { const f32x4 v = acc[ai][bj][m][n] * gt; const int c0 = pnl * 256 + bj * 128 + wc * 32 + n * 16 + fq * 4;
                        u32x2 w; w.x = pk2(v[0], v[1]); w.y = pk2(v[2], v[3]);
                        *(u32x2*)(row + c0) = w; } }
    }
};

template <class F>
__device__ __forceinline__ void convert_T(bf16_t* dst, int Nphys, int K, int ld, F rowsrc, long gid, long gstride) {
    const long total = (long)Nphys * (K >> 3);
    for (long idx0 = gid; idx0 < total; idx0 += 4 * gstride) {
        float v[4][8]; int nn[4], kk[4]; bool ok[4];
#pragma unroll
        for (int u = 0; u < 4; ++u) {
            const long idx = idx0 + u * gstride; ok[u] = idx < total;
            const long idc = ok[u] ? idx : idx0;
            nn[u] = (int)(idc % Nphys); kk[u] = (int)(idc / Nphys);
            const float* s = rowsrc(nn[u]);
            if (s) {
#pragma unroll
                for (int i = 0; i < 8; ++i) v[u][i] = s[(size_t)(kk[u] * 8 + i) * ld];
            } else {
#pragma unroll
                for (int i = 0; i < 8; ++i) v[u][i] = 0.f;
            }
        }
#pragma unroll
        for (int u = 0; u < 4; ++u) if (ok[u]) {
            uint4 w; w.x = pk2(v[u][0], v[u][1]); w.y = pk2(v[u][2], v[u][3]); w.z = pk2(v[u][4], v[u][5]); w.w = pk2(v[u][6], v[u][7]);
            *(uint4*)(dst + (size_t)nn[u] * K + kk[u] * 8) = w;
        }
    }
}
__device__ __forceinline__ int rope_nat(int n) { const int w = n & 63; return (n & ~63) + (w >> 1) + 32 * (w & 1); }

__device__ __forceinline__ void sincos_d(double a, double& s, double& c) {
    const double n = rint(a * 0.6366197723675814);
    double y = fma(-n, 1.5707963267948966, a); y = fma(-n, 6.123233995736766e-17, y);
    const int q = ((int)n) & 3;
    const double y2 = y * y;
    const double sp = y * (1.0 + y2 * (-1.0 / 6 + y2 * (1.0 / 120 + y2 * (-1.0 / 5040 + y2 * (1.0 / 362880 + y2 * (-1.0 / 39916800 + y2 * (1.0 / 6227020800.0)))))));
    const double cp = 1.0 + y2 * (-0.5 + y2 * (1.0 / 24 + y2 * (-1.0 / 720 + y2 * (1.0 / 40320 + y2 * (-1.0 / 3628800 + y2 * (1.0 / 479001600.0 + y2 * (-1.0 / 87178291200.0)))))));
    s = (q == 0) ? sp : (q == 1) ? cp : (q == 2) ? -sp : -cp;
    c = (q == 0) ? cp : (q == 1) ? -sp : (q == 2) ? -cp : sp;
}

template <class F>
__device__ __forceinline__ void convert_tiles(bf16_t* dst, int Nphys, int K, int ld, F src8, float* ldsf, int tile0, int tile_step) {
    const int tid = tid_();
    bf16_t* lt = (bf16_t*)ldsf;
    const int nkt = K >> 6, ntiles = (Nphys >> 7) * nkt;
    const int kl = tid >> 4, c = tid & 15;
    const int rn = tid >> 2, rq = tid & 3;
    float4 a0, a1, b0, b1;
#define CT_LOAD(tl, A0, A1, B0, B1) do { const int nt_ = (tl) / nkt, kt_ = (tl) - nt_ * nkt; const float* s_ = src8(nt_ * 128, c) + (size_t)(kt_ * 64 + kl) * ld; \
        A0 = *(const float4*)s_; A1 = *(const float4*)(s_ + 4); B0 = *(const float4*)(s_ + (size_t)32 * ld); B1 = *(const float4*)(s_ + (size_t)32 * ld + 4); } while (0)
    if (tile0 < ntiles) CT_LOAD(tile0, a0, a1, b0, b1);
    for (int tile = tile0; tile < ntiles; tile += tile_step) {
        const int nt = tile / nkt, kt = tile - nt * nkt, n0 = nt * 128, k0 = kt * 64;
        float4 na0 = a0, na1 = a1, nb0 = b0, nb1 = b1;
        if (tile + tile_step < ntiles) CT_LOAD(tile + tile_step, na0, na1, nb0, nb1);
        __syncthreads();
        const float va[8] = {a0.x, a0.y, a0.z, a0.w, a1.x, a1.y, a1.z, a1.w}, vb[8] = {b0.x, b0.y, b0.z, b0.w, b1.x, b1.y, b1.z, b1.w};
#pragma unroll
        for (int e = 0; e < 8; ++e) { lt[(8 * c + e) * 72 + kl] = f2bf(va[e]); lt[(8 * c + e) * 72 + kl + 32] = f2bf(vb[e]); }
        __syncthreads();
        const uint4 w0 = *(const uint4*)(lt + rn * 72 + rq * 16), w1 = *(const uint4*)(lt + rn * 72 + rq * 16 + 8);
        bf16_t* d = dst + (size_t)(n0 + rn) * K + k0 + rq * 16;
        *(uint4*)d = w0; *(uint4*)(d + 8) = w1;
        a0 = na0; a1 = na1; b0 = nb0; b1 = nb1;
    }
#undef CT_LOAD
}

__device__ __forceinline__ int rot_tile0(int rot, int G) { const int r = (int)blockIdx.x - rot % G; return r < 0 ? r + G : r; }
__device__ __forceinline__ void ph_init(const Params& p, float* lds) {
    const int tid = tid_();
    const long gid = (long)blockIdx.x * NT + tid, gs = (long)gridDim.x * NT;
    int rot = 0;
    for (long i = gid; i < 4096 * 32; i += gs) {
        const int pos = (int)(i >> 5), f = (int)(i & 31);
        const float angf = (float)pos * c_inv[f];
        double s, c; sincos_d((double)angf, s, c);
        p.ropecs[2 * i] = (float)c; p.ropecs[2 * i + 1] = (float)s;
    }
    if (gid < DM / 2) ((unsigned*)(p.Xb + (size_t)NTOK * DM))[gid] = 0u;
    const float4* xs = (const float4*)p.in[IN_X]; u32x2* xb = (u32x2*)p.Xb;
    for (long i = gid; i < (long)NTOK * DM / 4; i += 4 * gs) {
        float4 v[4];
#pragma unroll
        for (int u = 0; u < 4; ++u) { const long j = i + u * gs; v[u] = xs[j < (long)NTOK * DM / 4 ? j : i]; }
#pragma unroll
        for (int u = 0; u < 4; ++u) { const long j = i + u * gs; if (j < (long)NTOK * DM / 4) { u32x2 w; w.x = pk2(v[u].x, v[u].y); w.y = pk2(v[u].z, v[u].w); xb[j] = w; } }
    }
#pragma unroll 1
    for (int li = 0; li < 2; ++li) {
        { const float* W = p.in[IN_EV_WIN] + (size_t)li * DM * P_EVEN;
          convert_T(p.WinE + (size_t)li * NP_EVEN * DM, NP_EVEN, DM, P_EVEN, [=](int n) -> const float* {
              if (n >= P_EVEN) return nullptr;
              const bool rope = (n < 1024) || (n >= 1536 && n < 2176) || (n >= 2304 && n < 2624);
              return W + (rope ? rope_nat(n) : n); }, gid, gs); }
        { const float* W = p.in[IN_OD_WIN] + (size_t)li * DM * P_ODD;
          convert_T(p.WinO + (size_t)li * NP_ODD * DM, NP_ODD, DM, P_ODD, [=](int n) -> const float* {
              if (n >= P_ODD) return nullptr;
              const bool rope = (n < 1024) || (n >= O_DQ && n < O_KC) || (n >= O_KS && n < O_VS) || (n >= O_KW && n < O_VW);
              return W + (rope ? rope_nat(n) : n); }, gid, gs); }
        { const float* W = p.in[IN_EV_WOUT] + (size_t)li * DM * DM;
          convert_tiles(p.WoutE + (size_t)li * DM * DM, DM, DM, DM, [=](int n0, int c) -> const float* { return W + n0 + 8 * c; }, lds, rot_tile0(rot, gridDim.x), gridDim.x); rot += 128; }
        { const float* W = p.in[IN_OD_WOUT] + (size_t)li * DM * DM;
          convert_tiles(p.WoutO + (size_t)li * DM * DM, DM, DM, DM, [=](int n0, int c) -> const float* { return W + n0 + 8 * c; }, lds, rot_tile0(rot, gridDim.x), gridDim.x); rot += 128; }
        { const float* Wg = p.in[IN_FFD_WG] + (size_t)li * DM * F_DENSE; const float* Wu = p.in[IN_FFD_WU] + (size_t)li * DM * F_DENSE; const long dWu = (const char*)Wu - (const char*)Wg;
          convert_tiles(p.WguD + (size_t)li * 2 * F_DENSE * DM, 2 * F_DENSE, DM, F_DENSE, [=](int n0, int c) -> const float* {
              const int unit0 = n0 / 2 + (c >> 2) * 16 + (c & 1) * 8; return (const float*)((const char*)Wg + ((c & 2) ? dWu : 0l)) + unit0; }, lds, rot_tile0(rot, gridDim.x), gridDim.x); rot += 704; }
        { const float* W = p.in[IN_FFD_WD] + (size_t)li * F_DENSE * DM;
          convert_tiles(p.WdD + (size_t)li * DM * F_DENSE, DM, F_DENSE, DM, [=](int n0, int c) -> const float* { return W + n0 + 8 * c; }, lds, rot_tile0(rot, gridDim.x), gridDim.x); rot += 352; }
#pragma unroll 1
        for (int which = 0; which < 2; ++which) {
            const float* W1 = p.in[IN_NSA_W1] + (size_t)(li * 2 + which) * 2048 * 256;
            convert_tiles(p.W1T + (size_t)(li * 2 + which) * 256 * 2048, 256, 2048, 256, [=](int n0, int c) -> const float* { return W1 + n0 + 8 * c; }, lds, rot_tile0(rot, gridDim.x), gridDim.x); rot += 64;
            const float* W2 = p.in[IN_NSA_W2] + (size_t)(li * 2 + which) * 256 * 64;
            convert_T(p.W2T + (size_t)(li * 2 + which) * 256 * 256, 256, 256, 64, [=](int n) -> const float* { if (n >= 64) return nullptr; return W2 + (which ? n : rope_nat(n)); }, gid, gs);
        }
    }
}
__device__ __forceinline__ void ph_convert_moe(const Params& p, int li, float* lds) {
    const float* Wg = p.in[IN_MOE_WG] + (size_t)li * N_EXP * DM * F_EXPERT; const float* Wu = p.in[IN_MOE_WU] + (size_t)li * N_EXP * DM * F_EXPERT; const long dWu = (const char*)Wu - (const char*)Wg;
    convert_tiles(p.WguM, N_EXP * 2 * F_EXPERT, DM, F_EXPERT, [=](int n0, int c) -> const float* {
        const int e = n0 / (2 * F_EXPERT), unit0 = (n0 % (2 * F_EXPERT)) / 2 + (c >> 2) * 16 + (c & 1) * 8;
        return (const float*)((const char*)Wg + ((c & 2) ? dWu : 0l)) + (size_t)e * DM * F_EXPERT + unit0; }, lds, blockIdx.x, gridDim.x);
    const float* Wd = p.in[IN_MOE_WD] + (size_t)li * N_EXP * F_EXPERT * DM;
    convert_tiles(p.WdM, N_EXP * DM, F_EXPERT, DM, [=](int n0, int c) -> const float* { return Wd + (size_t)(n0 >> 10) * F_EXPERT * DM + (n0 & 1023) + 8 * c; }, lds, blockIdx.x, gridDim.x);
}

struct CvJob {
    const float* Wg; long dWu; const float* Wd; bf16_t* dgu; bf16_t* ddn; bf16_t* lt0;
    int t, tend, step_, par; bool pend; bf16_t* pdst;
    float4 a0, a1, b0, b1;
    static constexpr int NT1 = (N_EXP * 2 * F_EXPERT / 128) * (DM / 64), NT2 = (N_EXP * DM / 128) * (F_EXPERT / 64);
    __device__ __forceinline__ void load(int tl, int tid) {
        const int kl = tid >> 4, c = tid & 15; const float* s_; size_t ld;
        if (tl < NT1) { const int nt = tl >> 4, kt = tl & 15, n0 = nt * 128; const int e = n0 / (2 * F_EXPERT), unit0 = (n0 % (2 * F_EXPERT)) / 2 + (c >> 2) * 16 + (c & 1) * 8;
            ld = F_EXPERT; s_ = (const float*)((const char*)Wg + ((c & 2) ? dWu : 0l)) + (size_t)e * DM * F_EXPERT + unit0 + (size_t)(kt * 64 + kl) * ld; }
        else { const int t2 = tl - NT1, nt = t2 / (F_EXPERT / 64), kt = t2 - nt * (F_EXPERT / 64), n0 = nt * 128;
            ld = DM; s_ = Wd + (size_t)(n0 >> 10) * F_EXPERT * DM + (n0 & 1023) + 8 * c + (size_t)(kt * 64 + kl) * ld; }
        a0 = *(const float4*)s_; a1 = *(const float4*)(s_ + 4); b0 = *(const float4*)(s_ + 32 * ld); b1 = *(const float4*)(s_ + 32 * ld + 4);
    }
    __device__ __forceinline__ void init(const Params& p, int li, float* ldsf, int tid) {
        Wg = p.in[IN_MOE_WG] + (size_t)li * N_EXP * DM * F_EXPERT; const float* Wu = p.in[IN_MOE_WU] + (size_t)li * N_EXP * DM * F_EXPERT; dWu = (const char*)Wu - (const char*)Wg;
        Wd = p.in[IN_MOE_WD] + (size_t)li * N_EXP * F_EXPERT * DM; dgu = p.WguM; ddn = p.WdM; lt0 = (bf16_t*)ldsf;
        t = blockIdx.x; step_ = gridDim.x; tend = NT1 + NT2; par = 0; pend = false; pdst = dgu;
        if (t < tend) load(t, tid);
    }
    __device__ __forceinline__ void step(int tid) {
        const int kl = tid >> 4, c = tid & 15, rn = tid >> 2, rq = tid & 3;
        if (pend) { const bf16_t* lt = lt0 + (par ^ 1) * (128 * 72);
            const uint4 w0 = *(const uint4*)(lt + rn * 72 + rq * 16), w1 = *(const uint4*)(lt + rn * 72 + rq * 16 + 8);
            *(uint4*)pdst = w0; *(uint4*)(pdst + 8) = w1; }
        if (t < tend) {
            bf16_t* lt = lt0 + par * (128 * 72);
            const float va[8] = {a0.x, a0.y, a0.z, a0.w, a1.x, a1.y, a1.z, a1.w}, vb[8] = {b0.x, b0.y, b0.z, b0.w, b1.x, b1.y, b1.z, b1.w};
#pragma unroll
            for (int e = 0; e < 8; ++e) { lt[(8 * c + e) * 72 + kl] = f2bf(va[e]); lt[(8 * c + e) * 72 + kl + 32] = f2bf(vb[e]); }
            if (t < NT1) { const int nt = t >> 4, kt = t & 15; pdst = dgu + (size_t)(nt * 128 + rn) * DM + kt * 64 + rq * 16; }
            else { const int t2 = t - NT1, nt = t2 / (F_EXPERT / 64), kt = t2 - nt * (F_EXPERT / 64); pdst = ddn + (size_t)(nt * 128 + rn) * F_EXPERT + kt * 64 + rq * 16; }
            pend = true; t += step_;
            if (t < tend) load(t, tid);
        } else pend = false;
        par ^= 1;
    }
    __device__ __forceinline__ void finish(int tid) { while (pend || t < tend) { __syncthreads(); step(tid); } }
};

__device__ __forceinline__ void ph_kmean(const Params& p, float* lds) {
    const int tid = tid_(), ch = tid & 7, kg = tid >> 3;
    for (int item = blockIdx.x; item < 8 * 16 * 8; item += gridDim.x) {
        const int h = item & 7, blk = (item >> 3) & 15, b = item >> 7;
        float s[8] = {0.f, 0.f, 0.f, 0.f, 0.f, 0.f, 0.f, 0.f};
        uint4 kv[4];
#pragma unroll
        for (int j = 0; j < 4; ++j) kv[j] = *(const uint4*)(p.Pb + (size_t)(b * SEQ + blk * 256 + kg * 4 + j) * LDPB + O_CK + h * 64 + ch * 8);
#pragma unroll
        for (int j = 0; j < 4; ++j) {
            s[0] += __builtin_bit_cast(float, kv[j].x << 16); s[1] += __builtin_bit_cast(float, kv[j].x & 0xffff0000u);
            s[2] += __builtin_bit_cast(float, kv[j].y << 16); s[3] += __builtin_bit_cast(float, kv[j].y & 0xffff0000u);
            s[4] += __builtin_bit_cast(float, kv[j].z << 16); s[5] += __builtin_bit_cast(float, kv[j].z & 0xffff0000u);
            s[6] += __builtin_bit_cast(float, kv[j].w << 16); s[7] += __builtin_bit_cast(float, kv[j].w & 0xffff0000u);
        }
#pragma unroll
        for (int e = 0; e < 8; ++e) { s[e] += __shfl_xor(s[e], 8); s[e] += __shfl_xor(s[e], 16); s[e] += __shfl_xor(s[e], 32); }
        __syncthreads();
        if ((tid & 63) < 8) {
#pragma unroll
            for (int e = 0; e < 8; ++e) lds[(tid >> 6) * 64 + ch * 8 + e] = s[e];
        }
        __syncthreads();
        if (tid < 64) { float a = 0.f;
#pragma unroll
            for (int q = 0; q < 8; ++q) a += lds[q * 64 + tid];
            p.kmean[(size_t)item * 64 + tid] = a * (1.f / 256.f); }
    }
}

__device__ __forceinline__ void ph_cmp_build(const Params& p, int li) {
    const int tid = tid_();
    const long gs = (long)gridDim.x * NT;
    for (long idx0 = (long)blockIdx.x * NT + tid; idx0 < 2l * 4096 * 256; idx0 += 4 * gs) {
      pg8::u32x4 kvv[4]; float4 pe0[4], pe1[4];
#pragma unroll
      for (int u = 0; u < 4; ++u) {
        const long idx = (idx0 + u * gs < 2l * 4096 * 256) ? idx0 + u * gs : idx0;
        const int ch = (int)(idx & 255), m = (int)((idx >> 8) & 4095), which = (int)(idx >> 20);
        const int i = (m & 255) < 255 ? (m & 255) : 0, bg = m >> 8, b = bg >> 1, g = bg & 1, t = ch >> 3, d0 = (ch & 7) * 8;
        kvv[u] = *(const pg8::u32x4*)(p.Pb + (size_t)(b * SEQ + 16 * i + t) * LDPB + (which ? O_VC : O_KC) + g * 64 + d0);
        const float* pe = p.in[IN_NSA_PE] + (size_t)(li * 2 + which) * 2048 + t * 64 + d0;
        pe0[u] = *(const float4*)pe; pe1[u] = *(const float4*)(pe + 4);
      }
#pragma unroll
      for (int u = 0; u < 4; ++u) {
        const long idx = idx0 + u * gs;
        if (idx >= 2l * 4096 * 256) continue;
        const int ch = (int)(idx & 255), m = (int)((idx >> 8) & 4095), which = (int)(idx >> 20);
        const int i = m & 255, t = ch >> 3, d0 = (ch & 7) * 8;
        uint4 w = make_uint4(0u, 0u, 0u, 0u);
        if (i < 255) {
            uint4 kv; kv.x = kvv[u].x; kv.y = kvv[u].y; kv.z = kvv[u].z; kv.w = kvv[u].w;
            const float4 e0 = pe0[u], e1 = pe1[u];
            w.x = pk2(__builtin_bit_cast(float, kv.x << 16) + e0.x, __builtin_bit_cast(float, kv.x & 0xffff0000u) + e0.y);
            w.y = pk2(__builtin_bit_cast(float, kv.y << 16) + e0.z, __builtin_bit_cast(float, kv.y & 0xffff0000u) + e0.w);
            w.z = pk2(__builtin_bit_cast(float, kv.z << 16) + e1.x, __builtin_bit_cast(float, kv.z & 0xffff0000u) + e1.y);
            w.w = pk2(__builtin_bit_cast(float, kv.w << 16) + e1.z, __builtin_bit_cast(float, kv.w & 0xffff0000u) + e1.w);
        }
        *(uint4*)(p.Ac + ((size_t)(which * 4096 + m) * 2048 + ch * 8)) = w;
      }
    }
}

typedef unsigned u32x8v __attribute__((ext_vector_type(8)));
typedef float f32x16v __attribute__((ext_vector_type(16)));
__device__ __forceinline__ u32x8v ld_row8(const bf16_t* row, int lane) {
    const u32x2* r = (const u32x2*)row; const u32x2 a = r[lane], b = r[64 + lane], c = r[128 + lane], d = r[192 + lane];
    return (u32x8v){a.x, a.y, b.x, b.y, c.x, c.y, d.x, d.y};
}
__device__ __forceinline__ f32x16v ld_row16f(const float* row, int lane) {
    const float4* r = (const float4*)row; const float4 a = r[lane], b = r[64 + lane], c = r[128 + lane], d = r[192 + lane];
    return (f32x16v){a.x, a.y, a.z, a.w, b.x, b.y, b.z, b.w, c.x, c.y, c.z, c.w, d.x, d.y, d.z, d.w};
}
__device__ __forceinline__ float bf_el(const u32x8v v, int i) { const unsigned u = v[i >> 1]; return __builtin_bit_cast(float, (i & 1) ? (u & 0xffff0000u) : (u << 16)); }
__device__ __forceinline__ u32x8v ld_slot8(const Params& p, int slot_v, int lane) {
    const int slot = __builtin_amdgcn_readfirstlane(slot_v);
    if (slot < MOE_TAIL_T0 * 256) return ld_row8(p.Ys + (size_t)slot * DM, lane);
    u32x8v part[MOE_KSL];
#pragma unroll
    for (int sl = 0; sl < MOE_KSL; ++sl) part[sl] = ld_row8(p.Yp + ((size_t)sl * (MOE_TAIL_TILES * 256) + (slot - MOE_TAIL_T0 * 256)) * DM, lane);
    u32x8v o;
#pragma unroll
    for (int j = 0; j < 8; ++j) {
        float lo = 0.f, hi = 0.f;
#pragma unroll
        for (int sl = 0; sl < MOE_KSL; ++sl) { lo += __builtin_bit_cast(float, part[sl][j] << 16); hi += __builtin_bit_cast(float, part[sl][j] & 0xffff0000u); }
        o[j] = pk2(lo, hi);
    }
    return o;
}
template <int MODE, int XSRC>
__device__ __forceinline__ void ph_ln(const Params& p, const float* gam, const float* bet, const float* Xin, float* Xout, bf16_t* Xbout, const bool wf32) {
    const int lane = tid_() & 63, wid = tid_() >> 6;
    const int stride = gridDim.x * 8;
    int t = blockIdx.x * 8 + wid;
    float4 gg4[4], bb4[4];
#pragma unroll
    for (int c = 0; c < 4; ++c) { gg4[c] = ((const float4*)gam)[c * 64 + lane]; bb4[c] = ((const float4*)bet)[c * 64 + lane]; }
    if (t < NTOK) {
        f32x16v xf, xfn; u32x8v xb8, xbn, ya, yan, yb, ybn;
        int n0 = 0, n1 = 0;
#define LN_LOAD(tt, S0, S1, XF, XB, YA, YB) do { \
        if (XSRC == 0) XF = ld_row16f(Xin + (size_t)(tt) * DM, lane); else XB = ld_row8(Xbout + (size_t)(tt) * DM, lane); \
        if (MODE == 0) YA = ld_row8((const bf16_t*)p.Y + (size_t)(tt) * DM, lane); \
        else { YA = ld_slot8(p, S0, lane); YB = ld_slot8(p, S1, lane); } } while (0)
        {
            int s0 = 0, s1 = 0;
            if (MODE == 1) { s0 = p.tok_slot[2 * t]; s1 = p.tok_slot[2 * t + 1]; const int tn = (t + stride < NTOK) ? t + stride : t; n0 = p.tok_slot[2 * tn]; n1 = p.tok_slot[2 * tn + 1]; }
            LN_LOAD(t, s0, s1, xf, xb8, ya, yb);
        }
        for (; t < NTOK; t += stride) {
            const int tn = (t + stride < NTOK) ? t + stride : t;
            LN_LOAD(tn, n0, n1, xfn, xbn, yan, ybn);
            int m0 = 0, m1 = 0;
            if (MODE == 1) { const int t2 = (tn + stride < NTOK) ? tn + stride : tn; m0 = p.tok_slot[2 * t2]; m1 = p.tok_slot[2 * t2 + 1]; }
            f32x16v v; float s = 0.f;
#pragma unroll
            for (int c = 0; c < 4; ++c) {
#pragma unroll
                for (int e = 0; e < 4; ++e) {
                    const int i = c * 4 + e;
                    const float x = (XSRC == 0) ? xf[i] : bf_el(xb8, i);
                    const float y = (MODE == 0) ? bf_el(ya, i) : bf_el(ya, i) + bf_el(yb, i);
                    v[i] = ALPHA * x + y;
                }
                s += (v[c * 4] + v[c * 4 + 1]) + (v[c * 4 + 2] + v[c * 4 + 3]);
            }
            const float mu = wave_sum(s) * (1.f / 1024.f);
            float q = 0.f;
#pragma unroll
            for (int c = 0; c < 4; ++c) { const float a = v[c * 4] - mu, b2 = v[c * 4 + 1] - mu, c2 = v[c * 4 + 2] - mu, d2 = v[c * 4 + 3] - mu; q += (a * a + b2 * b2) + (c2 * c2 + d2 * d2); }
            const float var = wave_sum(q) * (1.f / 1024.f);
            const float rs = 1.0f / sqrtf(var + LN_EPS);
            u32x2* xb = (u32x2*)(Xbout + (size_t)t * DM); float4* xo = (float4*)(Xout + (size_t)t * DM);
#pragma unroll
            for (int c = 0; c < 4; ++c) {
                const float4 gg = gg4[c], bb = bb4[c];
                float4 o; o.x = (v[c * 4] - mu) * rs * gg.x + bb.x; o.y = (v[c * 4 + 1] - mu) * rs * gg.y + bb.y; o.z = (v[c * 4 + 2] - mu) * rs * gg.z + bb.z; o.w = (v[c * 4 + 3] - mu) * rs * gg.w + bb.w;
                if (wf32) xo[c * 64 + lane] = o;
                u32x2 w; w.x = pk2(o.x, o.y); w.y = pk2(o.z, o.w); xb[c * 64 + lane] = w;
            }
            xf = xfn; xb8 = xbn; ya = yan; yb = ybn; n0 = m0; n1 = m1;
        }
#undef LN_LOAD
    }
}

__device__ __forceinline__ void ph_ln_router(const Params& p, const float* gam, const float* bet, int li, float* lds) {
    const int tid = tid_(), lane = tid & 63, wid = tid >> 6;
    int* lcnt = (int*)lds;
    const float* wr = p.in[IN_MOE_WR] + (size_t)li * 1024 * 8;
    const float* br = p.in[IN_MOE_BR] + li * 8;
    float4 gg4[4], bb4[4];
#pragma unroll
    for (int c = 0; c < 4; ++c) { gg4[c] = ((const float4*)gam)[c * 64 + lane]; bb4[c] = ((const float4*)bet)[c * 64 + lane]; }
    for (int chunk = blockIdx.x; chunk < 256; chunk += gridDim.x) {
        __syncthreads();
        if (tid < 8) lcnt[tid] = 0;
        __syncthreads();
        u32x8v xb8 = ld_row8(p.Xb + (size_t)(chunk * 128 + wid * 16) * DM, lane), ya = ld_row8((const bf16_t*)p.Y + (size_t)(chunk * 128 + wid * 16) * DM, lane);
        for (int q = 0; q < 16; ++q) {
            const int t = chunk * 128 + wid * 16 + q;
            const int tn = (q < 15) ? t + 1 : t;
            const u32x8v xbn = ld_row8(p.Xb + (size_t)tn * DM, lane), yan = ld_row8((const bf16_t*)p.Y + (size_t)tn * DM, lane);
            float4 v[4]; float s = 0.f;
#pragma unroll
            for (int c = 0; c < 4; ++c) {
                v[c].x = ALPHA * bf_el(xb8, c * 4) + bf_el(ya, c * 4); v[c].y = ALPHA * bf_el(xb8, c * 4 + 1) + bf_el(ya, c * 4 + 1);
                v[c].z = ALPHA * bf_el(xb8, c * 4 + 2) + bf_el(ya, c * 4 + 2); v[c].w = ALPHA * bf_el(xb8, c * 4 + 3) + bf_el(ya, c * 4 + 3);
                s += (v[c].x + v[c].y) + (v[c].z + v[c].w);
            }
            xb8 = xbn; ya = yan;
            const float mu = wave_sum(s) * (1.f / 1024.f);
            float qq = 0.f;
#pragma unroll
            for (int c = 0; c < 4; ++c) { const float a = v[c].x - mu, b2 = v[c].y - mu, c2 = v[c].z - mu, d2 = v[c].w - mu; qq += (a * a + b2 * b2) + (c2 * c2 + d2 * d2); }
            const float var = wave_sum(qq) * (1.f / 1024.f);
            const float rs = 1.0f / sqrtf(var + LN_EPS);
            u32x2* xb = (u32x2*)(p.Xb + (size_t)t * DM);
            float a[8] = {0.f, 0.f, 0.f, 0.f, 0.f, 0.f, 0.f, 0.f};
            u32x2 wout[4];
#pragma unroll
            for (int c = 0; c < 4; ++c) {
                const float4 gg = gg4[c], bb = bb4[c];
                float4 o; o.x = (v[c].x - mu) * rs * gg.x + bb.x; o.y = (v[c].y - mu) * rs * gg.y + bb.y; o.z = (v[c].z - mu) * rs * gg.z + bb.z; o.w = (v[c].w - mu) * rs * gg.w + bb.w;
                wout[c].x = pk2(o.x, o.y); wout[c].y = pk2(o.z, o.w);
                const float ov[4] = {o.x, o.y, o.z, o.w};
                const float* wk = wr + (size_t)((c * 64 + lane) * 4) * 8;
#pragma unroll
                for (int j = 0; j < 4; ++j) { const float4 w0 = *(const float4*)(wk + j * 8), w1 = *(const float4*)(wk + j * 8 + 4);
                    a[0] += ov[j] * w0.x; a[1] += ov[j] * w0.y; a[2] += ov[j] * w0.z; a[3] += ov[j] * w0.w; a[4] += ov[j] * w1.x; a[5] += ov[j] * w1.y; a[6] += ov[j] * w1.z; a[7] += ov[j] * w1.w; }
            }
#pragma unroll
            for (int c = 0; c < 4; ++c) xb[c * 64 + lane] = wout[c];
            {
                float b4[4], b2[2], b1;
                const bool up1 = lane & 1, up2 = lane & 2, up4 = lane & 4;
#pragma unroll
                for (int e = 0; e < 4; ++e) { const float keep = up1 ? a[e + 4] : a[e], send = up1 ? a[e] : a[e + 4]; b4[e] = keep + __shfl_xor(send, 1); }
#pragma unroll
                for (int e = 0; e < 2; ++e) { const float keep = up2 ? b4[e + 2] : b4[e], send = up2 ? b4[e] : b4[e + 2]; b2[e] = keep + __shfl_xor(send, 2); }
                { const float keep = up4 ? b2[1] : b2[0], send = up4 ? b2[0] : b2[1]; b1 = keep + __shfl_xor(send, 4); }
                b1 += __shfl_xor(b1, 8); b1 += __shfl_xor(b1, 16); b1 += __shfl_xor(b1, 32);
#pragma unroll
                for (int e = 0; e < 8; ++e) { const int src = ((e >> 2) & 1) | (e & 2) | ((e & 1) << 2); a[e] = __shfl(b1, src) + br[e]; }
            }
            int e1 = 0; float l1 = a[0];
#pragma unroll
            for (int e = 1; e < 8; ++e) if (a[e] > l1) { l1 = a[e]; e1 = e; }
            int e2 = -1; float l2 = -INFINITY;
#pragma unroll
            for (int e = 0; e < 8; ++e) if (e != e1 && a[e] > l2) { l2 = a[e]; e2 = e; }
            const float ex = expf(l2 - l1);
            if (lane == 0) {
                p.tok_e[2 * t] = e1; p.tok_e[2 * t + 1] = e2;
                p.tok_g[2 * t] = 1.f / (1.f + ex); p.tok_g[2 * t + 1] = ex / (1.f + ex);
                atomicAdd(&lcnt[e1], 1); atomicAdd(&lcnt[e2], 1);
            }
        }
        __syncthreads();
        if (tid < 8) p.chunk_cnt[chunk * 8 + tid] = lcnt[tid];
    }
}
__device__ __forceinline__ void ph_slots(const Params& p, float* lds) {
    const int tid = tid_();
    int* lbase = (int*)lds;
    int* lpad = lbase + 8;
    int* ltot = lpad + 16;
    int* lent = ltot + 8;
    int* lslot = lent + 256;
    for (int chunk = blockIdx.x; chunk < 256; chunk += gridDim.x) {
        __syncthreads();
        {
            int* lcc = lslot + 256;
            const int4 v4 = ((const int4*)p.chunk_cnt)[tid]; ((int4*)lcc)[tid] = v4;
            if (tid < 256) lent[tid] = p.tok_e[chunk * 256 + tid];
            __syncthreads();
            {
                const int e = tid >> 6, ln = tid & 63; int tot = 0, before = 0;
#pragma unroll
                for (int q = 0; q < 4; ++q) { const int cc = ln * 4 + q, v = lcc[cc * 8 + e]; tot += v; before += (cc < chunk) ? v : 0; }
#pragma unroll
                for (int o = 32; o >= 1; o >>= 1) { tot += __shfl_xor(tot, o); before += __shfl_xor(before, o); }
                if (ln == 0) { lbase[e] = before; ltot[e] = tot; }
            }
        }
        __syncthreads();
        if (tid == 0) { int acc = 0; for (int e = 0; e < 8; ++e) { lpad[e] = acc; acc += (ltot[e] + 255) / 256 * 256; } lpad[8] = acc; }
        __syncthreads();
        {
            int* lwc = lslot + 256 + 2048;
            const int wv = tid >> 6, ln = tid & 63;
            int my_e = -1, my_rank = 0;
            if (tid < 256) {
                my_e = lent[tid];
#pragma unroll
                for (int e = 0; e < 8; ++e) { const unsigned long long mb = __ballot(my_e == e); if (my_e == e) my_rank = lane_rank(mb); if (ln == 0) lwc[wv * 8 + e] = __popcll(mb); }
            }
            __syncthreads();
            if (tid < 256) { int r = lpad[my_e] + lbase[my_e] + my_rank; for (int q = 0; q < wv; ++q) r += lwc[q * 8 + my_e]; lslot[tid] = r; }
        }
        __syncthreads();
        if (tid < 256) {
            const int slot = lslot[tid], tk = chunk * 128 + (tid >> 1);
            p.slot_tok[slot] = tk; p.slot_gate[slot] = p.tok_g[chunk * 256 + tid]; p.tok_slot[chunk * 256 + tid] = slot;
        }
        if (gridDim.x != 256)
        for (int idx0 = tid; idx0 < 256 * 128; idx0 += 8 * NT) {
            pg8::u32x4 v[8];
#pragma unroll
            for (int u = 0; u < 8; ++u) { const int idx = idx0 + u * NT, e = idx >> 7, piece = idx & 127; v[u] = ((const pg8::u32x4*)p.Xb)[(size_t)(chunk * 128 + (e >> 1)) * 128 + piece]; }
#pragma unroll
            for (int u = 0; u < 8; ++u) { const int idx = idx0 + u * NT, e = idx >> 7, piece = idx & 127; ((pg8::u32x4*)p.Xs)[(size_t)lslot[e] * 128 + piece] = v[u]; }
        }
        if (chunk < 8) {
            const int s0 = lpad[chunk] + ltot[chunk], s1 = lpad[chunk + 1];
            if (gridDim.x != 256) for (int idx = tid; idx < (s1 - s0) * 128; idx += NT) ((uint4*)p.Xs)[(size_t)(s0 + (idx >> 7)) * 128 + (idx & 127)] = make_uint4(0u, 0u, 0u, 0u);
            for (int s = s0 + tid; s < s1; s += NT) { p.slot_tok[s] = -1; p.slot_gate[s] = 0.f; }
        }
        if (chunk == 8 && tid < NTILE256) {
            const int s0 = tid * 256; int e = -1;
            for (int q = 0; q < 8; ++q) if (s0 >= lpad[q] && s0 < lpad[q + 1]) e = q;
            p.tile_e[tid] = e;
        }
    }
}

typedef short bf16x8 __attribute__((ext_vector_type(8)));
typedef short s16x4 __attribute__((ext_vector_type(4)));
typedef __attribute__((address_space(3))) const unsigned char* lds_cptr;
__device__ __forceinline__ s16x4 vtr(lds_cptr p) { return __builtin_bit_cast(s16x4, __builtin_amdgcn_ds_read_tr16_b64_v4i16((__attribute__((address_space(3))) s16x4*)p)); }
__device__ __forceinline__ bf16x8 cat8(s16x4 lo, s16x4 hi) { bf16x8 r; r[0] = lo[0]; r[1] = lo[1]; r[2] = lo[2]; r[3] = lo[3]; r[4] = hi[0]; r[5] = hi[1]; r[6] = hi[2]; r[7] = hi[3]; return r; }
constexpr int AT_KP = 160;
template <int VD> struct AtL { static constexpr int VP = VD * 2 + 32, KB = 64 * AT_KP, VB = 64 * VP, BUF = KB + VB; };
constexpr float AT_SCALE2 = 0.125f * 1.4426950408889634f;

template <int VD> struct AtState {
    f32x4 o[2][VD / 16]; float m[2], l[2];
    __device__ __forceinline__ void init() {
#pragma unroll
        for (int g = 0; g < 2; ++g) { m[g] = -1e30f; l[g] = 0.f;
#pragma unroll
            for (int n = 0; n < VD / 16; ++n) o[g][n] = Z4_; }
    }
};
typedef float f32x2 __attribute__((ext_vector_type(2)));
__device__ __forceinline__ float max3f_(float a, float b, float c) { float r; asm("v_max3_f32 %0, %1, %2, %3" : "=v"(r) : "v"(a), "v"(b), "v"(c)); return r; }
__device__ __forceinline__ float max2f_(float a, float b) { float r; asm("v_max_f32_e32 %0, %1, %2" : "=v"(r) : "v"(a), "v"(b)); return r; }
__device__ __forceinline__ float xmax16(float v) { const unsigned u = __builtin_bit_cast(unsigned, v); const auto r = __builtin_amdgcn_permlane16_swap(u, u, false, false);
    return max2f_(__builtin_bit_cast(float, r[0]), __builtin_bit_cast(float, r[1])); }
__device__ __forceinline__ float xmax32(float v) { const unsigned u = __builtin_bit_cast(unsigned, v); const auto r = __builtin_amdgcn_permlane32_swap(u, u, false, false);
    return max2f_(__builtin_bit_cast(float, r[0]), __builtin_bit_cast(float, r[1])); }
template <int VD, int MODE, class RowOk, class Allow>
__device__ __forceinline__ void at_tile(AtState<VD>& st, lds_cptr Kb, lds_cptr Vb, const bf16x8 (&q)[2][2], int fr, int fq, RowOk rowok, Allow allow) {
    f32x4 s[2][4];
    bf16x8 kn0 = *(const __attribute__((address_space(3))) bf16x8*)(Kb + fr * AT_KP + fq * 16);
    bf16x8 kn1 = *(const __attribute__((address_space(3))) bf16x8*)(Kb + fr * AT_KP + 64 + fq * 16);
#pragma unroll
    for (int kk = 0; kk < 4; ++kk) {
        const bf16x8 kf0 = kn0, kf1 = kn1;
        if (kk < 3) { kn0 = *(const __attribute__((address_space(3))) bf16x8*)(Kb + (16 * (kk + 1) + fr) * AT_KP + fq * 16);
                      kn1 = *(const __attribute__((address_space(3))) bf16x8*)(Kb + (16 * (kk + 1) + fr) * AT_KP + 64 + fq * 16); }
#pragma unroll
        for (int g = 0; g < 2; ++g) s[g][kk] = __builtin_amdgcn_mfma_f32_16x16x32_bf16(kf0, q[g][0], (f32x4){0.f, 0.f, 0.f, 0.f}, 0, 0, 0);
#pragma unroll
        for (int g = 0; g < 2; ++g) s[g][kk] = __builtin_amdgcn_mfma_f32_16x16x32_bf16(kf1, q[g][1], s[g][kk], 0, 0, 0);
    }
    const lds_cptr vp0 = Vb + (4 * fq + (fr >> 2)) * AtL<VD>::VP + (4 * (fr & 3)) * 2;
    bf16x8 vn = cat8(vtr(vp0), vtr(vp0 + 16 * AtL<VD>::VP));
    bf16x8 pf[2][2];
#pragma unroll
    for (int g = 0; g < 2; ++g) {
        float mloc = fmaxf(fmaxf(s[g][0][0], s[g][0][1]), s[g][0][2]);
        mloc = fmaxf(fmaxf(mloc, s[g][0][3]), s[g][1][0]);
        mloc = fmaxf(fmaxf(mloc, s[g][1][1]), s[g][1][2]);
        mloc = fmaxf(fmaxf(mloc, s[g][1][3]), s[g][2][0]);
        mloc = fmaxf(fmaxf(mloc, s[g][2][1]), s[g][2][2]);
        mloc = fmaxf(fmaxf(mloc, s[g][2][3]), s[g][3][0]);
        mloc = fmaxf(fmaxf(mloc, s[g][3][1]), s[g][3][2]);
        mloc = fmaxf(mloc, s[g][3][3]);
        mloc = xmax16(mloc); mloc = xmax32(mloc);
        float mn = max2f_(st.m[g], mloc * AT_SCALE2);
        float cadd;
        if (MODE & 1) { const bool ro = rowok(g); mn = ro ? mn : st.m[g]; cadd = ro ? -mn : -INFINITY; } else cadd = -mn;
        const float alpha = __builtin_amdgcn_exp2f(st.m[g] - mn);
        st.m[g] = mn;
        float ls = 0.f;
#pragma unroll
        for (int kk = 0; kk < 4; ++kk)
#pragma unroll
            for (int r = 0; r < 4; ++r) {
                float pv = __builtin_amdgcn_exp2f(__builtin_fmaf(s[g][kk][r], AT_SCALE2, cadd));
                if (MODE & 2) pv = allow(g, kk, r) ? pv : 0.f;
                if (MODE & 4) pv = __builtin_bit_cast(float, __builtin_bit_cast(int, pv) & allow(g, kk, r));
                s[g][kk][r] = pv; ls += pv;
            }
        st.l[g] = st.l[g] * alpha + ls;
#pragma unroll
        for (int n = 0; n < VD / 16; ++n) st.o[g][n] = st.o[g][n] * alpha;
#pragma unroll
        for (int sp = 0; sp < 2; ++sp) {
            const unsigned w0 = pk2(s[g][2 * sp][0], s[g][2 * sp][1]), w1 = pk2(s[g][2 * sp][2], s[g][2 * sp][3]);
            const unsigned w2 = pk2(s[g][2 * sp + 1][0], s[g][2 * sp + 1][1]), w3 = pk2(s[g][2 * sp + 1][2], s[g][2 * sp + 1][3]);
            pf[g][sp] = __builtin_bit_cast(bf16x8, (pg8::u32x4){w0, w1, w2, w3});
        }
    }
    {
#pragma unroll
        for (int st_ = 0; st_ < VD / 8; ++st_) {
            const int n = st_ >> 1, sp = st_ & 1;
            const bf16x8 vf = vn;
            if (st_ + 1 < VD / 8) { const int n2 = (st_ + 1) >> 1, sp2 = (st_ + 1) & 1;
                const lds_cptr vp = Vb + (32 * sp2 + 4 * fq + (fr >> 2)) * AtL<VD>::VP + (n2 * 16 + 4 * (fr & 3)) * 2;
                vn = cat8(vtr(vp), vtr(vp + 16 * AtL<VD>::VP)); }
#pragma unroll
            for (int g = 0; g < 2; ++g) st.o[g][n] = __builtin_amdgcn_mfma_f32_16x16x32_bf16(vf, pf[g][sp], st.o[g][n], 0, 0, 0);
        }
    }
}
struct AtNoRow { __device__ __forceinline__ bool operator()(int) const { return true; } };
struct AtNoEl { __device__ __forceinline__ bool operator()(int, int, int) const { return true; } };
template <int VD> struct AtStage {
    pg8::u32x4 k, v[VD / 64];
    __device__ __forceinline__ void load(const bf16_t* kbase, const bf16_t* vbase, int key0, int tid) {
        const int row = tid >> 3, ch = tid & 7;
        k = *(const pg8::u32x4*)(kbase + (size_t)(key0 + row) * LDPB + ch * 8);
#pragma unroll
        for (int i = 0; i < VD / 64; ++i) v[i] = *(const pg8::u32x4*)(vbase + (size_t)(key0 + row) * LDPB + (ch + 8 * i) * 8);
    }
    __device__ __forceinline__ void store(LAS unsigned char* buf, int tid) const {
        const int row = tid >> 3, ch = tid & 7;
        *(LAS pg8::u32x4*)(buf + row * AT_KP + ch * 16) = k;
#pragma unroll
        for (int i = 0; i < VD / 64; ++i) *(LAS pg8::u32x4*)(buf + AtL<VD>::KB + row * AtL<VD>::VP + (ch + 8 * i) * 16) = v[i];
    }
};
template <int VD>
__device__ __forceinline__ void at_finish(AtState<VD>& st) {
#pragma unroll
    for (int g = 0; g < 2; ++g) { float l = st.l[g]; l += __shfl_xor(l, 16); l += __shfl_xor(l, 32); st.l[g] = l; }
}


template <int VD> struct AtStageP {
    pg8::u32x4 k, v[VD / 64];
    __device__ __forceinline__ void load(const bf16_t* kbase, const bf16_t* vbase, int pitch, int key0, int tid) {
        const int row = tid >> 3, ch = tid & 7;
        k = *(const pg8::u32x4*)(kbase + (size_t)(key0 + row) * pitch + ch * 8);
#pragma unroll
        for (int i = 0; i < VD / 64; ++i) v[i] = *(const pg8::u32x4*)(vbase + (size_t)(key0 + row) * pitch + (ch + 8 * i) * 8);
    }
    __device__ __forceinline__ void store(LAS unsigned char* buf, int tid) const {
        const int row = tid >> 3, ch = tid & 7;
        *(LAS pg8::u32x4*)(buf + row * AT_KP + ch * 16) = k;
#pragma unroll
        for (int i = 0; i < VD / 64; ++i) *(LAS pg8::u32x4*)(buf + AtL<VD>::KB + row * AtL<VD>::VP + (ch + 8 * i) * 16) = v[i];
    }
};
template <int VD, class Fn>
__device__ __forceinline__ void at_run(LAS unsigned char* lds, const bf16_t* kbase, const bf16_t* vbase, int pitch, int tile_lo, int tile_hi, int tid, Fn fn) {
    if (tile_lo >= tile_hi) return;
    AtStageP<VD> sg; sg.load(kbase, vbase, pitch, tile_lo * 64, tid);
    __syncthreads();
    for (int i = tile_lo; i < tile_hi; ++i) {
        LAS unsigned char* buf = lds + ((i - tile_lo) & 1) * AtL<VD>::BUF;
        sg.store(buf, tid);
        __syncthreads();
        if (i + 1 < tile_hi) sg.load(kbase, vbase, pitch, (i + 1) * 64, tid);
        fn(i, (lds_cptr)buf, (lds_cptr)buf + AtL<VD>::KB);
    }
}
template <int VD, class Fn>
__device__ __forceinline__ void at_run_side(LAS unsigned char* lds, const bf16_t* kbase, const bf16_t* vbase, int pitch, int tile_lo, int tile_hi, int tid, CvJob& job, Fn fn) {
    if (tile_lo >= tile_hi) return;
    AtStageP<VD> sg; sg.load(kbase, vbase, pitch, tile_lo * 64, tid);
    __syncthreads();
    for (int i = tile_lo; i < tile_hi; ++i) {
        LAS unsigned char* buf = lds + ((i - tile_lo) & 1) * AtL<VD>::BUF;
        sg.store(buf, tid);
        __syncthreads();
        job.step(tid);
        if (i + 1 < tile_hi) sg.load(kbase, vbase, pitch, (i + 1) * 64, tid);
        fn(i, (lds_cptr)buf, (lds_cptr)buf + AtL<VD>::KB);
    }
}
template <int VD>
__device__ __forceinline__ void at_scores(f32x4 (&s)[2][4], lds_cptr Kb, const bf16x8 (&q)[2][2], int fr, int fq) {
    bf16x8 kn0 = *(const __attribute__((address_space(3))) bf16x8*)(Kb + fr * AT_KP + fq * 16);
    bf16x8 kn1 = *(const __attribute__((address_space(3))) bf16x8*)(Kb + fr * AT_KP + 64 + fq * 16);
#pragma unroll
    for (int kk = 0; kk < 4; ++kk) {
        const bf16x8 kf0 = kn0, kf1 = kn1;
        if (kk < 3) { kn0 = *(const __attribute__((address_space(3))) bf16x8*)(Kb + (16 * (kk + 1) + fr) * AT_KP + fq * 16);
                      kn1 = *(const __attribute__((address_space(3))) bf16x8*)(Kb + (16 * (kk + 1) + fr) * AT_KP + 64 + fq * 16); }
#pragma unroll
        for (int g = 0; g < 2; ++g) s[g][kk] = __builtin_amdgcn_mfma_f32_16x16x32_bf16(kf0, q[g][0], (f32x4){0.f, 0.f, 0.f, 0.f}, 0, 0, 0);
#pragma unroll
        for (int g = 0; g < 2; ++g) s[g][kk] = __builtin_amdgcn_mfma_f32_16x16x32_bf16(kf1, q[g][1], s[g][kk], 0, 0, 0);
    }
}

__device__ __forceinline__ void ph_diff_mfma(const Params& p, LAS unsigned char* lds, int li) {
    const int tid = tid_(), lane = tid & 63, w = tid >> 6, fr = lane & 15, fq = lane >> 4;
    const int G = gridDim.x, c = blockIdx.x;
    const float* lp = p.in[IN_DIF_LAMBDA] + li * 256;
    const float d01 = wave_sum(lp[lane] * lp[64 + lane]), d23 = wave_sum(lp[128 + lane] * lp[192 + lane]);
    const float lam_init = li ? p.lam_init[1] : p.lam_init[0];
    const float lam = expf(d01) - expf(d23) + lam_init;
    const float* subln = p.in[IN_DIF_SUBLN] + li * 128;
    LAS unsigned* oal = (LAS unsigned*)(lds + 2 * AtL<128>::BUF) + w * 2048 + lane;
    for (int L = c; L < 512; L += G) {
        int qb, b, h;
        if (G == 256) { const int rnd = L >> 8, x = c & 7, j = c >> 3; b = x; h = j >> 3; qb = rnd ? 15 - (j & 7) : (j & 7); }
        else { const int rnd = L / G; const int u = ((rnd & 1) && (512 % G == 0)) ? rnd * G + (G - 1 - (L - rnd * G)) : L; qb = u & 15; h = (u >> 4) & 3; b = u >> 6; }
        const bf16_t* vbase = p.Pb + (size_t)b * SEQ * LDPB + E_AV + h * 128;
        const int t0 = qb * 256 + w * 32;
#pragma unroll 1
        for (int jm = 0; jm < 2; ++jm) {
            const int hj = 2 * h + jm;
            const bf16_t* kbase = p.Pb + (size_t)b * SEQ * LDPB + E_AK + hj * 64;
            bf16x8 q[2][2];
#pragma unroll
            for (int g = 0; g < 2; ++g)
#pragma unroll
                for (int ks = 0; ks < 2; ++ks) q[g][ks] = *(const bf16x8*)(p.Pb + (size_t)(b * SEQ + t0 + g * 16 + fr) * LDPB + E_AQ + hj * 64 + ks * 32 + fq * 8);
            AtState<128> st; st.init();
            at_run<128>(lds, kbase, vbase, LDPB, 0, 4 * qb + 4, tid, [&](int i, lds_cptr Kb, lds_cptr Vb) {
                const int key0 = i * 64;
                if (key0 <= t0 + 31) {
                    if (key0 + 63 <= t0) at_tile<128, 0>(st, Kb, Vb, q, fr, fq, AtNoRow(), AtNoEl());
                    else { const int tq0 = t0 + fr - key0 - 4 * fq; at_tile<128, 2>(st, Kb, Vb, q, fr, fq, AtNoRow(), [=](int g, int kk, int r) { return 16 * kk + r <= tq0 + g * 16; }); }
                }
            });
            at_finish(st);
            if (jm == 0) {
#pragma unroll
                for (int g = 0; g < 2; ++g) { const float inv = 1.f / st.l[g];
#pragma unroll
                    for (int n = 0; n < 8; ++n) { const f32x4 o = st.o[g][n] * inv; oal[((g * 8 + n) * 2) * 64] = pk2(o[0], o[1]); oal[((g * 8 + n) * 2 + 1) * 64] = pk2(o[2], o[3]); } }
            } else {
#pragma unroll
                for (int g = 0; g < 2; ++g) { const float inv = 1.f / st.l[g];
                    float ss = 0.f;
#pragma unroll
                    for (int n = 0; n < 8; ++n) {
                        const f32x4 ob = st.o[g][n] * inv;
                        const unsigned b01 = pk2(ob[0], ob[1]), b23 = pk2(ob[2], ob[3]);
                        const unsigned a01 = oal[((g * 8 + n) * 2) * 64], a23 = oal[((g * 8 + n) * 2 + 1) * 64];
                        f32x4 r;
                        r[0] = __builtin_bit_cast(float, a01 << 16) - lam * __builtin_bit_cast(float, b01 << 16);
                        r[1] = __builtin_bit_cast(float, a01 & 0xffff0000u) - lam * __builtin_bit_cast(float, b01 & 0xffff0000u);
                        r[2] = __builtin_bit_cast(float, a23 << 16) - lam * __builtin_bit_cast(float, b23 << 16);
                        r[3] = __builtin_bit_cast(float, a23 & 0xffff0000u) - lam * __builtin_bit_cast(float, b23 & 0xffff0000u);
                        st.o[g][n] = r;
                        ss += (r[0] * r[0] + r[1] * r[1]) + (r[2] * r[2] + r[3] * r[3]);
                    }
                    ss += __shfl_xor(ss, 16); ss += __shfl_xor(ss, 32);
                    const float sc = (1.0f / sqrtf(ss * (1.f / 128.f) + LN_EPS)) * (1.f - lam_init);
                    bf16_t* dst = p.Ob + (size_t)(b * SEQ + t0 + g * 16 + fr) * DM + h * 128 + 4 * fq;
                    float4 swv[8];
#pragma unroll
                    for (int n = 0; n < 8; ++n) swv[n] = *(const float4*)(subln + n * 16 + 4 * fq);
#pragma unroll
                    for (int n = 0; n < 8; ++n) { const float4 sw = swv[n]; const f32x4 r = st.o[g][n];
                        u32x2 wv; wv.x = pk2(r[0] * sc * sw.x, r[1] * sc * sw.y); wv.y = pk2(r[2] * sc * sw.z, r[3] * sc * sw.w); *(u32x2*)(dst + n * 16) = wv; }
                }
            }
        }
    }
}

__device__ __forceinline__ float quad_xor1(float x) { return __builtin_bit_cast(float, __builtin_amdgcn_update_dpp(0, __builtin_bit_cast(int, x), 0xB1, 0xf, 0xf, false)); }
__device__ __forceinline__ float quad_xor2(float x) { return __builtin_bit_cast(float, __builtin_amdgcn_update_dpp(0, __builtin_bit_cast(int, x), 0x4E, 0xf, 0xf, false)); }
__device__ __forceinline__ void ph_moba_mfma(const Params& p, LAS unsigned char* lds, int li) {
    const int tid = tid_(), lane = tid & 63, w = tid >> 6, fr = lane & 15, fq = lane >> 4;
    CvJob job; job.init(p, li, (float*)((unsigned char*)lds + 65536), tid);
    const int G = gridDim.x, c = blockIdx.x;
    LAS unsigned* lmask = (LAS unsigned*)(lds + 40960);
#define MB_E(k, isb, qbv) ((unsigned long long)(((isb) << 4) | (qbv)) << (5 * (k)))
    unsigned long long code = 0ull; int nun = 0, sA = 0, sB = 0;
    if (G == 256) {
        if (c < 32) { sA = c; nun = 3; code = MB_E(0, 0, 15) | MB_E(1, 0, 8) | MB_E(2, 0, 1); }
        else {
            const int c2 = c - 32, pidx = c2 / 7, grp = c2 - pidx * 7; sA = pidx; sB = pidx + 32;
            if (grp == 0) { nun = 3; code = MB_E(0, 1, 15) | MB_E(1, 1, 14) | MB_E(2, 0, 4); }
            else if (grp == 1) { nun = 3; code = MB_E(0, 0, 14) | MB_E(1, 0, 13) | MB_E(2, 1, 6); }
            else if (grp == 2) { nun = 3; code = MB_E(0, 1, 13) | MB_E(1, 1, 12) | MB_E(2, 1, 8); }
            else if (grp == 3) { nun = 3; code = MB_E(0, 0, 12) | MB_E(1, 0, 11) | MB_E(2, 0, 10); }
            else if (grp == 4) { nun = 4; code = MB_E(0, 1, 11) | MB_E(1, 1, 10) | MB_E(2, 0, 7) | MB_E(3, 0, 3); }
            else if (grp == 5) { nun = 4; code = MB_E(0, 0, 9) | MB_E(1, 1, 9) | MB_E(2, 1, 7) | MB_E(3, 0, 6); }
            else { nun = 9; code = MB_E(0, 0, 5) | MB_E(1, 1, 5) | MB_E(2, 1, 4) | MB_E(3, 1, 3) | MB_E(4, 0, 2) | MB_E(5, 1, 2) | MB_E(6, 1, 1) | MB_E(7, 0, 0) | MB_E(8, 1, 0); }
        }
    } else nun = (c < 1024) ? (1024 - c + G - 1) / G : 0;
#undef MB_E
    for (int ui = 0; ui < nun; ++ui) {
        int qb, stream;
        if (G == 256) { const int e = (int)(code >> (5 * ui)) & 31; stream = (e & 16) ? sB : sA; qb = e & 15; }
        else { const int L = c + ui * G; const int rnd = L / G; const int u = ((rnd & 1) && (1024 % G == 0)) ? rnd * G + (G - 1 - (L - rnd * G)) : L; qb = u & 15; stream = u >> 4; }
        const int h = stream & 7, b = stream >> 3;
        const bf16_t* kbase = p.Pb + (size_t)b * SEQ * LDPB + O_CK + h * 64;
        const bf16_t* vbase = p.Pb + (size_t)b * SEQ * LDPB + O_CV + h * 64;
        const int t0 = qb * 256 + w * 32;
        bf16x8 q[2][2];
#pragma unroll
        for (int g = 0; g < 2; ++g)
#pragma unroll
            for (int ks = 0; ks < 2; ++ks) q[g][ks] = *(const bf16x8*)(p.Pb + (size_t)(b * SEQ + t0 + g * 16 + fr) * LDPB + O_CQ + h * 64 + ks * 32 + fq * 8);
        unsigned msk[2];
        {
            bf16x8 kmf[2];
#pragma unroll
            for (int ks = 0; ks < 2; ++ks) { const float* km = p.kmean + (size_t)((b * 16 + fr) * 8 + h) * 64 + ks * 32 + fq * 8;
                const float4 a0 = *(const float4*)km, a1 = *(const float4*)(km + 4);
                kmf[ks] = __builtin_bit_cast(bf16x8, (pg8::u32x4){pk2(a0.x, a0.y), pk2(a0.z, a0.w), pk2(a1.x, a1.y), pk2(a1.z, a1.w)}); }
            LAS float* lg = (LAS float*)(lds + 40960) + w * 512;
#pragma unroll
            for (int g = 0; g < 2; ++g) {
                f32x4 gs = Z4_;
                gs = __builtin_amdgcn_mfma_f32_16x16x32_bf16(kmf[0], q[g][0], gs, 0, 0, 0);
                gs = __builtin_amdgcn_mfma_f32_16x16x32_bf16(kmf[1], q[g][1], gs, 0, 0, 0);
                *(LAS f32x4*)(lg + (g * 16 + fr) * 16 + 4 * fq) = gs;
            }
#pragma unroll
            for (int g = 0; g < 2; ++g) {
                float gv[16];
#pragma unroll
                for (int c4 = 0; c4 < 4; ++c4) { const f32x4 t4 = *(const LAS f32x4*)(lg + (g * 16 + fr) * 16 + 4 * c4);
#pragma unroll
                    for (int e = 0; e < 4; ++e) gv[4 * c4 + e] = (4 * c4 + e < qb) ? t4[e] : -INFINITY; }
                unsigned m = 0u;
#pragma unroll
                for (int pick = 0; pick < 3; ++pick) {
                    float best = -INFINITY; int bi = -1;
#pragma unroll
                    for (int n = 0; n < 16; ++n) if (gv[n] > best) { best = gv[n]; bi = n; }
                    if (bi >= 0) m |= 1u << bi;
#pragma unroll
                    for (int n = 0; n < 16; ++n) gv[n] = (n == bi) ? -INFINITY : gv[n];
                }
                msk[g] = m;
            }
        }
        AtState<64> st; st.init();
        at_run_side<64>(lds, kbase, vbase, LDPB, 0, 4 * qb + 4, tid, job, [&](int i, lds_cptr Kb, lds_cptr Vb) {
            const int n = i >> 2, key0 = i * 64;
            if (n < qb) {
                const bool b0 = (msk[0] >> n) & 1u, b1 = (msk[1] >> n) & 1u;
                at_tile<64, 1>(st, Kb, Vb, q, fr, fq, [=](int g) { return g ? b1 : b0; }, AtNoEl());
            } else if (key0 <= t0 + 31) {
                const int tq0 = t0 + fr - key0 - 4 * fq;
                if (key0 + 63 <= t0) at_tile<64, 0>(st, Kb, Vb, q, fr, fq, AtNoRow(), AtNoEl());
                else at_tile<64, 2>(st, Kb, Vb, q, fr, fq, AtNoRow(), [=](int g, int kk, int r) { return 16 * kk + r <= tq0 + g * 16; });
            }
        });
        at_finish(st);
#pragma unroll
        for (int g = 0; g < 2; ++g) { const float inv = 1.f / st.l[g]; bf16_t* dst = p.Ob + (size_t)(b * SEQ + t0 + g * 16 + fr) * DM + h * 64 + 4 * fq;
#pragma unroll
            for (int n = 0; n < 4; ++n) { const f32x4 o = st.o[g][n] * inv; u32x2 wv; wv.x = pk2(o[0], o[1]); wv.y = pk2(o[2], o[3]); *(u32x2*)(dst + n * 16) = wv; } }
    }
    job.finish(tid);
}

__device__ __forceinline__ void ph_nsa_mfma(const Params& p, LAS unsigned char* lds, const bf16_t* cmpkb, const bf16_t* cmpvb) {
    const int tid = tid_(), lane = tid & 63, w = tid >> 6, fr = lane & 15, fq = lane >> 4;
    const int G = gridDim.x, c = blockIdx.x;
    LAS float* impA = (LAS float*)(lds + 40960) + w * 1024;
    LAS float* impB = impA + 512;
    LAS unsigned long long* selm = (LAS unsigned long long*)(lds + 73728) + w * 8;
    static_assert(2 * AtL<64>::BUF <= 40960, "NSA LDS map");
    for (int L = c; L < 1024; L += G) {
        int qb, stream;
        if (G == 256) { const int rnd = L >> 8, x = c & 7, j = c >> 3;
            stream = 2 * x + (rnd >> 1); qb = (rnd & 1) ? 63 - j : j; }
        else { const int rnd = L / G; const int u = ((rnd & 1) && (1024 % G == 0)) ? rnd * G + (G - 1 - (L - rnd * G)) : L; qb = u & 63; stream = u >> 6; }
        const int grp = stream & 1, b = stream >> 1;
        const int tw = qb * 64 + w * 8;
#define TQ(g) (tw + (g) * 4 + (fr >> 2))
#define TOKG(g) (b * SEQ + TQ(g))
        bf16x8 qraw[2][2];
#pragma unroll
        for (int g = 0; g < 2; ++g) {
            const int head = grp * 4 + (fr & 3);
#pragma unroll
            for (int ks = 0; ks < 2; ++ks) qraw[g][ks] = *(const bf16x8*)(p.Pb + (size_t)TOKG(g) * LDPB + O_DQ + head * 64 + ks * 32 + fq * 8);
        }
        LAS float* accl = (LAS float*)(lds + 75776) + w * 2048 + lane;
        const bf16_t* ck = cmpkb + (size_t)(b * 2 + grp) * 256 * 64; const bf16_t* cv = cmpvb + (size_t)(b * 2 + grp) * 256 * 64;
        int nv[2];
#pragma unroll
        for (int g = 0; g < 2; ++g) nv[g] = (TQ(g) >= 31) ? ((TQ(g) - 31) >> 4) + 1 : 0;
        const int nvmax_w = (tw + 7 >= 31) ? ((tw + 7 - 31) >> 4) + 1 : 0;
        const int nvmax_b = (qb * 64 + 63 >= 31) ? ((qb * 64 + 63 - 31) >> 4) + 1 : 0;
        const int ncmp_tiles = (nvmax_b + 63) >> 6;
        float mfin[2], linv[2];
        {
            AtState<64> st; st.init();
            at_run<64>(lds, ck, cv, 64, 0, ncmp_tiles, tid, [&](int i, lds_cptr Kb, lds_cptr Vb) {
                if (i * 64 < nvmax_w) { const int n0 = nv[0] - i * 64, n1 = nv[1] - i * 64;
                    at_tile<64, 2>(st, Kb, Vb, qraw, fr, fq, AtNoRow(), [=](int g, int kk, int r) { return 16 * kk + 4 * fq + r < (g ? n1 : n0); }); }
            });
            at_finish(st);
#pragma unroll
            for (int g = 0; g < 2; ++g) { mfin[g] = st.m[g]; linv[g] = st.l[g] > 0.f ? 1.f / st.l[g] : 0.f;
#pragma unroll
                for (int n = 0; n < 4; ++n) { const f32x4 o = st.o[g][n] * (linv[g] * p.GATES[(size_t)TOKG(g) * 24 + (grp * 4 + (fr & 3)) * 3]);
#pragma unroll
                    for (int r = 0; r < 4; ++r) accl[((g * 4 + n) * 4 + r) * 64] = o[r]; } }
        }
        for (int e = lane; e < 512; e += 64) { impA[e] = 0.f; impB[e] = 0.f; }
        at_run<64>(lds, ck, cv, 64, 0, ncmp_tiles, tid, [&](int i, lds_cptr Kb, lds_cptr) {
            if (i * 64 < nvmax_w) {
                f32x4 s[2][4]; at_scores<64>(s, Kb, qraw, fr, fq);
#pragma unroll
                for (int g = 0; g < 2; ++g)
#pragma unroll
                    for (int kk = 0; kk < 4; ++kk) {
                        float a = 0.f, last = 0.f;
#pragma unroll
                        for (int r = 0; r < 4; ++r) { const int n = i * 64 + 16 * kk + 4 * fq + r;
                            const float pv = (n < nv[g]) ? __builtin_amdgcn_exp2f(s[g][kk][r] * AT_SCALE2 - mfin[g]) * linv[g] : 0.f; a += pv; last = pv; }
                        a += quad_xor1(a); a += quad_xor2(a); last += quad_xor1(last); last += quad_xor2(last);
                        const int j = 16 * i + 4 * kk + fq, qi = g * 4 + (fr >> 2);
                        if ((fr & 3) == 0) { impA[qi * 64 + j] = a; if (j + 1 < 64) impB[qi * 64 + j + 1] = last; }
                    }
            }
        });
        {
            unsigned key[8], T[8];
#pragma unroll
            for (int qi = 0; qi < 8; ++qi) {
                const float imp = impA[qi * 64 + lane] + impB[qi * 64 + lane];
                const bool causal = lane <= qb, forced = (lane == 0) || (lane >= qb - 1 && causal);
                const float val = forced ? 1e30f : (causal ? imp : -1e30f);
                const unsigned u = __builtin_bit_cast(unsigned, val);
                key[qi] = (u & 0x80000000u) ? ~u : (u | 0x80000000u); T[qi] = 0u;
            }
#pragma nounroll
            for (int bit = 31; bit >= 0; --bit) {
#pragma unroll
                for (int qi = 0; qi < 8; ++qi) { const unsigned cand = T[qi] | (1u << bit); if (__popcll(__ballot(key[qi] >= cand)) >= 16) T[qi] = cand; }
            }
#pragma unroll
            for (int qi = 0; qi < 8; ++qi) {
                const bool gt = key[qi] > T[qi], eq = key[qi] == T[qi];
                const unsigned long long meq = __ballot(eq);
                const int need = 16 - __popcll(__ballot(gt));
                const unsigned long long mk = __ballot(gt || (eq && lane_rank(meq) < need));
                if (lane == 0) selm[qi] = mk;
            }
        }
        unsigned long long sm[2];
#pragma unroll
        for (int g = 0; g < 2; ++g) sm[g] = selm[g * 4 + (fr >> 2)];
        bf16x8 qrot[2][2];
#pragma unroll
        for (int g = 0; g < 2; ++g)
#pragma unroll
            for (int ks = 0; ks < 2; ++ks) qrot[g][ks] = *(const bf16x8*)(p.QRb + (size_t)TOKG(g) * 512 + (grp * 4 + (fr & 3)) * 64 + ks * 32 + fq * 8);
        {
            const bf16_t* kb = p.Pb + (size_t)b * SEQ * LDPB + O_KS + grp * 64; const bf16_t* vb = p.Pb + (size_t)b * SEQ * LDPB + O_VS + grp * 64;
            AtState<64> st; st.init();
            at_run<64>(lds, kb, vb, LDPB, 0, qb + 1, tid, [&](int i, lds_cptr Kb, lds_cptr Vb) {
                const bool b0 = (sm[0] >> i) & 1ull, b1 = (sm[1] >> i) & 1ull;
                { const int d0 = TQ(0) - i * 64, d1 = TQ(1) - i * 64;
                    if (i < qb) at_tile<64, 1>(st, Kb, Vb, qrot, fr, fq, [=](int g) { return g ? b1 : b0; }, AtNoEl());
                    else at_tile<64, 3>(st, Kb, Vb, qrot, fr, fq, [=](int g) { return g ? b1 : b0; }, [=](int g, int kk, int r) { return 16 * kk + 4 * fq + r <= (g ? d1 : d0); }); }
            });
            at_finish(st);
#pragma unroll
            for (int g = 0; g < 2; ++g) { const float sc = p.GATES[(size_t)TOKG(g) * 24 + (grp * 4 + (fr & 3)) * 3 + 1] / st.l[g];
#pragma unroll
                for (int n = 0; n < 4; ++n)
#pragma unroll
                    for (int r = 0; r < 4; ++r) accl[((g * 4 + n) * 4 + r) * 64] += st.o[g][n][r] * sc; }
        }
        {
            const bf16_t* kb = p.Pb + (size_t)b * SEQ * LDPB + O_KW + grp * 64; const bf16_t* vb = p.Pb + (size_t)b * SEQ * LDPB + O_VW + grp * 64;
            AtState<64> st; st.init();
            at_run<64>(lds, kb, vb, LDPB, (qb >= 8 ? qb - 8 : 0), qb + 1, tid, [&](int i, lds_cptr Kb, lds_cptr Vb) {
                const int d0 = TQ(0) - i * 64 - 4 * fq, d1 = TQ(1) - i * 64 - 4 * fq;
                if (i == qb || (qb >= 8 && i == qb - 8)) {
                    const int hi0 = (i == qb) ? d0 : 64, hi1 = (i == qb) ? d1 : 64, lo0 = (i == qb) ? -1 : d0 - 512, lo1 = (i == qb) ? -1 : d1 - 512;
                    at_tile<64, 2>(st, Kb, Vb, qrot, fr, fq, AtNoRow(), [=](int g, int kk, int r) { const int kx = 16 * kk + r; return kx <= (g ? hi1 : hi0) && kx > (g ? lo1 : lo0); });
                } else at_tile<64, 0>(st, Kb, Vb, qrot, fr, fq, AtNoRow(), AtNoEl());
            });
            at_finish(st);
#pragma unroll
            for (int g = 0; g < 2; ++g) { const float sc = p.GATES[(size_t)TOKG(g) * 24 + (grp * 4 + (fr & 3)) * 3 + 2] / st.l[g];
                bf16_t* dst = p.Ob + (size_t)TOKG(g) * DM + 512 + (grp * 4 + (fr & 3)) * 64 + 4 * fq;
#pragma unroll
                for (int n = 0; n < 4; ++n) { f32x4 o;
#pragma unroll
                    for (int r = 0; r < 4; ++r) o[r] = accl[((g * 4 + n) * 4 + r) * 64] + st.o[g][n][r] * sc;
                    u32x2 wv; wv.x = pk2(o[0], o[1]); wv.y = pk2(o[2], o[3]); *(u32x2*)(dst + n * 16) = wv; } }
        }
    }
#undef TQ
#undef TOKG
}

__device__ __forceinline__ unsigned pk_cnt_gt(unsigned acc, unsigned h, unsigned cm1, unsigned one2) {
    unsigned d;
    asm("v_pk_sub_u16 %0, %1, %2 clamp" : "=v"(d) : "v"(h), "v"(cm1));
    asm("v_pk_min_u16 %0, %1, %2" : "=v"(d) : "v"(d), "v"(one2));
    asm("v_pk_add_u16 %0, %1, %2" : "=v"(acc) : "v"(acc), "v"(d));
    return acc;
}
__device__ __forceinline__ int wave_total(int c) {
    int tot = 0;
#pragma unroll
    for (int bb = 0; bb < 7; ++bb) tot += __popcll(__ballot((c >> bb) & 1)) << bb;
    return tot;
}
#define SEL_CHUNKS(BODY) do { \
    _Pragma("unroll") for (int i = 0; i < 16; ++i) BODY(i) \
    if (tl >= 16) { _Pragma("unroll") for (int i = 16; i < 32; ++i) BODY(i) \
        if (tl >= 32) { _Pragma("unroll") for (int i = 32; i < 48; ++i) BODY(i) \
            if (tl >= 48) { _Pragma("unroll") for (int i = 48; i < 64; ++i) BODY(i) } } } } while (0)
__device__ __forceinline__ void ph_dsa_select(const Params& p, LAS unsigned char* lds, unsigned long long* BM) {
    const int tid = tid_(), lane = tid & 63, w = tid >> 6, fr = lane & 15, fq = lane >> 4;
    const int G = gridDim.x, c = blockIdx.x;
    LAS unsigned* sc = (LAS unsigned*)lds;
#define SEL_UNIT(LL, B, T0) do { if (G == 256) { const int rnd_ = (LL) >> 8, x_ = c & 7, j_ = c >> 3, idx_ = (rnd_ >> 1) * 32 + j_; B = x_; T0 = ((rnd_ & 1) ? (511 - idx_) : idx_) * 8; } \
        else { B = (LL) >> 9; T0 = ((LL) & 511) * 8; } } while (0)
#define SEL_LOADQ(B, T0) do { _Pragma("unroll") for (int g = 0; g < 2; ++g) { const size_t tokq_ = (size_t)(B) * SEQ + (T0) + g * 4 + (fr >> 2); \
        _Pragma("unroll") for (int ks = 0; ks < 2; ++ks) iq[g][ks] = *(const bf16x8*)(p.Pb + tokq_ * LDPB + E_IQ + (fr & 3) * 64 + ks * 32 + fq * 8); \
        iwv[g] = *(const float4*)(p.IW + ((size_t)(B) * SEQ + (T0) + g * 4 + fq) * 4); } } while (0)
#define SEL_LOADK(B, NSUB, SUB0, J0, J1) do { _Pragma("unroll") for (int j = J0; j < J1; ++j) { const int sub_ = ((SUB0) + 8 * j < (NSUB)) ? (SUB0) + 8 * j : (SUB0); \
        const bf16_t* kr_ = p.Pb + (size_t)((B) * SEQ + sub_ * 16 + fr) * LDPB + E_IK + fq * 8; \
        kf[j][0] = *(const bf16x8*)kr_; kf[j][1] = *(const bf16x8*)(kr_ + 32); } } while (0)
    bf16x8 iq[2][2]; float4 iwv[2]; bf16x8 kf[8][2];
    bool have = false;
    for (int L = c; L < 4096; L += G) {
        int b, t0; SEL_UNIT(L, b, t0);
        const int t = t0 + w; const size_t tok = (size_t)b * SEQ + t; const int ntile = (t >> 6) + 1;
        if (t0 + 7 < 256) {
            const int rem = t - lane * 64;
            const unsigned long long wd = (rem >= 63) ? ~0ull : (rem >= 0 ? ((1ull << (rem + 1)) - 1ull) : 0ull);
            if (lane < ntile) BM[tok * 64 + lane] = wd;
            continue;
        }
        const int nsub = (t0 + 8 + 15) >> 4;
        if (!have) { SEL_LOADQ(b, t0); SEL_LOADK(b, nsub, w, 0, 2); }
        have = false;
        SEL_LOADK(b, nsub, w, 2, 8);
        __syncthreads();
        for (int sub0 = w; sub0 < nsub; sub0 += 64) {
#pragma unroll
            for (int j = 0; j < 8; ++j) {
                const int sub = sub0 + 8 * j;
                if (sub < nsub) {
#pragma unroll
                    for (int g = 0; g < 2; ++g) {
                        f32x4 s = Z4_;
                        s = __builtin_amdgcn_mfma_f32_16x16x32_bf16(iq[g][0], kf[j][0], s, 0, 0, 0);
                        s = __builtin_amdgcn_mfma_f32_16x16x32_bf16(iq[g][1], kf[j][1], s, 0, 0, 0);
                        const int q = g * 4 + fq, key = sub * 16 + fr;
                        const float v = (iwv[g].x * fmaxf(s[0], 0.f) + iwv[g].y * fmaxf(s[1], 0.f)) + (iwv[g].z * fmaxf(s[2], 0.f) + iwv[g].w * fmaxf(s[3], 0.f));
                        const unsigned u = __builtin_bit_cast(unsigned, v);
                        const unsigned ks2 = (u & 0x80000000u) ? ~u : (u | 0x80000000u);
                        sc[q * 4096 + key] = (key <= t0 + q) ? ks2 : 0u;
                    }
                }
            }
            if (sub0 + 64 < nsub) SEL_LOADK(b, nsub, sub0 + 64, 0, 8);
        }
        __syncthreads();
        unsigned long long myword = 0ull;
        {
            const int tl = __builtin_amdgcn_readfirstlane(t >> 6);
            unsigned kreg[64];
#pragma unroll
            for (int i = 0; i < 64; ++i) kreg[i] = sc[w * 4096 + i * 64 + lane];
            __builtin_amdgcn_sched_barrier(0);
#pragma unroll
            for (int i = 0; i < 64; ++i) kreg[i] = (i * 64 + lane <= t) ? kreg[i] : 0u;
            unsigned T = 0u; bool exact = false; int need = 0;
            {
                LAS unsigned* hist = (LAS unsigned*)(lds + 131072) + w * 256;
                unsigned prefix = 0u, pmask = 0u; int remaining = 256;
                {
                    unsigned T8 = 0u; int acc_tot = t + 1, above = 0;
#pragma nounroll
                    for (int bit = 7; bit >= 0; --bit) {
                        const unsigned cand = (T8 | (1u << bit)) << 24;
                        int cnt = 0;
#define SEL_CNT(i) { cnt += (kreg[i] >= cand) ? 1 : 0; }
                        SEL_CHUNKS(SEL_CNT);
#undef SEL_CNT
                        const int tot = wave_total(cnt);
                        if (tot >= 256) { T8 |= 1u << bit; acc_tot = tot; } else above = tot;
                    }
                    remaining = 256 - above; prefix = T8 << 24; pmask = 0xff000000u;
                    exact = (acc_tot - above == remaining);
                }
                if (!exact) for (int pass = 1; pass < 4; ++pass) {
                    const int shift = 24 - 8 * pass;
#pragma unroll
                    for (int j = 0; j < 4; ++j) hist[lane + 64 * j] = 0u;
#define SEL_HIST(i) { const unsigned k = kreg[i]; if ((k & pmask) == prefix && k != 0u) __hip_atomic_fetch_add(&hist[(k >> shift) & 255u], 1u, __ATOMIC_RELAXED, __HIP_MEMORY_SCOPE_WORKGROUP); }
                    SEL_CHUNKS(SEL_HIST);
#undef SEL_HIST
                    unsigned cj[4]; unsigned sl = 0u;
#pragma unroll
                    for (int j = 0; j < 4; ++j) { cj[j] = hist[255 - 4 * lane - j]; sl += cj[j]; }
                    unsigned incl = 0u;
#pragma unroll
                    for (int bb = 0; bb < 13; ++bb) { const unsigned long long mb = __ballot((sl >> bb) & 1u); incl += (unsigned)(lane_rank(mb) + ((sl >> bb) & 1u)) << bb; }
                    const unsigned excl = incl - sl;
                    const bool cross = (excl < (unsigned)remaining) && ((unsigned)remaining <= incl);
                    unsigned dig = 0u, above = excl, cbin = 0u;
                    { unsigned accv = excl; bool found = false;
#pragma unroll
                      for (int j = 0; j < 4; ++j) { if (!found && accv + cj[j] >= (unsigned)remaining) { dig = 255u - 4u * lane - j; above = accv; cbin = cj[j]; found = true; } accv += cj[j]; } }
                    const unsigned long long mc = __ballot(cross);
                    const int src = mc ? __builtin_ctzll(mc) : 0;
                    dig = (unsigned)__builtin_amdgcn_readlane((int)dig, src); above = (unsigned)__builtin_amdgcn_readlane((int)above, src); cbin = (unsigned)__builtin_amdgcn_readlane((int)cbin, src);
                    prefix |= dig << shift; pmask |= 0xffu << shift; remaining -= (int)above;
                    if ((int)cbin == remaining) { exact = true; break; }
                }
                T = prefix; need = remaining;
            }
            if (exact) {
#define SEL_EX(i) { const unsigned long long msel = __ballot(kreg[i] >= T); if (lane == i) myword = msel; }
                SEL_CHUNKS(SEL_EX);
#undef SEL_EX
            } else {
                int taken = 0;
#define SEL_TIE(i) { const bool gt = kreg[i] > T, eq = kreg[i] == T; const unsigned long long meq = __ballot(eq); const bool sel = gt || (eq && (taken + lane_rank(meq) < need)); \
                    const unsigned long long msel = __ballot(sel); if (lane == i) myword = msel; taken += __popcll(meq); }
                SEL_CHUNKS(SEL_TIE);
#undef SEL_TIE
            }
        }
        if (lane < ntile) BM[tok * 64 + lane] = myword;
    }
#undef SEL_UNIT
#undef SEL_LOADQ
#undef SEL_LOADK
}
__device__ __forceinline__ void ph_dsa_attn(const Params& p, LAS unsigned char* lds, const unsigned long long* BM) {
    const int tid = tid_(), lane = tid & 63, w = tid >> 6, fr = lane & 15, fq = lane >> 4;
    const int G = gridDim.x, c = blockIdx.x;
    for (int L = c; L < 1024; L += G) {
        int qb, stream;
        if (G == 256) { const int rnd = L >> 8, x = c & 7, j = c >> 3;
            stream = 2 * x + (rnd >> 1); qb = (rnd & 1) ? 63 - j : j; }
        else { const int rnd = L / G; const int u = ((rnd & 1) && (1024 % G == 0)) ? rnd * G + (G - 1 - (L - rnd * G)) : L; qb = u & 63; stream = u >> 6; }
        const int grp = stream & 1, b = stream >> 1;
        const int tw = qb * 64 + w * 8, head = grp * 4 + (fr & 3);
#define TOKD(g) ((size_t)b * SEQ + tw + (g) * 4 + (fr >> 2))
        bf16x8 q[2][2];
#pragma unroll
        for (int g = 0; g < 2; ++g)
#pragma unroll
            for (int ks = 0; ks < 2; ++ks) q[g][ks] = *(const bf16x8*)(p.Pb + TOKD(g) * LDPB + E_BQ + head * 64 + ks * 32 + fq * 8);
        const bf16_t* kb = p.Pb + (size_t)b * SEQ * LDPB + E_BK + grp * 64; const bf16_t* vb = p.Pb + (size_t)b * SEQ * LDPB + E_BV + grp * 64;
        AtState<64> st; st.init();
        unsigned long long wn0 = BM[TOKD(0) * 64], wn1 = BM[TOKD(1) * 64];
        at_run<64>(lds, kb, vb, LDPB, 0, qb + 1, tid, [&](int i, lds_cptr Kb, lds_cptr Vb) {
            const unsigned long long w0 = wn0, w1 = wn1;
            if (i < qb) { wn0 = BM[TOKD(0) * 64 + i + 1]; wn1 = BM[TOKD(1) * 64 + i + 1]; }
            { const unsigned long long x0 = w0 >> (4 * fq), x1 = w1 >> (4 * fq);
                const int l0 = (int)(unsigned)x0, h0 = (int)(unsigned)(x0 >> 32), l1 = (int)(unsigned)x1, h1 = (int)(unsigned)(x1 >> 32);
                at_tile<64, 4>(st, Kb, Vb, q, fr, fq, AtNoRow(), [=](int g, int kk, int r) { const int bit = 16 * kk + r;
                    int mres; const int wsel = (bit < 32) ? (g ? l1 : l0) : (g ? h1 : h0);
                    asm("v_bfe_i32 %0, %1, %2, 1" : "=v"(mres) : "v"(wsel), "n"(bit & 31)); return mres; }); }
        });
        at_finish(st);
#pragma unroll
        for (int g = 0; g < 2; ++g) { const float inv = 1.f / st.l[g]; bf16_t* dst = p.Ob + TOKD(g) * DM + 512 + head * 64 + 4 * fq;
#pragma unroll
            for (int n = 0; n < 4; ++n) { const f32x4 o = st.o[g][n] * inv; u32x2 wv; wv.x = pk2(o[0], o[1]); wv.y = pk2(o[2], o[3]); *(u32x2*)(dst + n * 16) = wv; } }
#undef TOKD
    }
}

#define XB_TMO      128
#define XB_XCNT(j)  (256  + 64 * (j))
#define XB_XSUB(j)  (1280 + 64 * (j))
#define XB_XGEN(j)  (2304 + 64 * (j))
#define XB_TOP      3328
#define XB_TOPGEN   3392
#define XCD_BAR_WORDS 3456
#define XB_SPIN_CAP (1u << 24)
__device__ __forceinline__ unsigned xb_ld(unsigned* p)              { return __hip_atomic_load(p, __ATOMIC_RELAXED, __HIP_MEMORY_SCOPE_AGENT); }
__device__ __forceinline__ unsigned xb_add(unsigned* p, unsigned v) { return __hip_atomic_fetch_add(p, v, __ATOMIC_RELAXED, __HIP_MEMORY_SCOPE_AGENT); }
__device__ __forceinline__ unsigned xb_xcc_id() { return (unsigned)__builtin_amdgcn_s_getreg((3 << 11) | 20) & 0xFu; }
#define XB_SPIN(cond, bar) do { unsigned _sp = 0; while (cond) { __builtin_amdgcn_s_sleep(1); \
    if ((++_sp & 255u) == 0u) { if (xb_ld(&(bar)[XB_TMO])) break; if (_sp > XB_SPIN_CAP) { atomicAdd(&(bar)[XB_TMO], 1u); break; } } } } while (0)
struct XcdBarrier { unsigned* bar; unsigned x; volatile LAS unsigned* st; };
__device__ __forceinline__ XcdBarrier xcd_barrier_post(unsigned* bar, volatile LAS unsigned* st) {
    XcdBarrier b; b.bar = bar; b.x = xb_xcc_id(); b.st = st;
    if (threadIdx.x == 0) (void)xb_add(&bar[XB_XCNT(b.x)], 1u);
    return b;
}
__device__ __forceinline__ void xcd_barrier_complete(unsigned* bar, unsigned x, unsigned& nloc, unsigned& nx) {
    const unsigned G = gridDim.x * gridDim.y * gridDim.z;
    unsigned sum, cnt, mine, sp = 0u;
    for (;;) {
        sum = 0u; cnt = 0u; mine = 0u;
#pragma unroll
        for (unsigned j = 0; j < 16; ++j) { const unsigned c = xb_ld(&bar[XB_XCNT(j)]); sum += c; cnt += (c > 0u) ? 1u : 0u; mine = (j == x) ? c : mine; }
        if (sum == G) break;
        __builtin_amdgcn_s_sleep(1);
        if ((++sp & 255u) == 0u) { if (xb_ld(&bar[XB_TMO])) break; if (sp > XB_SPIN_CAP) { atomicAdd(&bar[XB_TMO], 1u); break; } }
    }
    nloc = mine > 0u ? mine : 1u; nx = cnt > 0u ? cnt : 1u;
}
__device__ __forceinline__ void xcd_barrier(unsigned* bar_in, volatile LAS unsigned* st) {
    asm volatile("s_waitcnt vmcnt(0)" ::: "memory");
    __syncthreads();
    if (threadIdx.x == 0) {
        unsigned* bar = bar_in; asm volatile("" : "+s"(bar));
        const unsigned x = xb_xcc_id();
        __builtin_amdgcn_s_waitcnt(0);
        unsigned nloc = st[0], nx = st[1];
        if (nloc == 0u) { xcd_barrier_complete(bar, x, nloc, nx); st[0] = nloc; st[1] = nx; }
        const unsigned old = xb_add(&bar[XB_XSUB(x)], 1u);
        const unsigned gen = old / nloc;
        if (old + 1u == (gen + 1u) * nloc) {
            __builtin_amdgcn_fence(__ATOMIC_RELEASE, "agent");
            asm volatile("s_waitcnt vmcnt(0)" ::: "memory");
            const unsigned og = xb_add(&bar[XB_TOP], 1u);
            const unsigned tg = og / nx;
            if (og + 1u == (tg + 1u) * nx) xb_add(&bar[XB_TOPGEN], 1u);
            else XB_SPIN(xb_ld(&bar[XB_TOPGEN]) == tg, bar);
            __builtin_amdgcn_fence(__ATOMIC_ACQUIRE, "agent");
            xb_add(&bar[XB_XGEN(x)], 1u);
            asm volatile("s_waitcnt vmcnt(0)" ::: "memory");
        } else {
            XB_SPIN(xb_ld(&bar[XB_XGEN(x)]) == gen, bar);
            __builtin_amdgcn_fence(__ATOMIC_ACQUIRE, "agent");
            asm volatile("s_waitcnt vmcnt(0)" ::: "memory");
        }
    }
    __syncthreads();
}

__global__ void __launch_bounds__(NT, 2) mega(Params p) {
    extern __shared__ __attribute__((aligned(16))) float lds[];
    PG8_LAS unsigned char* ldsL = (PG8_LAS unsigned char*)lds;
    volatile LAS unsigned* xst = (volatile LAS unsigned*)(lds + LDS_BYTES / 4);
    if (threadIdx.x == 0) { xst[0] = 0u; xst[1] = 0u; xst[2] = 0u; xst[3] = 0u; }
    __syncthreads();
    (void)xcd_barrier_post(p.bar, xst);
#define GRID_BAR() xcd_barrier(p.bar, xst)
    const int G = gridDim.x, cB = blockIdx.x;
    const float* const xin0 = p.in[IN_X];
    ph_init(p, lds);
    GRID_BAR();
    for (int l = 0; l < 4; ++l) {
        const int li = l >> 1;
        if ((l & 1) == 0) {
            {
                pg8::Gemm g{p.Xb, p.WinE + (size_t)li * NP_EVEN * DM, NTOK, NP_EVEN, DM}; pg8::StaticOrder S; S.init(NTOK, NP_EVEN, G, cB);
                EpiInEven E{p.Pb, p.IW, p.ropecs};
                pg8::gemm_phase<EpiInEven, pg8::StaticOrder, true, true>(ldsL, g, S, E);
            }
            GRID_BAR();
            ph_diff_mfma(p, (LAS unsigned char*)lds, li);
            __syncthreads();
            ph_dsa_select(p, (LAS unsigned char*)lds, p.BM);
            GRID_BAR();
            ph_dsa_attn(p, (LAS unsigned char*)lds, p.BM);
            GRID_BAR();
            {
                pg8::Gemm g{p.Ob, p.WoutE + (size_t)li * DM * DM, NTOK, DM, DM}; pg8::StaticOrder S; S.init(NTOK, DM, G, cB);
                EpiY E{(bf16_t*)p.Y};
                pg8::gemm_phase<EpiY, pg8::StaticOrder, true, true>(ldsL, g, S, E);
            }
            GRID_BAR();
        } else {
            {
                pg8::Gemm g{p.Xb, p.WinO + (size_t)li * NP_ODD * DM, NTOK, NP_ODD, DM}; pg8::StaticOrder S; S.init(NTOK, NP_ODD, G, cB);
                EpiInOdd E{p.Pb, p.QRb, p.GATES, p.ropecs, p.in[IN_NSA_GATE_B] + li * 24};
                pg8::gemm_phase<EpiInOdd, pg8::StaticOrder, true, true>(ldsL, g, S, E);
            }
            GRID_BAR();
            ph_kmean(p, lds);
            ph_cmp_build(p, li);
            GRID_BAR();
            {
                pg8::Gemm g{p.Ac, p.W1T + (size_t)li * 2 * 256 * 2048, 8192, 256, 2048}; ListOrder S{32, G, cB};
                EpiGeluH E{p.Hc};
                pg8::gemm_phase<EpiGeluH, ListOrder, true, true>(ldsL, g, S, E);
            }
            __syncthreads();
            ph_moba_mfma(p, (LAS unsigned char*)lds, li);
            GRID_BAR();
            {
                pg8::Gemm g{p.Hc, p.W2T + (size_t)li * 2 * 256 * 256, 8192, 256, 256}; ListOrder S{32, G, cB};
                EpiCmp E{p.CMP};
                pg8::gemm_phase<EpiCmp, ListOrder, true, true>(ldsL, g, S, E);
            }
            GRID_BAR();
            ph_nsa_mfma(p, (LAS unsigned char*)lds, p.CMP, p.CMP + (size_t)4096 * 64);
            GRID_BAR();
            {
                pg8::Gemm g{p.Ob, p.WoutO + (size_t)li * DM * DM, NTOK, DM, DM}; pg8::StaticOrder S; S.init(NTOK, DM, G, cB);
                EpiY E{(bf16_t*)p.Y};
                pg8::gemm_phase<EpiY, pg8::StaticOrder, true, true>(ldsL, g, S, E);
            }
            GRID_BAR();
        }
        if (l & 1) ph_ln_router(p, p.in[IN_LN_MIX_G] + l * DM, p.in[IN_LN_MIX_B] + l * DM, li, lds);
        else if (l == 0) ph_ln<0, 0>(p, p.in[IN_LN_MIX_G] + l * DM, p.in[IN_LN_MIX_B] + l * DM, xin0, p.X, p.Xb, false);
        else ph_ln<0, 1>(p, p.in[IN_LN_MIX_G] + l * DM, p.in[IN_LN_MIX_B] + l * DM, xin0, p.X, p.Xb, false);
        GRID_BAR();
        if ((l & 1) == 0) {
            {
                pg8::Gemm g{p.Xb, p.WguD + (size_t)li * 2 * F_DENSE * DM, NTOK, 2 * F_DENSE, DM}; pg8::StaticOrder S; S.init(NTOK, 2 * F_DENSE, G, cB);
                EpiGU E{p.H, F_DENSE, 2 * F_DENSE / 256, 0};
                pg8::gemm_phase<EpiGU, pg8::StaticOrder, true, true>(ldsL, g, S, E);
            }
            GRID_BAR();
            {
                pg8::Gemm g{p.H, p.WdD + (size_t)li * DM * F_DENSE, NTOK, DM, F_DENSE}; pg8::StaticOrder S; S.init(NTOK, DM, G, cB);
                EpiY E{(bf16_t*)p.Y};
                pg8::gemm_phase<EpiY, pg8::StaticOrder, true, true>(ldsL, g, S, E);
            }
            GRID_BAR();
            ph_ln<0, 1>(p, p.in[IN_LN_FFN_G] + l * DM, p.in[IN_LN_FFN_B] + l * DM, xin0, p.X, p.Xb, false);
            GRID_BAR();
        } else {
            ph_slots(p, lds);
            GRID_BAR();
            __syncthreads();
            for (int i = tid_(); i < NTILE256; i += NT) ((LAS int*)((LAS unsigned char*)lds + MOE_TE_LDS))[i] = p.tile_e[i];
            __syncthreads();
#pragma unroll 1
            for (int hf = 0; hf < 3; ++hf) {
                const int t0 = hf * 128, ntr = (hf < 2) ? 128 : NTILE256 - 256;
                if (G == 256) {
                    EpiGU E{p.Hm, F_EXPERT, 2 * F_EXPERT / 256, t0};
#pragma unroll 1
                    for (int rb = 0; rb < (hf < 2 ? 2 : 1); ++rb) {
                        pg8::Gemm g{p.Xb, p.WguM, NSLOT, 2 * F_EXPERT, DM}; MoeOrderG S{t0, ntr, 2 * F_EXPERT / 256, G, cB, rb, p.slot_tok};
                        pg8::gemm_phase<EpiGU, MoeOrderG, true, true>(ldsL, g, S, E);
                        __syncthreads();
                    }
                } else {
                    pg8::Gemm g{p.Xs, p.WguM, NSLOT, 2 * F_EXPERT, DM}; MoeOrder S{t0, ntr, 2 * F_EXPERT / 256, G, cB};
                    EpiGU E{p.Hm, F_EXPERT, 2 * F_EXPERT / 256, t0};
                    pg8::gemm_phase<EpiGU, MoeOrder, true, true>(ldsL, g, S, E);
                }
                GRID_BAR();
                if (hf < 2) {
                    pg8::Gemm g{p.Hm - (size_t)t0 * 256 * F_EXPERT, p.WdM, NSLOT, DM, F_EXPERT}; MoeOrder S{t0, ntr, DM / 256, G, cB};
                    EpiDownMoe E{p.Ys, p.slot_gate};
                    pg8::gemm_phase<EpiDownMoe, MoeOrder, true, true>(ldsL, g, S, E);
                } else {
                    pg8::Gemm g{p.Hm - (size_t)t0 * 256 * F_EXPERT, p.WdM, NSLOT, DM, MOE_KSL_K, F_EXPERT}; TailOrder S{G, cB};
                    EpiDownTail E{p.Yp, p.slot_gate};
                    pg8::gemm_phase<EpiDownTail, TailOrder, true, true>(ldsL, g, S, E);
                }
                GRID_BAR();
            }
            ph_ln<1, 1>(p, p.in[IN_LN_FFN_G] + l * DM, p.in[IN_LN_FFN_B] + l * DM, xin0, p.X, p.Xb, l == 3);
            GRID_BAR();
        }
    }
    if (xb_ld(&p.bar[XB_TMO])) { for (int i = blockIdx.x * NT + threadIdx.x; i < NTOK * DM; i += gridDim.x * NT) p.X[i] = __builtin_nanf(""); }
}

extern "C" void kernel_launch(void* const* d_in, const int* in_sizes, int n_in, void* d_out, int out_size, void* d_ws, size_t ws_size, hipStream_t stream) {
    Params p; memset(&p, 0, sizeof(p));
    for (int i = 0; i < 23; ++i) p.in[i] = (const float*)d_in[i];
    p.X = (float*)d_out;
    unsigned char* w = (unsigned char*)d_ws; size_t off = 0;
    auto take = [&](size_t bytes) { unsigned char* r = w + off; off += (bytes + 255) / 256 * 256; return r; };
    p.bar = (unsigned*)take(16384);
    p.ropecs = (float*)take(4096 * 32 * 2 * 4);
    p.IW = (float*)take((size_t)NTOK * 4 * 4);
    p.BM = (unsigned long long*)take((size_t)NTOK * 64 * 8);
    p.GATES = (float*)take((size_t)NTOK * 24 * 4);
    p.kmean = (float*)take(8 * 16 * 8 * 64 * 4);
    p.cmpk = (float*)take(8 * 256 * 2 * 64 * 4);
    p.cmpv = (float*)take(8 * 256 * 2 * 64 * 4);
    p.tok_e = (int*)take(NTOK * 2 * 4);
    p.tok_g = (float*)take(NTOK * 2 * 4);
    p.tok_slot = (int*)take(NTOK * 2 * 4);
    p.slot_tok = (int*)take(NSLOT * 4);
    p.slot_gate = (float*)take(NSLOT * 4);
    p.chunk_cnt = (int*)take(256 * 8 * 4);
    p.tile_e = (int*)take(NTILE256 * 4);
    p.W1T = (bf16_t*)take((size_t)2 * 2 * 256 * 2048 * 2);
    p.W2T = (bf16_t*)take((size_t)2 * 2 * 256 * 256 * 2);
    p.CMP = (bf16_t*)take((size_t)8192 * 64 * 2);
    p.WinE = (bf16_t*)take((size_t)2 * NP_EVEN * DM * 2);
    p.WoutE = (bf16_t*)take((size_t)2 * DM * DM * 2);
    p.WguD = (bf16_t*)take((size_t)2 * 2 * F_DENSE * DM * 2);
    p.WdD = (bf16_t*)take((size_t)2 * DM * F_DENSE * 2);
    p.WinO = (bf16_t*)take((size_t)2 * NP_ODD * DM * 2);
    p.WoutO = (bf16_t*)take((size_t)2 * DM * DM * 2);
    p.WguM = (bf16_t*)take((size_t)N_EXP * 2 * F_EXPERT * DM * 2);
    p.WdM = (bf16_t*)take((size_t)N_EXP * DM * F_EXPERT * 2);
    p.Xb = (bf16_t*)take((size_t)(NTOK + 1) * DM * 2);
    unsigned char* R = w + off;
    {   size_t o = 0; auto tk = [&](size_t bytes) { unsigned char* r = R + o; o += (bytes + 255) / 256 * 256; return r; };
        p.Pb = (bf16_t*)tk((size_t)NTOK * LDPB * 2); p.H = p.Pb;
        p.Ob = (bf16_t*)tk((size_t)NTOK * DM * 2);
        p.QRb = (bf16_t*)tk((size_t)NTOK * 512 * 2);
        p.Y = (float*)tk((size_t)NTOK * DM * 4);
        p.Ac = (bf16_t*)p.Y; p.Hc = p.Ac + (size_t)2 * 4096 * 2048; }
    {   size_t o = 0; auto tk = [&](size_t bytes) { unsigned char* r = R + o; o += (bytes + 255) / 256 * 256; return r; };
        p.Xs = (bf16_t*)tk((size_t)NSLOT * DM * 2);
        p.Hm = (bf16_t*)tk((size_t)MOE_HALF_TILES * 256 * F_EXPERT * 2);
        p.Ys = (bf16_t*)tk((size_t)NSLOT * DM * 2);
        p.Yp = p.Hm + (size_t)16 * 256 * F_EXPERT; }
    p.lam_init[0] = (float)(0.8 - 0.6 * exp(-0.3 * 0.0));
    p.lam_init[1] = (float)(0.8 - 0.6 * exp(-0.3 * 2.0));
    constexpr int kDynLds = LDS_BYTES + 16;
    static int grid = 0;
    if (!grid) {
        int dev = 0, cus = 0, per_cu = 0;
        (void)hipGetDevice(&dev);
        (void)hipDeviceGetAttribute(&cus, hipDeviceAttributeMultiprocessorCount, dev);
        (void)hipFuncSetAttribute((const void*)mega, hipFuncAttributeMaxDynamicSharedMemorySize, kDynLds);
        (void)hipOccupancyMaxActiveBlocksPerMultiprocessor(&per_cu, (const void*)mega, NT, kDynLds);
        if (cus <= 0) cus = 256;
        grid = cus;
    }
    (void)hipMemsetAsync(p.bar, 0, XCD_BAR_WORDS * sizeof(unsigned), stream);
    mega<<<grid, NT, kDynLds, stream>>>(p);
}
```

```cpp
#include <hip/hip_runtime.h>
#include <stdint.h>
#include <string.h>
#include <math.h>

__device__ __forceinline__ int tid_() { int t = threadIdx.x; asm volatile("" : "+v"(t)); return t; }
__device__ __forceinline__ float zero1_() { float z = 0.f; asm volatile("" : "+v"(z)); return z; }
namespace pg8 {
#define PG8_LAS __attribute__((address_space(3)))
typedef unsigned short bf16_t;
typedef short bf16x8 __attribute__((ext_vector_type(8)));
typedef float f32x4 __attribute__((ext_vector_type(4)));
typedef unsigned u32x4 __attribute__((ext_vector_type(4)));
constexpr int BM = 256, BK = 64, HALF = 128, HTB = HALF * BK * 2  , STAGE_BYTES = 8 * HTB, NXCD = 8, WGM = 8;

__host__ __device__ __forceinline__ int lds_byte(int r, int c) { const int st = (r >> 4) * 2 + (c >> 5), rr = r & 15, cc = c & 31, ob = rr * 64 + cc * 2; return st * 1024 + (ob ^ (((ob >> 9) & 1) << 5)); }
__host__ __device__ __forceinline__ void stage_rc(int b, int& R, int& C) { const int st = b / 1024, sb = b % 1024, swz = sb ^ (((sb >> 9) & 1) << 5); R = (st >> 1) * 16 + swz / 64; C = (st & 1) * 32 + (swz % 64) / 2; }
__host__ __device__ __forceinline__ int perm32(int rho) { const int n = rho >> 4, i = rho & 15; return 8 * (i >> 2) + 4 * n + (i & 3); }

struct Unit { int pm, pn, ko; };
struct Gemm { const bf16_t* A; const bf16_t* Bt; int M, N, K, ld; };

struct StaticOrder {
    static constexpr bool KSPLIT = false, GATHER_A = false;
    int nM, nN, nwg, G, c;
    __host__ __device__ void init(int M, int N, int G_, int c_) { nM = M / BM; nN = N / BM; nwg = nM * nN; G = G_; c = c_; }
    __host__ __device__ bool next(int i, Unit& u) const {
        const long L = (long)i * G + c; if (L >= nwg) return false;
        int wgid = (int)L; { const int q = nwg / NXCD, r = nwg % NXCD, xcd = wgid % NXCD, off = wgid / NXCD; wgid = (xcd < r ? xcd * (q + 1) : r * (q + 1) + (xcd - r) * q) + off; }
        const int nig = WGM * nN, gid = wgid / nig, fm = gid * WGM, gsz = (nM - fm) < WGM ? (nM - fm) : WGM;
        u.pm = fm + ((wgid % nig) % gsz); u.pn = (wgid % nig) / gsz; return true;
    }
    __device__ __forceinline__ void a_ready(const Unit&) const {}
    __device__ __forceinline__ void done(const Unit&) const {}
};

__device__ __forceinline__ unsigned cvt_pk_bf16(float lo, float hi) { unsigned r; asm volatile("v_cvt_pk_bf16_f32 %0, %1, %2" : "=v"(r) : "v"(lo), "v"(hi)); return r; }
typedef float f32x2 __attribute__((ext_vector_type(2)));
template <class Epi, class Sched, bool ALIGN_EPI = false, bool SP2 = false>
__device__ __forceinline__ void gemm_phase(PG8_LAS unsigned char* lds, const Gemm g, const Sched& S, const Epi& E) {
    const int tid = tid_(), wid = __builtin_amdgcn_readfirstlane(tid >> 6), lane = tid & 63, wr = wid >> 2, wc = wid & 3, fr = lane & 15, fq = lane >> 4;
    const int K = g.K, nt = K / BK, LD = g.ld ? g.ld : K;
    unsigned voffA[2], voffB[2];
#pragma unroll
    for (int i = 0; i < 2; ++i) { int R, C; stage_rc(tid * 16 + i * 8192, R, C); const int Rb = Epi::PERM ? ((R & ~31) + perm32(R & 31)) : R;
        voffA[i] = (unsigned)(R * LD + C) * 2u; voffB[i] = (unsigned)(Rb * LD + C) * 2u; }
    const size_t kstep = (size_t)(BK * 2);
    const size_t hstep = (size_t)HALF * LD * 2;
    const size_t tstep = 2 * hstep;
    const unsigned ldsw = (unsigned)wid * 1024u;
    const int aoff = lds_byte(wr * 64 + fr, fq * 8), boff = lds_byte(wc * 32 + fr, fq * 8);
#define PG8_SA(b, h) (((b) * 2 + (h)) * HTB)
#define PG8_SB(b, h) ((4 + (b) * 2 + (h)) * HTB)
#define PG8_STAGE(bufoff, gbase, voff) do { _Pragma("unroll") for (int _i = 0; _i < 2; ++_i) \
        __builtin_amdgcn_global_load_lds((const unsigned*)((const char*)(gbase) + (voff)[_i]), (PG8_LAS unsigned*)(lds + (bufoff) + ldsw + _i * 8192), 16, 0, 0); } while (0)
#define PG8_LDA(dst, b, h) do { _Pragma("unroll") for (int m = 0; m < 4; ++m) _Pragma("unroll") for (int k = 0; k < 2; ++k) dst[m][k] = *(const PG8_LAS bf16x8*)(lds + PG8_SA(b, h) + aoff + m * 2048 + k * 1024); } while (0)
#define PG8_LDB(dst, b, h) do { _Pragma("unroll") for (int n = 0; n < 2; ++n) _Pragma("unroll") for (int k = 0; k < 2; ++k) dst[n][k] = *(const PG8_LAS bf16x8*)(lds + PG8_SB(b, h) + boff + n * 2048 + k * 1024); } while (0)
#define PG8_MMA(ai, bj, At, Bt) do { __builtin_amdgcn_s_setprio(1); _Pragma("unroll") for (int m = 0; m < 4; ++m) _Pragma("unroll") for (int n = 0; n < 2; ++n) _Pragma("unroll") for (int k = 0; k < 2; ++k) \
        acc[ai][bj][m][n] = __builtin_amdgcn_mfma_f32_16x16x32_bf16(Bt[n][k], At[m][k], acc[ai][bj][m][n], 0, 0, 0); __builtin_amdgcn_s_setprio(0); } while (0)
#define PG8_WAIT_V(n) asm volatile("s_waitcnt vmcnt(" #n ")" ::: "memory")
#define PG8_WAIT_L(n) asm volatile("s_waitcnt lgkmcnt(" #n ")" ::: "memory")
#define PG8_BAR __builtin_amdgcn_s_barrier()
#define PG8_SCHED __builtin_amdgcn_sched_barrier(0)
    Unit cur, nxt; int ui = 0;
    if (!S.next(0, cur)) return;
    unsigned voffA1[2]; size_t hstepA = hstep;
#pragma unroll
    for (int i = 0; i < 2; ++i) voffA1[i] = voffA[i];
    if constexpr (Sched::GATHER_A) {
        hstepA = 0;
#pragma unroll
        for (int i = 0; i < 2; ++i) { int R, C; stage_rc(tid * 16 + i * 8192, R, C);
            voffA[i] = (unsigned)(S.arow(cur.pm * 256 + R) * LD + C) * 2u; voffA1[i] = (unsigned)(S.arow(cur.pm * 256 + 128 + R) * LD + C) * 2u; }
    }
    f32x4 acc[2][2][4][2];
#pragma unroll
    for (int a = 0; a < 2; ++a)
#pragma unroll
        for (int b = 0; b < 2; ++b)
#pragma unroll
            for (int m = 0; m < 4; ++m)
#pragma unroll
                for (int n = 0; n < 2; ++n) acc[a][b][m][n] = ([]() { const float z = zero1_(); return (f32x4){z, z, z, z}; }());
    bf16x8 At[4][2], B0[2][2], B1[2][2];
    const char* cA = (const char*)g.A + (Sched::GATHER_A ? (size_t)0 : (size_t)cur.pm * tstep); const char* cB = (const char*)g.Bt + (size_t)cur.pn * tstep;
    if constexpr (Sched::KSPLIT) { cA += (size_t)cur.ko * 2; cB += (size_t)cur.ko * 2; }
    S.a_ready(cur);
    if constexpr (SP2) {
        PG8_STAGE(PG8_SB(0, 0), cB, voffB); PG8_STAGE(PG8_SB(0, 1), cB + hstep, voffB); PG8_STAGE(PG8_SA(0, 0), cA, voffA); PG8_STAGE(PG8_SA(0, 1), cA + hstepA, voffA1);
        if (wr == 1) PG8_BAR;
        PG8_WAIT_V(2); PG8_BAR;
        PG8_STAGE(PG8_SB(1, 0), cB + kstep, voffB); PG8_STAGE(PG8_SA(1, 0), cA + kstep, voffA); PG8_STAGE(PG8_SB(1, 1), cB + hstep + kstep, voffB);
        PG8_WAIT_V(6); PG8_BAR;
    } else {
        PG8_STAGE(PG8_SB(0, 0), cB, voffB); PG8_STAGE(PG8_SA(0, 0), cA, voffA); PG8_STAGE(PG8_SB(0, 1), cB + hstep, voffB); PG8_STAGE(PG8_SA(0, 1), cA + hstepA, voffA1);
        if (wr == 1) PG8_BAR;
        PG8_WAIT_V(4); PG8_BAR;
        PG8_STAGE(PG8_SB(1, 0), cB + kstep, voffB); PG8_STAGE(PG8_SA(1, 0), cA + kstep, voffA); PG8_STAGE(PG8_SB(1, 1), cB + hstep + kstep, voffB);
        PG8_WAIT_V(6); PG8_BAR;
    }
    for (;;) {
        const bool has_next = S.next(ui + 1, nxt);
        const char* nA = has_next ? (const char*)g.A + (Sched::GATHER_A ? (size_t)0 : (size_t)nxt.pm * tstep) : cA; const char* nB = has_next ? (const char*)g.Bt + (size_t)nxt.pn * tstep : cB;
        if constexpr (Sched::KSPLIT) { if (has_next) { nA += (size_t)nxt.ko * 2; nB += (size_t)nxt.ko * 2; } }
        for (int t = 0; t < nt; t += 2) {
            const bool last = (t == nt - 2);
            const char* a1 = cA + (size_t)(t + 1) * kstep;
            const char* a2 = last ? nA : cA + (size_t)(t + 2) * kstep; const char* b2 = last ? nB : cB + (size_t)(t + 2) * kstep;
            const char* a3 = a2 + kstep; const char* b3 = b2 + kstep;
            if (last && has_next) S.a_ready(nxt);
            if constexpr (SP2) {
            PG8_LDB(B0, 0, 0); PG8_LDB(B1, 0, 1); PG8_SCHED; PG8_LDA(At, 0, 0); PG8_STAGE(PG8_SA(1, 1), a1 + hstepA, voffA1);
            PG8_WAIT_V(8); PG8_WAIT_L(0); PG8_BAR; PG8_MMA(0, 0, At, B0); PG8_MMA(0, 1, At, B1); PG8_BAR; PG8_SCHED;
            PG8_LDA(At, 0, 1); PG8_STAGE(PG8_SB(0, 0), b2, voffB); PG8_STAGE(PG8_SB(0, 1), b2 + hstep, voffB); PG8_STAGE(PG8_SA(0, 0), a2, voffA);
            PG8_WAIT_V(8); PG8_WAIT_L(0); PG8_BAR; PG8_MMA(1, 0, At, B0); PG8_MMA(1, 1, At, B1); PG8_BAR; PG8_SCHED;
            PG8_LDB(B0, 1, 0); PG8_LDB(B1, 1, 1); PG8_SCHED; PG8_LDA(At, 1, 0); PG8_STAGE(PG8_SA(0, 1), a2 + hstepA, voffA1);
            PG8_WAIT_V(8); PG8_WAIT_L(0); PG8_BAR; PG8_MMA(0, 0, At, B0); PG8_MMA(0, 1, At, B1); PG8_BAR; PG8_SCHED;
            PG8_LDA(At, 1, 1); PG8_STAGE(PG8_SB(1, 0), b3, voffB); PG8_STAGE(PG8_SB(1, 1), b3 + hstep, voffB); PG8_STAGE(PG8_SA(1, 0), a3, voffA);
            PG8_WAIT_V(8); PG8_WAIT_L(0); PG8_BAR; PG8_MMA(1, 0, At, B0); PG8_MMA(1, 1, At, B1); PG8_BAR; PG8_SCHED;
            } else {
            PG8_LDB(B0, 0, 0); PG8_SCHED; PG8_LDA(At, 0, 0); PG8_STAGE(PG8_SA(1, 1), a1 + hstepA, voffA1);
            PG8_WAIT_L(8); PG8_BAR; PG8_WAIT_L(0); PG8_MMA(0, 0, At, B0); PG8_BAR; PG8_SCHED;
            PG8_LDB(B1, 0, 1); PG8_STAGE(PG8_SB(0, 0), b2, voffB);
            PG8_BAR; PG8_WAIT_L(0); PG8_MMA(0, 1, At, B1); PG8_BAR;
            PG8_LDA(At, 0, 1); PG8_STAGE(PG8_SA(0, 0), a2, voffA);
            PG8_BAR; PG8_WAIT_L(0); PG8_MMA(1, 0, At, B0); PG8_BAR; PG8_SCHED;
            PG8_STAGE(PG8_SB(0, 1), b2 + hstep, voffB);
            PG8_WAIT_V(6); PG8_BAR; PG8_MMA(1, 1, At, B1); PG8_BAR;
            PG8_LDB(B0, 1, 0); PG8_SCHED; PG8_LDA(At, 1, 0); PG8_STAGE(PG8_SA(0, 1), a2 + hstepA, voffA1);
            PG8_WAIT_L(8); PG8_BAR; PG8_WAIT_L(0); PG8_MMA(0, 0, At, B0); PG8_BAR; PG8_SCHED;
            PG8_LDB(B1, 1, 1); PG8_STAGE(PG8_SB(1, 0), b3, voffB);
            PG8_BAR; PG8_WAIT_L(0); PG8_MMA(0, 1, At, B1); PG8_BAR;
            PG8_LDA(At, 1, 1); PG8_STAGE(PG8_SA(1, 0), a3, voffA);
            PG8_BAR; PG8_WAIT_L(0); PG8_MMA(1, 0, At, B0); PG8_BAR; PG8_SCHED;
            PG8_STAGE(PG8_SB(1, 1), b3 + hstep, voffB);
            PG8_WAIT_V(6); PG8_BAR; PG8_MMA(1, 1, At, B1); PG8_BAR;
            }
        }
        if constexpr (ALIGN_EPI) { if (wr == 0) PG8_BAR; }
        if constexpr (!Epi::AFTER_DRAIN) { E(acc, cur, wr, wc, fr, fq); S.done(cur); }
        if (!has_next) break;
#pragma unroll
        for (int a = 0; a < 2; ++a)
#pragma unroll
            for (int b = 0; b < 2; ++b)
#pragma unroll
                for (int m = 0; m < 4; ++m)
#pragma unroll
                    for (int n = 0; n < 2; ++n) acc[a][b][m][n] = ([]() { const float z = zero1_(); return (f32x4){z, z, z, z}; }());
        cur = nxt; cA = nA; cB = nB; ++ui;
        if constexpr (ALIGN_EPI) { if (wr == 1) PG8_BAR; }
    }
    PG8_WAIT_V(0);
    if constexpr (!ALIGN_EPI) { if (wr == 0) PG8_BAR; }
    PG8_BAR;
    if constexpr (Epi::AFTER_DRAIN) { E.fused(acc, cur, wr, wc, fr, fq, lds, wid, lane); S.done(cur); }
#undef PG8_SA
#undef PG8_SB
#undef PG8_STAGE
#undef PG8_LDA
#undef PG8_LDB
#undef PG8_MMA
#undef PG8_WAIT_V
#undef PG8_WAIT_L
#undef PG8_BAR
#undef PG8_SCHED
}
}
using pg8::bf16_t; using pg8::f32x4; using pg8::Unit;
typedef unsigned u32x2 __attribute__((ext_vector_type(2)));

#define NT 512
#define Z4_ ([]() { const float z = zero1_(); return (f32x4){z, z, z, z}; }())
#define LAS __attribute__((address_space(3)))
constexpr int NTOK = 32768, DM = 1024, SEQ = 4096;
constexpr int LDPB = 3072;
constexpr float ALPHA = 1.681792830507429f;
constexpr float LN_EPS = 1e-5f;
constexpr int E_AQ = 0, E_AK = 512, E_AV = 1024, E_BQ = 1536, E_BK = 2048, E_BV = 2176, E_IQ = 2304, E_IK = 2560, E_IW = 2624, P_EVEN = 2628, NP_EVEN = 2816;
constexpr int O_CQ = 0, O_CK = 512, O_CV = 1024, O_DQ = 1536, O_KC = 2048, O_VC = 2176, O_KS = 2304, O_VS = 2432, O_KW = 2560, O_VW = 2688, O_DG = 2816, P_ODD = 2840, NP_ODD = 3072;
constexpr int F_DENSE = 2816, F_EXPERT = 3584, N_EXP = 8;
constexpr int NSLOT = 65536 + 8 * 256;
constexpr int NTILE256 = NSLOT / 256;
constexpr int MOE_HALF_TILES = NTILE256 / 2;
constexpr int LDS_BYTES = 147456;

__constant__ float c_inv[32] = {1.0f, 0.7498942613601685f, 0.5623413324356079f, 0.4216965138912201f, 0.3162277638912201f, 0.23713737726211548f, 0.17782793939113617f, 0.133352130651474f,
    0.10000000149011612f, 0.07498941570520401f, 0.05623413249850273f, 0.04216965287923813f, 0.03162277489900589f, 0.023713737726211548f, 0.017782794311642647f, 0.01333521492779255f,
    0.009999999776482582f, 0.007498941849917173f, 0.005623413249850273f, 0.0042169648222625256f, 0.003162277629598975f, 0.00237137358635664f, 0.0017782794311642647f, 0.0013335214462131262f,
    0.0010000000474974513f, 0.0007498942431993783f, 0.000562341301701963f, 0.0004216965171508491f, 0.0003162277571391314f, 0.00023713737027719617f, 0.00017782794020604342f, 0.0001333521504420787f};

struct Params {
    const float* in[23];
    float* X;
    bf16_t* Xb;
    bf16_t* Pb;
    bf16_t* Ob;
    bf16_t* QRb;
    float* Y;
    bf16_t* H;
    bf16_t* Xs;
    bf16_t* Hm;
    bf16_t* Ys;
    bf16_t* Yp;
    bf16_t* W1T; bf16_t* W2T;
    bf16_t* Ac; bf16_t* Hc; bf16_t* CMP;
    bf16_t* WinE; bf16_t* WoutE; bf16_t* WguD; bf16_t* WdD; bf16_t* WinO; bf16_t* WoutO; bf16_t* WguM; bf16_t* WdM;
    float* ropecs;
    float* IW;
    unsigned long long* BM;
    float* GATES;
    float* kmean;
    float* cmpk;
    float* cmpv;
    int* tok_e; float* tok_g; int* tok_slot; int* slot_tok; float* slot_gate; int* chunk_cnt; int* tile_e;
    unsigned* bar;
    float lam_init[2];
};

enum { IN_X = 0, IN_EV_WIN, IN_EV_WOUT, IN_DIF_LAMBDA, IN_DIF_SUBLN, IN_FFD_WG, IN_FFD_WU, IN_FFD_WD, IN_OD_WIN, IN_OD_WOUT, IN_NSA_GATE_B, IN_NSA_PE, IN_NSA_W1, IN_NSA_W2,
       IN_MOE_WR, IN_MOE_BR, IN_MOE_WG, IN_MOE_WU, IN_MOE_WD, IN_LN_MIX_G, IN_LN_MIX_B, IN_LN_FFN_G, IN_LN_FFN_B };

__device__ __forceinline__ float bf2f(bf16_t u) { return __builtin_bit_cast(float, (unsigned)u << 16); }
__device__ __forceinline__ unsigned pk2(float lo, float hi) { return pg8::cvt_pk_bf16(lo, hi); }
__device__ __forceinline__ bf16_t f2bf(float f) { return (bf16_t)(pg8::cvt_pk_bf16(f, 0.f) & 0xffffu); }
__device__ __forceinline__ float wave_max(float v) {
#pragma unroll
    for (int o = 32; o >= 1; o >>= 1) v = fmaxf(v, __shfl_xor(v, o));
    return v;
}
__device__ __forceinline__ float wave_sum(float v) {
#pragma unroll
    for (int o = 32; o >= 1; o >>= 1) v += __shfl_xor(v, o);
    return v;
}
__device__ __forceinline__ int wave_sumi(int v) {
#pragma unroll
    for (int o = 32; o >= 1; o >>= 1) v += __shfl_xor(v, o);
    return v;
}
__device__ __forceinline__ float rl_f(float v, int l) { return __builtin_bit_cast(float, __builtin_amdgcn_readlane(__builtin_bit_cast(int, v), l)); }
__device__ __forceinline__ int lane_rank(unsigned long long m) { return __builtin_amdgcn_mbcnt_hi((unsigned)(m >> 32), __builtin_amdgcn_mbcnt_lo((unsigned)m, 0)); }

#define EPI_LOOP_BEGIN \
    _Pragma("unroll") for (int ai = 0; ai < 2; ++ai) _Pragma("unroll") for (int m = 0; m < 4; ++m) { const int rloc = ai * 128 + wr * 64 + m * 16 + fr; \
    _Pragma("unroll") for (int bj = 0; bj < 2; ++bj) _Pragma("unroll") for (int n = 0; n < 2; ++n) { const int cloc = bj * 128 + wc * 32 + n * 16 + fq * 4; const f32x4 v = acc[ai][bj][m][n];
#define EPI_LOOP_END } }

struct EpiInEven {
    static constexpr bool PERM = false, AFTER_DRAIN = false;
    bf16_t* Pb; float* IW; const float* cs;
    __device__ __forceinline__ void operator()(const f32x4 (&acc)[2][2][4][2], const Unit& u, int wr, int wc, int fr, int fq) const {
        EPI_LOOP_BEGIN
            const int row = u.pm * 256 + rloc, c0 = u.pn * 256 + cloc, pos = row & (SEQ - 1);
            if (c0 < P_EVEN) {
                if (c0 == E_IW) { *(f32x4*)(IW + (size_t)row * 4) = v; }
                else {
                    f32x4 o = v;
                    const bool rope = (c0 < 1024) || (c0 >= 1536 && c0 < 2176) || (c0 >= 2304 && c0 < 2624);
                    if (rope) { const f32x4 t = *(const f32x4*)(cs + ((size_t)pos * 32 + ((c0 & 63) >> 1)) * 2);
                        o[0] = v[0] * t[0] - v[1] * t[1]; o[1] = v[1] * t[0] + v[0] * t[1]; o[2] = v[2] * t[2] - v[3] * t[3]; o[3] = v[3] * t[2] + v[2] * t[3]; }
                    u32x2 w; w.x = pk2(o[0], o[1]); w.y = pk2(o[2], o[3]);
                    *(u32x2*)(Pb + (size_t)row * LDPB + c0) = w;
                }
            }
        EPI_LOOP_END
    }
};
struct EpiInOdd {
    static constexpr bool PERM = false, AFTER_DRAIN = false;
    bf16_t* Pb; bf16_t* QRb; float* G; const float* cs; const float* gb;
    __device__ __forceinline__ void operator()(const f32x4 (&acc)[2][2][4][2], const Unit& u, int wr, int wc, int fr, int fq) const {
        EPI_LOOP_BEGIN
            const int row = u.pm * 256 + rloc, c0 = u.pn * 256 + cloc, pos = row & (SEQ - 1);
            if (c0 < P_ODD) {
                if (c0 >= O_DG) {
                    const int j = c0 - O_DG; f32x4 o;
#pragma unroll
                    for (int e = 0; e < 4; ++e) o[e] = 1.f / (1.f + expf(-(v[e] + gb[j + e])));
                    *(f32x4*)(G + (size_t)row * 24 + j) = o;
                } else {
                    const bool isq = (c0 >= O_DQ && c0 < O_KC);
                    const bool rope = (c0 < 1024) || isq || (c0 >= O_KS && c0 < O_VS) || (c0 >= O_KW && c0 < O_VW);
                    f32x4 o = v;
                    if (rope) { const f32x4 t = *(const f32x4*)(cs + ((size_t)pos * 32 + ((c0 & 63) >> 1)) * 2);
                        o[0] = v[0] * t[0] - v[1] * t[1]; o[1] = v[1] * t[0] + v[0] * t[1]; o[2] = v[2] * t[2] - v[3] * t[3]; o[3] = v[3] * t[2] + v[2] * t[3]; }
                    u32x2 w; w.x = pk2(o[0], o[1]); w.y = pk2(o[2], o[3]);
                    if (isq) { *(u32x2*)(QRb + (size_t)row * 512 + (c0 - O_DQ)) = w; w.x = pk2(v[0], v[1]); w.y = pk2(v[2], v[3]); }
                    *(u32x2*)(Pb + (size_t)row * LDPB + c0) = w;
                }
            }
        EPI_LOOP_END
    }
};
struct EpiY {
    static constexpr bool PERM = false, AFTER_DRAIN = false;
    bf16_t* Y;
    __device__ __forceinline__ void operator()(const f32x4 (&acc)[2][2][4][2], const Unit& u, int wr, int wc, int fr, int fq) const {
        EPI_LOOP_BEGIN
            u32x2 w; w.x = pk2(v[0], v[1]); w.y = pk2(v[2], v[3]);
            *(u32x2*)(Y + (size_t)(u.pm * 256 + rloc) * DM + u.pn * 256 + cloc) = w;
        EPI_LOOP_END
    }
};
struct EpiGU {
    static constexpr bool PERM = false, AFTER_DRAIN = false;
    bf16_t* H; int ldh; int npn; int row_tile0;
    __device__ __forceinline__ void operator()(const f32x4 (&acc)[2][2][4][2], const Unit& u, int wr, int wc, int fr, int fq) const {
        const int pnl = u.pn % npn;
#pragma unroll
        for (int ai = 0; ai < 2; ++ai)
#pragma unroll
            for (int m = 0; m < 4; ++m) { const int rloc = ai * 128 + wr * 64 + m * 16 + fr;
                bf16_t* hrow = H + (size_t)((u.pm - row_tile0) * 256 + rloc) * ldh;
#pragma unroll
                for (int bj = 0; bj < 2; ++bj) { const f32x4 g = acc[ai][bj][m][0], uu = acc[ai][bj][m][1];
                    const int unit0 = (pnl * 256 + bj * 128 + wc * 32) / 2 + fq * 4;
                    f32x4 o;
#pragma unroll
                    for (int e = 0; e < 4; ++e) o[e] = g[e] * __builtin_amdgcn_rcpf(1.f + __expf(-g[e])) * uu[e];
                    u32x2 w; w.x = pk2(o[0], o[1]); w.y = pk2(o[2], o[3]);
                    *(u32x2*)(hrow + unit0) = w; } }
    }
};
struct EpiDownMoe {
    static constexpr bool PERM = false, AFTER_DRAIN = false;
    bf16_t* Ys; const float* sg;
    __device__ __forceinline__ void operator()(const f32x4 (&acc)[2][2][4][2], const Unit& u, int wr, int wc, int fr, int fq) const {
        const int pnl = u.pn & 3;
        float gts[2][4];
#pragma unroll
        for (int ai = 0; ai < 2; ++ai)
#pragma unroll
            for (int m = 0; m < 4; ++m) gts[ai][m] = sg[u.pm * 256 + ai * 128 + wr * 64 + m * 16 + fr];
#pragma unroll
        for (int ai = 0; ai < 2; ++ai)
#pragma unroll
            for (int m = 0; m < 4; ++m) { const int slot = u.pm * 256 + ai * 128 + wr * 64 + m * 16 + fr; const float gt = gts[ai][m];
#pragma unroll
                for (int bj = 0; bj < 2; ++bj)
#pragma unroll
                    for (int n = 0; n < 2; ++n) { const f32x4 v = acc[ai][bj][m][n] * gt; const int c0 = pnl * 256 + bj * 128 + wc * 32 + n * 16 + fq * 4;
                        u32x2 w; w.x = pk2(v[0], v[1]); w.y = pk2(v[2], v[3]);
                        *(u32x2*)(Ys + (size_t)slot * DM + c0) = w; } }
    }
};
struct EpiGeluH {
    static constexpr bool PERM = false, AFTER_DRAIN = false;
    bf16_t* Hc;
    __device__ __forceinline__ void operator()(const f32x4 (&acc)[2][2][4][2], const Unit& u, int wr, int wc, int fr, int fq) const {
        EPI_LOOP_BEGIN
            f32x4 o;
#pragma unroll
            for (int e = 0; e < 4; ++e) { const float x = v[e], uu = 0.7978845608028654f * (x + 0.044715f * x * x * x); o[e] = x - x * __builtin_amdgcn_rcpf(1.f + __expf(2.f * uu)); }
            u32x2 w; w.x = pk2(o[0], o[1]); w.y = pk2(o[2], o[3]);
            *(u32x2*)(Hc + (size_t)(u.pm * 256 + rloc) * 256 + cloc) = w;
        EPI_LOOP_END
    }
};
struct EpiCmp {
    static constexpr bool PERM = false, AFTER_DRAIN = false;
    bf16_t* C;
    __device__ __forceinline__ void operator()(const f32x4 (&acc)[2][2][4][2], const Unit& u, int wr, int wc, int fr, int fq) const {
        EPI_LOOP_BEGIN
            if (cloc < 64) { u32x2 w; w.x = pk2(v[0], v[1]); w.y = pk2(v[2], v[3]); *(u32x2*)(C + (size_t)(u.pm * 256 + rloc) * 64 + cloc) = w; }
        EPI_LOOP_END
    }
};
struct ListOrder {
    static constexpr bool KSPLIT = false, GATHER_A = false;
    int n, G, c;
    __device__ __forceinline__ bool next(int i, Unit& u) const { const int L = i * G + c; if (L >= n) return false; u.pm = L; u.pn = L >> 4; return true; }
    __device__ __forceinline__ void a_ready(const Unit&) const {}
    __device__ __forceinline__ void done(const Unit&) const {}
};
constexpr int MOE_TE_LDS = 139264;
struct MoeOrder {
    static constexpr bool KSPLIT = false, GATHER_A = false;
    int t0, ntr, npn, G, c;
    __device__ __forceinline__ bool next(int i, Unit& u) const {
        extern __shared__ __attribute__((aligned(16))) float lds_dyn_[];
        int tm, pl;
        if (G == 256 && ntr == 128) {
            const int x = c & 7, j = c >> 3, ncb = npn >> 2, nrounds = 2 * ncb;
            if (i >= nrounds) return false;
            const int rb = i / ncb, cb = i - rb * ncb;
            tm = t0 + 16 * x + 8 * rb + (j >> 2); pl = 4 * cb + (j & 3);
        } else {
            const int L = i * G + c; if (L >= ntr * npn) return false;
            tm = t0 + L / npn; pl = L % npn;
        }
        const int e = ((const LAS int*)((LAS unsigned char*)lds_dyn_ + MOE_TE_LDS))[tm];
        if (e < 0) return false;
        u.pm = tm; u.pn = e * npn + pl; return true;
    }
    __device__ __forceinline__ void a_ready(const Unit&) const {}
    __device__ __forceinline__ void done(const Unit&) const {}
};
struct MoeOrderG {
    static constexpr bool KSPLIT = false, GATHER_A = true;
    int t0, ntr, npn, G, c, rb; const int* slot_tok;
    __device__ __forceinline__ int arow(int slot) const { const int t = slot_tok[slot]; return t < 0 ? NTOK : t; }
    __device__ __forceinline__ bool next(int i, Unit& u) const {
        extern __shared__ __attribute__((aligned(16))) float lds_dyn_[];
        int tm, pl;
        if (ntr == 128) { const int x = c & 7, j = c >> 3, ncb = npn >> 2; if (i >= ncb) return false; tm = t0 + 16 * x + 8 * rb + (j >> 2); pl = 4 * i + (j & 3); }
        else { if (i > 0 || c >= ntr * npn) return false; tm = t0 + c / npn; pl = c % npn; }
        const int e = ((const LAS int*)((LAS unsigned char*)lds_dyn_ + MOE_TE_LDS))[tm];
        if (e < 0) return false;
        u.pm = tm; u.pn = e * npn + pl; return true;
    }
    __device__ __forceinline__ void a_ready(const Unit&) const {}
    __device__ __forceinline__ void done(const Unit&) const {}
};
constexpr int MOE_TAIL_T0 = 256, MOE_TAIL_TILES = NTILE256 - 256, MOE_KSL = 7, MOE_KSL_K = F_EXPERT / MOE_KSL;
struct TailOrder {
    static constexpr bool KSPLIT = true, GATHER_A = false;
    int G, c;
    __device__ __forceinline__ bool next(int i, Unit& u) const {
        extern __shared__ __attribute__((aligned(16))) float lds_dyn_[];
        const int L = i * G + c; if (L >= MOE_TAIL_TILES * 4 * MOE_KSL) return false;
        const int sl = L / (MOE_TAIL_TILES * 4), rem = L - sl * (MOE_TAIL_TILES * 4), tm = MOE_TAIL_T0 + (rem >> 2), pl = rem & 3;
        const int e = ((const LAS int*)((LAS unsigned char*)lds_dyn_ + MOE_TE_LDS))[tm];
        if (e < 0) return false;
        u.pm = tm; u.pn = e * 4 + pl; u.ko = sl * MOE_KSL_K; return true;
    }
    __device__ __forceinline__ void a_ready(const Unit&) const {}
    __device__ __forceinline__ void done(const Unit&) const {}
};
struct EpiDownTail {
    static constexpr bool PERM = false, AFTER_DRAIN = false;
    bf16_t* Yp; const float* sg;
    __device__ __forceinline__ void operator()(const f32x4 (&acc)[2][2][4][2], const Unit& u, int wr, int wc, int fr, int fq) const {
        const int pnl = u.pn & 3, sl = u.ko / MOE_KSL_K;
        float gts[2][4];
#pragma unroll
        for (int ai = 0; ai < 2; ++ai)
#pragma unroll
            for (int m = 0; m < 4; ++m) gts[ai][m] = sg[u.pm * 256 + ai * 128 + wr * 64 + m * 16 + fr];
#pragma unroll
        for (int ai = 0; ai < 2; ++ai)
#pragma unroll
            for (int m = 0; m < 4; ++m) { const int slot = u.pm * 256 + ai * 128 + wr * 64 + m * 16 + fr; const float gt = gts[ai][m];
                bf16_t* row = Yp + ((size_t)sl * (MOE_TAIL_TILES * 256) + (slot - MOE_TAIL_T0 * 256)) * DM;
#pragma unroll
                for (int bj = 0; bj < 2; ++bj)
#pragma unroll
                    for (int n = 0; n < 2; ++n) { const f32x4 v = acc[ai][bj][m][n] * gt; const int c0 = pnl * 256 + bj * 128 + wc * 32 + n * 16 + fq * 4;
                        u32x2 w; w.x = pk2(v[0], v[1]); w.y = pk2(v[2], v[3]);
                        *(u32x2*)(row + c0) = w; } }
    }
};

template <class F>
__device__ __forceinline__ void convert_T(bf16_t* dst, int Nphys, int K, int ld, F rowsrc, long gid, long gstride) {
    const long total = (long)Nphys * (K >> 3);
    for (long idx0 = gid; idx0 < total; idx0 += 4 * gstride) {
        float v[4][8]; int nn[4], kk[4]; bool ok[4];
#pragma unroll
        for (int u = 0; u < 4; ++u) {
            const long idx = idx0 + u * gstride; ok[u] = idx < total;
            const long idc = ok[u] ? idx : idx0;
            nn[u] = (int)(idc % Nphys); kk[u] = (int)(idc / Nphys);
            const float* s = rowsrc(nn[u]);
            if (s) {
#pragma unroll
                for (int i = 0; i < 8; ++i) v[u][i] = s[(size_t)(kk[u] * 8 + i) * ld];
            } else {
#pragma unroll
                for (int i = 0; i < 8; ++i) v[u][i] = 0.f;
            }
        }
#pragma unroll
        for (int u = 0; u < 4; ++u) if (ok[u]) {
            uint4 w; w.x = pk2(v[u][0], v[u][1]); w.y = pk2(v[u][2], v[u][3]); w.z = pk2(v[u][4], v[u][5]); w.w = pk2(v[u][6], v[u][7]);
            *(uint4*)(dst + (size_t)nn[u] * K + kk[u] * 8) = w;
        }
    }
}
__device__ __forceinline__ int rope_nat(int n) { const int w = n & 63; return (n & ~63) + (w >> 1) + 32 * (w & 1); }

__device__ __forceinline__ void sincos_d(double a, double& s, double& c) {
    const double n = rint(a * 0.6366197723675814);
    double y = fma(-n, 1.5707963267948966, a); y = fma(-n, 6.123233995736766e-17, y);
    const int q = ((int)n) & 3;
    const double y2 = y * y;
    const double sp = y * (1.0 + y2 * (-1.0 / 6 + y2 * (1.0 / 120 + y2 * (-1.0 / 5040 + y2 * (1.0 / 362880 + y2 * (-1.0 / 39916800 + y2 * (1.0 / 6227020800.0)))))));
    const double cp = 1.0 + y2 * (-0.5 + y2 * (1.0 / 24 + y2 * (-1.0 / 720 + y2 * (1.0 / 40320 + y2 * (-1.0 / 3628800 + y2 * (1.0 / 479001600.0 + y2 * (-1.0 / 87178291200.0)))))));
    s = (q == 0) ? sp : (q == 1) ? cp : (q == 2) ? -sp : -cp;
    c = (q == 0) ? cp : (q == 1) ? -sp : (q == 2) ? -cp : sp;
}

template <class F>
__device__ __forceinline__ void convert_tiles(bf16_t* dst, int Nphys, int K, int ld, F src8, float* ldsf, int tile0, int tile_step) {
    const int tid = tid_();
    bf16_t* lt = (bf16_t*)ldsf;
    const int nkt = K >> 6, ntiles = (Nphys >> 7) * nkt;
    const int kl = tid >> 4, c = tid & 15;
    const int rn = tid >> 2, rq = tid & 3;
    float4 a0, a1, b0, b1;
#define CT_LOAD(tl, A0, A1, B0, B1) do { const int nt_ = (tl) / nkt, kt_ = (tl) - nt_ * nkt; const float* s_ = src8(nt_ * 128, c) + (size_t)(kt_ * 64 + kl) * ld; \
        A0 = *(const float4*)s_; A1 = *(const float4*)(s_ + 4); B0 = *(const float4*)(s_ + (size_t)32 * ld); B1 = *(const float4*)(s_ + (size_t)32 * ld + 4); } while (0)
    if (tile0 < ntiles) CT_LOAD(tile0, a0, a1, b0, b1);
    for (int tile = tile0; tile < ntiles; tile += tile_step) {
        const int nt = tile / nkt, kt = tile - nt * nkt, n0 = nt * 128, k0 = kt * 64;
        float4 na0 = a0, na1 = a1, nb0 = b0, nb1 = b1;
        if (tile + tile_step < ntiles) CT_LOAD(tile + tile_step, na0, na1, nb0, nb1);
        __syncthreads();
        const float va[8] = {a0.x, a0.y, a0.z, a0.w, a1.x, a1.y, a1.z, a1.w}, vb[8] = {b0.x, b0.y, b0.z, b0.w, b1.x, b1.y, b1.z, b1.w};
#pragma unroll
        for (int e = 0; e < 8; ++e) { lt[(8 * c + e) * 72 + kl] = f2bf(va[e]); lt[(8 * c + e) * 72 + kl + 32] = f2bf(vb[e]); }
        __syncthreads();
        const uint4 w0 = *(const uint4*)(lt + rn * 72 + rq * 16), w1 = *(const uint4*)(lt + rn * 72 + rq * 16 + 8);
        bf16_t* d = dst + (size_t)(n0 + rn) * K + k0 + rq * 16;
        *(uint4*)d = w0; *(uint4*)(d + 8) = w1;
        a0 = na0; a1 = na1; b0 = nb0; b1 = nb1;
    }
#undef CT_LOAD
}

__device__ __forceinline__ int rot_tile0(int rot, int G) { const int r = (int)blockIdx.x - rot % G; return r < 0 ? r + G : r; }
__device__ __forceinline__ void ph_init(const Params& p, float* lds) {
    const int tid = tid_();
    const long gid = (long)blockIdx.x * NT + tid, gs = (long)gridDim.x * NT;
    int rot = 0;
    for (long i = gid; i < 4096 * 32; i += gs) {
        const int pos = (int)(i >> 5), f = (int)(i & 31);
        const float angf = (float)pos * c_inv[f];
        double s, c; sincos_d((double)angf, s, c);
        p.ropecs[2 * i] = (float)c; p.ropecs[2 * i + 1] = (float)s;
    }
    if (gid < DM / 2) ((unsigned*)(p.Xb + (size_t)NTOK * DM))[gid] = 0u;
    const float4* xs = (const float4*)p.in[IN_X]; u32x2* xb = (u32x2*)p.Xb;
    for (long i = gid; i < (long)NTOK * DM / 4; i += 4 * gs) {
        float4 v[4];
#pragma unroll
        for (int u = 0; u < 4; ++u) { const long j = i + u * gs; v[u] = xs[j < (long)NTOK * DM / 4 ? j : i]; }
#pragma unroll
        for (int u = 0; u < 4; ++u) { const long j = i + u * gs; if (j < (long)NTOK * DM / 4) { u32x2 w; w.x = pk2(v[u].x, v[u].y); w.y = pk2(v[u].z, v[u].w); xb[j] = w; } }
    }
#pragma unroll 1
    for (int li = 0; li < 2; ++li) {
        { const float* W = p.in[IN_EV_WIN] + (size_t)li * DM * P_EVEN;
          convert_T(p.WinE + (size_t)li * NP_EVEN * DM, NP_EVEN, DM, P_EVEN, [=](int n) -> const float* {
              if (n >= P_EVEN) return nullptr;
              const bool rope = (n < 1024) || (n >= 1536 && n < 2176) || (n >= 2304 && n < 2624);
              return W + (rope ? rope_nat(n) : n); }, gid, gs); }
        { const float* W = p.in[IN_OD_WIN] + (size_t)li * DM * P_ODD;
          convert_T(p.WinO + (size_t)li * NP_ODD * DM, NP_ODD, DM, P_ODD, [=](int n) -> const float* {
              if (n >= P_ODD) return nullptr;
              const bool rope = (n < 1024) || (n >= O_DQ && n < O_KC) || (n >= O_KS && n < O_VS) || (n >= O_KW && n < O_VW);
              return W + (rope ? rope_nat(n) : n); }, gid, gs); }
        { const float* W = p.in[IN_EV_WOUT] + (size_t)li * DM * DM;
          convert_tiles(p.WoutE + (size_t)li * DM * DM, DM, DM, DM, [=](int n0, int c) -> const float* { return W + n0 + 8 * c; }, lds, rot_tile0(rot, gridDim.x), gridDim.x); rot += 128; }
        { const float* W = p.in[IN_OD_WOUT] + (size_t)li * DM * DM;
          convert_tiles(p.WoutO + (size_t)li * DM * DM, DM, DM, DM, [=](int n0, int c) -> const float* { return W + n0 + 8 * c; }, lds, rot_tile0(rot, gridDim.x), gridDim.x); rot += 128; }
        { const float* Wg = p.in[IN_FFD_WG] + (size_t)li * DM * F_DENSE; const float* Wu = p.in[IN_FFD_WU] + (size_t)li * DM * F_DENSE; const long dWu = (const char*)Wu - (const char*)Wg;
          convert_tiles(p.WguD + (size_t)li * 2 * F_DENSE * DM, 2 * F_DENSE, DM, F_DENSE, [=](int n0, int c) -> const float* {
              const int unit0 = n0 / 2 + (c >> 2) * 16 + (c & 1) * 8; return (const float*)((const char*)Wg + ((c & 2) ? dWu : 0l)) + unit0; }, lds, rot_tile0(rot, gridDim.x), gridDim.x); rot += 704; }
        { const float* W = p.in[IN_FFD_WD] + (size_t)li * F_DENSE * DM;
          convert_tiles(p.WdD + (size_t)li * DM * F_DENSE, DM, F_DENSE, DM, [=](int n0, int c) -> const float* { return W + n0 + 8 * c; }, lds, rot_tile0(rot, gridDim.x), gridDim.x); rot += 352; }
#pragma unroll 1
        for (int which = 0; which < 2; ++which) {
            const float* W1 = p.in[IN_NSA_W1] + (size_t)(li * 2 + which) * 2048 * 256;
            convert_tiles(p.W1T + (size_t)(li * 2 + which) * 256 * 2048, 256, 2048, 256, [=](int n0, int c) -> const float* { return W1 + n0 + 8 * c; }, lds, rot_tile0(rot, gridDim.x), gridDim.x); rot += 64;
            const float* W2 = p.in[IN_NSA_W2] + (size_t)(li * 2 + which) * 256 * 64;
            convert_T(p.W2T + (size_t)(li * 2 + which) * 256 * 256, 256, 256, 64, [=](int n) -> const float* { if (n >= 64) return nullptr; return W2 + (which ? n : rope_nat(n)); }, gid, gs);
        }
    }
}
__device__ __forceinline__ void ph_convert_moe(const Params& p, int li, float* lds) {
    const float* Wg = p.in[IN_MOE_WG] + (size_t)li * N_EXP * DM * F_EXPERT; const float* Wu = p.in[IN_MOE_WU] + (size_t)li * N_EXP * DM * F_EXPERT; const long dWu = (const char*)Wu - (const char*)Wg;
    convert_tiles(p.WguM, N_EXP * 2 * F_EXPERT, DM, F_EXPERT, [=](int n0, int c) -> const float* {
        const int e = n0 / (2 * F_EXPERT), unit0 = (n0 % (2 * F_EXPERT)) / 2 + (c >> 2) * 16 + (c & 1) * 8;
        return (const float*)((const char*)Wg + ((c & 2) ? dWu : 0l)) + (size_t)e * DM * F_EXPERT + unit0; }, lds, blockIdx.x, gridDim.x);
    const float* Wd = p.in[IN_MOE_WD] + (size_t)li * N_EXP * F_EXPERT * DM;
    convert_tiles(p.WdM, N_EXP * DM, F_EXPERT, DM, [=](int n0, int c) -> const float* { return Wd + (size_t)(n0 >> 10) * F_EXPERT * DM + (n0 & 1023) + 8 * c; }, lds, blockIdx.x, gridDim.x);
}

struct CvJob {
    const float* Wg; long dWu; const float* Wd; bf16_t* dgu; bf16_t* ddn; bf16_t* lt0;
    int t, tend, step_, par; bool pend; bf16_t* pdst;
    float4 a0, a1, b0, b1;
    static constexpr int NT1 = (N_EXP * 2 * F_EXPERT / 128) * (DM / 64), NT2 = (N_EXP * DM / 128) * (F_EXPERT / 64);
    __device__ __forceinline__ void load(int tl, int tid) {
        const int kl = tid >> 4, c = tid & 15; const float* s_; size_t ld;
        if (tl < NT1) { const int nt = tl >> 4, kt = tl & 15, n0 = nt * 128; const int e = n0 / (2 * F_EXPERT), unit0 = (n0 % (2 * F_EXPERT)) / 2 + (c >> 2) * 16 + (c & 1) * 8;
            ld = F_EXPERT; s_ = (const float*)((const char*)Wg + ((c & 2) ? dWu : 0l)) + (size_t)e * DM * F_EXPERT + unit0 + (size_t)(kt * 64 + kl) * ld; }
        else { const int t2 = tl - NT1, nt = t2 / (F_EXPERT / 64), kt = t2 - nt * (F_EXPERT / 64), n0 = nt * 128;
            ld = DM; s_ = Wd + (size_t)(n0 >> 10) * F_EXPERT * DM + (n0 & 1023) + 8 * c + (size_t)(kt * 64 + kl) * ld; }
        a0 = *(const float4*)s_; a1 = *(const float4*)(s_ + 4); b0 = *(const float4*)(s_ + 32 * ld); b1 = *(const float4*)(s_ + 32 * ld + 4);
    }
    __device__ __forceinline__ void init(const Params& p, int li, float* ldsf, int tid) {
        Wg = p.in[IN_MOE_WG] + (size_t)li * N_EXP * DM * F_EXPERT; const float* Wu = p.in[IN_MOE_WU] + (size_t)li * N_EXP * DM * F_EXPERT; dWu = (const char*)Wu - (const char*)Wg;
        Wd = p.in[IN_MOE_WD] + (size_t)li * N_EXP * F_EXPERT * DM; dgu = p.WguM; ddn = p.WdM; lt0 = (bf16_t*)ldsf;
        t = blockIdx.x; step_ = gridDim.x; tend = NT1 + NT2; par = 0; pend = false; pdst = dgu;
        if (t < tend) load(t, tid);
    }
    __device__ __forceinline__ void step(int tid) {
        const int kl = tid >> 4, c = tid & 15, rn = tid >> 2, rq = tid & 3;
        if (pend) { const bf16_t* lt = lt0 + (par ^ 1) * (128 * 72);
            const uint4 w0 = *(const uint4*)(lt + rn * 72 + rq * 16), w1 = *(const uint4*)(lt + rn * 72 + rq * 16 + 8);
            *(uint4*)pdst = w0; *(uint4*)(pdst + 8) = w1; }
        if (t < tend) {
            bf16_t* lt = lt0 + par * (128 * 72);
            const float va[8] = {a0.x, a0.y, a0.z, a0.w, a1.x, a1.y, a1.z, a1.w}, vb[8] = {b0.x, b0.y, b0.z, b0.w, b1.x, b1.y, b1.z, b1.w};
#pragma unroll
            for (int e = 0; e < 8; ++e) { lt[(8 * c + e) * 72 + kl] = f2bf(va[e]); lt[(8 * c + e) * 72 + kl + 32] = f2bf(vb[e]); }
            if (t < NT1) { const int nt = t >> 4, kt = t & 15; pdst = dgu + (size_t)(nt * 128 + rn) * DM + kt * 64 + rq * 16; }
            else { const int t2 = t - NT1, nt = t2 / (F_EXPERT / 64), kt = t2 - nt * (F_EXPERT / 64); pdst = ddn + (size_t)(nt * 128 + rn) * F_EXPERT + kt * 64 + rq * 16; }
            pend = true; t += step_;
            if (t < tend) load(t, tid);
        } else pend = false;
        par ^= 1;
    }
    __device__ __forceinline__ void finish(int tid) { while (pend || t < tend) { __syncthreads(); step(tid); } }
};

__device__ __forceinline__ void ph_kmean(const Params& p, float* lds) {
    const int tid = tid_(), ch = tid & 7, kg = tid >> 3;
    for (int item = blockIdx.x; item < 8 * 16 * 8; item += gridDim.x) {
        const int h = item & 7, blk = (item >> 3) & 15, b = item >> 7;
        float s[8] = {0.f, 0.f, 0.f, 0.f, 0.f, 0.f, 0.f, 0.f};
        uint4 kv[4];
#pragma unroll
        for (int j = 0; j < 4; ++j) kv[j] = *(const uint4*)(p.Pb + (size_t)(b * SEQ + blk * 256 + kg * 4 + j) * LDPB + O_CK + h * 64 + ch * 8);
#pragma unroll
        for (int j = 0; j < 4; ++j) {
            s[0] += __builtin_bit_cast(float, kv[j].x << 16); s[1] += __builtin_bit_cast(float, kv[j].x & 0xffff0000u);
            s[2] += __builtin_bit_cast(float, kv[j].y << 16); s[3] += __builtin_bit_cast(float, kv[j].y & 0xffff0000u);
            s[4] += __builtin_bit_cast(float, kv[j].z << 16); s[5] += __builtin_bit_cast(float, kv[j].z & 0xffff0000u);
            s[6] += __builtin_bit_cast(float, kv[j].w << 16); s[7] += __builtin_bit_cast(float, kv[j].w & 0xffff0000u);
        }
#pragma unroll
        for (int e = 0; e < 8; ++e) { s[e] += __shfl_xor(s[e], 8); s[e] += __shfl_xor(s[e], 16); s[e] += __shfl_xor(s[e], 32); }
        __syncthreads();
        if ((tid & 63) < 8) {
#pragma unroll
            for (int e = 0; e < 8; ++e) lds[(tid >> 6) * 64 + ch * 8 + e] = s[e];
        }
        __syncthreads();
        if (tid < 64) { float a = 0.f;
#pragma unroll
            for (int q = 0; q < 8; ++q) a += lds[q * 64 + tid];
            p.kmean[(size_t)item * 64 + tid] = a * (1.f / 256.f); }
    }
}

__device__ __forceinline__ void ph_cmp_build(const Params& p, int li) {
    const int tid = tid_();
    const long gs = (long)gridDim.x * NT;
    for (long idx0 = (long)blockIdx.x * NT + tid; idx0 < 2l * 4096 * 256; idx0 += 4 * gs) {
      pg8::u32x4 kvv[4]; float4 pe0[4], pe1[4];
#pragma unroll
      for (int u = 0; u < 4; ++u) {
        const long idx = (idx0 + u * gs < 2l * 4096 * 256) ? idx0 + u * gs : idx0;
        const int ch = (int)(idx & 255), m = (int)((idx >> 8) & 4095), which = (int)(idx >> 20);
        const int i = (m & 255) < 255 ? (m & 255) : 0, bg = m >> 8, b = bg >> 1, g = bg & 1, t = ch >> 3, d0 = (ch & 7) * 8;
        kvv[u] = *(const pg8::u32x4*)(p.Pb + (size_t)(b * SEQ + 16 * i + t) * LDPB + (which ? O_VC : O_KC) + g * 64 + d0);
        const float* pe = p.in[IN_NSA_PE] + (size_t)(li * 2 + which) * 2048 + t * 64 + d0;
        pe0[u] = *(const float4*)pe; pe1[u] = *(const float4*)(pe + 4);
      }
#pragma unroll
      for (int u = 0; u < 4; ++u) {
        const long idx = idx0 + u * gs;
        if (idx >= 2l * 4096 * 256) continue;
        const int ch = (int)(idx & 255), m = (int)((idx >> 8) & 4095), which = (int)(idx >> 20);
        const int i = m & 255, t = ch >> 3, d0 = (ch & 7) * 8;
        uint4 w = make_uint4(0u, 0u, 0u, 0u);
        if (i < 255) {
            uint4 kv; kv.x = kvv[u].x; kv.y = kvv[u].y; kv.z = kvv[u].z; kv.w = kvv[u].w;
            const float4 e0 = pe0[u], e1 = pe1[u];
            w.x = pk2(__builtin_bit_cast(float, kv.x << 16) + e0.x, __builtin_bit_cast(float, kv.x & 0xffff0000u) + e0.y);
            w.y = pk2(__builtin_bit_cast(float, kv.y << 16) + e0.z, __builtin_bit_cast(float, kv.y & 0xffff0000u) + e0.w);
            w.z = pk2(__builtin_bit_cast(float, kv.z << 16) + e1.x, __builtin_bit_cast(float, kv.z & 0xffff0000u) + e1.y);
            w.w = pk2(__builtin_bit_cast(float, kv.w << 16) + e1.z, __builtin_bit_cast(float, kv.w & 0xffff0000u) + e1.w);
        }
        *(uint4*)(p.Ac + ((size_t)(which * 4096 + m) * 2048 + ch * 8)) = w;
      }
    }
}

typedef unsigned u32x8v __attribute__((ext_vector_type(8)));
typedef float f32x16v __attribute__((ext_vector_type(16)));
__device__ __forceinline__ u32x8v ld_row8(const bf16_t* row, int lane) {
    const u32x2* r = (const u32x2*)row; const u32x2 a = r[lane], b = r[64 + lane], c = r[128 + lane], d = r[192 + lane];
    return (u32x8v){a.x, a.y, b.x, b.y, c.x, c.y, d.x, d.y};
}
__device__ __forceinline__ f32x16v ld_row16f(const float* row, int lane) {
    const float4* r = (const float4*)row; const float4 a = r[lane], b = r[64 + lane], c = r[128 + lane], d = r[192 + lane];
    return (f32x16v){a.x, a.y, a.z, a.w, b.x, b.y, b.z, b.w, c.x, c.y, c.z, c.w, d.x, d.y, d.z, d.w};
}
__device__ __forceinline__ float bf_el(const u32x8v v, int i) { const unsigned u = v[i >> 1]; return __builtin_bit_cast(float, (i & 1) ? (u & 0xffff0000u) : (u << 16)); }
__device__ __forceinline__ u32x8v ld_slot8(const Params& p, int slot_v, int lane) {
    const int slot = __builtin_amdgcn_readfirstlane(slot_v);
    if (slot < MOE_TAIL_T0 * 256) return ld_row8(p.Ys + (size_t)slot * DM, lane);
    u32x8v part[MOE_KSL];
#pragma unroll
    for (int sl = 0; sl < MOE_KSL; ++sl) part[sl] = ld_row8(p.Yp + ((size_t)sl * (MOE_TAIL_TILES * 256) + (slot - MOE_TAIL_T0 * 256)) * DM, lane);
    u32x8v o;
#pragma unroll
    for (int j = 0; j < 8; ++j) {
        float lo = 0.f, hi = 0.f;
#pragma unroll
        for (int sl = 0; sl < MOE_KSL; ++sl) { lo += __builtin_bit_cast(float, part[sl][j] << 16); hi += __builtin_bit_cast(float, part[sl][j] & 0xffff0000u); }
        o[j] = pk2(lo, hi);
    }
    return o;
}
template <int MODE, int XSRC>
__device__ __forceinline__ void ph_ln(const Params& p, const float* gam, const float* bet, const float* Xin, float* Xout, bf16_t* Xbout, const bool wf32) {
    const int lane = tid_() & 63, wid = tid_() >> 6;
    const int stride = gridDim.x * 8;
    int t = blockIdx.x * 8 + wid;
    float4 gg4[4], bb4[4];
#pragma unroll
    for (int c = 0; c < 4; ++c) { gg4[c] = ((const float4*)gam)[c * 64 + lane]; bb4[c] = ((const float4*)bet)[c * 64 + lane]; }
    if (t < NTOK) {
        f32x16v xf, xfn; u32x8v xb8, xbn, ya, yan, yb, ybn;
        int n0 = 0, n1 = 0;
#define LN_LOAD(tt, S0, S1, XF, XB, YA, YB) do { \
        if (XSRC == 0) XF = ld_row16f(Xin + (size_t)(tt) * DM, lane); else XB = ld_row8(Xbout + (size_t)(tt) * DM, lane); \
        if (MODE == 0) YA = ld_row8((const bf16_t*)p.Y + (size_t)(tt) * DM, lane); \
        else { YA = ld_slot8(p, S0, lane); YB = ld_slot8(p, S1, lane); } } while (0)
        {
            int s0 = 0, s1 = 0;
            if (MODE == 1) { s0 = p.tok_slot[2 * t]; s1 = p.tok_slot[2 * t + 1]; const int tn = (t + stride < NTOK) ? t + stride : t; n0 = p.tok_slot[2 * tn]; n1 = p.tok_slot[2 * tn + 1]; }
            LN_LOAD(t, s0, s1, xf, xb8, ya, yb);
        }
        for (; t < NTOK; t += stride) {
            const int tn = (t + stride < NTOK) ? t + stride : t;
            LN_LOAD(tn, n0, n1, xfn, xbn, yan, ybn);
            int m0 = 0, m1 = 0;
            if (MODE == 1) { const int t2 = (tn + stride < NTOK) ? tn + stride : tn; m0 = p.tok_slot[2 * t2]; m1 = p.tok_slot[2 * t2 + 1]; }
            f32x16v v; float s = 0.f;
#pragma unroll
            for (int c = 0; c < 4; ++c) {
#pragma unroll
                for (int e = 0; e < 4; ++e) {
                    const int i = c * 4 + e;
                    const float x = (XSRC == 0) ? xf[i] : bf_el(xb8, i);
                    const float y = (MODE == 0) ? bf_el(ya, i) : bf_el(ya, i) + bf_el(yb, i);
                    v[i] = ALPHA * x + y;
                }
                s += (v[c * 4] + v[c * 4 + 1]) + (v[c * 4 + 2] + v[c * 4 + 3]);
            }
            const float mu = wave_sum(s) * (1.f / 1024.f);
            float q = 0.f;
#pragma unroll
            for (int c = 0; c < 4; ++c) { const float a = v[c * 4] - mu, b2 = v[c * 4 + 1] - mu, c2 = v[c * 4 + 2] - mu, d2 = v[c * 4 + 3] - mu; q += (a * a + b2 * b2) + (c2 * c2 + d2 * d2); }
            const float var = wave_sum(q) * (1.f / 1024.f);
            const float rs = 1.0f / sqrtf(var + LN_EPS);
            u32x2* xb = (u32x2*)(Xbout + (size_t)t * DM); float4* xo = (float4*)(Xout + (size_t)t * DM);
#pragma unroll
            for (int c = 0; c < 4; ++c) {
                const float4 gg = gg4[c], bb = bb4[c];
                float4 o; o.x = (v[c * 4] - mu) * rs * gg.x + bb.x; o.y = (v[c * 4 + 1] - mu) * rs * gg.y + bb.y; o.z = (v[c * 4 + 2] - mu) * rs * gg.z + bb.z; o.w = (v[c * 4 + 3] - mu) * rs * gg.w + bb.w;
                if (wf32) xo[c * 64 + lane] = o;
                u32x2 w; w.x = pk2(o.x, o.y); w.y = pk2(o.z, o.w); xb[c * 64 + lane] = w;
            }
            xf = xfn; xb8 = xbn; ya = yan; yb = ybn; n0 = m0; n1 = m1;
        }
#undef LN_LOAD
    }
}

__device__ __forceinline__ void ph_ln_router(const Params& p, const float* gam, const float* bet, int li, float* lds) {
    const int tid = tid_(), lane = tid & 63, wid = tid >> 6;
    int* lcnt = (int*)lds;
    const float* wr = p.in[IN_MOE_WR] + (size_t)li * 1024 * 8;
    const float* br = p.in[IN_MOE_BR] + li * 8;
    float4 gg4[4], bb4[4];
#pragma unroll
    for (int c = 0; c < 4; ++c) { gg4[c] = ((const float4*)gam)[c * 64 + lane]; bb4[c] = ((const float4*)bet)[c * 64 + lane]; }
    for (int chunk = blockIdx.x; chunk < 256; chunk += gridDim.x) {
        __syncthreads();
        if (tid < 8) lcnt[tid] = 0;
        __syncthreads();
        u32x8v xb8 = ld_row8(p.Xb + (size_t)(chunk * 128 + wid * 16) * DM, lane), ya = ld_row8((const bf16_t*)p.Y + (size_t)(chunk * 128 + wid * 16) * DM, lane);
        for (int q = 0; q < 16; ++q) {
            const int t = chunk * 128 + wid * 16 + q;
            const int tn = (q < 15) ? t + 1 : t;
            const u32x8v xbn = ld_row8(p.Xb + (size_t)tn * DM, lane), yan = ld_row8((const bf16_t*)p.Y + (size_t)tn * DM, lane);
            float4 v[4]; float s = 0.f;
#pragma unroll
            for (int c = 0; c < 4; ++c) {
                v[c].x = ALPHA * bf_el(xb8, c * 4) + bf_el(ya, c * 4); v[c].y = ALPHA * bf_el(xb8, c * 4 + 1) + bf_el(ya, c * 4 + 1);
                v[c].z = ALPHA * bf_el(xb8, c * 4 + 2) + bf_el(ya, c * 4 + 2); v[c].w = ALPHA * bf_el(xb8, c * 4 + 3) + bf_el(ya, c * 4 + 3);
                s += (v[c].x + v[c].y) + (v[c].z + v[c].w);
            }
            xb8 = xbn; ya = yan;
            const float mu = wave_sum(s) * (1.f / 1024.f);
            float qq = 0.f;
#pragma unroll
            for (int c = 0; c < 4; ++c) { const float a = v[c].x - mu, b2 = v[c].y - mu, c2 = v[c].z - mu, d2 = v[c].w - mu; qq += (a * a + b2 * b2) + (c2 * c2 + d2 * d2); }
            const float var = wave_sum(qq) * (1.f / 1024.f);
            const float rs = 1.0f / sqrtf(var + LN_EPS);
            u32x2* xb = (u32x2*)(p.Xb + (size_t)t * DM);
            float a[8] = {0.f, 0.f, 0.f, 0.f, 0.f, 0.f, 0.f, 0.f};
            u32x2 wout[4];
#pragma unroll
            for (int c = 0; c < 4; ++c) {
                const float4 gg = gg4[c], bb = bb4[c];
                float4 o; o.x = (v[c].x - mu) * rs * gg.x + bb.x; o.y = (v[c].y - mu) * rs * gg.y + bb.y; o.z = (v[c].z - mu) * rs * gg.z + bb.z; o.w = (v[c].w - mu) * rs * gg.w + bb.w;
                wout[c].x = pk2(o.x, o.y); wout[c].y = pk2(o.z, o.w);
                const float ov[4] = {o.x, o.y, o.z, o.w};
                const float* wk = wr + (size_t)((c * 64 + lane) * 4) * 8;
#pragma unroll
                for (int j = 0; j < 4; ++j) { const float4 w0 = *(const float4*)(wk + j * 8), w1 = *(const float4*)(wk + j * 8 + 4);
                    a[0] += ov[j] * w0.x; a[1] += ov[j] * w0.y; a[2] += ov[j] * w0.z; a[3] += ov[j] * w0.w; a[4] += ov[j] * w1.x; a[5] += ov[j] * w1.y; a[6] += ov[j] * w1.z; a[7] += ov[j] * w1.w; }
            }
#pragma unroll
            for (int c = 0; c < 4; ++c) xb[c * 64 + lane] = wout[c];
            {
                float b4[4], b2[2], b1;
                const bool up1 = lane & 1, up2 = lane & 2, up4 = lane & 4;
#pragma unroll
                for (int e = 0; e < 4; ++e) { const float keep = up1 ? a[e + 4] : a[e], send = up1 ? a[e] : a[e + 4]; b4[e] = keep + __shfl_xor(send, 1); }
#pragma unroll
                for (int e = 0; e < 2; ++e) { const float keep = up2 ? b4[e + 2] : b4[e], send = up2 ? b4[e] : b4[e + 2]; b2[e] = keep + __shfl_xor(send, 2); }
                { const float keep = up4 ? b2[1] : b2[0], send = up4 ? b2[0] : b2[1]; b1 = keep + __shfl_xor(send, 4); }
                b1 += __shfl_xor(b1, 8); b1 += __shfl_xor(b1, 16); b1 += __shfl_xor(b1, 32);
#pragma unroll
                for (int e = 0; e < 8; ++e) { const int src = ((e >> 2) & 1) | (e & 2) | ((e & 1) << 2); a[e] = __shfl(b1, src) + br[e]; }
            }
            int e1 = 0; float l1 = a[0];
#pragma unroll
            for (int e = 1; e < 8; ++e) if (a[e] > l1) { l1 = a[e]; e1 = e; }
            int e2 = -1; float l2 = -INFINITY;
#pragma unroll
            for (int e = 0; e < 8; ++e) if (e != e1 && a[e] > l2) { l2 = a[e]; e2 = e; }
            const float ex = expf(l2 - l1);
            if (lane == 0) {
                p.tok_e[2 * t] = e1; p.tok_e[2 * t + 1] = e2;
                p.tok_g[2 * t] = 1.f / (1.f + ex); p.tok_g[2 * t + 1] = ex / (1.f + ex);
                atomicAdd(&lcnt[e1], 1); atomicAdd(&lcnt[e2], 1);
            }
        }
        __syncthreads();
        if (tid < 8) p.chunk_cnt[chunk * 8 + tid] = lcnt[tid];
    }
}
__device__ __forceinline__ void ph_slots(const Params& p, float* lds) {
    const int tid = tid_();
    int* lbase = (int*)lds;
    int* lpad = lbase + 8;
    int* ltot = lpad + 16;
    int* lent = ltot + 8;
    int* lslot = lent + 256;
    for (int chunk = blockIdx.x; chunk < 256; chunk += gridDim.x) {
        __syncthreads();
        {
            int* lcc = lslot + 256;
            const int4 v4 = ((const int4*)p.chunk_cnt)[tid]; ((int4*)lcc)[tid] = v4;
            if (tid < 256) lent[tid] = p.tok_e[chunk * 256 + tid];
            __syncthreads();
            {
                const int e = tid >> 6, ln = tid & 63; int tot = 0, before = 0;
#pragma unroll
                for (int q = 0; q < 4; ++q) { const int cc = ln * 4 + q, v = lcc[cc * 8 + e]; tot += v; before += (cc < chunk) ? v : 0; }
#pragma unroll
                for (int o = 32; o >= 1; o >>= 1) { tot += __shfl_xor(tot, o); before += __shfl_xor(before, o); }
                if (ln == 0) { lbase[e] = before; ltot[e] = tot; }
            }
        }
        __syncthreads();
        if (tid == 0) { int acc = 0; for (int e = 0; e < 8; ++e) { lpad[e] = acc; acc += (ltot[e] + 255) / 256 * 256; } lpad[8] = acc; }
        __syncthreads();
        {
            int* lwc = lslot + 256 + 2048;
            const int wv = tid >> 6, ln = tid & 63;
            int my_e = -1, my_rank = 0;
            if (tid < 256) {
                my_e = lent[tid];
#pragma unroll
                for (int e = 0; e < 8; ++e) { const unsigned long long mb = __ballot(my_e == e); if (my_e == e) my_rank = lane_rank(mb); if (ln == 0) lwc[wv * 8 + e] = __popcll(mb); }
            }
            __syncthreads();
            if (tid < 256) { int r = lpad[my_e] + lbase[my_e] + my_rank; for (int q = 0; q < wv; ++q) r += lwc[q * 8 + my_e]; lslot[tid] = r; }
        }
        __syncthreads();
        if (tid < 256) {
            const int slot = lslot[tid], tk = chunk * 128 + (tid >> 1);
            p.slot_tok[slot] = tk; p.slot_gate[slot] = p.tok_g[chunk * 256 + tid]; p.tok_slot[chunk * 256 + tid] = slot;
        }
        if (gridDim.x != 256)
        for (int idx0 = tid; idx0 < 256 * 128; idx0 += 8 * NT) {
            pg8::u32x4 v[8];
#pragma unroll
            for (int u = 0; u < 8; ++u) { const int idx = idx0 + u * NT, e = idx >> 7, piece = idx & 127; v[u] = ((const pg8::u32x4*)p.Xb)[(size_t)(chunk * 128 + (e >> 1)) * 128 + piece]; }
#pragma unroll
            for (int u = 0; u < 8; ++u) { const int idx = idx0 + u * NT, e = idx >> 7, piece = idx & 127; ((pg8::u32x4*)p.Xs)[(size_t)lslot[e] * 128 + piece] = v[u]; }
        }
        if (chunk < 8) {
            const int s0 = lpad[chunk] + ltot[chunk], s1 = lpad[chunk + 1];
            if (gridDim.x != 256) for (int idx = tid; idx < (s1 - s0) * 128; idx += NT) ((uint4*)p.Xs)[(size_t)(s0 + (idx >> 7)) * 128 + (idx & 127)] = make_uint4(0u, 0u, 0u, 0u);
            for (int s = s0 + tid; s < s1; s += NT) { p.slot_tok[s] = -1; p.slot_gate[s] = 0.f; }
        }
        if (chunk == 8 && tid < NTILE256) {
            const int s0 = tid * 256; int e = -1;
            for (int q = 0; q < 8; ++q) if (s0 >= lpad[q] && s0 < lpad[q + 1]) e = q;
            p.tile_e[tid] = e;
        }
    }
}

typedef short bf16x8 __attribute__((ext_vector_type(8)));
typedef short s16x4 __attribute__((ext_vector_type(4)));
typedef __attribute__((address_space(3))) const unsigned char* lds_cptr;
__device__ __forceinline__ s16x4 vtr(lds_cptr p) { return __builtin_bit_cast(s16x4, __builtin_amdgcn_ds_read_tr16_b64_v4i16((__attribute__((address_space(3))) s16x4*)p)); }
__device__ __forceinline__ bf16x8 cat8(s16x4 lo, s16x4 hi) { bf16x8 r; r[0] = lo[0]; r[1] = lo[1]; r[2] = lo[2]; r[3] = lo[3]; r[4] = hi[0]; r[5] = hi[1]; r[6] = hi[2]; r[7] = hi[3]; return r; }
constexpr int AT_KP = 160;
template <int VD> struct AtL { static constexpr int VP = VD * 2 + 32, KB = 64 * AT_KP, VB = 64 * VP, BUF = KB + VB; };
constexpr float AT_SCALE2 = 0.125f * 1.4426950408889634f;

template <int VD> struct AtState {
    f32x4 o[2][VD / 16]; float m[2], l[2];
    __device__ __forceinline__ void init() {
#pragma unroll
        for (int g = 0; g < 2; ++g) { m[g] = -1e30f; l[g] = 0.f;
#pragma unroll
            for (int n = 0; n < VD / 16; ++n) o[g][n] = Z4_; }
    }
};
typedef float f32x2 __attribute__((ext_vector_type(2)));
__device__ __forceinline__ float max3f_(float a, float b, float c) { float r; asm("v_max3_f32 %0, %1, %2, %3" : "=v"(r) : "v"(a), "v"(b), "v"(c)); return r; }
__device__ __forceinline__ float max2f_(float a, float b) { float r; asm("v_max_f32_e32 %0, %1, %2" : "=v"(r) : "v"(a), "v"(b)); return r; }
__device__ __forceinline__ float xmax16(float v) { const unsigned u = __builtin_bit_cast(unsigned, v); const auto r = __builtin_amdgcn_permlane16_swap(u, u, false, false);
    return max2f_(__builtin_bit_cast(float, r[0]), __builtin_bit_cast(float, r[1])); }
__device__ __forceinline__ float xmax32(float v) { const unsigned u = __builtin_bit_cast(unsigned, v); const auto r = __builtin_amdgcn_permlane32_swap(u, u, false, false);
    return max2f_(__builtin_bit_cast(float, r[0]), __builtin_bit_cast(float, r[1])); }
template <int VD, int MODE, class RowOk, class Allow>
__device__ __forceinline__ void at_tile(AtState<VD>& st, lds_cptr Kb, lds_cptr Vb, const bf16x8 (&q)[2][2], int fr, int fq, RowOk rowok, Allow allow) {
    f32x4 s[2][4];
    bf16x8 kn0 = *(const __attribute__((address_space(3))) bf16x8*)(Kb + fr * AT_KP + fq * 16);
    bf16x8 kn1 = *(const __attribute__((address_space(3))) bf16x8*)(Kb + fr * AT_KP + 64 + fq * 16);
    bf16x8 kp1 = kn1;
#pragma unroll
    for (int kk = 0; kk < 4; ++kk) {
        const bf16x8 kf0 = kn0, kf1 = kn1;
        if (kk < 3) { kn0 = *(const __attribute__((address_space(3))) bf16x8*)(Kb + (16 * (kk + 1) + fr) * AT_KP + fq * 16);
                      kn1 = *(const __attribute__((address_space(3))) bf16x8*)(Kb + (16 * (kk + 1) + fr) * AT_KP + 64 + fq * 16); }
#pragma unroll
        for (int g = 0; g < 2; ++g) s[g][kk] = __builtin_amdgcn_mfma_f32_16x16x32_bf16(kf0, q[g][0], (f32x4){0.f, 0.f, 0.f, 0.f}, 0, 0, 0);
        if (kk > 0) {
#pragma unroll
            for (int g = 0; g < 2; ++g) s[g][kk - 1] = __builtin_amdgcn_mfma_f32_16x16x32_bf16(kp1, q[g][1], s[g][kk - 1], 0, 0, 0);
        }
        kp1 = kf1;
    }
#pragma unroll
    for (int g = 0; g < 2; ++g) s[g][3] = __builtin_amdgcn_mfma_f32_16x16x32_bf16(kp1, q[g][1], s[g][3], 0, 0, 0);
    const lds_cptr vp0 = Vb + (4 * fq + (fr >> 2)) * AtL<VD>::VP + (4 * (fr & 3)) * 2;
    bf16x8 vn = cat8(vtr(vp0), vtr(vp0 + 16 * AtL<VD>::VP));
    bf16x8 pf[2][2];
#pragma unroll
    for (int g = 0; g < 2; ++g) {
        float mloc = fmaxf(fmaxf(s[g][0][0], s[g][0][1]), s[g][0][2]);
        mloc = fmaxf(fmaxf(mloc, s[g][0][3]), s[g][1][0]);
        mloc = fmaxf(fmaxf(mloc, s[g][1][1]), s[g][1][2]);
        mloc = fmaxf(fmaxf(mloc, s[g][1][3]), s[g][2][0]);
        mloc = fmaxf(fmaxf(mloc, s[g][2][1]), s[g][2][2]);
        mloc = fmaxf(fmaxf(mloc, s[g][2][3]), s[g][3][0]);
        mloc = fmaxf(fmaxf(mloc, s[g][3][1]), s[g][3][2]);
        mloc = fmaxf(mloc, s[g][3][3]);
        mloc = xmax16(mloc); mloc = xmax32(mloc);
        float mn = max2f_(st.m[g], mloc * AT_SCALE2);
        float cadd;
        if (MODE & 1) { const bool ro = rowok(g); mn = ro ? mn : st.m[g]; cadd = ro ? -mn : -INFINITY; } else cadd = -mn;
        const float alpha = __builtin_amdgcn_exp2f(st.m[g] - mn);
        st.m[g] = mn;
        float ls = 0.f;
#pragma unroll
        for (int kk = 0; kk < 4; ++kk)
#pragma unroll
            for (int r = 0; r < 4; ++r) {
                float pv = __builtin_amdgcn_exp2f(__builtin_fmaf(s[g][kk][r], AT_SCALE2, cadd));
                if (MODE & 2) pv = allow(g, kk, r) ? pv : 0.f;
                if (MODE & 4) pv = __builtin_bit_cast(float, __builtin_bit_cast(int, pv) & allow(g, kk, r));
                s[g][kk][r] = pv; ls += pv;
            }
        st.l[g] = st.l[g] * alpha + ls;
#pragma unroll
        for (int n = 0; n < VD / 16; ++n) st.o[g][n] = st.o[g][n] * alpha;
#pragma unroll
        for (int sp = 0; sp < 2; ++sp) {
            const unsigned w0 = pk2(s[g][2 * sp][0], s[g][2 * sp][1]), w1 = pk2(s[g][2 * sp][2], s[g][2 * sp][3]);
            const unsigned w2 = pk2(s[g][2 * sp + 1][0], s[g][2 * sp + 1][1]), w3 = pk2(s[g][2 * sp + 1][2], s[g][2 * sp + 1][3]);
            pf[g][sp] = __builtin_bit_cast(bf16x8, (pg8::u32x4){w0, w1, w2, w3});
        }
    }
    {
#pragma unroll
        for (int st_ = 0; st_ < VD / 8; ++st_) {
            const int n = st_ % (VD / 16), sp = st_ / (VD / 16);
            const bf16x8 vf = vn;
            if (st_ + 1 < VD / 8) { const int n2 = (st_ + 1) % (VD / 16), sp2 = (st_ + 1) / (VD / 16);
                const lds_cptr vp = Vb + (32 * sp2 + 4 * fq + (fr >> 2)) * AtL<VD>::VP + (n2 * 16 + 4 * (fr & 3)) * 2;
                vn = cat8(vtr(vp), vtr(vp + 16 * AtL<VD>::VP)); }
#pragma unroll
            for (int g = 0; g < 2; ++g) st.o[g][n] = __builtin_amdgcn_mfma_f32_16x16x32_bf16(vf, pf[g][sp], st.o[g][n], 0, 0, 0);
        }
    }
}
struct AtNoRow { __device__ __forceinline__ bool operator()(int) const { return true; } };
struct AtNoEl { __device__ __forceinline__ bool operator()(int, int, int) const { return true; } };
template <int VD> struct AtStage {
    pg8::u32x4 k, v[VD / 64];
    __device__ __forceinline__ void load(const bf16_t* kbase, const bf16_t* vbase, int key0, int tid) {
        const int row = tid >> 3, ch = tid & 7;
        k = *(const pg8::u32x4*)(kbase + (size_t)(key0 + row) * LDPB + ch * 8);
#pragma unroll
        for (int i = 0; i < VD / 64; ++i) v[i] = *(const pg8::u32x4*)(vbase + (size_t)(key0 + row) * LDPB + (ch + 8 * i) * 8);
    }
    __device__ __forceinline__ void store(LAS unsigned char* buf, int tid) const {
        const int row = tid >> 3, ch = tid & 7;
        *(LAS pg8::u32x4*)(buf + row * AT_KP + ch * 16) = k;
#pragma unroll
        for (int i = 0; i < VD / 64; ++i) *(LAS pg8::u32x4*)(buf + AtL<VD>::KB + row * AtL<VD>::VP + (ch + 8 * i) * 16) = v[i];
    }
};
template <int VD>
__device__ __forceinline__ void at_finish(AtState<VD>& st) {
#pragma unroll
    for (int g = 0; g < 2; ++g) { float l = st.l[g]; l += __shfl_xor(l, 16); l += __shfl_xor(l, 32); st.l[g] = l; }
}


template <int VD> struct AtStageP {
    pg8::u32x4 k, v[VD / 64];
    __device__ __forceinline__ void load(const bf16_t* kbase, const bf16_t* vbase, int pitch, int key0, int tid) {
        const int row = tid >> 3, ch = tid & 7;
        k = *(const pg8::u32x4*)(kbase + (size_t)(key0 + row) * pitch + ch * 8);
#pragma unroll
        for (int i = 0; i < VD / 64; ++i) v[i] = *(const pg8::u32x4*)(vbase + (size_t)(key0 + row) * pitch + (ch + 8 * i) * 8);
    }
    __device__ __forceinline__ void store(LAS unsigned char* buf, int tid) const {
        const int row = tid >> 3, ch = tid & 7;
        *(LAS pg8::u32x4*)(buf + row * AT_KP + ch * 16) = k;
#pragma unroll
        for (int i = 0; i < VD / 64; ++i) *(LAS pg8::u32x4*)(buf + AtL<VD>::KB + row * AtL<VD>::VP + (ch + 8 * i) * 16) = v[i];
    }
};
template <int VD, class Fn>
__device__ __forceinline__ void at_run(LAS unsigned char* lds, const bf16_t* kbase, const bf16_t* vbase, int pitch, int tile_lo, int tile_hi, int tid, Fn fn) {
    if (tile_lo >= tile_hi) return;
    AtStageP<VD> sg; sg.load(kbase, vbase, pitch, tile_lo * 64, tid);
    __syncthreads();
    for (int i = tile_lo; i < tile_hi; ++i) {
        LAS unsigned char* buf = lds + ((i - tile_lo) & 1) * AtL<VD>::BUF;
        sg.store(buf, tid);
        __syncthreads();
        if (i + 1 < tile_hi) sg.load(kbase, vbase, pitch, (i + 1) * 64, tid);
        fn(i, (lds_cptr)buf, (lds_cptr)buf + AtL<VD>::KB);
    }
}
template <int VD, class Fn>
__device__ __forceinline__ void at_run_side(LAS unsigned char* lds, const bf16_t* kbase, const bf16_t* vbase, int pitch, int tile_lo, int tile_hi, int tid, CvJob& job, Fn fn) {
    if (tile_lo >= tile_hi) return;
    AtStageP<VD> sg; sg.load(kbase, vbase, pitch, tile_lo * 64, tid);
    __syncthreads();
    for (int i = tile_lo; i < tile_hi; ++i) {
        LAS unsigned char* buf = lds + ((i - tile_lo) & 1) * AtL<VD>::BUF;
        sg.store(buf, tid);
        __syncthreads();
        job.step(tid);
        if (i + 1 < tile_hi) sg.load(kbase, vbase, pitch, (i + 1) * 64, tid);
        fn(i, (lds_cptr)buf, (lds_cptr)buf + AtL<VD>::KB);
    }
}
template <int VD>
__device__ __forceinline__ void at_scores(f32x4 (&s)[2][4], lds_cptr Kb, const bf16x8 (&q)[2][2], int fr, int fq) {
    bf16x8 kn0 = *(const __attribute__((address_space(3))) bf16x8*)(Kb + fr * AT_KP + fq * 16);
    bf16x8 kn1 = *(const __attribute__((address_space(3))) bf16x8*)(Kb + fr * AT_KP + 64 + fq * 16);
#pragma unroll
    for (int kk = 0; kk < 4; ++kk) {
        const bf16x8 kf0 = kn0, kf1 = kn1;
        if (kk < 3) { kn0 = *(const __attribute__((address_space(3))) bf16x8*)(Kb + (16 * (kk + 1) + fr) * AT_KP + fq * 16);
                      kn1 = *(const __attribute__((address_space(3))) bf16x8*)(Kb + (16 * (kk + 1) + fr) * AT_KP + 64 + fq * 16); }
#pragma unroll
        for (int g = 0; g < 2; ++g) s[g][kk] = __builtin_amdgcn_mfma_f32_16x16x32_bf16(kf0, q[g][0], (f32x4){0.f, 0.f, 0.f, 0.f}, 0, 0, 0);
#pragma unroll
        for (int g = 0; g < 2; ++g) s[g][kk] = __builtin_amdgcn_mfma_f32_16x16x32_bf16(kf1, q[g][1], s[g][kk], 0, 0, 0);
    }
}

__device__ __forceinline__ void ph_diff_mfma(const Params& p, LAS unsigned char* lds, int li) {
    const int tid = tid_(), lane = tid & 63, w = tid >> 6, fr = lane & 15, fq = lane >> 4;
    const int G = gridDim.x, c = blockIdx.x;
    const float* lp = p.in[IN_DIF_LAMBDA] + li * 256;
    const float d01 = wave_sum(lp[lane] * lp[64 + lane]), d23 = wave_sum(lp[128 + lane] * lp[192 + lane]);
    const float lam_init = li ? p.lam_init[1] : p.lam_init[0];
    const float lam = expf(d01) - expf(d23) + lam_init;
    const float* subln = p.in[IN_DIF_SUBLN] + li * 128;
    LAS unsigned* oal = (LAS unsigned*)(lds + 2 * AtL<128>::BUF) + w * 2048 + lane;
    for (int L = c; L < 512; L += G) {
        int qb, b, h;
        if (G == 256) { const int rnd = L >> 8, x = c & 7, j = c >> 3; b = x; h = j >> 3; qb = rnd ? 15 - (j & 7) : (j & 7); }
        else { const int rnd = L / G; const int u = ((rnd & 1) && (512 % G == 0)) ? rnd * G + (G - 1 - (L - rnd * G)) : L; qb = u & 15; h = (u >> 4) & 3; b = u >> 6; }
        const bf16_t* vbase = p.Pb + (size_t)b * SEQ * LDPB + E_AV + h * 128;
        const int t0 = qb * 256 + w * 32;
#pragma unroll 1
        for (int jm = 0; jm < 2; ++jm) {
            const int hj = 2 * h + jm;
            const bf16_t* kbase = p.Pb + (size_t)b * SEQ * LDPB + E_AK + hj * 64;
            bf16x8 q[2][2];
#pragma unroll
            for (int g = 0; g < 2; ++g)
#pragma unroll
                for (int ks = 0; ks < 2; ++ks) q[g][ks] = *(const bf16x8*)(p.Pb + (size_t)(b * SEQ + t0 + g * 16 + fr) * LDPB + E_AQ + hj * 64 + ks * 32 + fq * 8);
            AtState<128> st; st.init();
            at_run<128>(lds, kbase, vbase, LDPB, 0, 4 * qb + 4, tid, [&](int i, lds_cptr Kb, lds_cptr Vb) {
                const int key0 = i * 64;
                if (key0 <= t0 + 31) {
                    if (key0 + 63 <= t0) at_tile<128, 0>(st, Kb, Vb, q, fr, fq, AtNoRow(), AtNoEl());
                    else { const int tq0 = t0 + fr - key0 - 4 * fq; at_tile<128, 2>(st, Kb, Vb, q, fr, fq, AtNoRow(), [=](int g, int kk, int r) { return 16 * kk + r <= tq0 + g * 16; }); }
                }
            });
            at_finish(st);
            if (jm == 0) {
#pragma unroll
                for (int g = 0; g < 2; ++g) { const float inv = 1.f / st.l[g];
#pragma unroll
                    for (int n = 0; n < 8; ++n) { const f32x4 o = st.o[g][n] * inv; oal[((g * 8 + n) * 2) * 64] = pk2(o[0], o[1]); oal[((g * 8 + n) * 2 + 1) * 64] = pk2(o[2], o[3]); } }
            } else {
#pragma unroll
                for (int g = 0; g < 2; ++g) { const float inv = 1.f / st.l[g];
                    float ss = 0.f;
#pragma unroll
                    for (int n = 0; n < 8; ++n) {
                        const f32x4 ob = st.o[g][n] * inv;
                        const unsigned b01 = pk2(ob[0], ob[1]), b23 = pk2(ob[2], ob[3]);
                        const unsigned a01 = oal[((g * 8 + n) * 2) * 64], a23 = oal[((g * 8 + n) * 2 + 1) * 64];
                        f32x4 r;
                        r[0] = __builtin_bit_cast(float, a01 << 16) - lam * __builtin_bit_cast(float, b01 << 16);
                        r[1] = __builtin_bit_cast(float, a01 & 0xffff0000u) - lam * __builtin_bit_cast(float, b01 & 0xffff0000u);
                        r[2] = __builtin_bit_cast(float, a23 << 16) - lam * __builtin_bit_cast(float, b23 << 16);
                        r[3] = __builtin_bit_cast(float, a23 & 0xffff0000u) - lam * __builtin_bit_cast(float, b23 & 0xffff0000u);
                        st.o[g][n] = r;
                        ss += (r[0] * r[0] + r[1] * r[1]) + (r[2] * r[2] + r[3] * r[3]);
                    }
                    ss += __shfl_xor(ss, 16); ss += __shfl_xor(ss, 32);
                    const float sc = (1.0f / sqrtf(ss * (1.f / 128.f) + LN_EPS)) * (1.f - lam_init);
                    bf16_t* dst = p.Ob + (size_t)(b * SEQ + t0 + g * 16 + fr) * DM + h * 128 + 4 * fq;
                    float4 swv[8];
#pragma unroll
                    for (int n = 0; n < 8; ++n) swv[n] = *(const float4*)(subln + n * 16 + 4 * fq);
#pragma unroll
                    for (int n = 0; n < 8; ++n) { const float4 sw = swv[n]; const f32x4 r = st.o[g][n];
                        u32x2 wv; wv.x = pk2(r[0] * sc * sw.x, r[1] * sc * sw.y); wv.y = pk2(r[2] * sc * sw.z, r[3] * sc * sw.w); *(u32x2*)(dst + n * 16) = wv; }
                }
            }
        }
    }
}

__device__ __forceinline__ float quad_xor1(float x) { return __builtin_bit_cast(float, __builtin_amdgcn_update_dpp(0, __builtin_bit_cast(int, x), 0xB1, 0xf, 0xf, false)); }
__device__ __forceinline__ float quad_xor2(float x) { return __builtin_bit_cast(float, __builtin_amdgcn_update_dpp(0, __builtin_bit_cast(int, x), 0x4E, 0xf, 0xf, false)); }
__device__ __forceinline__ void ph_moba_mfma(const Params& p, LAS unsigned char* lds, int li) {
    const int tid = tid_(), lane = tid & 63, w = tid >> 6, fr = lane & 15, fq = lane >> 4;
    CvJob job; job.init(p, li, (float*)((unsigned char*)lds + 65536), tid);
    const int G = gridDim.x, c = blockIdx.x;
    LAS unsigned* lmask = (LAS unsigned*)(lds + 40960);
#define MB_E(k, isb, qbv) ((unsigned long long)(((isb) << 4) | (qbv)) << (5 * (k)))
    unsigned long long code = 0ull; int nun = 0, sA = 0, sB = 0;
    if (G == 256) {
        if (c < 32) { sA = c; nun = 3; code = MB_E(0, 0, 15) | MB_E(1, 0, 8) | MB_E(2, 0, 1); }
        else {
            const int c2 = c - 32, pidx = c2 / 7, grp = c2 - pidx * 7; sA = pidx; sB = pidx + 32;
            if (grp == 0) { nun = 3; code = MB_E(0, 1, 15) | MB_E(1, 1, 14) | MB_E(2, 0, 4); }
            else if (grp == 1) { nun = 3; code = MB_E(0, 0, 14) | MB_E(1, 0, 13) | MB_E(2, 1, 6); }
            else if (grp == 2) { nun = 3; code = MB_E(0, 1, 13) | MB_E(1, 1, 12) | MB_E(2, 1, 8); }
            else if (grp == 3) { nun = 3; code = MB_E(0, 0, 12) | MB_E(1, 0, 11) | MB_E(2, 0, 10); }
            else if (grp == 4) { nun = 4; code = MB_E(0, 1, 11) | MB_E(1, 1, 10) | MB_E(2, 0, 7) | MB_E(3, 0, 3); }
            else if (grp == 5) { nun = 4; code = MB_E(0, 0, 9) | MB_E(1, 1, 9) | MB_E(2, 1, 7) | MB_E(3, 0, 6); }
            else { nun = 9; code = MB_E(0, 0, 5) | MB_E(1, 1, 5) | MB_E(2, 1, 4) | MB_E(3, 1, 3) | MB_E(4, 0, 2) | MB_E(5, 1, 2) | MB_E(6, 1, 1) | MB_E(7, 0, 0) | MB_E(8, 1, 0); }
        }
    } else nun = (c < 1024) ? (1024 - c + G - 1) / G : 0;
#undef MB_E
    for (int ui = 0; ui < nun; ++ui) {
        int qb, stream;
        if (G == 256) { const int e = (int)(code >> (5 * ui)) & 31; stream = (e & 16) ? sB : sA; qb = e & 15; }
        else { const int L = c + ui * G; const int rnd = L / G; const int u = ((rnd & 1) && (1024 % G == 0)) ? rnd * G + (G - 1 - (L - rnd * G)) : L; qb = u & 15; stream = u >> 4; }
        const int h = stream & 7, b = stream >> 3;
        const bf16_t* kbase = p.Pb + (size_t)b * SEQ * LDPB + O_CK + h * 64;
        const bf16_t* vbase = p.Pb + (size_t)b * SEQ * LDPB + O_CV + h * 64;
        const int t0 = qb * 256 + w * 32;
        bf16x8 q[2][2];
#pragma unroll
        for (int g = 0; g < 2; ++g)
#pragma unroll
            for (int ks = 0; ks < 2; ++ks) q[g][ks] = *(const bf16x8*)(p.Pb + (size_t)(b * SEQ + t0 + g * 16 + fr) * LDPB + O_CQ + h * 64 + ks * 32 + fq * 8);
        unsigned msk[2];
        {
            bf16x8 kmf[2];
#pragma unroll
            for (int ks = 0; ks < 2; ++ks) { const float* km = p.kmean + (size_t)((b * 16 + fr) * 8 + h) * 64 + ks * 32 + fq * 8;
                const float4 a0 = *(const float4*)km, a1 = *(const float4*)(km + 4);
                kmf[ks] = __builtin_bit_cast(bf16x8, (pg8::u32x4){pk2(a0.x, a0.y), pk2(a0.z, a0.w), pk2(a1.x, a1.y), pk2(a1.z, a1.w)}); }
            LAS float* lg = (LAS float*)(lds + 40960) + w * 512;
#pragma unroll
            for (int g = 0; g < 2; ++g) {
                f32x4 gs = Z4_;
                gs = __builtin_amdgcn_mfma_f32_16x16x32_bf16(kmf[0], q[g][0], gs, 0, 0, 0);
                gs = __builtin_amdgcn_mfma_f32_16x16x32_bf16(kmf[1], q[g][1], gs, 0, 0, 0);
                *(LAS f32x4*)(lg + (g * 16 + fr) * 16 + 4 * fq) = gs;
            }
#pragma unroll
            for (int g = 0; g < 2; ++g) {
                float gv[16];
#pragma unroll
                for (int c4 = 0; c4 < 4; ++c4) { const f32x4 t4 = *(const LAS f32x4*)(lg + (g * 16 + fr) * 16 + 4 * c4);
#pragma unroll
                    for (int e = 0; e < 4; ++e) gv[4 * c4 + e] = (4 * c4 + e < qb) ? t4[e] : -INFINITY; }
                unsigned m = 0u;
#pragma unroll
                for (int pick = 0; pick < 3; ++pick) {
                    float best = -INFINITY; int bi = -1;
#pragma unroll
                    for (int n = 0; n < 16; ++n) if (gv[n] > best) { best = gv[n]; bi = n; }
                    if (bi >= 0) m |= 1u << bi;
#pragma unroll
                    for (int n = 0; n < 16; ++n) gv[n] = (n == bi) ? -INFINITY : gv[n];
                }
                msk[g] = m;
            }
        }
        AtState<64> st; st.init();
        at_run_side<64>(lds, kbase, vbase, LDPB, 0, 4 * qb + 4, tid, job, [&](int i, lds_cptr Kb, lds_cptr Vb) {
            const int n = i >> 2, key0 = i * 64;
            if (n < qb) {
                const bool b0 = (msk[0] >> n) & 1u, b1 = (msk[1] >> n) & 1u;
                at_tile<64, 1>(st, Kb, Vb, q, fr, fq, [=](int g) { return g ? b1 : b0; }, AtNoEl());
            } else if (key0 <= t0 + 31) {
                const int tq0 = t0 + fr - key0 - 4 * fq;
                if (key0 + 63 <= t0) at_tile<64, 0>(st, Kb, Vb, q, fr, fq, AtNoRow(), AtNoEl());
                else at_tile<64, 2>(st, Kb, Vb, q, fr, fq, AtNoRow(), [=](int g, int kk, int r) { return 16 * kk + r <= tq0 + g * 16; });
            }
        });
        at_finish(st);
#pragma unroll
        for (int g = 0; g < 2; ++g) { const float inv = 1.f / st.l[g]; bf16_t* dst = p.Ob + (size_t)(b * SEQ + t0 + g * 16 + fr) * DM + h * 64 + 4 * fq;
#pragma unroll
            for (int n = 0; n < 4; ++n) { const f32x4 o = st.o[g][n] * inv; u32x2 wv; wv.x = pk2(o[0], o[1]); wv.y = pk2(o[2], o[3]); *(u32x2*)(dst + n * 16) = wv; } }
    }
    job.finish(tid);
}

__device__ __forceinline__ void ph_nsa_mfma(const Params& p, LAS unsigned char* lds, const bf16_t* cmpkb, const bf16_t* cmpvb) {
    const int tid = tid_(), lane = tid & 63, w = tid >> 6, fr = lane & 15, fq = lane >> 4;
    const int G = gridDim.x, c = blockIdx.x;
    LAS float* impA = (LAS float*)(lds + 40960) + w * 1024;
    LAS float* impB = impA + 512;
    LAS unsigned long long* selm = (LAS unsigned long long*)(lds + 73728) + w * 8;
    static_assert(2 * AtL<64>::BUF <= 40960, "NSA LDS map");
    for (int L = c; L < 1024; L += G) {
        int qb, stream;
        if (G == 256) { const int rnd = L >> 8, x = c & 7, j = c >> 3;
            stream = 2 * x + (rnd >> 1); qb = (rnd & 1) ? 63 - j : j; }
        else { const int rnd = L / G; const int u = ((rnd & 1) && (1024 % G == 0)) ? rnd * G + (G - 1 - (L - rnd * G)) : L; qb = u & 63; stream = u >> 6; }
        const int grp = stream & 1, b = stream >> 1;
        const int tw = qb * 64 + w * 8;
#define TQ(g) (tw + (g) * 4 + (fr >> 2))
#define TOKG(g) (b * SEQ + TQ(g))
        bf16x8 qraw[2][2];
#pragma unroll
        for (int g = 0; g < 2; ++g) {
            const int head = grp * 4 + (fr & 3);
#pragma unroll
            for (int ks = 0; ks < 2; ++ks) qraw[g][ks] = *(const bf16x8*)(p.Pb + (size_t)TOKG(g) * LDPB + O_DQ + head * 64 + ks * 32 + fq * 8);
        }
        LAS float* accl = (LAS float*)(lds + 75776) + w * 2048 + lane;
        const bf16_t* ck = cmpkb + (size_t)(b * 2 + grp) * 256 * 64; const bf16_t* cv = cmpvb + (size_t)(b * 2 + grp) * 256 * 64;
        int nv[2];
#pragma unroll
        for (int g = 0; g < 2; ++g) nv[g] = (TQ(g) >= 31) ? ((TQ(g) - 31) >> 4) + 1 : 0;
        const int nvmax_w = (tw + 7 >= 31) ? ((tw + 7 - 31) >> 4) + 1 : 0;
        const int nvmax_b = (qb * 64 + 63 >= 31) ? ((qb * 64 + 63 - 31) >> 4) + 1 : 0;
        const int ncmp_tiles = (nvmax_b + 63) >> 6;
        float mfin[2], linv[2];
        {
            AtState<64> st; st.init();
            at_run<64>(lds, ck, cv, 64, 0, ncmp_tiles, tid, [&](int i, lds_cptr Kb, lds_cptr Vb) {
                if (i * 64 < nvmax_w) { const int n0 = nv[0] - i * 64, n1 = nv[1] - i * 64;
                    at_tile<64, 2>(st, Kb, Vb, qraw, fr, fq, AtNoRow(), [=](int g, int kk, int r) { return 16 * kk + 4 * fq + r < (g ? n1 : n0); }); }
            });
            at_finish(st);
#pragma unroll
            for (int g = 0; g < 2; ++g) { mfin[g] = st.m[g]; linv[g] = st.l[g] > 0.f ? 1.f / st.l[g] : 0.f;
#pragma unroll
                for (int n = 0; n < 4; ++n) { const f32x4 o = st.o[g][n] * (linv[g] * p.GATES[(size_t)TOKG(g) * 24 + (grp * 4 + (fr & 3)) * 3]);
#pragma unroll
                    for (int r = 0; r < 4; ++r) accl[((g * 4 + n) * 4 + r) * 64] = o[r]; } }
        }
        for (int e = lane; e < 512; e += 64) { impA[e] = 0.f; impB[e] = 0.f; }
        at_run<64>(lds, ck, cv, 64, 0, ncmp_tiles, tid, [&](int i, lds_cptr Kb, lds_cptr) {
            if (i * 64 < nvmax_w) {
                f32x4 s[2][4]; at_scores<64>(s, Kb, qraw, fr, fq);
#pragma unroll
                for (int g = 0; g < 2; ++g)
#pragma unroll
                    for (int kk = 0; kk < 4; ++kk) {
                        float a = 0.f, last = 0.f;
#pragma unroll
                        for (int r = 0; r < 4; ++r) { const int n = i * 64 + 16 * kk + 4 * fq + r;
                            const float pv = (n < nv[g]) ? __builtin_amdgcn_exp2f(s[g][kk][r] * AT_SCALE2 - mfin[g]) * linv[g] : 0.f; a += pv; last = pv; }
                        a += quad_xor1(a); a += quad_xor2(a); last += quad_xor1(last); last += quad_xor2(last);
                        const int j = 16 * i + 4 * kk + fq, qi = g * 4 + (fr >> 2);
                        if ((fr & 3) == 0) { impA[qi * 64 + j] = a; if (j + 1 < 64) impB[qi * 64 + j + 1] = last; }
                    }
            }
        });
        {
            unsigned key[8], T[8];
#pragma unroll
            for (int qi = 0; qi < 8; ++qi) {
                const float imp = impA[qi * 64 + lane] + impB[qi * 64 + lane];
                const bool causal = lane <= qb, forced = (lane == 0) || (lane >= qb - 1 && causal);
                const float val = forced ? 1e30f : (causal ? imp : -1e30f);
                const unsigned u = __builtin_bit_cast(unsigned, val);
                key[qi] = (u & 0x80000000u) ? ~u : (u | 0x80000000u); T[qi] = 0u;
            }
#pragma nounroll
            for (int bit = 31; bit >= 0; --bit) {
#pragma unroll
                for (int qi = 0; qi < 8; ++qi) { const unsigned cand = T[qi] | (1u << bit); if (__popcll(__ballot(key[qi] >= cand)) >= 16) T[qi] = cand; }
            }
#pragma unroll
            for (int qi = 0; qi < 8; ++qi) {
                const bool gt = key[qi] > T[qi], eq = key[qi] == T[qi];
                const unsigned long long meq = __ballot(eq);
                const int need = 16 - __popcll(__ballot(gt));
                const unsigned long long mk = __ballot(gt || (eq && lane_rank(meq) < need));
                if (lane == 0) selm[qi] = mk;
            }
        }
        unsigned long long sm[2];
#pragma unroll
        for (int g = 0; g < 2; ++g) sm[g] = selm[g * 4 + (fr >> 2)];
        bf16x8 qrot[2][2];
#pragma unroll
        for (int g = 0; g < 2; ++g)
#pragma unroll
            for (int ks = 0; ks < 2; ++ks) qrot[g][ks] = *(const bf16x8*)(p.QRb + (size_t)TOKG(g) * 512 + (grp * 4 + (fr & 3)) * 64 + ks * 32 + fq * 8);
        {
            const bf16_t* kb = p.Pb + (size_t)b * SEQ * LDPB + O_KS + grp * 64; const bf16_t* vb = p.Pb + (size_t)b * SEQ * LDPB + O_VS + grp * 64;
            AtState<64> st; st.init();
            at_run<64>(lds, kb, vb, LDPB, 0, qb + 1, tid, [&](int i, lds_cptr Kb, lds_cptr Vb) {
                const bool b0 = (sm[0] >> i) & 1ull, b1 = (sm[1] >> i) & 1ull;
                { const int d0 = TQ(0) - i * 64, d1 = TQ(1) - i * 64;
                    if (i < qb) at_tile<64, 1>(st, Kb, Vb, qrot, fr, fq, [=](int g) { return g ? b1 : b0; }, AtNoEl());
                    else at_tile<64, 3>(st, Kb, Vb, qrot, fr, fq, [=](int g) { return g ? b1 : b0; }, [=](int g, int kk, int r) { return 16 * kk + 4 * fq + r <= (g ? d1 : d0); }); }
            });
            at_finish(st);
#pragma unroll
            for (int g = 0; g < 2; ++g) { const float sc = p.GATES[(size_t)TOKG(g) * 24 + (grp * 4 + (fr & 3)) * 3 + 1] / st.l[g];
#pragma unroll
                for (int n = 0; n < 4; ++n)
#pragma unroll
                    for (int r = 0; r < 4; ++r) accl[((g * 4 + n) * 4 + r) * 64] += st.o[g][n][r] * sc; }
        }
        {
            const bf16_t* kb = p.Pb + (size_t)b * SEQ * LDPB + O_KW + grp * 64; const bf16_t* vb = p.Pb + (size_t)b * SEQ * LDPB + O_VW + grp * 64;
            AtState<64> st; st.init();
            at_run<64>(lds, kb, vb, LDPB, (qb >= 8 ? qb - 8 : 0), qb + 1, tid, [&](int i, lds_cptr Kb, lds_cptr Vb) {
                const int d0 = TQ(0) - i * 64 - 4 * fq, d1 = TQ(1) - i * 64 - 4 * fq;
                if (i == qb || (qb >= 8 && i == qb - 8)) {
                    const int hi0 = (i == qb) ? d0 : 64, hi1 = (i == qb) ? d1 : 64, lo0 = (i == qb) ? -1 : d0 - 512, lo1 = (i == qb) ? -1 : d1 - 512;
                    at_tile<64, 2>(st, Kb, Vb, qrot, fr, fq, AtNoRow(), [=](int g, int kk, int r) { const int kx = 16 * kk + r; return kx <= (g ? hi1 : hi0) && kx > (g ? lo1 : lo0); });
                } else at_tile<64, 0>(st, Kb, Vb, qrot, fr, fq, AtNoRow(), AtNoEl());
            });
            at_finish(st);
#pragma unroll
            for (int g = 0; g < 2; ++g) { const float sc = p.GATES[(size_t)TOKG(g) * 24 + (grp * 4 + (fr & 3)) * 3 + 2] / st.l[g];
                bf16_t* dst = p.Ob + (size_t)TOKG(g) * DM + 512 + (grp * 4 + (fr & 3)) * 64 + 4 * fq;
#pragma unroll
                for (int n = 0; n < 4; ++n) { f32x4 o;
#pragma unroll
                    for (int r = 0; r < 4; ++r) o[r] = accl[((g * 4 + n) * 4 + r) * 64] + st.o[g][n][r] * sc;
                    u32x2 wv; wv.x = pk2(o[0], o[1]); wv.y = pk2(o[2], o[3]); *(u32x2*)(dst + n * 16) = wv; } }
        }
    }
#undef TQ
#undef TOKG
}

__device__ __forceinline__ unsigned pk_cnt_gt(unsigned acc, unsigned h, unsigned cm1, unsigned one2) {
    unsigned d;
    asm("v_pk_sub_u16 %0, %1, %2 clamp" : "=v"(d) : "v"(h), "v"(cm1));
    asm("v_pk_min_u16 %0, %1, %2" : "=v"(d) : "v"(d), "v"(one2));
    asm("v_pk_add_u16 %0, %1, %2" : "=v"(acc) : "v"(acc), "v"(d));
    return acc;
}
__device__ __forceinline__ int wave_total(int c) {
    int tot = 0;
#pragma unroll
    for (int bb = 0; bb < 7; ++bb) tot += __popcll(__ballot((c >> bb) & 1)) << bb;
    return tot;
}
#define SEL_CHUNKS(BODY) do { \
    _Pragma("unroll") for (int i = 0; i < 16; ++i) BODY(i) \
    if (tl >= 16) { _Pragma("unroll") for (int i = 16; i < 32; ++i) BODY(i) \
        if (tl >= 32) { _Pragma("unroll") for (int i = 32; i < 48; ++i) BODY(i) \
            if (tl >= 48) { _Pragma("unroll") for (int i = 48; i < 64; ++i) BODY(i) } } } } while (0)
__device__ __forceinline__ void ph_dsa_select(const Params& p, LAS unsigned char* lds, unsigned long long* BM) {
    const int tid = tid_(), lane = tid & 63, w = tid >> 6, fr = lane & 15, fq = lane >> 4;
    const int G = gridDim.x, c = blockIdx.x;
    LAS unsigned* sc = (LAS unsigned*)lds;
#define SEL_UNIT(LL, B, T0) do { if (G == 256) { const int rnd_ = (LL) >> 8, x_ = c & 7, j_ = c >> 3, idx_ = (rnd_ >> 1) * 32 + j_; B = x_; T0 = ((rnd_ & 1) ? (511 - idx_) : idx_) * 8; } \
        else { B = (LL) >> 9; T0 = ((LL) & 511) * 8; } } while (0)
#define SEL_LOADQ(B, T0) do { _Pragma("unroll") for (int g = 0; g < 2; ++g) { const size_t tokq_ = (size_t)(B) * SEQ + (T0) + g * 4 + (fr >> 2); \
        _Pragma("unroll") for (int ks = 0; ks < 2; ++ks) iq[g][ks] = *(const bf16x8*)(p.Pb + tokq_ * LDPB + E_IQ + (fr & 3) * 64 + ks * 32 + fq * 8); \
        iwv[g] = *(const float4*)(p.IW + ((size_t)(B) * SEQ + (T0) + g * 4 + fq) * 4); } } while (0)
#define SEL_LOADK(B, NSUB, SUB0, J0, J1) do { _Pragma("unroll") for (int j = J0; j < J1; ++j) { const int sub_ = ((SUB0) + 8 * j < (NSUB)) ? (SUB0) + 8 * j : (SUB0); \
        const bf16_t* kr_ = p.Pb + (size_t)((B) * SEQ + sub_ * 16 + fr) * LDPB + E_IK + fq * 8; \
        kf[j][0] = *(const bf16x8*)kr_; kf[j][1] = *(const bf16x8*)(kr_ + 32); } } while (0)
    bf16x8 iq[2][2]; float4 iwv[2]; bf16x8 kf[8][2];
    bool have = false;
    for (int L = c; L < 4096; L += G) {
        int b, t0; SEL_UNIT(L, b, t0);
        const int t = t0 + w; const size_t tok = (size_t)b * SEQ + t; const int ntile = (t >> 6) + 1;
        if (t0 + 7 < 256) {
            const int rem = t - lane * 64;
            const unsigned long long wd = (rem >= 63) ? ~0ull : (rem >= 0 ? ((1ull << (rem + 1)) - 1ull) : 0ull);
            if (lane < ntile) BM[tok * 64 + lane] = wd;
            continue;
        }
        const int nsub = (t0 + 8 + 15) >> 4;
        if (!have) { SEL_LOADQ(b, t0); SEL_LOADK(b, nsub, w, 0, 2); }
        have = false;
        SEL_LOADK(b, nsub, w, 2, 8);
        __syncthreads();
        for (int sub0 = w; sub0 < nsub; sub0 += 64) {
#pragma unroll
            for (int j = 0; j < 8; ++j) {
                const int sub = sub0 + 8 * j;
                if (sub < nsub) {
#pragma unroll
                    for (int g = 0; g < 2; ++g) {
                        f32x4 s = Z4_;
                        s = __builtin_amdgcn_mfma_f32_16x16x32_bf16(iq[g][0], kf[j][0], s, 0, 0, 0);
                        s = __builtin_amdgcn_mfma_f32_16x16x32_bf16(iq[g][1], kf[j][1], s, 0, 0, 0);
                        const int q = g * 4 + fq, key = sub * 16 + fr;
                        const float v = (iwv[g].x * fmaxf(s[0], 0.f) + iwv[g].y * fmaxf(s[1], 0.f)) + (iwv[g].z * fmaxf(s[2], 0.f) + iwv[g].w * fmaxf(s[3], 0.f));
                        const unsigned u = __builtin_bit_cast(unsigned, v);
                        const unsigned ks2 = (u & 0x80000000u) ? ~u : (u | 0x80000000u);
                        sc[q * 4096 + key] = (key <= t0 + q) ? ks2 : 0u;
                    }
                }
            }
            if (sub0 + 64 < nsub) SEL_LOADK(b, nsub, sub0 + 64, 0, 8);
        }
        __syncthreads();
        unsigned long long myword = 0ull;
        {
            const int tl = __builtin_amdgcn_readfirstlane(t >> 6);
            unsigned kreg[64];
#pragma unroll
            for (int i = 0; i < 64; ++i) kreg[i] = sc[w * 4096 + i * 64 + lane];
            __builtin_amdgcn_sched_barrier(0);
#pragma unroll
            for (int i = 0; i < 64; ++i) kreg[i] = (i * 64 + lane <= t) ? kreg[i] : 0u;
            unsigned T = 0u; bool exact = false; int need = 0;
            {
                LAS unsigned* hist = (LAS unsigned*)(lds + 131072) + w * 256;
                unsigned prefix = 0u, pmask = 0u; int remaining = 256;
                {
                    unsigned T8 = 0u; int acc_tot = t + 1, above = 0;
#pragma nounroll
                    for (int bit = 7; bit >= 0; --bit) {
                        const unsigned cand = (T8 | (1u << bit)) << 24;
                        int cnt = 0;
#define SEL_CNT(i) { cnt += (kreg[i] >= cand) ? 1 : 0; }
                        SEL_CHUNKS(SEL_CNT);
#undef SEL_CNT
                        const int tot = wave_total(cnt);
                        if (tot >= 256) { T8 |= 1u << bit; acc_tot = tot; } else above = tot;
                    }
                    remaining = 256 - above; prefix = T8 << 24; pmask = 0xff000000u;
                    exact = (acc_tot - above == remaining);
                }
                if (!exact) for (int pass = 1; pass < 4; ++pass) {
                    const int shift = 24 - 8 * pass;
#pragma unroll
                    for (int j = 0; j < 4; ++j) hist[lane + 64 * j] = 0u;
#define SEL_HIST(i) { const unsigned k = kreg[i]; if ((k & pmask) == prefix && k != 0u) __hip_atomic_fetch_add(&hist[(k >> shift) & 255u], 1u, __ATOMIC_RELAXED, __HIP_MEMORY_SCOPE_WORKGROUP); }
                    SEL_CHUNKS(SEL_HIST);
#undef SEL_HIST
                    unsigned cj[4]; unsigned sl = 0u;
#pragma unroll
                    for (int j = 0; j < 4; ++j) { cj[j] = hist[255 - 4 * lane - j]; sl += cj[j]; }
                    unsigned incl = 0u;
#pragma unroll
                    for (int bb = 0; bb < 13; ++bb) { const unsigned long long mb = __ballot((sl >> bb) & 1u); incl += (unsigned)(lane_rank(mb) + ((sl >> bb) & 1u)) << bb; }
                    const unsigned excl = incl - sl;
                    const bool cross = (excl < (unsigned)remaining) && ((unsigned)remaining <= incl);
                    unsigned dig = 0u, above = excl, cbin = 0u;
                    { unsigned accv = excl; bool found = false;
#pragma unroll
                      for (int j = 0; j < 4; ++j) { if (!found && accv + cj[j] >= (unsigned)remaining) { dig = 255u - 4u * lane - j; above = accv; cbin = cj[j]; found = true; } accv += cj[j]; } }
                    const unsigned long long mc = __ballot(cross);
                    const int src = mc ? __builtin_ctzll(mc) : 0;
                    dig = (unsigned)__builtin_amdgcn_readlane((int)dig, src); above = (unsigned)__builtin_amdgcn_readlane((int)above, src); cbin = (unsigned)__builtin_amdgcn_readlane((int)cbin, src);
                    prefix |= dig << shift; pmask |= 0xffu << shift; remaining -= (int)above;
                    if ((int)cbin == remaining) { exact = true; break; }
                }
                T = prefix; need = remaining;
            }
            if (exact) {
#define SEL_EX(i) { const unsigned long long msel = __ballot(kreg[i] >= T); if (lane == i) myword = msel; }
                SEL_CHUNKS(SEL_EX);
#undef SEL_EX
            } else {
                int taken = 0;
#define SEL_TIE(i) { const bool gt = kreg[i] > T, eq = kreg[i] == T; const unsigned long long meq = __ballot(eq); const bool sel = gt || (eq && (taken + lane_rank(meq) < need)); \
                    const unsigned long long msel = __ballot(sel); if (lane == i) myword = msel; taken += __popcll(meq); }
                SEL_CHUNKS(SEL_TIE);
#undef SEL_TIE
            }
        }
        if (lane < ntile) BM[tok * 64 + lane] = myword;
    }
#undef SEL_UNIT
#undef SEL_LOADQ
#undef SEL_LOADK
}
__device__ __forceinline__ void ph_dsa_attn(const Params& p, LAS unsigned char* lds, const unsigned long long* BM) {
    const int tid = tid_(), lane = tid & 63, w = tid >> 6, fr = lane & 15, fq = lane >> 4;
    const int G = gridDim.x, c = blockIdx.x;
    for (int L = c; L < 1024; L += G) {
        int qb, stream;
        if (G == 256) { const int rnd = L >> 8, x = c & 7, j = c >> 3;
            stream = 2 * x + (rnd >> 1); qb = (rnd & 1) ? 63 - j : j; }
        else { const int rnd = L / G; const int u = ((rnd & 1) && (1024 % G == 0)) ? rnd * G + (G - 1 - (L - rnd * G)) : L; qb = u & 63; stream = u >> 6; }
        const int grp = stream & 1, b = stream >> 1;
        const int tw = qb * 64 + w * 8, head = grp * 4 + (fr & 3);
#define TOKD(g) ((size_t)b * SEQ + tw + (g) * 4 + (fr >> 2))
        bf16x8 q[2][2];
#pragma unroll
        for (int g = 0; g < 2; ++g)
#pragma unroll
            for (int ks = 0; ks < 2; ++ks) q[g][ks] = *(const bf16x8*)(p.Pb + TOKD(g) * LDPB + E_BQ + head * 64 + ks * 32 + fq * 8);
        const bf16_t* kb = p.Pb + (size_t)b * SEQ * LDPB + E_BK + grp * 64; const bf16_t* vb = p.Pb + (size_t)b * SEQ * LDPB + E_BV + grp * 64;
        AtState<64> st; st.init();
        unsigned long long wn0 = BM[TOKD(0) * 64], wn1 = BM[TOKD(1) * 64];
        at_run<64>(lds, kb, vb, LDPB, 0, qb + 1, tid, [&](int i, lds_cptr Kb, lds_cptr Vb) {
            const unsigned long long w0 = wn0, w1 = wn1;
            if (i < qb) { wn0 = BM[TOKD(0) * 64 + i + 1]; wn1 = BM[TOKD(1) * 64 + i + 1]; }
            { const unsigned long long x0 = w0 >> (4 * fq), x1 = w1 >> (4 * fq);
                const int l0 = (int)(unsigned)x0, h0 = (int)(unsigned)(x0 >> 32), l1 = (int)(unsigned)x1, h1 = (int)(unsigned)(x1 >> 32);
                at_tile<64, 4>(st, Kb, Vb, q, fr, fq, AtNoRow(), [=](int g, int kk, int r) { const int bit = 16 * kk + r;
                    int mres; const int wsel = (bit < 32) ? (g ? l1 : l0) : (g ? h1 : h0);
                    asm("v_bfe_i32 %0, %1, %2, 1" : "=v"(mres) : "v"(wsel), "n"(bit & 31)); return mres; }); }
        });
        at_finish(st);
#pragma unroll
        for (int g = 0; g < 2; ++g) { const float inv = 1.f / st.l[g]; bf16_t* dst = p.Ob + TOKD(g) * DM + 512 + head * 64 + 4 * fq;
#pragma unroll
            for (int n = 0; n < 4; ++n) { const f32x4 o = st.o[g][n] * inv; u32x2 wv; wv.x = pk2(o[0], o[1]); wv.y = pk2(o[2], o[3]); *(u32x2*)(dst + n * 16) = wv; } }
#undef TOKD
    }
}

#define XB_TMO      128
#define XB_XCNT(j)  (256  + 64 * (j))
#define XB_XSUB(j)  (1280 + 64 * (j))
#define XB_XGEN(j)  (2304 + 64 * (j))
#define XB_TOP      3328
#define XB_TOPGEN   3392
#define XCD_BAR_WORDS 3456
#define XB_SPIN_CAP (1u << 24)
__device__ __forceinline__ unsigned xb_ld(unsigned* p)              { return __hip_atomic_load(p, __ATOMIC_RELAXED, __HIP_MEMORY_SCOPE_AGENT); }
__device__ __forceinline__ unsigned xb_add(unsigned* p, unsigned v) { return __hip_atomic_fetch_add(p, v, __ATOMIC_RELAXED, __HIP_MEMORY_SCOPE_AGENT); }
__device__ __forceinline__ unsigned xb_xcc_id() { return (unsigned)__builtin_amdgcn_s_getreg((3 << 11) | 20) & 0xFu; }
#define XB_SPIN(cond, bar) do { unsigned _sp = 0; while (cond) { __builtin_amdgcn_s_sleep(1); \
    if ((++_sp & 255u) == 0u) { if (xb_ld(&(bar)[XB_TMO])) break; if (_sp > XB_SPIN_CAP) { atomicAdd(&(bar)[XB_TMO], 1u); break; } } } } while (0)
struct XcdBarrier { unsigned* bar; unsigned x; volatile LAS unsigned* st; };
__device__ __forceinline__ XcdBarrier xcd_barrier_post(unsigned* bar, volatile LAS unsigned* st) {
    XcdBarrier b; b.bar = bar; b.x = xb_xcc_id(); b.st = st;
    if (threadIdx.x == 0) (void)xb_add(&bar[XB_XCNT(b.x)], 1u);
    return b;
}
__device__ __forceinline__ void xcd_barrier_complete(unsigned* bar, unsigned x, unsigned& nloc, unsigned& nx) {
    const unsigned G = gridDim.x * gridDim.y * gridDim.z;
    unsigned sum, cnt, mine, sp = 0u;
    for (;;) {
        sum = 0u; cnt = 0u; mine = 0u;
#pragma unroll
        for (unsigned j = 0; j < 16; ++j) { const unsigned c = xb_ld(&bar[XB_XCNT(j)]); sum += c; cnt += (c > 0u) ? 1u : 0u; mine = (j == x) ? c : mine; }
        if (sum == G) break;
        __builtin_amdgcn_s_sleep(1);
        if ((++sp & 255u) == 0u) { if (xb_ld(&bar[XB_TMO])) break; if (sp > XB_SPIN_CAP) { atomicAdd(&bar[XB_TMO], 1u); break; } }
    }
    nloc = mine > 0u ? mine : 1u; nx = cnt > 0u ? cnt : 1u;
}
__device__ __forceinline__ void xcd_barrier(unsigned* bar_in, volatile LAS unsigned* st) {
    asm volatile("s_waitcnt vmcnt(0)" ::: "memory");
    __syncthreads();
    if (threadIdx.x == 0) {
        unsigned* bar = bar_in; asm volatile("" : "+s"(bar));
        const unsigned x = xb_xcc_id();
        __builtin_amdgcn_s_waitcnt(0);
        unsigned nloc = st[0], nx = st[1];
        if (nloc == 0u) { xcd_barrier_complete(bar, x, nloc, nx); st[0] = nloc; st[1] = nx; }
        const unsigned old = xb_add(&bar[XB_XSUB(x)], 1u);
        const unsigned gen = old / nloc;
        if (old + 1u == (gen + 1u) * nloc) {
            __builtin_amdgcn_fence(__ATOMIC_RELEASE, "agent");
            asm volatile("s_waitcnt vmcnt(0)" ::: "memory");
            const unsigned og = xb_add(&bar[XB_TOP], 1u);
            const unsigned tg = og / nx;
            if (og + 1u == (tg + 1u) * nx) xb_add(&bar[XB_TOPGEN], 1u);
            else XB_SPIN(xb_ld(&bar[XB_TOPGEN]) == tg, bar);
            __builtin_amdgcn_fence(__ATOMIC_ACQUIRE, "agent");
            xb_add(&bar[XB_XGEN(x)], 1u);
            asm volatile("s_waitcnt vmcnt(0)" ::: "memory");
        } else {
            XB_SPIN(xb_ld(&bar[XB_XGEN(x)]) == gen, bar);
            __builtin_amdgcn_fence(__ATOMIC_ACQUIRE, "agent");
            asm volatile("s_waitcnt vmcnt(0)" ::: "memory");
        }
    }
    __syncthreads();
}

__global__ void __launch_bounds__(NT, 2) mega(Params p) {
    extern __shared__ __attribute__((aligned(16))) float lds[];
    PG8_LAS unsigned char* ldsL = (PG8_LAS unsigned char*)lds;
    volatile LAS unsigned* xst = (volatile LAS unsigned*)(lds + LDS_BYTES / 4);
    if (threadIdx.x == 0) { xst[0] = 0u; xst[1] = 0u; xst[2] = 0u; xst[3] = 0u; }
    __syncthreads();
    (void)xcd_barrier_post(p.bar, xst);
#define GRID_BAR() xcd_barrier(p.bar, xst)
    const int G = gridDim.x, cB = blockIdx.x;
    const float* const xin0 = p.in[IN_X];
    ph_init(p, lds);
    GRID_BAR();
    for (int l = 0; l < 4; ++l) {
        const int li = l >> 1;
        if ((l & 1) == 0) {
            {
                pg8::Gemm g{p.Xb, p.WinE + (size_t)li * NP_EVEN * DM, NTOK, NP_EVEN, DM}; pg8::StaticOrder S; S.init(NTOK, NP_EVEN, G, cB);
                EpiInEven E{p.Pb, p.IW, p.ropecs};
                pg8::gemm_phase<EpiInEven, pg8::StaticOrder, true, true>(ldsL, g, S, E);
            }
            GRID_BAR();
            ph_diff_mfma(p, (LAS unsigned char*)lds, li);
            __syncthreads();
            ph_dsa_select(p, (LAS unsigned char*)lds, p.BM);
            GRID_BAR();
            ph_dsa_attn(p, (LAS unsigned char*)lds, p.BM);
            GRID_BAR();
            {
                pg8::Gemm g{p.Ob, p.WoutE + (size_t)li * DM * DM, NTOK, DM, DM}; pg8::StaticOrder S; S.init(NTOK, DM, G, cB);
                EpiY E{(bf16_t*)p.Y};
                pg8::gemm_phase<EpiY, pg8::StaticOrder, true, true>(ldsL, g, S, E);
            }
            GRID_BAR();
        } else {
            {
                pg8::Gemm g{p.Xb, p.WinO + (size_t)li * NP_ODD * DM, NTOK, NP_ODD, DM}; pg8::StaticOrder S; S.init(NTOK, NP_ODD, G, cB);
                EpiInOdd E{p.Pb, p.QRb, p.GATES, p.ropecs, p.in[IN_NSA_GATE_B] + li * 24};
                pg8::gemm_phase<EpiInOdd, pg8::StaticOrder, true, true>(ldsL, g, S, E);
            }
            GRID_BAR();
            ph_kmean(p, lds);
            ph_cmp_build(p, li);
            GRID_BAR();
            {
                pg8::Gemm g{p.Ac, p.W1T + (size_t)li * 2 * 256 * 2048, 8192, 256, 2048}; ListOrder S{32, G, cB};
                EpiGeluH E{p.Hc};
                pg8::gemm_phase<EpiGeluH, ListOrder, true, true>(ldsL, g, S, E);
            }
            __syncthreads();
            ph_moba_mfma(p, (LAS unsigned char*)lds, li);
            GRID_BAR();
            {
                pg8::Gemm g{p.Hc, p.W2T + (size_t)li * 2 * 256 * 256, 8192, 256, 256}; ListOrder S{32, G, cB};
                EpiCmp E{p.CMP};
                pg8::gemm_phase<EpiCmp, ListOrder, true, true>(ldsL, g, S, E);
            }
            GRID_BAR();
            ph_nsa_mfma(p, (LAS unsigned char*)lds, p.CMP, p.CMP + (size_t)4096 * 64);
            GRID_BAR();
            {
                pg8::Gemm g{p.Ob, p.WoutO + (size_t)li * DM * DM, NTOK, DM, DM}; pg8::StaticOrder S; S.init(NTOK, DM, G, cB);
                EpiY E{(bf16_t*)p.Y};
                pg8::gemm_phase<EpiY, pg8::StaticOrder, true, true>(ldsL, g, S, E);
            }
            GRID_BAR();
        }
        if (l & 1) ph_ln_router(p, p.in[IN_LN_MIX_G] + l * DM, p.in[IN_LN_MIX_B] + l * DM, li, lds);
        else if (l == 0) ph_ln<0, 0>(p, p.in[IN_LN_MIX_G] + l * DM, p.in[IN_LN_MIX_B] + l * DM, xin0, p.X, p.Xb, false);
        else ph_ln<0, 1>(p, p.in[IN_LN_MIX_G] + l * DM, p.in[IN_LN_MIX_B] + l * DM, xin0, p.X, p.Xb, false);
        GRID_BAR();
        if ((l & 1) == 0) {
            {
                pg8::Gemm g{p.Xb, p.WguD + (size_t)li * 2 * F_DENSE * DM, NTOK, 2 * F_DENSE, DM}; pg8::StaticOrder S; S.init(NTOK, 2 * F_DENSE, G, cB);
                EpiGU E{p.H, F_DENSE, 2 * F_DENSE / 256, 0};
                pg8::gemm_phase<EpiGU, pg8::StaticOrder, true, true>(ldsL, g, S, E);
            }
            GRID_BAR();
            {
                pg8::Gemm g{p.H, p.WdD + (size_t)li * DM * F_DENSE, NTOK, DM, F_DENSE}; pg8::StaticOrder S; S.init(NTOK, DM, G, cB);
                EpiY E{(bf16_t*)p.Y};
                pg8::gemm_phase<EpiY, pg8::StaticOrder, true, true>(ldsL, g, S, E);
            }
            GRID_BAR();
            ph_ln<0, 1>(p, p.in[IN_LN_FFN_G] + l * DM, p.in[IN_LN_FFN_B] + l * DM, xin0, p.X, p.Xb, false);
            GRID_BAR();
        } else {
            ph_slots(p, lds);
            GRID_BAR();
            __syncthreads();
            for (int i = tid_(); i < NTILE256; i += NT) ((LAS int*)((LAS unsigned char*)lds + MOE_TE_LDS))[i] = p.tile_e[i];
            __syncthreads();
#pragma unroll 1
            for (int hf = 0; hf < 3; ++hf) {
                const int t0 = hf * 128, ntr = (hf < 2) ? 128 : NTILE256 - 256;
                if (G == 256) {
                    EpiGU E{p.Hm, F_EXPERT, 2 * F_EXPERT / 256, t0};
#pragma unroll 1
                    for (int rb = 0; rb < (hf < 2 ? 2 : 1); ++rb) {
                        pg8::Gemm g{p.Xb, p.WguM, NSLOT, 2 * F_EXPERT, DM}; MoeOrderG S{t0, ntr, 2 * F_EXPERT / 256, G, cB, rb, p.slot_tok};
                        pg8::gemm_phase<EpiGU, MoeOrderG, true, true>(ldsL, g, S, E);
                        __syncthreads();
                    }
                } else {
                    pg8::Gemm g{p.Xs, p.WguM, NSLOT, 2 * F_EXPERT, DM}; MoeOrder S{t0, ntr, 2 * F_EXPERT / 256, G, cB};
                    EpiGU E{p.Hm, F_EXPERT, 2 * F_EXPERT / 256, t0};
                    pg8::gemm_phase<EpiGU, MoeOrder, true, true>(ldsL, g, S, E);
                }
                GRID_BAR();
                if (hf < 2) {
                    pg8::Gemm g{p.Hm - (size_t)t0 * 256 * F_EXPERT, p.WdM, NSLOT, DM, F_EXPERT}; MoeOrder S{t0, ntr, DM / 256, G, cB};
                    EpiDownMoe E{p.Ys, p.slot_gate};
                    pg8::gemm_phase<EpiDownMoe, MoeOrder, true, true>(ldsL, g, S, E);
                } else {
                    pg8::Gemm g{p.Hm - (size_t)t0 * 256 * F_EXPERT, p.WdM, NSLOT, DM, MOE_KSL_K, F_EXPERT}; TailOrder S{G, cB};
                    EpiDownTail E{p.Yp, p.slot_gate};
                    pg8::gemm_phase<EpiDownTail, TailOrder, true, true>(ldsL, g, S, E);
                }
                GRID_BAR();
            }
            ph_ln<1, 1>(p, p.in[IN_LN_FFN_G] + l * DM, p.in[IN_LN_FFN_B] + l * DM, xin0, p.X, p.Xb, l == 3);
            GRID_BAR();
        }
    }
    if (xb_ld(&p.bar[XB_TMO])) { for (int i = blockIdx.x * NT + threadIdx.x; i < NTOK * DM; i += gridDim.x * NT) p.X[i] = __builtin_nanf(""); }
}

extern "C" void kernel_launch(void* const* d_in, const int* in_sizes, int n_in, void* d_out, int out_size, void* d_ws, size_t ws_size, hipStream_t stream) {
    Params p; memset(&p, 0, sizeof(p));
    for (int i = 0; i < 23; ++i) p.in[i] = (const float*)d_in[i];
    p.X = (float*)d_out;
    unsigned char* w = (unsigned char*)d_ws; size_t off = 0;
    auto take = [&](size_t bytes) { unsigned char* r = w + off; off += (bytes + 255) / 256 * 256; return r; };
    p.bar = (unsigned*)take(16384);
    p.ropecs = (float*)take(4096 * 32 * 2 * 4);
    p.IW = (float*)take((size_t)NTOK * 4 * 4);
    p.BM = (unsigned long long*)take((size_t)NTOK * 64 * 8);
    p.GATES = (float*)take((size_t)NTOK * 24 * 4);
    p.kmean = (float*)take(8 * 16 * 8 * 64 * 4);
    p.cmpk = (float*)take(8 * 256 * 2 * 64 * 4);
    p.cmpv = (float*)take(8 * 256 * 2 * 64 * 4);
    p.tok_e = (int*)take(NTOK * 2 * 4);
    p.tok_g = (float*)take(NTOK * 2 * 4);
    p.tok_slot = (int*)take(NTOK * 2 * 4);
    p.slot_tok = (int*)take(NSLOT * 4);
    p.slot_gate = (float*)take(NSLOT * 4);
    p.chunk_cnt = (int*)take(256 * 8 * 4);
    p.tile_e = (int*)take(NTILE256 * 4);
    p.W1T = (bf16_t*)take((size_t)2 * 2 * 256 * 2048 * 2);
    p.W2T = (bf16_t*)take((size_t)2 * 2 * 256 * 256 * 2);
    p.CMP = (bf16_t*)take((size_t)8192 * 64 * 2);
    p.WinE = (bf16_t*)take((size_t)2 * NP_EVEN * DM * 2);
    p.WoutE = (bf16_t*)take((size_t)2 * DM * DM * 2);
    p.WguD = (bf16_t*)take((size_t)2 * 2 * F_DENSE * DM * 2);
    p.WdD = (bf16_t*)take((size_t)2 * DM * F_DENSE * 2);
    p.WinO = (bf16_t*)take((size_t)2 * NP_ODD * DM * 2);
    p.WoutO = (bf16_t*)take((size_t)2 * DM * DM * 2);
    p.WguM = (bf16_t*)take((size_t)N_EXP * 2 * F_EXPERT * DM * 2);
    p.WdM = (bf16_t*)take((size_t)N_EXP * DM * F_EXPERT * 2);
    p.Xb = (bf16_t*)take((size_t)(NTOK + 1) * DM * 2);
    unsigned char* R = w + off;
    {   size_t o = 0; auto tk = [&](size_t bytes) { unsigned char* r = R + o; o += (bytes + 255) / 256 * 256; return r; };
        p.Pb = (bf16_t*)tk((size_t)NTOK * LDPB * 2); p.H = p.Pb;
        p.Ob = (bf16_t*)tk((size_t)NTOK * DM * 2);
        p.QRb = (bf16_t*)tk((size_t)NTOK * 512 * 2);
        p.Y = (float*)tk((size_t)NTOK * DM * 4);
        p.Ac = (bf16_t*)p.Y; p.Hc = p.Ac + (size_t)2 * 4096 * 2048; }
    {   size_t o = 0; auto tk = [&](size_t bytes) { unsigned char* r = R + o; o += (bytes + 255) / 256 * 256; return r; };
        p.Xs = (bf16_t*)tk((size_t)NSLOT * DM * 2);
        p.Hm = (bf16_t*)tk((size_t)MOE_HALF_TILES * 256 * F_EXPERT * 2);
        p.Ys = (bf16_t*)tk((size_t)NSLOT * DM * 2);
        p.Yp = p.Hm + (size_t)16 * 256 * F_EXPERT; }
    p.lam_init[0] = (float)(0.8 - 0.6 * exp(-0.3 * 0.0));
    p.lam_init[1] = (float)(0.8 - 0.6 * exp(-0.3 * 2.0));
    constexpr int kDynLds = LDS_BYTES + 16;
    static int grid = 0;
    if (!grid) {
        int dev = 0, cus = 0, per_cu = 0;
        (void)hipGetDevice(&dev);
        (void)hipDeviceGetAttribute(&cus, hipDeviceAttributeMultiprocessorCount, dev);
        (void)hipFuncSetAttribute((const void*)mega, hipFuncAttributeMaxDynamicSharedMemorySize, kDynLds);
        (void)hipOccupancyMaxActiveBlocksPerMultiprocessor(&per_cu, (const void*)mega, NT, kDynLds);
        if (cus <= 0) cus = 256;
        grid = cus;
    }
    (void)hipMemsetAsync(p.bar, 0, XCD_BAR_WORDS * sizeof(unsigned), stream);
    mega<<<grid, NT, kDynLds, stream>>>(p);
}
```

```cpp
#include <hip/hip_runtime.h>
#include <stdint.h>
#include <string.h>
#include <math.h>

__device__ __forceinline__ int tid_() { int t = threadIdx.x; asm volatile("" : "+v"(t)); return t; }
__device__ __forceinline__ float zero1_() { float z = 0.f; asm volatile("" : "+v"(z)); return z; }
namespace pg8 {
#define PG8_LAS __attribute__((address_space(3)))
typedef unsigned short bf16_t;
typedef short bf16x8 __attribute__((ext_vector_type(8)));
typedef float f32x4 __attribute__((ext_vector_type(4)));
typedef unsigned u32x4 __attribute__((ext_vector_type(4)));
constexpr int BM = 256, BK = 64, HALF = 128, HTB = HALF * BK * 2  , STAGE_BYTES = 8 * HTB, NXCD = 8, WGM = 8;

__host__ __device__ __forceinline__ int lds_byte(int r, int c) { const int st = (r >> 4) * 2 + (c >> 5), rr = r & 15, cc = c & 31, ob = rr * 64 + cc * 2; return st * 1024 + (ob ^ (((ob >> 9) & 1) << 5)); }
__host__ __device__ __forceinline__ void stage_rc(int b, int& R, int& C) { const int st = b / 1024, sb = b % 1024, swz = sb ^ (((sb >> 9) & 1) << 5); R = (st >> 1) * 16 + swz / 64; C = (st & 1) * 32 + (swz % 64) / 2; }
__host__ __device__ __forceinline__ int perm32(int rho) { const int n = rho >> 4, i = rho & 15; return 8 * (i >> 2) + 4 * n + (i & 3); }

struct Unit { int pm, pn, ko; };
struct Gemm { const bf16_t* A; const bf16_t* Bt; int M, N, K, ld; };

struct StaticOrder {
    static constexpr bool KSPLIT = false, GATHER_A = false;
    int nM, nN, nwg, G, c;
    __host__ __device__ void init(int M, int N, int G_, int c_) { nM = M / BM; nN = N / BM; nwg = nM * nN; G = G_; c = c_; }
    __host__ __device__ bool next(int i, Unit& u) const {
        const long L = (long)i * G + c; if (L >= nwg) return false;
        int wgid = (int)L; { const int q = nwg / NXCD, r = nwg % NXCD, xcd = wgid % NXCD, off = wgid / NXCD; wgid = (xcd < r ? xcd * (q + 1) : r * (q + 1) + (xcd - r) * q) + off; }
        const int nig = WGM * nN, gid = wgid / nig, fm = gid * WGM, gsz = (nM - fm) < WGM ? (nM - fm) : WGM;
        u.pm = fm + ((wgid % nig) % gsz); u.pn = (wgid % nig) / gsz; return true;
    }
    __device__ __forceinline__ void a_ready(const Unit&) const {}
    __device__ __forceinline__ void done(const Unit&) const {}
};

__device__ __forceinline__ unsigned cvt_pk_bf16(float lo, float hi) { unsigned r; asm volatile("v_cvt_pk_bf16_f32 %0, %1, %2" : "=v"(r) : "v"(lo), "v"(hi)); return r; }
typedef float f32x2 __attribute__((ext_vector_type(2)));
template <class Epi, class Sched, bool ALIGN_EPI = false, bool SP2 = false>
__device__ __forceinline__ void gemm_phase(PG8_LAS unsigned char* lds, const Gemm g, const Sched& S, const Epi& E) {
    const int tid = tid_(), wid = __builtin_amdgcn_readfirstlane(tid >> 6), lane = tid & 63, wr = wid >> 2, wc = wid & 3, fr = lane & 15, fq = lane >> 4;
    const int K = g.K, nt = K / BK, LD = g.ld ? g.ld : K;
    unsigned voffA[2], voffB[2];
#pragma unroll
    for (int i = 0; i < 2; ++i) { int R, C; stage_rc(tid * 16 + i * 8192, R, C); const int Rb = Epi::PERM ? ((R & ~31) + perm32(R & 31)) : R;
        voffA[i] = (unsigned)(R * LD + C) * 2u; voffB[i] = (unsigned)(Rb * LD + C) * 2u; }
    const size_t kstep = (size_t)(BK * 2);
    const size_t hstep = (size_t)HALF * LD * 2;
    const size_t tstep = 2 * hstep;
    const unsigned ldsw = (unsigned)wid * 1024u;
    const int aoff = lds_byte(wr * 64 + fr, fq * 8), boff = lds_byte(wc * 32 + fr, fq * 8);
#define PG8_SA(b, h) (((b) * 2 + (h)) * HTB)
#define PG8_SB(b, h) ((4 + (b) * 2 + (h)) * HTB)
#define PG8_STAGE(bufoff, gbase, voff) do { _Pragma("unroll") for (int _i = 0; _i < 2; ++_i) \
        __builtin_amdgcn_global_load_lds((const unsigned*)((const char*)(gbase) + (voff)[_i]), (PG8_LAS unsigned*)(lds + (bufoff) + ldsw + _i * 8192), 16, 0, 0); } while (0)
#define PG8_LDA(dst, b, h) do { _Pragma("unroll") for (int m = 0; m < 4; ++m) _Pragma("unroll") for (int k = 0; k < 2; ++k) dst[m][k] = *(const PG8_LAS bf16x8*)(lds + PG8_SA(b, h) + aoff + m * 2048 + k * 1024); } while (0)
#define PG8_LDB(dst, b, h) do { _Pragma("unroll") for (int n = 0; n < 2; ++n) _Pragma("unroll") for (int k = 0; k < 2; ++k) dst[n][k] = *(const PG8_LAS bf16x8*)(lds + PG8_SB(b, h) + boff + n * 2048 + k * 1024); } while (0)
#define PG8_MMA(ai, bj, At, Bt) do { __builtin_amdgcn_s_setprio(1); _Pragma("unroll") for (int m = 0; m < 4; ++m) _Pragma("unroll") for (int n = 0; n < 2; ++n) _Pragma("unroll") for (int k = 0; k < 2; ++k) \
        acc[ai][bj][m][n] = __builtin_amdgcn_mfma_f32_16x16x32_bf16(Bt[n][k], At[m][k], acc[ai][bj][m][n], 0, 0, 0); __builtin_amdgcn_s_setprio(0); } while (0)
#define PG8_WAIT_V(n) asm volatile("s_waitcnt vmcnt(" #n ")" ::: "memory")
#define PG8_WAIT_L(n) asm volatile("s_waitcnt lgkmcnt(" #n ")" ::: "memory")
#define PG8_BAR __builtin_amdgcn_s_barrier()
#define PG8_SCHED __builtin_amdgcn_sched_barrier(0)
    Unit cur, nxt; int ui = 0;
    if (!S.next(0, cur)) return;
    unsigned voffA1[2]; size_t hstepA = hstep;
#pragma unroll
    for (int i = 0; i < 2; ++i) voffA1[i] = voffA[i];
    if constexpr (Sched::GATHER_A) {
        hstepA = 0;
#pragma unroll
        for (int i = 0; i < 2; ++i) { int R, C; stage_rc(tid * 16 + i * 8192, R, C);
            voffA[i] = (unsigned)(S.arow(cur.pm * 256 + R) * LD + C) * 2u; voffA1[i] = (unsigned)(S.arow(cur.pm * 256 + 128 + R) * LD + C) * 2u; }
    }
    f32x4 acc[2][2][4][2];
#pragma unroll
    for (int a = 0; a < 2; ++a)
#pragma unroll
        for (int b = 0; b < 2; ++b)
#pragma unroll
            for (int m = 0; m < 4; ++m)
#pragma unroll
                for (int n = 0; n < 2; ++n) acc[a][b][m][n] = ([]() { const float z = zero1_(); return (f32x4){z, z, z, z}; }());
    bf16x8 At[4][2], B0[2][2], B1[2][2];
    const char* cA = (const char*)g.A + (Sched::GATHER_A ? (size_t)0 : (size_t)cur.pm * tstep); const char* cB = (const char*)g.Bt + (size_t)cur.pn * tstep;
    if constexpr (Sched::KSPLIT) { cA += (size_t)cur.ko * 2; cB += (size_t)cur.ko * 2; }
    S.a_ready(cur);
    if constexpr (SP2) {
        PG8_STAGE(PG8_SB(0, 0), cB, voffB); PG8_STAGE(PG8_SB(0, 1), cB + hstep, voffB); PG8_STAGE(PG8_SA(0, 0), cA, voffA); PG8_STAGE(PG8_SA(0, 1), cA + hstepA, voffA1);
        if (wr == 1) PG8_BAR;
        PG8_WAIT_V(2); PG8_BAR;
        PG8_STAGE(PG8_SB(1, 0), cB + kstep, voffB); PG8_STAGE(PG8_SA(1, 0), cA + kstep, voffA); PG8_STAGE(PG8_SB(1, 1), cB + hstep + kstep, voffB);
        PG8_WAIT_V(6); PG8_BAR;
    } else {
        PG8_STAGE(PG8_SB(0, 0), cB, voffB); PG8_STAGE(PG8_SA(0, 0), cA, voffA); PG8_STAGE(PG8_SB(0, 1), cB + hstep, voffB); PG8_STAGE(PG8_SA(0, 1), cA + hstepA, voffA1);
        if (wr == 1) PG8_BAR;
        PG8_WAIT_V(4); PG8_BAR;
        PG8_STAGE(PG8_SB(1, 0), cB + kstep, voffB); PG8_STAGE(PG8_SA(1, 0), cA + kstep, voffA); PG8_STAGE(PG8_SB(1, 1), cB + hstep + kstep, voffB);
        PG8_WAIT_V(6); PG8_BAR;
    }
    for (;;) {
        const bool has_next = S.next(ui + 1, nxt);
        const char* nA = has_next ? (const char*)g.A + (Sched::GATHER_A ? (size_t)0 : (size_t)nxt.pm * tstep) : cA; const char* nB = has_next ? (const char*)g.Bt + (size_t)nxt.pn * tstep : cB;
        if constexpr (Sched::KSPLIT) { if (has_next) { nA += (size_t)nxt.ko * 2; nB += (size_t)nxt.ko * 2; } }
        for (int t = 0; t < nt; t += 2) {
            const bool last = (t == nt - 2);
            const char* a1 = cA + (size_t)(t + 1) * kstep;
            const char* a2 = last ? nA : cA + (size_t)(t + 2) * kstep; const char* b2 = last ? nB : cB + (size_t)(t + 2) * kstep;
            const char* a3 = a2 + kstep; const char* b3 = b2 + kstep;
            if (last && has_next) S.a_ready(nxt);
            if constexpr (SP2) {
            PG8_LDB(B0, 0, 0); PG8_LDB(B1, 0, 1); PG8_SCHED; PG8_LDA(At, 0, 0); PG8_STAGE(PG8_SA(1, 1), a1 + hstepA, voffA1);
            PG8_WAIT_V(8); PG8_WAIT_L(0); PG8_BAR; PG8_MMA(0, 0, At, B0); PG8_MMA(0, 1, At, B1); PG8_BAR; PG8_SCHED;
            PG8_LDA(At, 0, 1); PG8_STAGE(PG8_SB(0, 0), b2, voffB); PG8_STAGE(PG8_SB(0, 1), b2 + hstep, voffB); PG8_STAGE(PG8_SA(0, 0), a2, voffA);
            PG8_WAIT_V(8); PG8_WAIT_L(0); PG8_BAR; PG8_MMA(1, 0, At, B0); PG8_MMA(1, 1, At, B1); PG8_BAR; PG8_SCHED;
            PG8_LDB(B0, 1, 0); PG8_LDB(B1, 1, 1); PG8_SCHED; PG8_LDA(At, 1, 0); PG8_STAGE(PG8_SA(0, 1), a2 + hstepA, voffA1);
            PG8_WAIT_V(8); PG8_WAIT_L(0); PG8_BAR; PG8_MMA(0, 0, At, B0); PG8_MMA(0, 1, At, B1); PG8_BAR; PG8_SCHED;
            PG8_LDA(At, 1, 1); PG8_STAGE(PG8_SB(1, 0), b3, voffB); PG8_STAGE(PG8_SB(1, 1), b3 + hstep, voffB); PG8_STAGE(PG8_SA(1, 0), a3, voffA);
            PG8_WAIT_V(8); PG8_WAIT_L(0); PG8_BAR; PG8_MMA(1, 0, At, B0); PG8_MMA(1, 1, At, B1); PG8_BAR; PG8_SCHED;
            } else {
            PG8_LDB(B0, 0, 0); PG8_SCHED; PG8_LDA(At, 0, 0); PG8_STAGE(PG8_SA(1, 1), a1 + hstepA, voffA1);
            PG8_WAIT_L(8); PG8_BAR; PG8_WAIT_L(0); PG8_MMA(0, 0, At, B0); PG8_BAR; PG8_SCHED;
            PG8_LDB(B1, 0, 1); PG8_STAGE(PG8_SB(0, 0), b2, voffB);
            PG8_BAR; PG8_WAIT_L(0); PG8_MMA(0, 1, At, B1); PG8_BAR;
            PG8_LDA(At, 0, 1); PG8_STAGE(PG8_SA(0, 0), a2, voffA);
            PG8_BAR; PG8_WAIT_L(0); PG8_MMA(1, 0, At, B0); PG8_BAR; PG8_SCHED;
            PG8_STAGE(PG8_SB(0, 1), b2 + hstep, voffB);
            PG8_WAIT_V(6); PG8_BAR; PG8_MMA(1, 1, At, B1); PG8_BAR;
            PG8_LDB(B0, 1, 0); PG8_SCHED; PG8_LDA(At, 1, 0); PG8_STAGE(PG8_SA(0, 1), a2 + hstepA, voffA1);
            PG8_WAIT_L(8); PG8_BAR; PG8_WAIT_L(0); PG8_MMA(0, 0, At, B0); PG8_BAR; PG8_SCHED;
            PG8_LDB(B1, 1, 1); PG8_STAGE(PG8_SB(1, 0), b3, voffB);
            PG8_BAR; PG8_WAIT_L(0); PG8_MMA(0, 1, At, B1); PG8_BAR;
            PG8_LDA(At, 1, 1); PG8_STAGE(PG8_SA(1, 0), a3, voffA);
            PG8_BAR; PG8_WAIT_L(0); PG8_MMA(1, 0, At, B0); PG8_BAR; PG8_SCHED;
            PG8_STAGE(PG8_SB(1, 1), b3 + hstep, voffB);
            PG8_WAIT_V(6); PG8_BAR; PG8_MMA(1, 1, At, B1); PG8_BAR;
            }
        }
        if constexpr (ALIGN_EPI) { if (wr == 0) PG8_BAR; }
        if constexpr (!Epi::AFTER_DRAIN) { E(acc, cur, wr, wc, fr, fq); S.done(cur); }
        if (!has_next) break;
#pragma unroll
        for (int a = 0; a < 2; ++a)
#pragma unroll
            for (int b = 0; b < 2; ++b)
#pragma unroll
                for (int m = 0; m < 4; ++m)
#pragma unroll
                    for (int n = 0; n < 2; ++n) acc[a][b][m][n] = ([]() { const float z = zero1_(); return (f32x4){z, z, z, z}; }());
        cur = nxt; cA = nA; cB = nB; ++ui;
        if constexpr (ALIGN_EPI) { if (wr == 1) PG8_BAR; }
    }
    PG8_WAIT_V(0);
    if constexpr (!ALIGN_EPI) { if (wr == 0) PG8_BAR; }
    PG8_BAR;
    if constexpr (Epi::AFTER_DRAIN) { E.fused(acc, cur, wr, wc, fr, fq, lds, wid, lane); S.done(cur); }
#undef PG8_SA
#undef PG8_SB
#undef PG8_STAGE
#undef PG8_LDA
#undef PG8_LDB
#undef PG8_MMA
#undef PG8_WAIT_V
#undef PG8_WAIT_L
#undef PG8_BAR
#undef PG8_SCHED
}
}
using pg8::bf16_t; using pg8::f32x4; using pg8::Unit;
typedef unsigned u32x2 __attribute__((ext_vector_type(2)));

#define NT 512
#define Z4_ ([]() { const float z = zero1_(); return (f32x4){z, z, z, z}; }())
#define LAS __attribute__((address_space(3)))
constexpr int NTOK = 32768, DM = 1024, SEQ = 4096;
constexpr int LDPB = 3072;
constexpr float ALPHA = 1.681792830507429f;
constexpr float LN_EPS = 1e-5f;
constexpr int E_AQ = 0, E_AK = 512, E_AV = 1024, E_BQ = 1536, E_BK = 2048, E_BV = 2176, E_IQ = 2304, E_IK = 2560, E_IW = 2624, P_EVEN = 2628, NP_EVEN = 2816;
constexpr int O_CQ = 0, O_CK = 512, O_CV = 1024, O_DQ = 1536, O_KC = 2048, O_VC = 2176, O_KS = 2304, O_VS = 2432, O_KW = 2560, O_VW = 2688, O_DG = 2816, P_ODD = 2840, NP_ODD = 3072;
constexpr int F_DENSE = 2816, F_EXPERT = 3584, N_EXP = 8;
constexpr int NSLOT = 65536 + 8 * 256;
constexpr int NTILE256 = NSLOT / 256;
constexpr int MOE_HALF_TILES = NTILE256 / 2;
constexpr int LDS_BYTES = 147456;

__constant__ float c_inv[32] = {1.0f, 0.7498942613601685f, 0.5623413324356079f, 0.4216965138912201f, 0.3162277638912201f, 0.23713737726211548f, 0.17782793939113617f, 0.133352130651474f,
    0.10000000149011612f, 0.07498941570520401f, 0.05623413249850273f, 0.04216965287923813f, 0.03162277489900589f, 0.023713737726211548f, 0.017782794311642647f, 0.01333521492779255f,
    0.009999999776482582f, 0.007498941849917173f, 0.005623413249850273f, 0.0042169648222625256f, 0.003162277629598975f, 0.00237137358635664f, 0.0017782794311642647f, 0.0013335214462131262f,
    0.0010000000474974513f, 0.0007498942431993783f, 0.000562341301701963f, 0.0004216965171508491f, 0.0003162277571391314f, 0.00023713737027719617f, 0.00017782794020604342f, 0.0001333521504420787f};

struct Params {
    const float* in[23];
    float* X;
    bf16_t* Xb;
    bf16_t* Pb;
    bf16_t* Ob;
    bf16_t* QRb;
    float* Y;
    bf16_t* H;
    bf16_t* Xs;
    bf16_t* Hm;
    bf16_t* Ys;
    bf16_t* Yp;
    bf16_t* W1T; bf16_t* W2T;
    bf16_t* Ac; bf16_t* Hc; bf16_t* CMP;
    bf16_t* WinE; bf16_t* WoutE; bf16_t* WguD; bf16_t* WdD; bf16_t* WinO; bf16_t* WoutO; bf16_t* WguM; bf16_t* WdM;
    float* ropecs;
    float* IW;
    unsigned long long* BM;
    float* GATES;
    float* kmean;
    float* cmpk;
    float* cmpv;
    int* tok_e; float* tok_g; int* tok_slot; int* slot_tok; float* slot_gate; int* chunk_cnt; int* tile_e;
    unsigned* bar;
    float lam_init[2];
};

enum { IN_X = 0, IN_EV_WIN, IN_EV_WOUT, IN_DIF_LAMBDA, IN_DIF_SUBLN, IN_FFD_WG, IN_FFD_WU, IN_FFD_WD, IN_OD_WIN, IN_OD_WOUT, IN_NSA_GATE_B, IN_NSA_PE, IN_NSA_W1, IN_NSA_W2,
       IN_MOE_WR, IN_MOE_BR, IN_MOE_WG, IN_MOE_WU, IN_MOE_WD, IN_LN_MIX_G, IN_LN_MIX_B, IN_LN_FFN_G, IN_LN_FFN_B };

__device__ __forceinline__ float bf2f(bf16_t u) { return __builtin_bit_cast(float, (unsigned)u << 16); }
__device__ __forceinline__ unsigned pk2(float lo, float hi) { return pg8::cvt_pk_bf16(lo, hi); }
__device__ __forceinline__ bf16_t f2bf(float f) { return (bf16_t)(pg8::cvt_pk_bf16(f, 0.f) & 0xffffu); }
__device__ __forceinline__ float wave_max(float v) {
#pragma unroll
    for (int o = 32; o >= 1; o >>= 1) v = fmaxf(v, __shfl_xor(v, o));
    return v;
}
__device__ __forceinline__ float wave_sum(float v) {
#pragma unroll
    for (int o = 32; o >= 1; o >>= 1) v += __shfl_xor(v, o);
    return v;
}
__device__ __forceinline__ int wave_sumi(int v) {
#pragma unroll
    for (int o = 32; o >= 1; o >>= 1) v += __shfl_xor(v, o);
    return v;
}
__device__ __forceinline__ float rl_f(float v, int l) { return __builtin_bit_cast(float, __builtin_amdgcn_readlane(__builtin_bit_cast(int, v), l)); }
__device__ __forceinline__ int lane_rank(unsigned long long m) { return __builtin_amdgcn_mbcnt_hi((unsigned)(m >> 32), __builtin_amdgcn_mbcnt_lo((unsigned)m, 0)); }

constexpr float QK_PRESCALE = 0.125f * 1.4426950408889634f;
#define EPI_LOOP_BEGIN \
    _Pragma("unroll") for (int ai = 0; ai < 2; ++ai) _Pragma("unroll") for (int m = 0; m < 4; ++m) { const int rloc = ai * 128 + wr * 64 + m * 16 + fr; \
    _Pragma("unroll") for (int bj = 0; bj < 2; ++bj) _Pragma("unroll") for (int n = 0; n < 2; ++n) { const int cloc = bj * 128 + wc * 32 + n * 16 + fq * 4; f32x4 v = acc[ai][bj][m][n];
#define EPI_LOOP_END } }

struct EpiInEven {
    static constexpr bool PERM = true, AFTER_DRAIN = false;
    bf16_t* Pb; float* IW; const float* cs;
    __device__ __forceinline__ void operator()(const f32x4 (&acc)[2][2][4][2], const Unit& u, int wr, int wc, int fr, int fq) const {
#pragma unroll
        for (int ai = 0; ai < 2; ++ai)
#pragma unroll
            for (int m = 0; m < 4; ++m) { const int row = u.pm * 256 + ai * 128 + wr * 64 + m * 16 + fr, pos = row & (SEQ - 1);
#pragma unroll
                for (int bj = 0; bj < 2; ++bj) { const int c8 = u.pn * 256 + bj * 128 + wc * 32 + fq * 8;
                    if (c8 < P_EVEN) {
                        u32x2 wh[2];
#pragma unroll
                        for (int n = 0; n < 2; ++n) { const int c0 = c8 + 4 * n; f32x4 v = acc[ai][bj][m][n];
                            if (c0 == E_IW) { *(f32x4*)(IW + (size_t)row * 4) = v; }
                            if (c0 < 512 || (c0 >= 1536 && c0 < 2048)) v = v * QK_PRESCALE;
                            f32x4 o = v;
                            const bool rope = (c0 < 1024) || (c0 >= 1536 && c0 < 2176) || (c0 >= 2304 && c0 < 2624);
                            if (rope) { const f32x4 t = *(const f32x4*)(cs + ((size_t)pos * 32 + ((c0 & 63) >> 1)) * 2);
                                o[0] = v[0] * t[0] - v[1] * t[1]; o[1] = v[1] * t[0] + v[0] * t[1]; o[2] = v[2] * t[2] - v[3] * t[3]; o[3] = v[3] * t[2] + v[2] * t[3]; }
                            wh[n].x = pk2(o[0], o[1]); wh[n].y = pk2(o[2], o[3]); }
                        if (c8 < E_IW) *(pg8::u32x4*)(Pb + (size_t)row * LDPB + c8) = (pg8::u32x4){wh[0].x, wh[0].y, wh[1].x, wh[1].y};
                    }
                } }
    }
};
struct EpiInOdd {
    static constexpr bool PERM = true, AFTER_DRAIN = false;
    bf16_t* Pb; bf16_t* QRb; float* G; const float* cs; const float* gb;
    __device__ __forceinline__ void operator()(const f32x4 (&acc)[2][2][4][2], const Unit& u, int wr, int wc, int fr, int fq) const {
#pragma unroll
        for (int ai = 0; ai < 2; ++ai)
#pragma unroll
            for (int m = 0; m < 4; ++m) { const int row = u.pm * 256 + ai * 128 + wr * 64 + m * 16 + fr, pos = row & (SEQ - 1);
#pragma unroll
                for (int bj = 0; bj < 2; ++bj) { const int c8 = u.pn * 256 + bj * 128 + wc * 32 + fq * 8;
                    if (c8 < P_ODD) {
                        if (c8 >= O_DG) {
#pragma unroll
                            for (int n = 0; n < 2; ++n) { const int j = c8 + 4 * n - O_DG; const f32x4 v = acc[ai][bj][m][n]; f32x4 o;
#pragma unroll
                                for (int e = 0; e < 4; ++e) o[e] = 1.f / (1.f + expf(-(v[e] + gb[j + e])));
                                *(f32x4*)(G + (size_t)row * 24 + j) = o; }
                        } else {
                            const bool isq = (c8 >= O_DQ && c8 < O_KC);
                            const bool rope = (c8 < 1024) || isq || (c8 >= O_KS && c8 < O_VS) || (c8 >= O_KW && c8 < O_VW);
                            u32x2 wh[2], wr2[2];
#pragma unroll
                            for (int n = 0; n < 2; ++n) { const int c0 = c8 + 4 * n; f32x4 v = acc[ai][bj][m][n];
                                if (c8 < 512 || isq) v = v * QK_PRESCALE;
                                f32x4 o = v;
                                if (rope) { const f32x4 t = *(const f32x4*)(cs + ((size_t)pos * 32 + ((c0 & 63) >> 1)) * 2);
                                    o[0] = v[0] * t[0] - v[1] * t[1]; o[1] = v[1] * t[0] + v[0] * t[1]; o[2] = v[2] * t[2] - v[3] * t[3]; o[3] = v[3] * t[2] + v[2] * t[3]; }
                                wh[n].x = pk2(o[0], o[1]); wh[n].y = pk2(o[2], o[3]);
                                wr2[n].x = pk2(v[0], v[1]); wr2[n].y = pk2(v[2], v[3]); }
                            if (isq) { *(pg8::u32x4*)(QRb + (size_t)row * 512 + (c8 - O_DQ)) = (pg8::u32x4){wh[0].x, wh[0].y, wh[1].x, wh[1].y};
                                       *(pg8::u32x4*)(Pb + (size_t)row * LDPB + c8) = (pg8::u32x4){wr2[0].x, wr2[0].y, wr2[1].x, wr2[1].y}; }
                            else *(pg8::u32x4*)(Pb + (size_t)row * LDPB + c8) = (pg8::u32x4){wh[0].x, wh[0].y, wh[1].x, wh[1].y};
                        }
                    }
                } }
    }
};
struct EpiY {
    static constexpr bool PERM = true, AFTER_DRAIN = false;
    bf16_t* Y;
    __device__ __forceinline__ void operator()(const f32x4 (&acc)[2][2][4][2], const Unit& u, int wr, int wc, int fr, int fq) const {
#pragma unroll
        for (int ai = 0; ai < 2; ++ai)
#pragma unroll
            for (int m = 0; m < 4; ++m) { const int rloc = ai * 128 + wr * 64 + m * 16 + fr;
#pragma unroll
                for (int bj = 0; bj < 2; ++bj) { const f32x4 v0 = acc[ai][bj][m][0], v1 = acc[ai][bj][m][1];
                    const pg8::u32x4 w = {pk2(v0[0], v0[1]), pk2(v0[2], v0[3]), pk2(v1[0], v1[1]), pk2(v1[2], v1[3])};
                    *(pg8::u32x4*)(Y + (size_t)(u.pm * 256 + rloc) * DM + u.pn * 256 + bj * 128 + wc * 32 + fq * 8) = w; } }
    }
};
struct EpiGU {
    static constexpr bool PERM = false, AFTER_DRAIN = false;
    bf16_t* H; int ldh; int npn; int row_tile0;
    __device__ __forceinline__ void operator()(const f32x4 (&acc)[2][2][4][2], const Unit& u, int wr, int wc, int fr, int fq) const {
        const int pnl = u.pn % npn;
#pragma unroll
        for (int ai = 0; ai < 2; ++ai)
#pragma unroll
            for (int mp = 0; mp < 2; ++mp) { const int rloc = ai * 128 + wr * 64 + (2 * mp + (fq & 1)) * 16 + fr;
                bf16_t* hrow = H + (size_t)((u.pm - row_tile0) * 256 + rloc) * ldh;
#pragma unroll
                for (int bj = 0; bj < 2; ++bj) {
                    u32x2 wm[2];
#pragma unroll
                    for (int mm = 0; mm < 2; ++mm) { const f32x4 g = acc[ai][bj][2 * mp + mm][0], uu = acc[ai][bj][2 * mp + mm][1];
                        f32x4 o;
#pragma unroll
                        for (int e = 0; e < 4; ++e) o[e] = g[e] * __builtin_amdgcn_rcpf(1.f + __expf(-g[e])) * uu[e];
                        wm[mm].x = pk2(o[0], o[1]); wm[mm].y = pk2(o[2], o[3]); }
                    const auto rx = __builtin_amdgcn_permlane16_swap(wm[0].x, wm[1].x, false, false);
                    const auto ry = __builtin_amdgcn_permlane16_swap(wm[0].y, wm[1].y, false, false);
                    const int unit0 = (pnl * 256 + bj * 128 + wc * 32) / 2 + (fq & ~1) * 4;
                    *(pg8::u32x4*)(hrow + unit0) = (pg8::u32x4){rx[0], ry[0], rx[1], ry[1]}; } }
    }
};
struct EpiDownMoe {
    static constexpr bool PERM = true, AFTER_DRAIN = false;
    bf16_t* Ys; const float* sg;
    __device__ __forceinline__ void operator()(const f32x4 (&acc)[2][2][4][2], const Unit& u, int wr, int wc, int fr, int fq) const {
        const int pnl = u.pn & 3;
        float gts[2][4];
#pragma unroll
        for (int ai = 0; ai < 2; ++ai)
#pragma unroll
            for (int m = 0; m < 4; ++m) gts[ai][m] = sg[u.pm * 256 + ai * 128 + wr * 64 + m * 16 + fr];
#pragma unroll
        for (int ai = 0; ai < 2; ++ai)
#pragma unroll
            for (int m = 0; m < 4; ++m) { const int slot = u.pm * 256 + ai * 128 + wr * 64 + m * 16 + fr; const float gt = gts[ai][m];
#pragma unroll
                for (int bj = 0; bj < 2; ++bj) { const f32x4 v0 = acc[ai][bj][m][0] * gt, v1 = acc[ai][bj][m][1] * gt;
                    const pg8::u32x4 w = {pk2(v0[0], v0[1]), pk2(v0[2], v0[3]), pk2(v1[0], v1[1]), pk2(v1[2], v1[3])};
                    *(pg8::u32x4*)(Ys + (size_t)slot * DM + pnl * 256 + bj * 128 + wc * 32 + fq * 8) = w; } }
    }
};
struct EpiGeluH {
    static constexpr bool PERM = false, AFTER_DRAIN = false;
    bf16_t* Hc;
    __device__ __forceinline__ void operator()(const f32x4 (&acc)[2][2][4][2], const Unit& u, int wr, int wc, int fr, int fq) const {
        EPI_LOOP_BEGIN
            f32x4 o;
#pragma unroll
            for (int e = 0; e < 4; ++e) { const float x = v[e], uu = 0.7978845608028654f * (x + 0.044715f * x * x * x); o[e] = x - x * __builtin_amdgcn_rcpf(1.f + __expf(2.f * uu)); }
            u32x2 w; w.x = pk2(o[0], o[1]); w.y = pk2(o[2], o[3]);
            *(u32x2*)(Hc + (size_t)(u.pm * 256 + rloc) * 256 + cloc) = w;
        EPI_LOOP_END
    }
};
struct EpiCmp {
    static constexpr bool PERM = false, AFTER_DRAIN = false;
    bf16_t* C;
    __device__ __forceinline__ void operator()(const f32x4 (&acc)[2][2][4][2], const Unit& u, int wr, int wc, int fr, int fq) const {
        EPI_LOOP_BEGIN
            if (cloc < 64) { u32x2 w; w.x = pk2(v[0], v[1]); w.y = pk2(v[2], v[3]); *(u32x2*)(C + (size_t)(u.pm * 256 + rloc) * 64 + cloc) = w; }
        EPI_LOOP_END
    }
};
struct ListOrder {
    static constexpr bool KSPLIT = false, GATHER_A = false;
    int n, G, c;
    __device__ __forceinline__ bool next(int i, Unit& u) const { const int L = i * G + c; if (L >= n) return false; u.pm = L; u.pn = L >> 4; return true; }
    __device__ __forceinline__ void a_ready(const Unit&) const {}
    __device__ __forceinline__ void done(const Unit&) const {}
};
constexpr int MOE_TE_LDS = 139264;
struct MoeOrder {
    static constexpr bool KSPLIT = false, GATHER_A = false;
    int t0, ntr, npn, G, c;
    __device__ __forceinline__ bool next(int i, Unit& u) const {
        extern __shared__ __attribute__((aligned(16))) float lds_dyn_[];
        int tm, pl;
        if (G == 256 && ntr == 128) {
            const int x = c & 7, j = c >> 3, ncb = npn >> 2, nrounds = 2 * ncb;
            if (i >= nrounds) return false;
            const int rb = i / ncb, cb = i - rb * ncb;
            tm = t0 + 16 * x + 8 * rb + (j >> 2); pl = 4 * cb + (j & 3);
        } else {
            const int L = i * G + c; if (L >= ntr * npn) return false;
            tm = t0 + L / npn; pl = L % npn;
        }
        const int e = ((const LAS int*)((LAS unsigned char*)lds_dyn_ + MOE_TE_LDS))[tm];
        if (e < 0) return false;
        u.pm = tm; u.pn = e * npn + pl; return true;
    }
    __device__ __forceinline__ void a_ready(const Unit&) const {}
    __device__ __forceinline__ void done(const Unit&) const {}
};
struct MoeOrderG {
    static constexpr bool KSPLIT = false, GATHER_A = true;
    int t0, ntr, npn, G, c, rb; const int* slot_tok;
    __device__ __forceinline__ int arow(int slot) const { const int t = slot_tok[slot]; return t < 0 ? NTOK : t; }
    __device__ __forceinline__ bool next(int i, Unit& u) const {
        extern __shared__ __attribute__((aligned(16))) float lds_dyn_[];
        int tm, pl;
        if (ntr == 128) { const int x = c & 7, j = c >> 3, ncb = npn >> 2; if (i >= ncb) return false; tm = t0 + 16 * x + 8 * rb + (j >> 2); pl = 4 * i + (j & 3); }
        else { if (i > 0 || c >= ntr * npn) return false; tm = t0 + c / npn; pl = c % npn; }
        const int e = ((const LAS int*)((LAS unsigned char*)lds_dyn_ + MOE_TE_LDS))[tm];
        if (e < 0) return false;
        u.pm = tm; u.pn = e * npn + pl; return true;
    }
    __device__ __forceinline__ void a_ready(const Unit&) const {}
    __device__ __forceinline__ void done(const Unit&) const {}
};
constexpr int MOE_TAIL_T0 = 256, MOE_TAIL_TILES = NTILE256 - 256, MOE_KSL = 7, MOE_KSL_K = F_EXPERT / MOE_KSL;
struct TailOrder {
    static constexpr bool KSPLIT = true, GATHER_A = false;
    int G, c;
    __device__ __forceinline__ bool next(int i, Unit& u) const {
        extern __shared__ __attribute__((aligned(16))) float lds_dyn_[];
        const int L = i * G + c; if (L >= MOE_TAIL_TILES * 4 * MOE_KSL) return false;
        const int sl = L / (MOE_TAIL_TILES * 4), rem = L - sl * (MOE_TAIL_TILES * 4), tm = MOE_TAIL_T0 + (rem >> 2), pl = rem & 3;
        const int e = ((const LAS int*)((LAS unsigned char*)lds_dyn_ + MOE_TE_LDS))[tm];
        if (e < 0) return false;
        u.pm = tm; u.pn = e * 4 + pl; u.ko = sl * MOE_KSL_K; return true;
    }
    __device__ __forceinline__ void a_ready(const Unit&) const {}
    __device__ __forceinline__ void done(const Unit&) const {}
};
struct EpiDownTail {
    static constexpr bool PERM = false, AFTER_DRAIN = false;
    bf16_t* Yp; const float* sg;
    __device__ __forceinline__ void operator()(const f32x4 (&acc)[2][2][4][2], const Unit& u, int wr, int wc, int fr, int fq) const {
        const int pnl = u.pn & 3, sl = u.ko / MOE_KSL_K;
        float gts[2][4];
#pragma unroll
        for (int ai = 0; ai < 2; ++ai)
#pragma unroll
            for (int m = 0; m < 4; ++m) gts[ai][m] = sg[u.pm * 256 + ai * 128 + wr * 64 + m * 16 + fr];
#pragma unroll
        for (int ai = 0; ai < 2; ++ai)
#pragma unroll
            for (int m = 0; m < 4; ++m) { const int slot = u.pm * 256 + ai * 128 + wr * 64 + m * 16 + fr; const float gt = gts[ai][m];
                bf16_t* row = Yp + ((size_t)sl * (MOE_TAIL_TILES * 256) + (slot - MOE_TAIL_T0 * 256)) * DM;
#pragma unroll
                for (int bj = 0; bj < 2; ++bj)
#pragma unroll
                    for (int n = 0; n < 2; ++n) { const f32x4 v = acc[ai][bj][m][n] * gt; const int c0 = pnl * 256 + bj * 128 + wc * 32 + n * 16 + fq * 4;
                        u32x2 w; w.x = pk2(v[0], v[1]); w.y = pk2(v[2], v[3]);
                        *(u32x2*)(row + c0) = w; } }
    }
};

template <class F>
__device__ __forceinline__ void convert_T(bf16_t* dst, int Nphys, int K, int ld, F rowsrc, long gid, long gstride) {
    const long total = (long)Nphys * (K >> 3);
    for (long idx0 = gid; idx0 < total; idx0 += 4 * gstride) {
        float v[4][8]; int nn[4], kk[4]; bool ok[4];
#pragma unroll
        for (int u = 0; u < 4; ++u) {
            const long idx = idx0 + u * gstride; ok[u] = idx < total;
            const long idc = ok[u] ? idx : idx0;
            nn[u] = (int)(idc % Nphys); kk[u] = (int)(idc / Nphys);
            const float* s = rowsrc(nn[u]);
            if (s) {
#pragma unroll
                for (int i = 0; i < 8; ++i) v[u][i] = s[(size_t)(kk[u] * 8 + i) * ld];
            } else {
#pragma unroll
                for (int i = 0; i < 8; ++i) v[u][i] = 0.f;
            }
        }
#pragma unroll
        for (int u = 0; u < 4; ++u) if (ok[u]) {
            uint4 w; w.x = pk2(v[u][0], v[u][1]); w.y = pk2(v[u][2], v[u][3]); w.z = pk2(v[u][4], v[u][5]); w.w = pk2(v[u][6], v[u][7]);
            *(uint4*)(dst + (size_t)nn[u] * K + kk[u] * 8) = w;
        }
    }
}
__device__ __forceinline__ int rope_nat(int n) { const int w = n & 63; return (n & ~63) + (w >> 1) + 32 * (w & 1); }

__device__ __forceinline__ void sincos_d(double a, double& s, double& c) {
    const double n = rint(a * 0.6366197723675814);
    double y = fma(-n, 1.5707963267948966, a); y = fma(-n, 6.123233995736766e-17, y);
    const int q = ((int)n) & 3;
    const double y2 = y * y;
    const double sp = y * (1.0 + y2 * (-1.0 / 6 + y2 * (1.0 / 120 + y2 * (-1.0 / 5040 + y2 * (1.0 / 362880 + y2 * (-1.0 / 39916800 + y2 * (1.0 / 6227020800.0)))))));
    const double cp = 1.0 + y2 * (-0.5 + y2 * (1.0 / 24 + y2 * (-1.0 / 720 + y2 * (1.0 / 40320 + y2 * (-1.0 / 3628800 + y2 * (1.0 / 479001600.0 + y2 * (-1.0 / 87178291200.0)))))));
    s = (q == 0) ? sp : (q == 1) ? cp : (q == 2) ? -sp : -cp;
    c = (q == 0) ? cp : (q == 1) ? -sp : (q == 2) ? -cp : sp;
}

template <class F>
__device__ __forceinline__ void convert_tiles(bf16_t* dst, int Nphys, int K, int ld, F src8, float* ldsf, int tile0, int tile_step) {
    const int tid = tid_();
    bf16_t* lt = (bf16_t*)ldsf;
    const int nkt = K >> 6, ntiles = (Nphys >> 7) * nkt;
    const int kl = tid >> 4, c = tid & 15;
    const int rn = tid >> 2, rq = tid & 3;
    float4 a0, a1, b0, b1;
#define CT_LOAD(tl, A0, A1, B0, B1) do { const int nt_ = (tl) / nkt, kt_ = (tl) - nt_ * nkt; const float* s_ = src8(nt_ * 128, c) + (size_t)(kt_ * 64 + 2 * kl) * ld; \
        A0 = *(const float4*)s_; A1 = *(const float4*)(s_ + 4); B0 = *(const float4*)(s_ + (size_t)ld); B1 = *(const float4*)(s_ + (size_t)ld + 4); } while (0)
    if (tile0 < ntiles) CT_LOAD(tile0, a0, a1, b0, b1);
    for (int tile = tile0; tile < ntiles; tile += tile_step) {
        const int nt = tile / nkt, kt = tile - nt * nkt, n0 = nt * 128, k0 = kt * 64;
        float4 na0 = a0, na1 = a1, nb0 = b0, nb1 = b1;
        if (tile + tile_step < ntiles) CT_LOAD(tile + tile_step, na0, na1, nb0, nb1);
        __syncthreads();
        const float va[8] = {a0.x, a0.y, a0.z, a0.w, a1.x, a1.y, a1.z, a1.w}, vb[8] = {b0.x, b0.y, b0.z, b0.w, b1.x, b1.y, b1.z, b1.w};
#pragma unroll
        for (int e = 0; e < 8; ++e) ((unsigned*)lt)[(8 * c + e) * 36 + (kl ^ ((c & 7) << 2))] = pk2(va[e], vb[e]);
        __syncthreads();
        const int crd = (rn >> 3) & 7;
        const uint4 w0 = *(const uint4*)((const unsigned*)lt + rn * 36 + 4 * ((2 * rq) ^ crd)), w1 = *(const uint4*)((const unsigned*)lt + rn * 36 + 4 * ((2 * rq + 1) ^ crd));
        bf16_t* d = dst + (size_t)(n0 + rn) * K + k0 + rq * 16;
        *(uint4*)d = w0; *(uint4*)(d + 8) = w1;
        a0 = na0; a1 = na1; b0 = nb0; b1 = nb1;
    }
#undef CT_LOAD
}

__device__ __forceinline__ int rot_tile0(int rot, int G) { const int r = (int)blockIdx.x - rot % G; return r < 0 ? r + G : r; }
__device__ __forceinline__ void ph_init(const Params& p, float* lds) {
    const int tid = tid_();
    const long gid = (long)blockIdx.x * NT + tid, gs = (long)gridDim.x * NT;
    int rot = 0;
    for (long i = gid; i < 4096 * 32; i += gs) {
        const int pos = (int)(i >> 5), f = (int)(i & 31);
        const float angf = (float)pos * c_inv[f];
        double s, c; sincos_d((double)angf, s, c);
        p.ropecs[2 * i] = (float)c; p.ropecs[2 * i + 1] = (float)s;
    }
    if (gid < DM / 2) ((unsigned*)(p.Xb + (size_t)NTOK * DM))[gid] = 0u;
    const float4* xs = (const float4*)p.in[IN_X]; u32x2* xb = (u32x2*)p.Xb;
    for (long i = gid; i < (long)NTOK * DM / 4; i += 4 * gs) {
        float4 v[4];
#pragma unroll
        for (int u = 0; u < 4; ++u) { const long j = i + u * gs; v[u] = xs[j < (long)NTOK * DM / 4 ? j : i]; }
#pragma unroll
        for (int u = 0; u < 4; ++u) { const long j = i + u * gs; if (j < (long)NTOK * DM / 4) { u32x2 w; w.x = pk2(v[u].x, v[u].y); w.y = pk2(v[u].z, v[u].w); xb[j] = w; } }
    }
#pragma unroll 1
    for (int li = 0; li < 2; ++li) {
        { const float* W = p.in[IN_EV_WIN] + (size_t)li * DM * P_EVEN;
          convert_T(p.WinE + (size_t)li * NP_EVEN * DM, NP_EVEN, DM, P_EVEN, [=](int n) -> const float* {
              if (n >= P_EVEN) return nullptr;
              const bool rope = (n < 1024) || (n >= 1536 && n < 2176) || (n >= 2304 && n < 2624);
              return W + (rope ? rope_nat(n) : n); }, gid, gs); }
        { const float* W = p.in[IN_OD_WIN] + (size_t)li * DM * P_ODD;
          convert_T(p.WinO + (size_t)li * NP_ODD * DM, NP_ODD, DM, P_ODD, [=](int n) -> const float* {
              if (n >= P_ODD) return nullptr;
              const bool rope = (n < 1024) || (n >= O_DQ && n < O_KC) || (n >= O_KS && n < O_VS) || (n >= O_KW && n < O_VW);
              return W + (rope ? rope_nat(n) : n); }, gid, gs); }
        { const float* W = p.in[IN_EV_WOUT] + (size_t)li * DM * DM;
          convert_tiles(p.WoutE + (size_t)li * DM * DM, DM, DM, DM, [=](int n0, int c) -> const float* { return W + n0 + 8 * c; }, lds, rot_tile0(rot, gridDim.x), gridDim.x); rot += 128; }
        { const float* W = p.in[IN_OD_WOUT] + (size_t)li * DM * DM;
          convert_tiles(p.WoutO + (size_t)li * DM * DM, DM, DM, DM, [=](int n0, int c) -> const float* { return W + n0 + 8 * c; }, lds, rot_tile0(rot, gridDim.x), gridDim.x); rot += 128; }
        { const float* Wg = p.in[IN_FFD_WG] + (size_t)li * DM * F_DENSE; const float* Wu = p.in[IN_FFD_WU] + (size_t)li * DM * F_DENSE; const long dWu = (const char*)Wu - (const char*)Wg;
          convert_tiles(p.WguD + (size_t)li * 2 * F_DENSE * DM, 2 * F_DENSE, DM, F_DENSE, [=](int n0, int c) -> const float* {
              const int unit0 = n0 / 2 + (c >> 2) * 16 + (c & 1) * 8; return (const float*)((const char*)Wg + ((c & 2) ? dWu : 0l)) + unit0; }, lds, rot_tile0(rot, gridDim.x), gridDim.x); rot += 704; }
        { const float* W = p.in[IN_FFD_WD] + (size_t)li * F_DENSE * DM;
          convert_tiles(p.WdD + (size_t)li * DM * F_DENSE, DM, F_DENSE, DM, [=](int n0, int c) -> const float* { return W + n0 + 8 * c; }, lds, rot_tile0(rot, gridDim.x), gridDim.x); rot += 352; }
#pragma unroll 1
        for (int which = 0; which < 2; ++which) {
            const float* W1 = p.in[IN_NSA_W1] + (size_t)(li * 2 + which) * 2048 * 256;
            convert_tiles(p.W1T + (size_t)(li * 2 + which) * 256 * 2048, 256, 2048, 256, [=](int n0, int c) -> const float* { return W1 + n0 + 8 * c; }, lds, rot_tile0(rot, gridDim.x), gridDim.x); rot += 64;
            const float* W2 = p.in[IN_NSA_W2] + (size_t)(li * 2 + which) * 256 * 64;
            convert_T(p.W2T + (size_t)(li * 2 + which) * 256 * 256, 256, 256, 64, [=](int n) -> const float* { if (n >= 64) return nullptr; return W2 + (which ? n : rope_nat(n)); }, gid, gs);
        }
    }
}
__device__ __forceinline__ void ph_convert_moe(const Params& p, int li, float* lds) {
    const float* Wg = p.in[IN_MOE_WG] + (size_t)li * N_EXP * DM * F_EXPERT; const float* Wu = p.in[IN_MOE_WU] + (size_t)li * N_EXP * DM * F_EXPERT; const long dWu = (const char*)Wu - (const char*)Wg;
    convert_tiles(p.WguM, N_EXP * 2 * F_EXPERT, DM, F_EXPERT, [=](int n0, int c) -> const float* {
        const int e = n0 / (2 * F_EXPERT), unit0 = (n0 % (2 * F_EXPERT)) / 2 + (c >> 2) * 16 + (c & 1) * 8;
        return (const float*)((const char*)Wg + ((c & 2) ? dWu : 0l)) + (size_t)e * DM * F_EXPERT + unit0; }, lds, blockIdx.x, gridDim.x);
    const float* Wd = p.in[IN_MOE_WD] + (size_t)li * N_EXP * F_EXPERT * DM;
    convert_tiles(p.WdM, N_EXP * DM, F_EXPERT, DM, [=](int n0, int c) -> const float* { return Wd + (size_t)(n0 >> 10) * F_EXPERT * DM + (n0 & 1023) + 8 * c; }, lds, blockIdx.x, gridDim.x);
}

struct CvJob {
    const float* Wg; long dWu; const float* Wd; bf16_t* dgu; bf16_t* ddn; bf16_t* lt0;
    int t, tend, step_, par; bool pend; bf16_t* pdst;
    float4 a0, a1, b0, b1;
    static constexpr int NT1 = (N_EXP * 2 * F_EXPERT / 128) * (DM / 64), NT2 = (N_EXP * DM / 128) * (F_EXPERT / 64);
    __device__ __forceinline__ void load(int tl, int tid) {
        const int kl = tid >> 4, c = tid & 15; const float* s_; size_t ld;
        if (tl < NT1) { const int nt = tl >> 4, kt = tl & 15, n0 = nt * 128; const int e = n0 / (2 * F_EXPERT), unit0 = (n0 % (2 * F_EXPERT)) / 2 + (c >> 2) * 16 + (c & 1) * 8;
            ld = F_EXPERT; s_ = (const float*)((const char*)Wg + ((c & 2) ? dWu : 0l)) + (size_t)e * DM * F_EXPERT + unit0 + (size_t)(kt * 64 + 2 * kl) * ld; }
        else { const int t2 = tl - NT1, nt = t2 / (F_EXPERT / 64), kt = t2 - nt * (F_EXPERT / 64), n0 = nt * 128;
            ld = DM; s_ = Wd + (size_t)(n0 >> 10) * F_EXPERT * DM + (n0 & 1023) + 8 * c + (size_t)(kt * 64 + 2 * kl) * ld; }
        a0 = *(const float4*)s_; a1 = *(const float4*)(s_ + 4); b0 = *(const float4*)(s_ + ld); b1 = *(const float4*)(s_ + ld + 4);
    }
    __device__ __forceinline__ void init(const Params& p, int li, float* ldsf, int tid) {
        Wg = p.in[IN_MOE_WG] + (size_t)li * N_EXP * DM * F_EXPERT; const float* Wu = p.in[IN_MOE_WU] + (size_t)li * N_EXP * DM * F_EXPERT; dWu = (const char*)Wu - (const char*)Wg;
        Wd = p.in[IN_MOE_WD] + (size_t)li * N_EXP * F_EXPERT * DM; dgu = p.WguM; ddn = p.WdM; lt0 = (bf16_t*)ldsf;
        t = blockIdx.x; step_ = gridDim.x; tend = NT1 + NT2; par = 0; pend = false; pdst = dgu;
        if (t < tend) load(t, tid);
    }
    __device__ __forceinline__ void step(int tid) {
        const int kl = tid >> 4, c = tid & 15, rn = tid >> 2, rq = tid & 3;
        const int crd = (rn >> 3) & 7;
        if (pend) { const unsigned* lt = (const unsigned*)(lt0 + (par ^ 1) * (128 * 72));
            const uint4 w0 = *(const uint4*)(lt + rn * 36 + 4 * ((2 * rq) ^ crd)), w1 = *(const uint4*)(lt + rn * 36 + 4 * ((2 * rq + 1) ^ crd));
            *(uint4*)pdst = w0; *(uint4*)(pdst + 8) = w1; }
        if (t < tend) {
            unsigned* lt = (unsigned*)(lt0 + par * (128 * 72));
            const float va[8] = {a0.x, a0.y, a0.z, a0.w, a1.x, a1.y, a1.z, a1.w}, vb[8] = {b0.x, b0.y, b0.z, b0.w, b1.x, b1.y, b1.z, b1.w};
#pragma unroll
            for (int e = 0; e < 8; ++e) lt[(8 * c + e) * 36 + (kl ^ ((c & 7) << 2))] = pk2(va[e], vb[e]);
            if (t < NT1) { const int nt = t >> 4, kt = t & 15; pdst = dgu + (size_t)(nt * 128 + rn) * DM + kt * 64 + rq * 16; }
            else { const int t2 = t - NT1, nt = t2 / (F_EXPERT / 64), kt = t2 - nt * (F_EXPERT / 64); pdst = ddn + (size_t)(nt * 128 + rn) * F_EXPERT + kt * 64 + rq * 16; }
            pend = true; t += step_;
            if (t < tend) load(t, tid);
        } else pend = false;
        par ^= 1;
    }
    __device__ __forceinline__ void finish(int tid) { while (pend || t < tend) { __syncthreads(); step(tid); } }
};

__device__ __forceinline__ void ph_kmean(const Params& p, float* lds) {
    const int tid = tid_(), ch = tid & 7, kg = tid >> 3;
    for (int item = blockIdx.x; item < 8 * 16 * 8; item += gridDim.x) {
        const int h = item & 7, blk = (item >> 3) & 15, b = item >> 7;
        float s[8] = {0.f, 0.f, 0.f, 0.f, 0.f, 0.f, 0.f, 0.f};
        uint4 kv[4];
#pragma unroll
        for (int j = 0; j < 4; ++j) kv[j] = *(const uint4*)(p.Pb + (size_t)(b * SEQ + blk * 256 + kg * 4 + j) * LDPB + O_CK + h * 64 + ch * 8);
#pragma unroll
        for (int j = 0; j < 4; ++j) {
            s[0] += __builtin_bit_cast(float, kv[j].x << 16); s[1] += __builtin_bit_cast(float, kv[j].x & 0xffff0000u);
            s[2] += __builtin_bit_cast(float, kv[j].y << 16); s[3] += __builtin_bit_cast(float, kv[j].y & 0xffff0000u);
            s[4] += __builtin_bit_cast(float, kv[j].z << 16); s[5] += __builtin_bit_cast(float, kv[j].z & 0xffff0000u);
            s[6] += __builtin_bit_cast(float, kv[j].w << 16); s[7] += __builtin_bit_cast(float, kv[j].w & 0xffff0000u);
        }
#pragma unroll
        for (int e = 0; e < 8; ++e) { s[e] += __shfl_xor(s[e], 8); s[e] += __shfl_xor(s[e], 16); s[e] += __shfl_xor(s[e], 32); }
        __syncthreads();
        if ((tid & 63) < 8) {
#pragma unroll
            for (int e = 0; e < 8; ++e) lds[(tid >> 6) * 64 + ch * 8 + e] = s[e];
        }
        __syncthreads();
        if (tid < 64) { float a = 0.f;
#pragma unroll
            for (int q = 0; q < 8; ++q) a += lds[q * 64 + tid];
            p.kmean[(size_t)item * 64 + tid] = a * (1.f / 256.f); }
    }
}

__device__ __forceinline__ void ph_cmp_build(const Params& p, int li) {
    const int tid = tid_();
    const long gs = (long)gridDim.x * NT;
    for (long idx0 = (long)blockIdx.x * NT + tid; idx0 < 2l * 4096 * 256; idx0 += 4 * gs) {
      pg8::u32x4 kvv[4]; float4 pe0[4], pe1[4];
#pragma unroll
      for (int u = 0; u < 4; ++u) {
        const long idx = (idx0 + u * gs < 2l * 4096 * 256) ? idx0 + u * gs : idx0;
        const int ch = (int)(idx & 255), m = (int)((idx >> 8) & 4095), which = (int)(idx >> 20);
        const int i = (m & 255) < 255 ? (m & 255) : 0, bg = m >> 8, b = bg >> 1, g = bg & 1, t = ch >> 3, d0 = (ch & 7) * 8;
        kvv[u] = *(const pg8::u32x4*)(p.Pb + (size_t)(b * SEQ + 16 * i + t) * LDPB + (which ? O_VC : O_KC) + g * 64 + d0);
        const float* pe = p.in[IN_NSA_PE] + (size_t)(li * 2 + which) * 2048 + t * 64 + d0;
        pe0[u] = *(const float4*)pe; pe1[u] = *(const float4*)(pe + 4);
      }
#pragma unroll
      for (int u = 0; u < 4; ++u) {
        const long idx = idx0 + u * gs;
        if (idx >= 2l * 4096 * 256) continue;
        const int ch = (int)(idx & 255), m = (int)((idx >> 8) & 4095), which = (int)(idx >> 20);
        const int i = m & 255, t = ch >> 3, d0 = (ch & 7) * 8;
        uint4 w = make_uint4(0u, 0u, 0u, 0u);
        if (i < 255) {
            uint4 kv; kv.x = kvv[u].x; kv.y = kvv[u].y; kv.z = kvv[u].z; kv.w = kvv[u].w;
            const float4 e0 = pe0[u], e1 = pe1[u];
            w.x = pk2(__builtin_bit_cast(float, kv.x << 16) + e0.x, __builtin_bit_cast(float, kv.x & 0xffff0000u) + e0.y);
            w.y = pk2(__builtin_bit_cast(float, kv.y << 16) + e0.z, __builtin_bit_cast(float, kv.y & 0xffff0000u) + e0.w);
            w.z = pk2(__builtin_bit_cast(float, kv.z << 16) + e1.x, __builtin_bit_cast(float, kv.z & 0xffff0000u) + e1.y);
            w.w = pk2(__builtin_bit_cast(float, kv.w << 16) + e1.z, __builtin_bit_cast(float, kv.w & 0xffff0000u) + e1.w);
        }
        *(uint4*)(p.Ac + ((size_t)(which * 4096 + m) * 2048 + ch * 8)) = w;
      }
    }
}

typedef unsigned u32x8v __attribute__((ext_vector_type(8)));
typedef float f32x16v __attribute__((ext_vector_type(16)));
#define LN_G4(c) ((((c) >> 1) * 64 + lane) * 2 + ((c) & 1))
__device__ __forceinline__ u32x8v ld_row8(const bf16_t* row, int lane) {
    const pg8::u32x4* r = (const pg8::u32x4*)row; const pg8::u32x4 a = r[lane], b = r[64 + lane];
    return (u32x8v){a.x, a.y, a.z, a.w, b.x, b.y, b.z, b.w};
}
__device__ __forceinline__ f32x16v ld_row16f(const float* row, int lane) {
    const float4* r = (const float4*)row; const float4 a = r[LN_G4(0)], b = r[LN_G4(1)], c = r[LN_G4(2)], d = r[LN_G4(3)];
    return (f32x16v){a.x, a.y, a.z, a.w, b.x, b.y, b.z, b.w, c.x, c.y, c.z, c.w, d.x, d.y, d.z, d.w};
}
__device__ __forceinline__ float bf_el(const u32x8v v, int i) { const unsigned u = v[i >> 1]; return __builtin_bit_cast(float, (i & 1) ? (u & 0xffff0000u) : (u << 16)); }
__device__ __forceinline__ u32x8v ld_slot8(const Params& p, int slot_v, int lane) {
    const int slot = __builtin_amdgcn_readfirstlane(slot_v);
    if (slot < MOE_TAIL_T0 * 256) return ld_row8(p.Ys + (size_t)slot * DM, lane);
    u32x8v part[MOE_KSL];
#pragma unroll
    for (int sl = 0; sl < MOE_KSL; ++sl) part[sl] = ld_row8(p.Yp + ((size_t)sl * (MOE_TAIL_TILES * 256) + (slot - MOE_TAIL_T0 * 256)) * DM, lane);
    u32x8v o;
#pragma unroll
    for (int j = 0; j < 8; ++j) {
        float lo = 0.f, hi = 0.f;
#pragma unroll
        for (int sl = 0; sl < MOE_KSL; ++sl) { lo += __builtin_bit_cast(float, part[sl][j] << 16); hi += __builtin_bit_cast(float, part[sl][j] & 0xffff0000u); }
        o[j] = pk2(lo, hi);
    }
    return o;
}
template <int MODE, int XSRC>
__device__ __forceinline__ void ph_ln(const Params& p, const float* gam, const float* bet, const float* Xin, float* Xout, bf16_t* Xbout, const bool wf32) {
    const int lane = tid_() & 63, wid = tid_() >> 6;
    const int stride = gridDim.x * 8;
    int t = blockIdx.x * 8 + wid;
    float4 gg4[4], bb4[4];
#pragma unroll
    for (int c = 0; c < 4; ++c) { gg4[c] = ((const float4*)gam)[LN_G4(c)]; bb4[c] = ((const float4*)bet)[LN_G4(c)]; }
    if (t < NTOK) {
        f32x16v xf, xfn; u32x8v xb8, xbn, ya, yan, yb, ybn;
        int n0 = 0, n1 = 0;
#define LN_LOAD(tt, S0, S1, XF, XB, YA, YB) do { \
        if (XSRC == 0) XF = ld_row16f(Xin + (size_t)(tt) * DM, lane); else XB = ld_row8(Xbout + (size_t)(tt) * DM, lane); \
        if (MODE == 0) YA = ld_row8((const bf16_t*)p.Y + (size_t)(tt) * DM, lane); \
        else { YA = ld_slot8(p, S0, lane); YB = ld_slot8(p, S1, lane); } } while (0)
        {
            int s0 = 0, s1 = 0;
            if (MODE == 1) { s0 = p.tok_slot[2 * t]; s1 = p.tok_slot[2 * t + 1]; const int tn = (t + stride < NTOK) ? t + stride : t; n0 = p.tok_slot[2 * tn]; n1 = p.tok_slot[2 * tn + 1]; }
            LN_LOAD(t, s0, s1, xf, xb8, ya, yb);
        }
        for (; t < NTOK; t += stride) {
            const int tn = (t + stride < NTOK) ? t + stride : t;
            LN_LOAD(tn, n0, n1, xfn, xbn, yan, ybn);
            int m0 = 0, m1 = 0;
            if (MODE == 1) { const int t2 = (tn + stride < NTOK) ? tn + stride : tn; m0 = p.tok_slot[2 * t2]; m1 = p.tok_slot[2 * t2 + 1]; }
            f32x16v v; float s = 0.f;
#pragma unroll
            for (int c = 0; c < 4; ++c) {
#pragma unroll
                for (int e = 0; e < 4; ++e) {
                    const int i = c * 4 + e;
                    const float x = (XSRC == 0) ? xf[i] : bf_el(xb8, i);
                    const float y = (MODE == 0) ? bf_el(ya, i) : bf_el(ya, i) + bf_el(yb, i);
                    v[i] = ALPHA * x + y;
                }
                s += (v[c * 4] + v[c * 4 + 1]) + (v[c * 4 + 2] + v[c * 4 + 3]);
            }
            const float mu = wave_sum(s) * (1.f / 1024.f);
            float q = 0.f;
#pragma unroll
            for (int c = 0; c < 4; ++c) { const float a = v[c * 4] - mu, b2 = v[c * 4 + 1] - mu, c2 = v[c * 4 + 2] - mu, d2 = v[c * 4 + 3] - mu; q += (a * a + b2 * b2) + (c2 * c2 + d2 * d2); }
            const float var = wave_sum(q) * (1.f / 1024.f);
            const float rs = 1.0f / sqrtf(var + LN_EPS);
            pg8::u32x4* xb = (pg8::u32x4*)(Xbout + (size_t)t * DM); float4* xo = (float4*)(Xout + (size_t)t * DM);
            u32x2 wo[4];
#pragma unroll
            for (int c = 0; c < 4; ++c) {
                const float4 gg = gg4[c], bb = bb4[c];
                float4 o; o.x = (v[c * 4] - mu) * rs * gg.x + bb.x; o.y = (v[c * 4 + 1] - mu) * rs * gg.y + bb.y; o.z = (v[c * 4 + 2] - mu) * rs * gg.z + bb.z; o.w = (v[c * 4 + 3] - mu) * rs * gg.w + bb.w;
                if (wf32) xo[LN_G4(c)] = o;
                wo[c].x = pk2(o.x, o.y); wo[c].y = pk2(o.z, o.w);
            }
            xb[lane] = (pg8::u32x4){wo[0].x, wo[0].y, wo[1].x, wo[1].y}; xb[64 + lane] = (pg8::u32x4){wo[2].x, wo[2].y, wo[3].x, wo[3].y};
            xf = xfn; xb8 = xbn; ya = yan; yb = ybn; n0 = m0; n1 = m1;
        }
#undef LN_LOAD
    }
}

__device__ __forceinline__ void ph_ln_router(const Params& p, const float* gam, const float* bet, int li, float* lds) {
    const int tid = tid_(), lane = tid & 63, wid = tid >> 6;
    int* lcnt = (int*)lds;
    const float* wr = p.in[IN_MOE_WR] + (size_t)li * 1024 * 8;
    const float* br = p.in[IN_MOE_BR] + li * 8;
    float4 gg4[4], bb4[4];
#pragma unroll
    for (int c = 0; c < 4; ++c) { gg4[c] = ((const float4*)gam)[LN_G4(c)]; bb4[c] = ((const float4*)bet)[LN_G4(c)]; }
    for (int chunk = blockIdx.x; chunk < 256; chunk += gridDim.x) {
        __syncthreads();
        if (tid < 8) lcnt[tid] = 0;
        __syncthreads();
        u32x8v xb8 = ld_row8(p.Xb + (size_t)(chunk * 128 + wid * 16) * DM, lane), ya = ld_row8((const bf16_t*)p.Y + (size_t)(chunk * 128 + wid * 16) * DM, lane);
        for (int q = 0; q < 16; ++q) {
            const int t = chunk * 128 + wid * 16 + q;
            const int tn = (q < 15) ? t + 1 : t;
            const u32x8v xbn = ld_row8(p.Xb + (size_t)tn * DM, lane), yan = ld_row8((const bf16_t*)p.Y + (size_t)tn * DM, lane);
            float4 v[4]; float s = 0.f;
#pragma unroll
            for (int c = 0; c < 4; ++c) {
                v[c].x = ALPHA * bf_el(xb8, c * 4) + bf_el(ya, c * 4); v[c].y = ALPHA * bf_el(xb8, c * 4 + 1) + bf_el(ya, c * 4 + 1);
                v[c].z = ALPHA * bf_el(xb8, c * 4 + 2) + bf_el(ya, c * 4 + 2); v[c].w = ALPHA * bf_el(xb8, c * 4 + 3) + bf_el(ya, c * 4 + 3);
                s += (v[c].x + v[c].y) + (v[c].z + v[c].w);
            }
            xb8 = xbn; ya = yan;
            const float mu = wave_sum(s) * (1.f / 1024.f);
            float qq = 0.f;
#pragma unroll
            for (int c = 0; c < 4; ++c) { const float a = v[c].x - mu, b2 = v[c].y - mu, c2 = v[c].z - mu, d2 = v[c].w - mu; qq += (a * a + b2 * b2) + (c2 * c2 + d2 * d2); }
            const float var = wave_sum(qq) * (1.f / 1024.f);
            const float rs = 1.0f / sqrtf(var + LN_EPS);
            pg8::u32x4* xb = (pg8::u32x4*)(p.Xb + (size_t)t * DM);
            float a[8] = {0.f, 0.f, 0.f, 0.f, 0.f, 0.f, 0.f, 0.f};
            u32x2 wout[4];
#pragma unroll
            for (int c = 0; c < 4; ++c) {
                const float4 gg = gg4[c], bb = bb4[c];
                float4 o; o.x = (v[c].x - mu) * rs * gg.x + bb.x; o.y = (v[c].y - mu) * rs * gg.y + bb.y; o.z = (v[c].z - mu) * rs * gg.z + bb.z; o.w = (v[c].w - mu) * rs * gg.w + bb.w;
                wout[c].x = pk2(o.x, o.y); wout[c].y = pk2(o.z, o.w);
                const float ov[4] = {o.x, o.y, o.z, o.w};
                const float* wk = wr + (size_t)(LN_G4(c) * 4) * 8;
#pragma unroll
                for (int j = 0; j < 4; ++j) { const float4 w0 = *(const float4*)(wk + j * 8), w1 = *(const float4*)(wk + j * 8 + 4);
                    a[0] += ov[j] * w0.x; a[1] += ov[j] * w0.y; a[2] += ov[j] * w0.z; a[3] += ov[j] * w0.w; a[4] += ov[j] * w1.x; a[5] += ov[j] * w1.y; a[6] += ov[j] * w1.z; a[7] += ov[j] * w1.w; }
            }
            xb[lane] = (pg8::u32x4){wout[0].x, wout[0].y, wout[1].x, wout[1].y}; xb[64 + lane] = (pg8::u32x4){wout[2].x, wout[2].y, wout[3].x, wout[3].y};
            {
                float b4[4], b2[2], b1;
                const bool up1 = lane & 1, up2 = lane & 2, up4 = lane & 4;
#pragma unroll
                for (int e = 0; e < 4; ++e) { const float keep = up1 ? a[e + 4] : a[e], send = up1 ? a[e] : a[e + 4]; b4[e] = keep + __shfl_xor(send, 1); }
#pragma unroll
                for (int e = 0; e < 2; ++e) { const float keep = up2 ? b4[e + 2] : b4[e], send = up2 ? b4[e] : b4[e + 2]; b2[e] = keep + __shfl_xor(send, 2); }
                { const float keep = up4 ? b2[1] : b2[0], send = up4 ? b2[0] : b2[1]; b1 = keep + __shfl_xor(send, 4); }
                b1 += __shfl_xor(b1, 8); b1 += __shfl_xor(b1, 16); b1 += __shfl_xor(b1, 32);
#pragma unroll
                for (int e = 0; e < 8; ++e) { const int src = ((e >> 2) & 1) | (e & 2) | ((e & 1) << 2); a[e] = __shfl(b1, src) + br[e]; }
            }
            int e1 = 0; float l1 = a[0];
#pragma unroll
            for (int e = 1; e < 8; ++e) if (a[e] > l1) { l1 = a[e]; e1 = e; }
            int e2 = -1; float l2 = -INFINITY;
#pragma unroll
            for (int e = 0; e < 8; ++e) if (e != e1 && a[e] > l2) { l2 = a[e]; e2 = e; }
            const float ex = expf(l2 - l1);
            if (lane == 0) {
                p.tok_e[2 * t] = e1; p.tok_e[2 * t + 1] = e2;
                p.tok_g[2 * t] = 1.f / (1.f + ex); p.tok_g[2 * t + 1] = ex / (1.f + ex);
                atomicAdd(&lcnt[e1], 1); atomicAdd(&lcnt[e2], 1);
            }
        }
        __syncthreads();
        if (tid < 8) p.chunk_cnt[chunk * 8 + tid] = lcnt[tid];
    }
}
__device__ __forceinline__ void ph_slots(const Params& p, float* lds) {
    const int tid = tid_();
    int* lbase = (int*)lds;
    int* lpad = lbase + 8;
    int* ltot = lpad + 16;
    int* lent = ltot + 8;
    int* lslot = lent + 256;
    for (int chunk = blockIdx.x; chunk < 256; chunk += gridDim.x) {
        __syncthreads();
        {
            int* lcc = lslot + 256;
            const int4 v4 = ((const int4*)p.chunk_cnt)[tid]; ((int4*)lcc)[tid] = v4;
            if (tid < 256) lent[tid] = p.tok_e[chunk * 256 + tid];
            __syncthreads();
            {
                const int e = tid >> 6, ln = tid & 63; int tot = 0, before = 0;
#pragma unroll
                for (int q = 0; q < 4; ++q) { const int cc = ln * 4 + q, v = lcc[cc * 8 + e]; tot += v; before += (cc < chunk) ? v : 0; }
#pragma unroll
                for (int o = 32; o >= 1; o >>= 1) { tot += __shfl_xor(tot, o); before += __shfl_xor(before, o); }
                if (ln == 0) { lbase[e] = before; ltot[e] = tot; }
            }
        }
        __syncthreads();
        if (tid == 0) { int acc = 0; for (int e = 0; e < 8; ++e) { lpad[e] = acc; acc += (ltot[e] + 255) / 256 * 256; } lpad[8] = acc; }
        __syncthreads();
        {
            int* lwc = lslot + 256 + 2048;
            const int wv = tid >> 6, ln = tid & 63;
            int my_e = -1, my_rank = 0;
            if (tid < 256) {
                my_e = lent[tid];
#pragma unroll
                for (int e = 0; e < 8; ++e) { const unsigned long long mb = __ballot(my_e == e); if (my_e == e) my_rank = lane_rank(mb); if (ln == 0) lwc[wv * 8 + e] = __popcll(mb); }
            }
            __syncthreads();
            if (tid < 256) { int r = lpad[my_e] + lbase[my_e] + my_rank; for (int q = 0; q < wv; ++q) r += lwc[q * 8 + my_e]; lslot[tid] = r; }
        }
        __syncthreads();
        if (tid < 256) {
            const int slot = lslot[tid], tk = chunk * 128 + (tid >> 1);
            p.slot_tok[slot] = tk; p.slot_gate[slot] = p.tok_g[chunk * 256 + tid]; p.tok_slot[chunk * 256 + tid] = slot;
        }
        if (gridDim.x != 256)
        for (int idx0 = tid; idx0 < 256 * 128; idx0 += 8 * NT) {
            pg8::u32x4 v[8];
#pragma unroll
            for (int u = 0; u < 8; ++u) { const int idx = idx0 + u * NT, e = idx >> 7, piece = idx & 127; v[u] = ((const pg8::u32x4*)p.Xb)[(size_t)(chunk * 128 + (e >> 1)) * 128 + piece]; }
#pragma unroll
            for (int u = 0; u < 8; ++u) { const int idx = idx0 + u * NT, e = idx >> 7, piece = idx & 127; ((pg8::u32x4*)p.Xs)[(size_t)lslot[e] * 128 + piece] = v[u]; }
        }
        if (chunk < 8) {
            const int s0 = lpad[chunk] + ltot[chunk], s1 = lpad[chunk + 1];
            if (gridDim.x != 256) { unsigned z0 = 0u; asm volatile("" : "+v"(z0));
                for (int idx = tid; idx < (s1 - s0) * 128; idx += NT) ((uint4*)p.Xs)[(size_t)(s0 + (idx >> 7)) * 128 + (idx & 127)] = make_uint4(z0, z0, z0, z0); }
            for (int s = s0 + tid; s < s1; s += NT) { p.slot_tok[s] = -1; p.slot_gate[s] = 0.f; }
        }
        if (chunk == 8 && tid < NTILE256) {
            const int s0 = tid * 256; int e = -1;
            for (int q = 0; q < 8; ++q) if (s0 >= lpad[q] && s0 < lpad[q + 1]) e = q;
            p.tile_e[tid] = e;
        }
    }
}

typedef short bf16x8 __attribute__((ext_vector_type(8)));
typedef short s16x4 __attribute__((ext_vector_type(4)));
typedef __attribute__((address_space(3))) const unsigned char* lds_cptr;
__device__ __forceinline__ s16x4 vtr(lds_cptr p) { return __builtin_bit_cast(s16x4, __builtin_amdgcn_ds_read_tr16_b64_v4i16((__attribute__((address_space(3))) s16x4*)p)); }
__device__ __forceinline__ bf16x8 cat8(s16x4 lo, s16x4 hi) { bf16x8 r; r[0] = lo[0]; r[1] = lo[1]; r[2] = lo[2]; r[3] = lo[3]; r[4] = hi[0]; r[5] = hi[1]; r[6] = hi[2]; r[7] = hi[3]; return r; }
constexpr int AT_KP = 160;
template <int VD> struct AtL { static constexpr int VP = VD * 2 + 32, KB = 64 * AT_KP, VB = 64 * VP, BUF = KB + VB; };
constexpr float AT_M0 = -64.0f;
constexpr float AT_THR = 8.0f;

template <int VD> struct AtState {
    f32x4 o[2][VD / 16]; float m[2], l[2];
    __device__ __forceinline__ void init_plain() { init(); m[0] = -1e30f; m[1] = -1e30f; }
    __device__ __forceinline__ void init() {
#pragma unroll
        for (int g = 0; g < 2; ++g) { m[g] = AT_M0; l[g] = 0.f;
#pragma unroll
            for (int n = 0; n < VD / 16; ++n) o[g][n] = Z4_; }
    }
};
typedef float f32x2 __attribute__((ext_vector_type(2)));
__device__ __forceinline__ float max3f_(float a, float b, float c) { float r; asm("v_max3_f32 %0, %1, %2, %3" : "=v"(r) : "v"(a), "v"(b), "v"(c)); return r; }
__device__ __forceinline__ float max2f_(float a, float b) { float r; asm("v_max_f32_e32 %0, %1, %2" : "=v"(r) : "v"(a), "v"(b)); return r; }
__device__ __forceinline__ float xmax16(float v) { const unsigned u = __builtin_bit_cast(unsigned, v); const auto r = __builtin_amdgcn_permlane16_swap(u, u, false, false);
    return max2f_(__builtin_bit_cast(float, r[0]), __builtin_bit_cast(float, r[1])); }
__device__ __forceinline__ float xmax32(float v) { const unsigned u = __builtin_bit_cast(unsigned, v); const auto r = __builtin_amdgcn_permlane32_swap(u, u, false, false);
    return max2f_(__builtin_bit_cast(float, r[0]), __builtin_bit_cast(float, r[1])); }
template <int VD, int MODE, class RowOk, class Allow>
__device__ __forceinline__ void at_tile(AtState<VD>& st, lds_cptr Kb, lds_cptr Vb, const bf16x8 (&q)[2][2], int fr, int fq, RowOk rowok, Allow allow) {
    f32x4 s[2][4];
    f32x4 c4[2];
#pragma unroll
    for (int g = 0; g < 2; ++g) { float c = -st.m[g]; if (MODE & 1) c = rowok(g) ? c : -INFINITY; c4[g] = (f32x4){c, c, c, c}; }
    bf16x8 kn0 = *(const __attribute__((address_space(3))) bf16x8*)(Kb + fr * AT_KP + fq * 16);
    bf16x8 kn1 = *(const __attribute__((address_space(3))) bf16x8*)(Kb + fr * AT_KP + 64 + fq * 16);
    bf16x8 kp1 = kn1;
#pragma unroll
    for (int kk = 0; kk < 4; ++kk) {
        const bf16x8 kf0 = kn0, kf1 = kn1;
        if (kk < 3) { kn0 = *(const __attribute__((address_space(3))) bf16x8*)(Kb + (16 * (kk + 1) + fr) * AT_KP + fq * 16);
                      kn1 = *(const __attribute__((address_space(3))) bf16x8*)(Kb + (16 * (kk + 1) + fr) * AT_KP + 64 + fq * 16); }
#pragma unroll
        for (int g = 0; g < 2; ++g) s[g][kk] = __builtin_amdgcn_mfma_f32_16x16x32_bf16(kf0, q[g][0], c4[g], 0, 0, 0);
        if (kk > 0) {
#pragma unroll
            for (int g = 0; g < 2; ++g) s[g][kk - 1] = __builtin_amdgcn_mfma_f32_16x16x32_bf16(kp1, q[g][1], s[g][kk - 1], 0, 0, 0);
        }
        kp1 = kf1;
    }
#pragma unroll
    for (int g = 0; g < 2; ++g) s[g][3] = __builtin_amdgcn_mfma_f32_16x16x32_bf16(kp1, q[g][1], s[g][3], 0, 0, 0);
    const lds_cptr vp0 = Vb + (4 * fq + (fr >> 2)) * AtL<VD>::VP + (4 * (fr & 3)) * 2;
    bf16x8 vn = cat8(vtr(vp0), vtr(vp0 + 16 * AtL<VD>::VP));
    bf16x8 pf[2][2];
    float mloc[2]; bool need[2];
#pragma unroll
    for (int g = 0; g < 2; ++g) {
        float ml = fmaxf(fmaxf(s[g][0][0], s[g][0][1]), s[g][0][2]);
        ml = fmaxf(fmaxf(ml, s[g][0][3]), s[g][1][0]);
        ml = fmaxf(fmaxf(ml, s[g][1][1]), s[g][1][2]);
        ml = fmaxf(fmaxf(ml, s[g][1][3]), s[g][2][0]);
        ml = fmaxf(fmaxf(ml, s[g][2][1]), s[g][2][2]);
        ml = fmaxf(fmaxf(ml, s[g][2][3]), s[g][3][0]);
        ml = fmaxf(fmaxf(ml, s[g][3][1]), s[g][3][2]);
        ml = fmaxf(ml, s[g][3][3]);
        if (VD != 64) { ml = xmax16(ml); ml = xmax32(ml); }
        mloc[g] = ml;
        need[g] = ml > AT_THR;
    }
    if (__ballot(need[0] || need[1]) != 0ull) {
#pragma unroll
        for (int g = 0; g < 2; ++g) {
            const float mr = (VD != 64) ? mloc[g] : xmax32(xmax16(mloc[g]));
            const bool nd = mr > AT_THR;
            const float d = nd ? mr : 0.f;
            const float alpha = __builtin_amdgcn_exp2f(-d);
            st.m[g] += d; st.l[g] *= alpha;
#pragma unroll
            for (int n = 0; n < VD / 16; ++n) st.o[g][n] = st.o[g][n] * alpha;
#pragma unroll
            for (int kk = 0; kk < 4; ++kk) s[g][kk] = s[g][kk] - d;
        }
    }
#pragma unroll
    for (int g = 0; g < 2; ++g) {
        float ls = 0.f;
#pragma unroll
        for (int kk = 0; kk < 4; ++kk)
#pragma unroll
            for (int r = 0; r < 4; ++r) {
                float pv = __builtin_amdgcn_exp2f(s[g][kk][r]);
                if (MODE & 2) pv = allow(g, kk, r) ? pv : 0.f;
                if (MODE & 4) pv = __builtin_bit_cast(float, __builtin_bit_cast(int, pv) & allow(g, kk, r));
                s[g][kk][r] = pv; ls += pv;
            }
        st.l[g] += ls;
#pragma unroll
        for (int sp = 0; sp < 2; ++sp) {
            const unsigned w0 = pk2(s[g][2 * sp][0], s[g][2 * sp][1]), w1 = pk2(s[g][2 * sp][2], s[g][2 * sp][3]);
            const unsigned w2 = pk2(s[g][2 * sp + 1][0], s[g][2 * sp + 1][1]), w3 = pk2(s[g][2 * sp + 1][2], s[g][2 * sp + 1][3]);
            pf[g][sp] = __builtin_bit_cast(bf16x8, (pg8::u32x4){w0, w1, w2, w3});
        }
    }
    {
#pragma unroll
        for (int st_ = 0; st_ < VD / 8; ++st_) {
            const int n = st_ % (VD / 16), sp = st_ / (VD / 16);
            const bf16x8 vf = vn;
            if (st_ + 1 < VD / 8) { const int n2 = (st_ + 1) % (VD / 16), sp2 = (st_ + 1) / (VD / 16);
                const lds_cptr vp = Vb + (32 * sp2 + 4 * fq + (fr >> 2)) * AtL<VD>::VP + (n2 * 16 + 4 * (fr & 3)) * 2;
                vn = cat8(vtr(vp), vtr(vp + 16 * AtL<VD>::VP)); }
#pragma unroll
            for (int g = 0; g < 2; ++g) st.o[g][n] = __builtin_amdgcn_mfma_f32_16x16x32_bf16(vf, pf[g][sp], st.o[g][n], 0, 0, 0);
        }
    }
}
template <int VD, int MODE, class RowOk, class Allow>
__device__ __forceinline__ void at_tile_plain(AtState<VD>& st, lds_cptr Kb, lds_cptr Vb, const bf16x8 (&q)[2][2], int fr, int fq, RowOk rowok, Allow allow) {
    f32x4 s[2][4];
    bf16x8 kn0 = *(const __attribute__((address_space(3))) bf16x8*)(Kb + fr * AT_KP + fq * 16);
    bf16x8 kn1 = *(const __attribute__((address_space(3))) bf16x8*)(Kb + fr * AT_KP + 64 + fq * 16);
    bf16x8 kp1 = kn1;
#pragma unroll
    for (int kk = 0; kk < 4; ++kk) {
        const bf16x8 kf0 = kn0, kf1 = kn1;
        if (kk < 3) { kn0 = *(const __attribute__((address_space(3))) bf16x8*)(Kb + (16 * (kk + 1) + fr) * AT_KP + fq * 16);
                      kn1 = *(const __attribute__((address_space(3))) bf16x8*)(Kb + (16 * (kk + 1) + fr) * AT_KP + 64 + fq * 16); }
#pragma unroll
        for (int g = 0; g < 2; ++g) s[g][kk] = __builtin_amdgcn_mfma_f32_16x16x32_bf16(kf0, q[g][0], (f32x4){0.f, 0.f, 0.f, 0.f}, 0, 0, 0);
        if (kk > 0) {
#pragma unroll
            for (int g = 0; g < 2; ++g) s[g][kk - 1] = __builtin_amdgcn_mfma_f32_16x16x32_bf16(kp1, q[g][1], s[g][kk - 1], 0, 0, 0);
        }
        kp1 = kf1;
    }
#pragma unroll
    for (int g = 0; g < 2; ++g) s[g][3] = __builtin_amdgcn_mfma_f32_16x16x32_bf16(kp1, q[g][1], s[g][3], 0, 0, 0);
    const lds_cptr vp0 = Vb + (4 * fq + (fr >> 2)) * AtL<VD>::VP + (4 * (fr & 3)) * 2;
    bf16x8 vn = cat8(vtr(vp0), vtr(vp0 + 16 * AtL<VD>::VP));
    bf16x8 pf[2][2];
#pragma unroll
    for (int g = 0; g < 2; ++g) {
        float mloc = fmaxf(fmaxf(s[g][0][0], s[g][0][1]), s[g][0][2]);
        mloc = fmaxf(fmaxf(mloc, s[g][0][3]), s[g][1][0]);
        mloc = fmaxf(fmaxf(mloc, s[g][1][1]), s[g][1][2]);
        mloc = fmaxf(fmaxf(mloc, s[g][1][3]), s[g][2][0]);
        mloc = fmaxf(fmaxf(mloc, s[g][2][1]), s[g][2][2]);
        mloc = fmaxf(fmaxf(mloc, s[g][2][3]), s[g][3][0]);
        mloc = fmaxf(fmaxf(mloc, s[g][3][1]), s[g][3][2]);
        mloc = fmaxf(mloc, s[g][3][3]);
        mloc = xmax16(mloc); mloc = xmax32(mloc);
        float mn = max2f_(st.m[g], mloc);
        float cadd;
        if (MODE & 1) { const bool ro = rowok(g); mn = ro ? mn : st.m[g]; cadd = ro ? -mn : -INFINITY; } else cadd = -mn;
        const float alpha = __builtin_amdgcn_exp2f(st.m[g] - mn);
        st.m[g] = mn;
        float ls = 0.f;
#pragma unroll
        for (int kk = 0; kk < 4; ++kk)
#pragma unroll
            for (int r = 0; r < 4; ++r) {
                float pv = __builtin_amdgcn_exp2f(s[g][kk][r] + cadd);
                if (MODE & 2) pv = allow(g, kk, r) ? pv : 0.f;
                if (MODE & 4) pv = __builtin_bit_cast(float, __builtin_bit_cast(int, pv) & allow(g, kk, r));
                s[g][kk][r] = pv; ls += pv;
            }
        st.l[g] = st.l[g] * alpha + ls;
#pragma unroll
        for (int n = 0; n < VD / 16; ++n) st.o[g][n] = st.o[g][n] * alpha;
#pragma unroll
        for (int sp = 0; sp < 2; ++sp) {
            const unsigned w0 = pk2(s[g][2 * sp][0], s[g][2 * sp][1]), w1 = pk2(s[g][2 * sp][2], s[g][2 * sp][3]);
            const unsigned w2 = pk2(s[g][2 * sp + 1][0], s[g][2 * sp + 1][1]), w3 = pk2(s[g][2 * sp + 1][2], s[g][2 * sp + 1][3]);
            pf[g][sp] = __builtin_bit_cast(bf16x8, (pg8::u32x4){w0, w1, w2, w3});
        }
    }
    {
#pragma unroll
        for (int st_ = 0; st_ < VD / 8; ++st_) {
            const int n = st_ % (VD / 16), sp = st_ / (VD / 16);
            const bf16x8 vf = vn;
            if (st_ + 1 < VD / 8) { const int n2 = (st_ + 1) % (VD / 16), sp2 = (st_ + 1) / (VD / 16);
                const lds_cptr vp = Vb + (32 * sp2 + 4 * fq + (fr >> 2)) * AtL<VD>::VP + (n2 * 16 + 4 * (fr & 3)) * 2;
                vn = cat8(vtr(vp), vtr(vp + 16 * AtL<VD>::VP)); }
#pragma unroll
            for (int g = 0; g < 2; ++g) st.o[g][n] = __builtin_amdgcn_mfma_f32_16x16x32_bf16(vf, pf[g][sp], st.o[g][n], 0, 0, 0);
        }
    }
}
struct AtNoRow { __device__ __forceinline__ bool operator()(int) const { return true; } };
struct AtNoEl { __device__ __forceinline__ bool operator()(int, int, int) const { return true; } };
template <int VD> struct AtStage {
    pg8::u32x4 k, v[VD / 64];
    __device__ __forceinline__ void load(const bf16_t* kbase, const bf16_t* vbase, int key0, int tid) {
        const int row = tid >> 3, ch = tid & 7;
        k = *(const pg8::u32x4*)(kbase + (size_t)(key0 + row) * LDPB + ch * 8);
#pragma unroll
        for (int i = 0; i < VD / 64; ++i) v[i] = *(const pg8::u32x4*)(vbase + (size_t)(key0 + row) * LDPB + (ch + 8 * i) * 8);
    }
    __device__ __forceinline__ void store(LAS unsigned char* buf, int tid) const {
        const int row = tid >> 3, ch = tid & 7;
        *(LAS pg8::u32x4*)(buf + row * AT_KP + ch * 16) = k;
#pragma unroll
        for (int i = 0; i < VD / 64; ++i) *(LAS pg8::u32x4*)(buf + AtL<VD>::KB + row * AtL<VD>::VP + (ch + 8 * i) * 16) = v[i];
    }
};
template <int VD>
__device__ __forceinline__ void at_finish(AtState<VD>& st) {
#pragma unroll
    for (int g = 0; g < 2; ++g) { float l = st.l[g]; l += __shfl_xor(l, 16); l += __shfl_xor(l, 32); st.l[g] = l; }
}


template <int VD> struct AtStageP {
    pg8::u32x4 k, v[VD / 64];
    __device__ __forceinline__ void load(const bf16_t* kbase, const bf16_t* vbase, int pitch, int key0, int tid) {
        const int row = tid >> 3, ch = tid & 7;
        k = *(const pg8::u32x4*)(kbase + (size_t)(key0 + row) * pitch + ch * 8);
#pragma unroll
        for (int i = 0; i < VD / 64; ++i) v[i] = *(const pg8::u32x4*)(vbase + (size_t)(key0 + row) * pitch + (ch + 8 * i) * 8);
    }
    __device__ __forceinline__ void store(LAS unsigned char* buf, int tid) const {
        const int row = tid >> 3, ch = tid & 7;
        *(LAS pg8::u32x4*)(buf + row * AT_KP + ch * 16) = k;
#pragma unroll
        for (int i = 0; i < VD / 64; ++i) *(LAS pg8::u32x4*)(buf + AtL<VD>::KB + row * AtL<VD>::VP + (ch + 8 * i) * 16) = v[i];
    }
};
template <int VD, class Fn>
__device__ __forceinline__ void at_run(LAS unsigned char* lds, const bf16_t* kbase, const bf16_t* vbase, int pitch, int tile_lo, int tile_hi, int tid, Fn fn) {
    if (tile_lo >= tile_hi) return;
    AtStageP<VD> sg; sg.load(kbase, vbase, pitch, tile_lo * 64, tid);
    __syncthreads();
    for (int i = tile_lo; i < tile_hi; ++i) {
        LAS unsigned char* buf = lds + ((i - tile_lo) & 1) * AtL<VD>::BUF;
        sg.store(buf, tid);
        __syncthreads();
        if (i + 1 < tile_hi) sg.load(kbase, vbase, pitch, (i + 1) * 64, tid);
        fn(i, (lds_cptr)buf, (lds_cptr)buf + AtL<VD>::KB);
    }
}
template <int VD, class Fn>
__device__ __forceinline__ void at_run_side(LAS unsigned char* lds, const bf16_t* kbase, const bf16_t* vbase, int pitch, int tile_lo, int tile_hi, int tid, CvJob& job, Fn fn) {
    if (tile_lo >= tile_hi) return;
    AtStageP<VD> sg; sg.load(kbase, vbase, pitch, tile_lo * 64, tid);
    __syncthreads();
    for (int i = tile_lo; i < tile_hi; ++i) {
        LAS unsigned char* buf = lds + ((i - tile_lo) & 1) * AtL<VD>::BUF;
        sg.store(buf, tid);
        __syncthreads();
        job.step(tid);
        if (i + 1 < tile_hi) sg.load(kbase, vbase, pitch, (i + 1) * 64, tid);
        fn(i, (lds_cptr)buf, (lds_cptr)buf + AtL<VD>::KB);
    }
}
template <int VD>
__device__ __forceinline__ void at_scores(f32x4 (&s)[2][4], lds_cptr Kb, const bf16x8 (&q)[2][2], int fr, int fq) {
    bf16x8 kn0 = *(const __attribute__((address_space(3))) bf16x8*)(Kb + fr * AT_KP + fq * 16);
    bf16x8 kn1 = *(const __attribute__((address_space(3))) bf16x8*)(Kb + fr * AT_KP + 64 + fq * 16);
#pragma unroll
    for (int kk = 0; kk < 4; ++kk) {
        const bf16x8 kf0 = kn0, kf1 = kn1;
        if (kk < 3) { kn0 = *(const __attribute__((address_space(3))) bf16x8*)(Kb + (16 * (kk + 1) + fr) * AT_KP + fq * 16);
                      kn1 = *(const __attribute__((address_space(3))) bf16x8*)(Kb + (16 * (kk + 1) + fr) * AT_KP + 64 + fq * 16); }
#pragma unroll
        for (int g = 0; g < 2; ++g) s[g][kk] = __builtin_amdgcn_mfma_f32_16x16x32_bf16(kf0, q[g][0], (f32x4){0.f, 0.f, 0.f, 0.f}, 0, 0, 0);
#pragma unroll
        for (int g = 0; g < 2; ++g) s[g][kk] = __builtin_amdgcn_mfma_f32_16x16x32_bf16(kf1, q[g][1], s[g][kk], 0, 0, 0);
    }
}

__device__ __forceinline__ void ph_diff_mfma(const Params& p, LAS unsigned char* lds, int li) {
    const int tid = tid_(), lane = tid & 63, w = tid >> 6, fr = lane & 15, fq = lane >> 4;
    const int G = gridDim.x, c = blockIdx.x;
    const float* lp = p.in[IN_DIF_LAMBDA] + li * 256;
    const float d01 = wave_sum(lp[lane] * lp[64 + lane]), d23 = wave_sum(lp[128 + lane] * lp[192 + lane]);
    const float lam_init = li ? p.lam_init[1] : p.lam_init[0];
    const float lam = expf(d01) - expf(d23) + lam_init;
    const float* subln = p.in[IN_DIF_SUBLN] + li * 128;
    LAS unsigned* oal = (LAS unsigned*)(lds + 2 * AtL<128>::BUF) + w * 2048 + lane;
    for (int L = c; L < 512; L += G) {
        int qb, b, h;
        if (G == 256) { const int rnd = L >> 8, x = c & 7, j = c >> 3; b = x; h = j >> 3; qb = rnd ? 15 - (j & 7) : (j & 7); }
        else { const int rnd = L / G; const int u = ((rnd & 1) && (512 % G == 0)) ? rnd * G + (G - 1 - (L - rnd * G)) : L; qb = u & 15; h = (u >> 4) & 3; b = u >> 6; }
        const bf16_t* vbase = p.Pb + (size_t)b * SEQ * LDPB + E_AV + h * 128;
        const int t0 = qb * 256 + w * 32;
#pragma unroll 1
        for (int jm = 0; jm < 2; ++jm) {
            const int hj = 2 * h + jm;
            const bf16_t* kbase = p.Pb + (size_t)b * SEQ * LDPB + E_AK + hj * 64;
            bf16x8 q[2][2];
#pragma unroll
            for (int g = 0; g < 2; ++g)
#pragma unroll
                for (int ks = 0; ks < 2; ++ks) q[g][ks] = *(const bf16x8*)(p.Pb + (size_t)(b * SEQ + t0 + g * 16 + fr) * LDPB + E_AQ + hj * 64 + ks * 32 + fq * 8);
            AtState<128> st; st.init();
            at_run<128>(lds, kbase, vbase, LDPB, 0, 4 * qb + 4, tid, [&](int i, lds_cptr Kb, lds_cptr Vb) {
                const int key0 = i * 64;
                if (key0 <= t0 + 31) {
                    if (key0 + 63 <= t0) at_tile<128, 0>(st, Kb, Vb, q, fr, fq, AtNoRow(), AtNoEl());
                    else { const int tq0 = t0 + fr - key0 - 4 * fq; at_tile<128, 2>(st, Kb, Vb, q, fr, fq, AtNoRow(), [=](int g, int kk, int r) { return 16 * kk + r <= tq0 + g * 16; }); }
                }
            });
            at_finish(st);
            if (jm == 0) {
#pragma unroll
                for (int g = 0; g < 2; ++g) { const float inv = 1.f / st.l[g];
#pragma unroll
                    for (int n = 0; n < 8; ++n) { const f32x4 o = st.o[g][n] * inv; oal[((g * 8 + n) * 2) * 64] = pk2(o[0], o[1]); oal[((g * 8 + n) * 2 + 1) * 64] = pk2(o[2], o[3]); } }
            } else {
#pragma unroll
                for (int g = 0; g < 2; ++g) { const float inv = 1.f / st.l[g];
                    float ss = 0.f;
#pragma unroll
                    for (int n = 0; n < 8; ++n) {
                        const f32x4 ob = st.o[g][n] * inv;
                        const unsigned b01 = pk2(ob[0], ob[1]), b23 = pk2(ob[2], ob[3]);
                        const unsigned a01 = oal[((g * 8 + n) * 2) * 64], a23 = oal[((g * 8 + n) * 2 + 1) * 64];
                        f32x4 r;
                        r[0] = __builtin_bit_cast(float, a01 << 16) - lam * __builtin_bit_cast(float, b01 << 16);
                        r[1] = __builtin_bit_cast(float, a01 & 0xffff0000u) - lam * __builtin_bit_cast(float, b01 & 0xffff0000u);
                        r[2] = __builtin_bit_cast(float, a23 << 16) - lam * __builtin_bit_cast(float, b23 << 16);
                        r[3] = __builtin_bit_cast(float, a23 & 0xffff0000u) - lam * __builtin_bit_cast(float, b23 & 0xffff0000u);
                        st.o[g][n] = r;
                        ss += (r[0] * r[0] + r[1] * r[1]) + (r[2] * r[2] + r[3] * r[3]);
                    }
                    ss += __shfl_xor(ss, 16); ss += __shfl_xor(ss, 32);
                    const float sc = (1.0f / sqrtf(ss * (1.f / 128.f) + LN_EPS)) * (1.f - lam_init);
                    bf16_t* dst = p.Ob + (size_t)(b * SEQ + t0 + g * 16 + fr) * DM + h * 128 + 4 * fq;
                    float4 swv[8];
#pragma unroll
                    for (int n = 0; n < 8; ++n) swv[n] = *(const float4*)(subln + n * 16 + 4 * fq);
#pragma unroll
                    for (int n = 0; n < 8; ++n) { const float4 sw = swv[n]; const f32x4 r = st.o[g][n];
                        u32x2 wv; wv.x = pk2(r[0] * sc * sw.x, r[1] * sc * sw.y); wv.y = pk2(r[2] * sc * sw.z, r[3] * sc * sw.w); *(u32x2*)(dst + n * 16) = wv; }
                }
            }
        }
    }
}

__device__ __forceinline__ float quad_xor1(float x) { return __builtin_bit_cast(float, __builtin_amdgcn_update_dpp(0, __builtin_bit_cast(int, x), 0xB1, 0xf, 0xf, false)); }
__device__ __forceinline__ float quad_xor2(float x) { return __builtin_bit_cast(float, __builtin_amdgcn_update_dpp(0, __builtin_bit_cast(int, x), 0x4E, 0xf, 0xf, false)); }
__device__ __forceinline__ void ph_moba_mfma(const Params& p, LAS unsigned char* lds, int li) {
    const int tid = tid_(), lane = tid & 63, w = tid >> 6, fr = lane & 15, fq = lane >> 4;
    CvJob job; job.init(p, li, (float*)((unsigned char*)lds + 65536), tid);
    const int G = gridDim.x, c = blockIdx.x;
    LAS unsigned* lmask = (LAS unsigned*)(lds + 40960);
#define MB_E(k, isb, qbv) ((unsigned long long)(((isb) << 4) | (qbv)) << (5 * (k)))
    unsigned long long code = 0ull; int nun = 0, sA = 0, sB = 0;
    if (G == 256) {
        if (c < 32) { sA = c; nun = 3; code = MB_E(0, 0, 15) | MB_E(1, 0, 8) | MB_E(2, 0, 1); }
        else {
            const int c2 = c - 32, pidx = c2 / 7, grp = c2 - pidx * 7; sA = pidx; sB = pidx + 32;
            if (grp == 0) { nun = 3; code = MB_E(0, 1, 15) | MB_E(1, 1, 14) | MB_E(2, 0, 4); }
            else if (grp == 1) { nun = 3; code = MB_E(0, 0, 14) | MB_E(1, 0, 13) | MB_E(2, 1, 6); }
            else if (grp == 2) { nun = 3; code = MB_E(0, 1, 13) | MB_E(1, 1, 12) | MB_E(2, 1, 8); }
            else if (grp == 3) { nun = 3; code = MB_E(0, 0, 12) | MB_E(1, 0, 11) | MB_E(2, 0, 10); }
            else if (grp == 4) { nun = 4; code = MB_E(0, 1, 11) | MB_E(1, 1, 10) | MB_E(2, 0, 7) | MB_E(3, 0, 3); }
            else if (grp == 5) { nun = 4; code = MB_E(0, 0, 9) | MB_E(1, 1, 9) | MB_E(2, 1, 7) | MB_E(3, 0, 6); }
            else { nun = 9; code = MB_E(0, 0, 5) | MB_E(1, 1, 5) | MB_E(2, 1, 4) | MB_E(3, 1, 3) | MB_E(4, 0, 2) | MB_E(5, 1, 2) | MB_E(6, 1, 1) | MB_E(7, 0, 0) | MB_E(8, 1, 0); }
        }
    } else nun = (c < 1024) ? (1024 - c + G - 1) / G : 0;
#undef MB_E
    for (int ui = 0; ui < nun; ++ui) {
        int qb, stream;
        if (G == 256) { const int e = (int)(code >> (5 * ui)) & 31; stream = (e & 16) ? sB : sA; qb = e & 15; }
        else { const int L = c + ui * G; const int rnd = L / G; const int u = ((rnd & 1) && (1024 % G == 0)) ? rnd * G + (G - 1 - (L - rnd * G)) : L; qb = u & 15; stream = u >> 4; }
        const int h = stream & 7, b = stream >> 3;
        const bf16_t* kbase = p.Pb + (size_t)b * SEQ * LDPB + O_CK + h * 64;
        const bf16_t* vbase = p.Pb + (size_t)b * SEQ * LDPB + O_CV + h * 64;
        const int t0 = qb * 256 + w * 32;
        bf16x8 q[2][2];
#pragma unroll
        for (int g = 0; g < 2; ++g)
#pragma unroll
            for (int ks = 0; ks < 2; ++ks) q[g][ks] = *(const bf16x8*)(p.Pb + (size_t)(b * SEQ + t0 + g * 16 + fr) * LDPB + O_CQ + h * 64 + ks * 32 + fq * 8);
        unsigned msk[2];
        {
            bf16x8 kmf[2];
#pragma unroll
            for (int ks = 0; ks < 2; ++ks) { const float* km = p.kmean + (size_t)((b * 16 + fr) * 8 + h) * 64 + ks * 32 + fq * 8;
                const float4 a0 = *(const float4*)km, a1 = *(const float4*)(km + 4);
                kmf[ks] = __builtin_bit_cast(bf16x8, (pg8::u32x4){pk2(a0.x, a0.y), pk2(a0.z, a0.w), pk2(a1.x, a1.y), pk2(a1.z, a1.w)}); }
            LAS float* lg = (LAS float*)(lds + 40960) + w * 512;
#pragma unroll
            for (int g = 0; g < 2; ++g) {
                f32x4 gs = Z4_;
                gs = __builtin_amdgcn_mfma_f32_16x16x32_bf16(kmf[0], q[g][0], gs, 0, 0, 0);
                gs = __builtin_amdgcn_mfma_f32_16x16x32_bf16(kmf[1], q[g][1], gs, 0, 0, 0);
                *(LAS f32x4*)(lg + (g * 16 + fr) * 16 + 4 * fq) = gs;
            }
#pragma unroll
            for (int g = 0; g < 2; ++g) {
                float gv[16];
#pragma unroll
                for (int c4 = 0; c4 < 4; ++c4) { const f32x4 t4 = *(const LAS f32x4*)(lg + (g * 16 + fr) * 16 + 4 * c4);
#pragma unroll
                    for (int e = 0; e < 4; ++e) gv[4 * c4 + e] = (4 * c4 + e < qb) ? t4[e] : -INFINITY; }
                unsigned m = 0u;
#pragma unroll
                for (int pick = 0; pick < 3; ++pick) {
                    float best = -INFINITY; int bi = -1;
#pragma unroll
                    for (int n = 0; n < 16; ++n) if (gv[n] > best) { best = gv[n]; bi = n; }
                    if (bi >= 0) m |= 1u << bi;
#pragma unroll
                    for (int n = 0; n < 16; ++n) gv[n] = (n == bi) ? -INFINITY : gv[n];
                }
                msk[g] = m;
            }
        }
        AtState<64> st; st.init();
        at_run_side<64>(lds, kbase, vbase, LDPB, 0, 4 * qb + 4, tid, job, [&](int i, lds_cptr Kb, lds_cptr Vb) {
            const int n = i >> 2, key0 = i * 64;
            if (n < qb) {
                const bool b0 = (msk[0] >> n) & 1u, b1 = (msk[1] >> n) & 1u;
                at_tile<64, 1>(st, Kb, Vb, q, fr, fq, [=](int g) { return g ? b1 : b0; }, AtNoEl());
            } else if (key0 <= t0 + 31) {
                const int tq0 = t0 + fr - key0 - 4 * fq;
                if (key0 + 63 <= t0) at_tile<64, 0>(st, Kb, Vb, q, fr, fq, AtNoRow(), AtNoEl());
                else at_tile<64, 2>(st, Kb, Vb, q, fr, fq, AtNoRow(), [=](int g, int kk, int r) { return 16 * kk + r <= tq0 + g * 16; });
            }
        });
        at_finish(st);
#pragma unroll
        for (int g = 0; g < 2; ++g) { const float inv = 1.f / st.l[g]; bf16_t* dst = p.Ob + (size_t)(b * SEQ + t0 + g * 16 + fr) * DM + h * 64 + 4 * fq;
#pragma unroll
            for (int n = 0; n < 4; ++n) { const f32x4 o = st.o[g][n] * inv; u32x2 wv; wv.x = pk2(o[0], o[1]); wv.y = pk2(o[2], o[3]); *(u32x2*)(dst + n * 16) = wv; } }
    }
    job.finish(tid);
}

__device__ __forceinline__ void ph_nsa_mfma(const Params& p, LAS unsigned char* lds, const bf16_t* cmpkb, const bf16_t* cmpvb) {
    const int tid = tid_(), lane = tid & 63, w = tid >> 6, fr = lane & 15, fq = lane >> 4;
    const int G = gridDim.x, c = blockIdx.x;
    LAS float* impA = (LAS float*)(lds + 40960) + w * 1024;
    LAS float* impB = impA + 512;
    LAS unsigned long long* selm = (LAS unsigned long long*)(lds + 73728) + w * 8;
    static_assert(2 * AtL<64>::BUF <= 40960, "NSA LDS map");
    for (int L = c; L < 1024; L += G) {
        int qb, stream;
        if (G == 256) { const int rnd = L >> 8, x = c & 7, j = c >> 3;
            stream = 2 * x + (rnd >> 1); qb = (rnd & 1) ? 63 - j : j; }
        else { const int rnd = L / G; const int u = ((rnd & 1) && (1024 % G == 0)) ? rnd * G + (G - 1 - (L - rnd * G)) : L; qb = u & 63; stream = u >> 6; }
        const int grp = stream & 1, b = stream >> 1;
        const int tw = qb * 64 + w * 8;
#define TQ(g) (tw + (g) * 4 + (fr >> 2))
#define TOKG(g) (b * SEQ + TQ(g))
        bf16x8 qraw[2][2];
#pragma unroll
        for (int g = 0; g < 2; ++g) {
            const int head = grp * 4 + (fr & 3);
#pragma unroll
            for (int ks = 0; ks < 2; ++ks) qraw[g][ks] = *(const bf16x8*)(p.Pb + (size_t)TOKG(g) * LDPB + O_DQ + head * 64 + ks * 32 + fq * 8);
        }
        LAS float* accl = (LAS float*)(lds + 75776) + w * 2048 + lane;
        const bf16_t* ck = cmpkb + (size_t)(b * 2 + grp) * 256 * 64; const bf16_t* cv = cmpvb + (size_t)(b * 2 + grp) * 256 * 64;
        int nv[2];
#pragma unroll
        for (int g = 0; g < 2; ++g) nv[g] = (TQ(g) >= 31) ? ((TQ(g) - 31) >> 4) + 1 : 0;
        const int nvmax_w = (tw + 7 >= 31) ? ((tw + 7 - 31) >> 4) + 1 : 0;
        const int nvmax_b = (qb * 64 + 63 >= 31) ? ((qb * 64 + 63 - 31) >> 4) + 1 : 0;
        const int ncmp_tiles = (nvmax_b + 63) >> 6;
        float mfin[2], linv[2];
        {
            AtState<64> st; st.init();
            at_run<64>(lds, ck, cv, 64, 0, ncmp_tiles, tid, [&](int i, lds_cptr Kb, lds_cptr Vb) {
                if (i * 64 < nvmax_w) { const int n0 = nv[0] - i * 64, n1 = nv[1] - i * 64;
                    at_tile<64, 2>(st, Kb, Vb, qraw, fr, fq, AtNoRow(), [=](int g, int kk, int r) { return 16 * kk + 4 * fq + r < (g ? n1 : n0); }); }
            });
            at_finish(st);
#pragma unroll
            for (int g = 0; g < 2; ++g) { mfin[g] = st.m[g]; linv[g] = st.l[g] > 0.f ? 1.f / st.l[g] : 0.f;
#pragma unroll
                for (int n = 0; n < 4; ++n) { const f32x4 o = st.o[g][n] * (linv[g] * p.GATES[(size_t)TOKG(g) * 24 + (grp * 4 + (fr & 3)) * 3]);
#pragma unroll
                    for (int r = 0; r < 4; ++r) accl[((g * 4 + n) * 4 + r) * 64] = o[r]; } }
        }
        for (int e = lane; e < 512; e += 64) { impA[e] = 0.f; impB[e] = 0.f; }
        at_run<64>(lds, ck, cv, 64, 0, ncmp_tiles, tid, [&](int i, lds_cptr Kb, lds_cptr) {
            if (i * 64 < nvmax_w) {
                f32x4 s[2][4]; at_scores<64>(s, Kb, qraw, fr, fq);
#pragma unroll
                for (int g = 0; g < 2; ++g)
#pragma unroll
                    for (int kk = 0; kk < 4; ++kk) {
                        float a = 0.f, last = 0.f;
#pragma unroll
                        for (int r = 0; r < 4; ++r) { const int n = i * 64 + 16 * kk + 4 * fq + r;
                            const float pv = (n < nv[g]) ? __builtin_amdgcn_exp2f(s[g][kk][r] - mfin[g]) * linv[g] : 0.f; a += pv; last = pv; }
                        a += quad_xor1(a); a += quad_xor2(a); last += quad_xor1(last); last += quad_xor2(last);
                        const int j = 16 * i + 4 * kk + fq, qi = g * 4 + (fr >> 2);
                        if ((fr & 3) == 0) { impA[qi * 64 + j] = a; if (j + 1 < 64) impB[qi * 64 + j + 1] = last; }
                    }
            }
        });
        {
            unsigned key[8], T[8];
#pragma unroll
            for (int qi = 0; qi < 8; ++qi) {
                const float imp = impA[qi * 64 + lane] + impB[qi * 64 + lane];
                const bool causal = lane <= qb, forced = (lane == 0) || (lane >= qb - 1 && causal);
                const float val = forced ? 1e30f : (causal ? imp : -1e30f);
                const unsigned u = __builtin_bit_cast(unsigned, val);
                key[qi] = (u & 0x80000000u) ? ~u : (u | 0x80000000u); T[qi] = 0u;
            }
#pragma nounroll
            for (int bit = 31; bit >= 0; --bit) {
#pragma unroll
                for (int qi = 0; qi < 8; ++qi) { const unsigned cand = T[qi] | (1u << bit); if (__popcll(__ballot(key[qi] >= cand)) >= 16) T[qi] = cand; }
            }
#pragma unroll
            for (int qi = 0; qi < 8; ++qi) {
                const bool gt = key[qi] > T[qi], eq = key[qi] == T[qi];
                const unsigned long long meq = __ballot(eq);
                const int need = 16 - __popcll(__ballot(gt));
                const unsigned long long mk = __ballot(gt || (eq && lane_rank(meq) < need));
                if (lane == 0) selm[qi] = mk;
            }
        }
        unsigned long long sm[2];
#pragma unroll
        for (int g = 0; g < 2; ++g) sm[g] = selm[g * 4 + (fr >> 2)];
        bf16x8 qrot[2][2];
#pragma unroll
        for (int g = 0; g < 2; ++g)
#pragma unroll
            for (int ks = 0; ks < 2; ++ks) qrot[g][ks] = *(const bf16x8*)(p.QRb + (size_t)TOKG(g) * 512 + (grp * 4 + (fr & 3)) * 64 + ks * 32 + fq * 8);
        {
            const bf16_t* kb = p.Pb + (size_t)b * SEQ * LDPB + O_KS + grp * 64; const bf16_t* vb = p.Pb + (size_t)b * SEQ * LDPB + O_VS + grp * 64;
            AtState<64> st; st.init();
            at_run<64>(lds, kb, vb, LDPB, 0, qb + 1, tid, [&](int i, lds_cptr Kb, lds_cptr Vb) {
                const bool b0 = (sm[0] >> i) & 1ull, b1 = (sm[1] >> i) & 1ull;
                { const int d0 = TQ(0) - i * 64, d1 = TQ(1) - i * 64;
                    if (i < qb) at_tile<64, 1>(st, Kb, Vb, qrot, fr, fq, [=](int g) { return g ? b1 : b0; }, AtNoEl());
                    else at_tile<64, 3>(st, Kb, Vb, qrot, fr, fq, [=](int g) { return g ? b1 : b0; }, [=](int g, int kk, int r) { return 16 * kk + 4 * fq + r <= (g ? d1 : d0); }); }
            });
            at_finish(st);
#pragma unroll
            for (int g = 0; g < 2; ++g) { const float sc = p.GATES[(size_t)TOKG(g) * 24 + (grp * 4 + (fr & 3)) * 3 + 1] / st.l[g];
#pragma unroll
                for (int n = 0; n < 4; ++n)
#pragma unroll
                    for (int r = 0; r < 4; ++r) accl[((g * 4 + n) * 4 + r) * 64] += st.o[g][n][r] * sc; }
        }
        {
            const bf16_t* kb = p.Pb + (size_t)b * SEQ * LDPB + O_KW + grp * 64; const bf16_t* vb = p.Pb + (size_t)b * SEQ * LDPB + O_VW + grp * 64;
            AtState<64> st; st.init();
            at_run<64>(lds, kb, vb, LDPB, (qb >= 8 ? qb - 8 : 0), qb + 1, tid, [&](int i, lds_cptr Kb, lds_cptr Vb) {
                const int d0 = TQ(0) - i * 64 - 4 * fq, d1 = TQ(1) - i * 64 - 4 * fq;
                if (i == qb || (qb >= 8 && i == qb - 8)) {
                    const int hi0 = (i == qb) ? d0 : 64, hi1 = (i == qb) ? d1 : 64, lo0 = (i == qb) ? -1 : d0 - 512, lo1 = (i == qb) ? -1 : d1 - 512;
                    at_tile<64, 2>(st, Kb, Vb, qrot, fr, fq, AtNoRow(), [=](int g, int kk, int r) { const int kx = 16 * kk + r; return kx <= (g ? hi1 : hi0) && kx > (g ? lo1 : lo0); });
                } else at_tile<64, 0>(st, Kb, Vb, qrot, fr, fq, AtNoRow(), AtNoEl());
            });
            at_finish(st);
#pragma unroll
            for (int g = 0; g < 2; ++g) { const float sc = p.GATES[(size_t)TOKG(g) * 24 + (grp * 4 + (fr & 3)) * 3 + 2] / st.l[g];
                bf16_t* dst = p.Ob + (size_t)TOKG(g) * DM + 512 + (grp * 4 + (fr & 3)) * 64 + 4 * fq;
#pragma unroll
                for (int n = 0; n < 4; ++n) { f32x4 o;
#pragma unroll
                    for (int r = 0; r < 4; ++r) o[r] = accl[((g * 4 + n) * 4 + r) * 64] + st.o[g][n][r] * sc;
                    u32x2 wv; wv.x = pk2(o[0], o[1]); wv.y = pk2(o[2], o[3]); *(u32x2*)(dst + n * 16) = wv; } }
        }
    }
#undef TQ
#undef TOKG
}

__device__ __forceinline__ unsigned pk_cnt_gt(unsigned acc, unsigned h, unsigned cm1, unsigned one2) {
    unsigned d;
    asm("v_pk_sub_u16 %0, %1, %2 clamp" : "=v"(d) : "v"(h), "v"(cm1));
    asm("v_pk_min_u16 %0, %1, %2" : "=v"(d) : "v"(d), "v"(one2));
    asm("v_pk_add_u16 %0, %1, %2" : "=v"(acc) : "v"(acc), "v"(d));
    return acc;
}
__device__ __forceinline__ int wave_total(int c) {
    int tot = 0;
#pragma unroll
    for (int bb = 0; bb < 7; ++bb) tot += __popcll(__ballot((c >> bb) & 1)) << bb;
    return tot;
}
#define SEL_CHUNKS(BODY) do { \
    _Pragma("unroll") for (int i = 0; i < 16; ++i) BODY(i) \
    if (tl >= 16) { _Pragma("unroll") for (int i = 16; i < 32; ++i) BODY(i) \
        if (tl >= 32) { _Pragma("unroll") for (int i = 32; i < 48; ++i) BODY(i) \
            if (tl >= 48) { _Pragma("unroll") for (int i = 48; i < 64; ++i) BODY(i) } } } } while (0)
__device__ __forceinline__ void ph_dsa_select(const Params& p, LAS unsigned char* lds, unsigned long long* BM) {
    const int tid = tid_(), lane = tid & 63, w = tid >> 6, fr = lane & 15, fq = lane >> 4;
    const int G = gridDim.x, c = blockIdx.x;
    LAS unsigned* sc = (LAS unsigned*)lds;
#define SEL_UNIT(LL, B, T0) do { if (G == 256) { const int rnd_ = (LL) >> 8, x_ = c & 7, j_ = c >> 3, idx_ = (rnd_ >> 1) * 32 + j_; B = x_; T0 = ((rnd_ & 1) ? (511 - idx_) : idx_) * 8; } \
        else { B = (LL) >> 9; T0 = ((LL) & 511) * 8; } } while (0)
#define SEL_LOADQ(B, T0) do { _Pragma("unroll") for (int g = 0; g < 2; ++g) { const size_t tokq_ = (size_t)(B) * SEQ + (T0) + g * 4 + (fr >> 2); \
        _Pragma("unroll") for (int ks = 0; ks < 2; ++ks) iq[g][ks] = *(const bf16x8*)(p.Pb + tokq_ * LDPB + E_IQ + (fr & 3) * 64 + ks * 32 + fq * 8); \
        iwv[g] = *(const float4*)(p.IW + ((size_t)(B) * SEQ + (T0) + g * 4 + fq) * 4); } } while (0)
#define SEL_LOADK(B, NSUB, SUB0, J0, J1) do { _Pragma("unroll") for (int j = J0; j < J1; ++j) { const int sub_ = ((SUB0) + 8 * j < (NSUB)) ? (SUB0) + 8 * j : (SUB0); \
        const bf16_t* kr_ = p.Pb + (size_t)((B) * SEQ + sub_ * 16 + fr) * LDPB + E_IK + fq * 8; \
        kf[j][0] = *(const bf16x8*)kr_; kf[j][1] = *(const bf16x8*)(kr_ + 32); } } while (0)
    bf16x8 iq[2][2]; float4 iwv[2]; bf16x8 kf[8][2];
    bool have = false;
    for (int L = c; L < 4096; L += G) {
        int b, t0; SEL_UNIT(L, b, t0);
        const int t = t0 + w; const size_t tok = (size_t)b * SEQ + t; const int ntile = (t >> 6) + 1;
        if (t0 + 7 < 256) {
            const int rem = t - lane * 64;
            const unsigned long long wd = (rem >= 63) ? ~0ull : (rem >= 0 ? ((1ull << (rem + 1)) - 1ull) : 0ull);
            if (lane < ntile) BM[tok * 64 + lane] = wd;
            continue;
        }
        const int nsub = (t0 + 8 + 15) >> 4;
        if (!have) { SEL_LOADQ(b, t0); SEL_LOADK(b, nsub, w, 0, 2); }
        have = false;
        SEL_LOADK(b, nsub, w, 2, 8);
        __syncthreads();
        for (int sub0 = w; sub0 < nsub; sub0 += 64) {
#pragma unroll
            for (int j = 0; j < 8; ++j) {
                const int sub = sub0 + 8 * j;
                if (sub < nsub) {
#pragma unroll
                    for (int g = 0; g < 2; ++g) {
                        f32x4 s = Z4_;
                        s = __builtin_amdgcn_mfma_f32_16x16x32_bf16(iq[g][0], kf[j][0], s, 0, 0, 0);
                        s = __builtin_amdgcn_mfma_f32_16x16x32_bf16(iq[g][1], kf[j][1], s, 0, 0, 0);
                        const int q = g * 4 + fq, key = sub * 16 + fr;
                        const float v = (iwv[g].x * fmaxf(s[0], 0.f) + iwv[g].y * fmaxf(s[1], 0.f)) + (iwv[g].z * fmaxf(s[2], 0.f) + iwv[g].w * fmaxf(s[3], 0.f));
                        const unsigned u = __builtin_bit_cast(unsigned, v);
                        const unsigned ks2 = (u & 0x80000000u) ? ~u : (u | 0x80000000u);
                        sc[q * 4096 + key] = (key <= t0 + q) ? ks2 : 0u;
                    }
                }
            }
            if (sub0 + 64 < nsub) SEL_LOADK(b, nsub, sub0 + 64, 0, 8);
        }
        __syncthreads();
        unsigned long long myword = 0ull;
        {
            const int tl = __builtin_amdgcn_readfirstlane(t >> 6);
            unsigned kreg[64];
#pragma unroll
            for (int i = 0; i < 64; ++i) kreg[i] = sc[w * 4096 + i * 64 + lane];
            __builtin_amdgcn_sched_barrier(0);
#pragma unroll
            for (int i = 0; i < 64; ++i) kreg[i] = (i * 64 + lane <= t) ? kreg[i] : 0u;
            unsigned T = 0u; bool exact = false; int need = 0;
            {
                LAS unsigned* hist = (LAS unsigned*)(lds + 131072) + w * 256;
                unsigned prefix = 0u, pmask = 0u; int remaining = 256;
                {
                    unsigned T8 = 0u; int acc_tot = t + 1, above = 0;
#pragma nounroll
                    for (int bit = 7; bit >= 0; --bit) {
                        const unsigned cand = (T8 | (1u << bit)) << 24;
                        int cnt = 0;
#define SEL_CNT(i) { cnt += (kreg[i] >= cand) ? 1 : 0; }
                        SEL_CHUNKS(SEL_CNT);
#undef SEL_CNT
                        const int tot = wave_total(cnt);
                        if (tot >= 256) { T8 |= 1u << bit; acc_tot = tot; } else above = tot;
                    }
                    remaining = 256 - above; prefix = T8 << 24; pmask = 0xff000000u;
                    exact = (acc_tot - above == remaining);
                }
                if (!exact) for (int pass = 1; pass < 4; ++pass) {
                    const int shift = 24 - 8 * pass;
#pragma unroll
                    for (int j = 0; j < 4; ++j) hist[lane + 64 * j] = 0u;
#define SEL_HIST(i) { const unsigned k = kreg[i]; if ((k & pmask) == prefix && k != 0u) __hip_atomic_fetch_add(&hist[(k >> shift) & 255u], 1u, __ATOMIC_RELAXED, __HIP_MEMORY_SCOPE_WORKGROUP); }
                    SEL_CHUNKS(SEL_HIST);
#undef SEL_HIST
                    unsigned cj[4]; unsigned sl = 0u;
#pragma unroll
                    for (int j = 0; j < 4; ++j) { cj[j] = hist[255 - 4 * lane - j]; sl += cj[j]; }
                    unsigned incl = 0u;
#pragma unroll
                    for (int bb = 0; bb < 13; ++bb) { const unsigned long long mb = __ballot((sl >> bb) & 1u); incl += (unsigned)(lane_rank(mb) + ((sl >> bb) & 1u)) << bb; }
                    const unsigned excl = incl - sl;
                    const bool cross = (excl < (unsigned)remaining) && ((unsigned)remaining <= incl);
                    unsigned dig = 0u, above = excl, cbin = 0u;
                    { unsigned accv = excl; bool found = false;
#pragma unroll
                      for (int j = 0; j < 4; ++j) { if (!found && accv + cj[j] >= (unsigned)remaining) { dig = 255u - 4u * lane - j; above = accv; cbin = cj[j]; found = true; } accv += cj[j]; } }
                    const unsigned long long mc = __ballot(cross);
                    const int src = mc ? __builtin_ctzll(mc) : 0;
                    dig = (unsigned)__builtin_amdgcn_readlane((int)dig, src); above = (unsigned)__builtin_amdgcn_readlane((int)above, src); cbin = (unsigned)__builtin_amdgcn_readlane((int)cbin, src);
                    prefix |= dig << shift; pmask |= 0xffu << shift; remaining -= (int)above;
                    if ((int)cbin == remaining) { exact = true; break; }
                }
                T = prefix; need = remaining;
            }
            if (exact) {
#define SEL_EX(i) { const unsigned long long msel = __ballot(kreg[i] >= T); if (lane == i) myword = msel; }
                SEL_CHUNKS(SEL_EX);
#undef SEL_EX
            } else {
                int taken = 0;
#define SEL_TIE(i) { const bool gt = kreg[i] > T, eq = kreg[i] == T; const unsigned long long meq = __ballot(eq); const bool sel = gt || (eq && (taken + lane_rank(meq) < need)); \
                    const unsigned long long msel = __ballot(sel); if (lane == i) myword = msel; taken += __popcll(meq); }
                SEL_CHUNKS(SEL_TIE);
#undef SEL_TIE
            }
        }
        if (lane < ntile) BM[tok * 64 + lane] = myword;
    }
#undef SEL_UNIT
#undef SEL_LOADQ
#undef SEL_LOADK
}
__device__ __forceinline__ void ph_dsa_attn(const Params& p, LAS unsigned char* lds, const unsigned long long* BM) {
    const int tid = tid_(), lane = tid & 63, w = tid >> 6, fr = lane & 15, fq = lane >> 4;
    const int G = gridDim.x, c = blockIdx.x;
    for (int L = c; L < 1024; L += G) {
        int qb, stream;
        if (G == 256) { const int rnd = L >> 8, x = c & 7, j = c >> 3;
            stream = 2 * x + (rnd >> 1); qb = (rnd & 1) ? 63 - j : j; }
        else { const int rnd = L / G; const int u = ((rnd & 1) && (1024 % G == 0)) ? rnd * G + (G - 1 - (L - rnd * G)) : L; qb = u & 63; stream = u >> 6; }
        const int grp = stream & 1, b = stream >> 1;
        const int tw = qb * 64 + w * 8, head = grp * 4 + (fr & 3);
#define TOKD(g) ((size_t)b * SEQ + tw + (g) * 4 + (fr >> 2))
        bf16x8 q[2][2];
#pragma unroll
        for (int g = 0; g < 2; ++g)
#pragma unroll
            for (int ks = 0; ks < 2; ++ks) q[g][ks] = *(const bf16x8*)(p.Pb + TOKD(g) * LDPB + E_BQ + head * 64 + ks * 32 + fq * 8);
        const bf16_t* kb = p.Pb + (size_t)b * SEQ * LDPB + E_BK + grp * 64; const bf16_t* vb = p.Pb + (size_t)b * SEQ * LDPB + E_BV + grp * 64;
        AtState<64> st; st.init();
        unsigned long long wn0 = BM[TOKD(0) * 64], wn1 = BM[TOKD(1) * 64];
        at_run<64>(lds, kb, vb, LDPB, 0, qb + 1, tid, [&](int i, lds_cptr Kb, lds_cptr Vb) {
            const unsigned long long w0 = wn0, w1 = wn1;
            if (i < qb) { wn0 = BM[TOKD(0) * 64 + i + 1]; wn1 = BM[TOKD(1) * 64 + i + 1]; }
            { const unsigned long long x0 = w0 >> (4 * fq), x1 = w1 >> (4 * fq);
                const int l0 = (int)(unsigned)x0, h0 = (int)(unsigned)(x0 >> 32), l1 = (int)(unsigned)x1, h1 = (int)(unsigned)(x1 >> 32);
                at_tile<64, 4>(st, Kb, Vb, q, fr, fq, AtNoRow(), [=](int g, int kk, int r) { const int bit = 16 * kk + r;
                    int mres; const int wsel = (bit < 32) ? (g ? l1 : l0) : (g ? h1 : h0);
                    asm("v_bfe_i32 %0, %1, %2, 1" : "=v"(mres) : "v"(wsel), "n"(bit & 31)); return mres; }); }
        });
        at_finish(st);
#pragma unroll
        for (int g = 0; g < 2; ++g) { const float inv = 1.f / st.l[g]; bf16_t* dst = p.Ob + TOKD(g) * DM + 512 + head * 64 + 4 * fq;
#pragma unroll
            for (int n = 0; n < 4; ++n) { const f32x4 o = st.o[g][n] * inv; u32x2 wv; wv.x = pk2(o[0], o[1]); wv.y = pk2(o[2], o[3]); *(u32x2*)(dst + n * 16) = wv; } }
#undef TOKD
    }
}

#define XB_TMO      128
#define XB_XCNT(j)  (256  + 64 * (j))
#define XB_XSUB(j)  (1280 + 64 * (j))
#define XB_XGEN(j)  (2304 + 64 * (j))
#define XB_TOP      3328
#define XB_TOPGEN   3392
#define XCD_BAR_WORDS 3456
#define XB_SPIN_CAP (1u << 24)
__device__ __forceinline__ unsigned xb_ld(unsigned* p)              { return __hip_atomic_load(p, __ATOMIC_RELAXED, __HIP_MEMORY_SCOPE_AGENT); }
__device__ __forceinline__ unsigned xb_add(unsigned* p, unsigned v) { return __hip_atomic_fetch_add(p, v, __ATOMIC_RELAXED, __HIP_MEMORY_SCOPE_AGENT); }
__device__ __forceinline__ unsigned xb_xcc_id() { return (unsigned)__builtin_amdgcn_s_getreg((3 << 11) | 20) & 0xFu; }
#define XB_SPIN(cond, bar) do { unsigned _sp = 0; while (cond) { __builtin_amdgcn_s_sleep(1); \
    if ((++_sp & 255u) == 0u) { if (xb_ld(&(bar)[XB_TMO])) break; if (_sp > XB_SPIN_CAP) { atomicAdd(&(bar)[XB_TMO], 1u); break; } } } } while (0)
struct XcdBarrier { unsigned* bar; unsigned x; volatile LAS unsigned* st; };
__device__ __forceinline__ XcdBarrier xcd_barrier_post(unsigned* bar, volatile LAS unsigned* st) {
    XcdBarrier b; b.bar = bar; b.x = xb_xcc_id(); b.st = st;
    if (threadIdx.x == 0) (void)xb_add(&bar[XB_XCNT(b.x)], 1u);
    return b;
}
__device__ __forceinline__ void xcd_barrier_complete(unsigned* bar, unsigned x, unsigned& nloc, unsigned& nx) {
    const unsigned G = gridDim.x * gridDim.y * gridDim.z;
    unsigned sum, cnt, mine, sp = 0u;
    for (;;) {
        sum = 0u; cnt = 0u; mine = 0u;
#pragma unroll
        for (unsigned j = 0; j < 16; ++j) { const unsigned c = xb_ld(&bar[XB_XCNT(j)]); sum += c; cnt += (c > 0u) ? 1u : 0u; mine = (j == x) ? c : mine; }
        if (sum == G) break;
        __builtin_amdgcn_s_sleep(1);
        if ((++sp & 255u) == 0u) { if (xb_ld(&bar[XB_TMO])) break; if (sp > XB_SPIN_CAP) { atomicAdd(&bar[XB_TMO], 1u); break; } }
    }
    nloc = mine > 0u ? mine : 1u; nx = cnt > 0u ? cnt : 1u;
}
__device__ __forceinline__ void xcd_barrier(unsigned* bar_in, volatile LAS unsigned* st) {
    asm volatile("s_waitcnt vmcnt(0)" ::: "memory");
    __syncthreads();
    if (threadIdx.x == 0) {
        unsigned* bar = bar_in; asm volatile("" : "+s"(bar));
        const unsigned x = xb_xcc_id();
        __builtin_amdgcn_s_waitcnt(0);
        __builtin_amdgcn_fence(__ATOMIC_ACQUIRE, "agent");
        unsigned nloc = st[0], nx = st[1];
        if (nloc == 0u) { xcd_barrier_complete(bar, x, nloc, nx); st[0] = nloc; st[1] = nx; }
        const unsigned old = xb_add(&bar[XB_XSUB(x)], 1u);
        const unsigned gen = old / nloc;
        if (old + 1u == (gen + 1u) * nloc) {
            __builtin_amdgcn_fence(__ATOMIC_RELEASE, "agent");
            asm volatile("s_waitcnt vmcnt(0)" ::: "memory");
            const unsigned og = xb_add(&bar[XB_TOP], 1u);
            const unsigned tg = og / nx;
            if (og + 1u == (tg + 1u) * nx) xb_add(&bar[XB_TOPGEN], 1u);
            else XB_SPIN(xb_ld(&bar[XB_TOPGEN]) == tg, bar);
            xb_add(&bar[XB_XGEN(x)], 1u);
            asm volatile("s_waitcnt vmcnt(0)" ::: "memory");
        } else {
            XB_SPIN(xb_ld(&bar[XB_XGEN(x)]) == gen, bar);
            asm volatile("s_waitcnt vmcnt(0)" ::: "memory");
        }
    }
    __syncthreads();
}

__global__ void __launch_bounds__(NT, 2) mega(Params p) {
    extern __shared__ __attribute__((aligned(16))) float lds[];
    PG8_LAS unsigned char* ldsL = (PG8_LAS unsigned char*)lds;
    volatile LAS unsigned* xst = (volatile LAS unsigned*)(lds + LDS_BYTES / 4);
    if (threadIdx.x == 0) { xst[0] = 0u; xst[1] = 0u; xst[2] = 0u; xst[3] = 0u; }
    __syncthreads();
    (void)xcd_barrier_post(p.bar, xst);
#define GRID_BAR() xcd_barrier(p.bar, xst)
    const int G = gridDim.x, cB = blockIdx.x;
    const float* const xin0 = p.in[IN_X];
    ph_init(p, lds);
    GRID_BAR();
    for (int l = 0; l < 4; ++l) {
        const int li = l >> 1;
        if ((l & 1) == 0) {
            {
                pg8::Gemm g{p.Xb, p.WinE + (size_t)li * NP_EVEN * DM, NTOK, NP_EVEN, DM}; pg8::StaticOrder S; S.init(NTOK, NP_EVEN, G, cB);
                EpiInEven E{p.Pb, p.IW, p.ropecs};
                pg8::gemm_phase<EpiInEven, pg8::StaticOrder, true, true>(ldsL, g, S, E);
            }
            GRID_BAR();
            ph_diff_mfma(p, (LAS unsigned char*)lds, li);
            __syncthreads();
            ph_dsa_select(p, (LAS unsigned char*)lds, p.BM);
            GRID_BAR();
            ph_dsa_attn(p, (LAS unsigned char*)lds, p.BM);
            GRID_BAR();
            {
                pg8::Gemm g{p.Ob, p.WoutE + (size_t)li * DM * DM, NTOK, DM, DM}; pg8::StaticOrder S; S.init(NTOK, DM, G, cB);
                EpiY E{(bf16_t*)p.Y};
                pg8::gemm_phase<EpiY, pg8::StaticOrder, true, true>(ldsL, g, S, E);
            }
            GRID_BAR();
        } else {
            {
                pg8::Gemm g{p.Xb, p.WinO + (size_t)li * NP_ODD * DM, NTOK, NP_ODD, DM}; pg8::StaticOrder S; S.init(NTOK, NP_ODD, G, cB);
                EpiInOdd E{p.Pb, p.QRb, p.GATES, p.ropecs, p.in[IN_NSA_GATE_B] + li * 24};
                pg8::gemm_phase<EpiInOdd, pg8::StaticOrder, true, true>(ldsL, g, S, E);
            }
            GRID_BAR();
            ph_kmean(p, lds);
            ph_cmp_build(p, li);
            GRID_BAR();
            {
                pg8::Gemm g{p.Ac, p.W1T + (size_t)li * 2 * 256 * 2048, 8192, 256, 2048}; ListOrder S{32, G, cB};
                EpiGeluH E{p.Hc};
                pg8::gemm_phase<EpiGeluH, ListOrder, true, true>(ldsL, g, S, E);
            }
            __syncthreads();
            ph_moba_mfma(p, (LAS unsigned char*)lds, li);
            GRID_BAR();
            {
                pg8::Gemm g{p.Hc, p.W2T + (size_t)li * 2 * 256 * 256, 8192, 256, 256}; ListOrder S{32, G, cB};
                EpiCmp E{p.CMP};
                pg8::gemm_phase<EpiCmp, ListOrder, true, true>(ldsL, g, S, E);
            }
            GRID_BAR();
            ph_nsa_mfma(p, (LAS unsigned char*)lds, p.CMP, p.CMP + (size_t)4096 * 64);
            GRID_BAR();
            {
                pg8::Gemm g{p.Ob, p.WoutO + (size_t)li * DM * DM, NTOK, DM, DM}; pg8::StaticOrder S; S.init(NTOK, DM, G, cB);
                EpiY E{(bf16_t*)p.Y};
                pg8::gemm_phase<EpiY, pg8::StaticOrder, true, true>(ldsL, g, S, E);
            }
            GRID_BAR();
        }
        if (l & 1) ph_ln_router(p, p.in[IN_LN_MIX_G] + l * DM, p.in[IN_LN_MIX_B] + l * DM, li, lds);
        else if (l == 0) ph_ln<0, 0>(p, p.in[IN_LN_MIX_G] + l * DM, p.in[IN_LN_MIX_B] + l * DM, xin0, p.X, p.Xb, false);
        else ph_ln<0, 1>(p, p.in[IN_LN_MIX_G] + l * DM, p.in[IN_LN_MIX_B] + l * DM, xin0, p.X, p.Xb, false);
        GRID_BAR();
        if ((l & 1) == 0) {
            {
                pg8::Gemm g{p.Xb, p.WguD + (size_t)li * 2 * F_DENSE * DM, NTOK, 2 * F_DENSE, DM}; pg8::StaticOrder S; S.init(NTOK, 2 * F_DENSE, G, cB);
                EpiGU E{p.H, F_DENSE, 2 * F_DENSE / 256, 0};
                pg8::gemm_phase<EpiGU, pg8::StaticOrder, true, true>(ldsL, g, S, E);
            }
            GRID_BAR();
            {
                pg8::Gemm g{p.H, p.WdD + (size_t)li * DM * F_DENSE, NTOK, DM, F_DENSE}; pg8::StaticOrder S; S.init(NTOK, DM, G, cB);
                EpiY E{(bf16_t*)p.Y};
                pg8::gemm_phase<EpiY, pg8::StaticOrder, true, true>(ldsL, g, S, E);
            }
            GRID_BAR();
            ph_ln<0, 1>(p, p.in[IN_LN_FFN_G] + l * DM, p.in[IN_LN_FFN_B] + l * DM, xin0, p.X, p.Xb, false);
            GRID_BAR();
        } else {
            ph_slots(p, lds);
            GRID_BAR();
            __syncthreads();
            for (int i = tid_(); i < NTILE256; i += NT) ((LAS int*)((LAS unsigned char*)lds + MOE_TE_LDS))[i] = p.tile_e[i];
            __syncthreads();
#pragma unroll 1
            for (int hf = 0; hf < 3; ++hf) {
                const int t0 = hf * 128, ntr = (hf < 2) ? 128 : NTILE256 - 256;
                if (G == 256) {
                    EpiGU E{p.Hm, F_EXPERT, 2 * F_EXPERT / 256, t0};
#pragma unroll 1
                    for (int rb = 0; rb < (hf < 2 ? 2 : 1); ++rb) {
                        pg8::Gemm g{p.Xb, p.WguM, NSLOT, 2 * F_EXPERT, DM}; MoeOrderG S{t0, ntr, 2 * F_EXPERT / 256, G, cB, rb, p.slot_tok};
                        pg8::gemm_phase<EpiGU, MoeOrderG, true, true>(ldsL, g, S, E);
                        __syncthreads();
                    }
                } else {
                    pg8::Gemm g{p.Xs, p.WguM, NSLOT, 2 * F_EXPERT, DM}; MoeOrder S{t0, ntr, 2 * F_EXPERT / 256, G, cB};
                    EpiGU E{p.Hm, F_EXPERT, 2 * F_EXPERT / 256, t0};
                    pg8::gemm_phase<EpiGU, MoeOrder, true, true>(ldsL, g, S, E);
                }
                GRID_BAR();
                if (hf < 2) {
                    pg8::Gemm g{p.Hm - (size_t)t0 * 256 * F_EXPERT, p.WdM, NSLOT, DM, F_EXPERT}; MoeOrder S{t0, ntr, DM / 256, G, cB};
                    EpiDownMoe E{p.Ys, p.slot_gate};
                    pg8::gemm_phase<EpiDownMoe, MoeOrder, true, true>(ldsL, g, S, E);
                } else {
                    pg8::Gemm g{p.Hm - (size_t)t0 * 256 * F_EXPERT, p.WdM, NSLOT, DM, MOE_KSL_K, F_EXPERT}; TailOrder S{G, cB};
                    EpiDownTail E{p.Yp, p.slot_gate};
                    pg8::gemm_phase<EpiDownTail, TailOrder, true, true>(ldsL, g, S, E);
                }
                GRID_BAR();
            }
            ph_ln<1, 1>(p, p.in[IN_LN_FFN_G] + l * DM, p.in[IN_LN_FFN_B] + l * DM, xin0, p.X, p.Xb, l == 3);
            GRID_BAR();
        }
    }
    if (xb_ld(&p.bar[XB_TMO])) { for (int i = blockIdx.x * NT + threadIdx.x; i < NTOK * DM; i += gridDim.x * NT) p.X[i] = __builtin_nanf(""); }
}

extern "C" void kernel_launch(void* const* d_in, const int* in_sizes, int n_in, void* d_out, int out_size, void* d_ws, size_t ws_size, hipStream_t stream) {
    Params p; memset(&p, 0, sizeof(p));
    for (int i = 0; i < 23; ++i) p.in[i] = (const float*)d_in[i];
    p.X = (float*)d_out;
    unsigned char* w = (unsigned char*)d_ws; size_t off = 0;
    auto take = [&](size_t bytes) { unsigned char* r = w + off; off += (bytes + 255) / 256 * 256; return r; };
    p.bar = (unsigned*)take(16384);
    p.ropecs = (float*)take(4096 * 32 * 2 * 4);
    p.IW = (float*)take((size_t)NTOK * 4 * 4);
    p.BM = (unsigned long long*)take((size_t)NTOK * 64 * 8);
    p.GATES = (float*)take((size_t)NTOK * 24 * 4);
    p.kmean = (float*)take(8 * 16 * 8 * 64 * 4);
    p.cmpk = (float*)take(8 * 256 * 2 * 64 * 4);
    p.cmpv = (float*)take(8 * 256 * 2 * 64 * 4);
    p.tok_e = (int*)take(NTOK * 2 * 4);
    p.tok_g = (float*)take(NTOK * 2 * 4);
    p.tok_slot = (int*)take(NTOK * 2 * 4);
    p.slot_tok = (int*)take(NSLOT * 4);
    p.slot_gate = (float*)take(NSLOT * 4);
    p.chunk_cnt = (int*)take(256 * 8 * 4);
    p.tile_e = (int*)take(NTILE256 * 4);
    p.W1T = (bf16_t*)take((size_t)2 * 2 * 256 * 2048 * 2);
    p.W2T = (bf16_t*)take((size_t)2 * 2 * 256 * 256 * 2);
    p.CMP = (bf16_t*)take((size_t)8192 * 64 * 2);
    p.WinE = (bf16_t*)take((size_t)2 * NP_EVEN * DM * 2);
    p.WoutE = (bf16_t*)take((size_t)2 * DM * DM * 2);
    p.WguD = (bf16_t*)take((size_t)2 * 2 * F_DENSE * DM * 2);
    p.WdD = (bf16_t*)take((size_t)2 * DM * F_DENSE * 2);
    p.WinO = (bf16_t*)take((size_t)2 * NP_ODD * DM * 2);
    p.WoutO = (bf16_t*)take((size_t)2 * DM * DM * 2);
    p.WguM = (bf16_t*)take((size_t)N_EXP * 2 * F_EXPERT * DM * 2);
    p.WdM = (bf16_t*)take((size_t)N_EXP * DM * F_EXPERT * 2);
    p.Xb = (bf16_t*)take((size_t)(NTOK + 1) * DM * 2);
    unsigned char* R = w + off;
    {   size_t o = 0; auto tk = [&](size_t bytes) { unsigned char* r = R + o; o += (bytes + 255) / 256 * 256; return r; };
        p.Pb = (bf16_t*)tk((size_t)NTOK * LDPB * 2); p.H = p.Pb;
        p.Ob = (bf16_t*)tk((size_t)NTOK * DM * 2);
        p.QRb = (bf16_t*)tk((size_t)NTOK * 512 * 2);
        p.Y = (float*)tk((size_t)NTOK * DM * 4);
        p.Ac = (bf16_t*)p.Y; p.Hc = p.Ac + (size_t)2 * 4096 * 2048; }
    {   size_t o = 0; auto tk = [&](size_t bytes) { unsigned char* r = R + o; o += (bytes + 255) / 256 * 256; return r; };
        p.Xs = (bf16_t*)tk((size_t)NSLOT * DM * 2);
        p.Hm = (bf16_t*)tk((size_t)MOE_HALF_TILES * 256 * F_EXPERT * 2);
        p.Ys = (bf16_t*)tk((size_t)NSLOT * DM * 2);
        p.Yp = p.Hm + (size_t)16 * 256 * F_EXPERT; }
    p.lam_init[0] = (float)(0.8 - 0.6 * exp(-0.3 * 0.0));
    p.lam_init[1] = (float)(0.8 - 0.6 * exp(-0.3 * 2.0));
    constexpr int kDynLds = LDS_BYTES + 16;
    static int grid = 0;
    if (!grid) {
        int dev = 0, cus = 0, per_cu = 0;
        (void)hipGetDevice(&dev);
        (void)hipDeviceGetAttribute(&cus, hipDeviceAttributeMultiprocessorCount, dev);
        (void)hipFuncSetAttribute((const void*)mega, hipFuncAttributeMaxDynamicSharedMemorySize, kDynLds);
        (void)hipOccupancyMaxActiveBlocksPerMultiprocessor(&per_cu, (const void*)mega, NT, kDynLds);
        if (cus <= 0) cus = 256;
        grid = cus;
    }
    (void)hipMemsetAsync(p.bar, 0, XCD_BAR_WORDS * sizeof(unsigned), stream);
    mega<<<grid, NT, kDynLds, stream>>>(p);
}
```
